# Optimizing an MI355X kernel written in HIP

```python
import math
import jax, jax.numpy as jnp
from jax import lax
import numpy as np

D_MODEL = 1024
BATCH = 4
SEQ = 4096
DEPTH = 2

SB_HEADS = 8
SB_HEAD_DIM = 64
D_SB = SB_HEADS * SB_HEAD_DIM
MLA_HEADS = 8
MLA_NOPE_DIM = 64
MLA_ROPE_DIM = 32
MLA_QK_DIM = MLA_NOPE_DIM + MLA_ROPE_DIM
MLA_V_DIM = 64
MLA_Q_RANK = 256
MLA_KV_RANK = 128
D_MLA_OUT = MLA_HEADS * MLA_V_DIM
ROPE_THETA = 10000.0
D_MIX = D_SB + D_MLA_OUT
D_IN = 3 * D_SB + MLA_Q_RANK + MLA_KV_RANK + MLA_ROPE_DIM
Q_BLOCK = 128
PEER_HEADS = 8
PEER_N_KEYS = 128
PEER_N_EXPERTS = PEER_N_KEYS * PEER_N_KEYS
PEER_KEY_DIM = 256
PEER_HALF = PEER_KEY_DIM // 2
PEER_TOPK = 16
TOKEN_CHUNK = 128
DEEPNORM_ALPHA = (2.0 * DEPTH) ** 0.25
DEEPNORM_BETA = (8.0 * DEPTH) ** -0.25
LN_EPS = 1e-5
RMS_EPS = 1e-6

kernel_name = "hymba_sb_mla_peer_deepnorm"


def layer_norm(x, g, b):
    xf = x.astype(jnp.float32)
    mu = jnp.mean(xf, axis=-1, keepdims=True)
    var = jnp.mean(jnp.square(xf - mu), axis=-1, keepdims=True)
    return ((xf - mu) * lax.rsqrt(var + LN_EPS) * g + b).astype(x.dtype)


def rms_norm(x, g):
    xf = x.astype(jnp.float32)
    return (xf * lax.rsqrt(jnp.mean(jnp.square(xf), axis=-1, keepdims=True) + RMS_EPS) * g).astype(x.dtype)


def apply_rope(x, cos, sin):
    half = x.shape[-1] // 2
    x1, x2 = x[..., :half], x[..., half:]
    return jnp.concatenate([x1 * cos - x2 * sin, x2 * cos + x1 * sin], axis=-1).astype(x.dtype)


def stick_breaking_attention(q, k, v):
    S, d = q.shape[2], q.shape[3]
    scale = 1.0 / math.sqrt(d)
    outs = []
    for i in range(S // Q_BLOCK):
        q0, end = i * Q_BLOCK, (i + 1) * Q_BLOCK
        z = jnp.einsum('bhqd,bhkd->bhqk', q[:, :, q0:end], k[:, :, :end]).astype(jnp.float32) * scale
        t_idx = q0 + jnp.arange(Q_BLOCK)[:, None]
        s_idx = jnp.arange(end)[None, :]
        causal = s_idx < t_idx
        log_1m = jnp.where(causal, jax.nn.log_sigmoid(-z), 0.0)
        tail = lax.cumsum(log_1m, axis=3, reverse=True) - log_1m
        w = jnp.where(causal, jnp.exp(jax.nn.log_sigmoid(z) + tail), 0.0)
        outs.append(jnp.einsum('bhqk,bhkd->bhqd', w.astype(v.dtype), v[:, :, :end]))
    return jnp.concatenate(outs, axis=2)


def causal_softmax_attention(q, k, v):
    S, d = q.shape[2], q.shape[3]
    scale = 1.0 / math.sqrt(d)
    outs = []
    for i in range(S // Q_BLOCK):
        q0, end = i * Q_BLOCK, (i + 1) * Q_BLOCK
        s = jnp.einsum('bhqd,bhkd->bhqk', q[:, :, q0:end], k[:, :, :end]).astype(jnp.float32) * scale
        causal = jnp.arange(end)[None, :] <= (q0 + jnp.arange(Q_BLOCK)[:, None])
        p = jax.nn.softmax(jnp.where(causal, s, -jnp.inf), axis=-1)
        outs.append(jnp.einsum('bhqk,bhkd->bhqd', p.astype(v.dtype), v[:, :, :end]))
    return jnp.concatenate(outs, axis=2)


def hybrid_mixer(x, w_in, g_cq, w_uq, g_ckv, w_ukv, w_o, cos, sin):
    B, S, _ = x.shape
    h = x @ w_in
    cuts = [D_SB, 2 * D_SB, 3 * D_SB, 3 * D_SB + MLA_Q_RANK, 3 * D_SB + MLA_Q_RANK + MLA_KV_RANK]
    sb_q, sb_k, sb_v, c_q, c_kv, k_r = jnp.split(h, cuts, axis=-1)

    def heads(t, n):
        return t.reshape(B, S, n, -1).transpose(0, 2, 1, 3)

    o_sb = stick_breaking_attention(heads(sb_q, SB_HEADS), heads(sb_k, SB_HEADS), heads(sb_v, SB_HEADS))
    o_sb = o_sb.transpose(0, 2, 1, 3).reshape(B, S, D_SB)

    q = (rms_norm(c_q, g_cq) @ w_uq).reshape(B, S, MLA_HEADS, MLA_QK_DIM)
    q_nope, q_rope = q[..., :MLA_NOPE_DIM], q[..., MLA_NOPE_DIM:]
    q_rope = apply_rope(q_rope, cos[:, None, :], sin[:, None, :])
    k_rope = apply_rope(k_r, cos, sin)
    kv = (rms_norm(c_kv, g_ckv) @ w_ukv).reshape(B, S, MLA_HEADS, MLA_NOPE_DIM + MLA_V_DIM)
    k_nope, v_mla = kv[..., :MLA_NOPE_DIM], kv[..., MLA_NOPE_DIM:]
    q_full = jnp.concatenate([q_nope, q_rope], axis=-1)
    k_full = jnp.concatenate([k_nope, jnp.broadcast_to(k_rope[:, :, None, :], (B, S, MLA_HEADS, MLA_ROPE_DIM))], axis=-1)
    o_mla = causal_softmax_attention(q_full.transpose(0, 2, 1, 3), k_full.transpose(0, 2, 1, 3), v_mla.transpose(0, 2, 1, 3))
    o_mla = o_mla.transpose(0, 2, 1, 3).reshape(B, S, D_MLA_OUT)

    return jnp.concatenate([o_sb, o_mla], axis=-1) @ w_o


def peer_ffn(x, w_q, sub_keys, u_tab, v_tab):
    B, S, D = x.shape
    K = PEER_TOPK
    q = (x @ w_q).reshape(B, S, PEER_HEADS, 2, PEER_HALF)
    scores = jnp.einsum('bshcd,hcnd->bshcn', q, sub_keys).astype(jnp.float32)
    s_half, i_half = lax.top_k(scores, K)
    cand = (s_half[..., 0, :, None] + s_half[..., 1, None, :]).reshape(B, S, PEER_HEADS, K * K)
    s_top, c_idx = lax.top_k(cand, K)
    e_idx = (jnp.take_along_axis(i_half[..., 0, :], c_idx // K, axis=-1) * PEER_N_KEYS
             + jnp.take_along_axis(i_half[..., 1, :], c_idx % K, axis=-1))
    gate = jax.nn.softmax(s_top, axis=-1)
    n_chunks = (B * S) // TOKEN_CHUNK
    xs = x.reshape(n_chunks, TOKEN_CHUNK, D)
    idx = e_idx.reshape(n_chunks, TOKEN_CHUNK, PEER_HEADS * K)
    gs = gate.reshape(n_chunks, TOKEN_CHUNK, PEER_HEADS * K).astype(x.dtype)

    def chunk(args):
        xc, ic, gc = args
        u = jnp.take(u_tab, ic, axis=0)
        a = gc * jax.nn.gelu(jnp.einsum('td,tkd->tk', xc, u), approximate=False)
        v = jnp.take(v_tab, ic, axis=0)
        return jnp.einsum('tk,tkd->td', a, v)

    return lax.map(chunk, (xs, idx, gs)).reshape(B, S, D)


def setup_inputs(seed: int = 0) -> dict:
    key = jax.random.key(seed)
    ks = jax.random.split(key, 16)
    f32 = jnp.float32
    nrm = lambda k, shape: jax.random.normal(k, shape, f32)
    x = nrm(ks[0], (BATCH, SEQ, D_MODEL))
    col_scale = jnp.concatenate([jnp.ones((2 * D_SB,), f32), jnp.full((D_SB,), DEEPNORM_BETA, f32),
                                 jnp.ones((D_IN - 3 * D_SB,), f32)])
    w_in = nrm(ks[1], (DEPTH, D_MODEL, D_IN)) * D_MODEL ** -0.5 * col_scale
    g_cq = 1.0 + 0.02 * nrm(ks[2], (DEPTH, MLA_Q_RANK))
    w_uq = nrm(ks[3], (DEPTH, MLA_Q_RANK, MLA_HEADS * MLA_QK_DIM)) * MLA_Q_RANK ** -0.5
    g_ckv = 1.0 + 0.02 * nrm(ks[4], (DEPTH, MLA_KV_RANK))
    kv_scale = jnp.concatenate([jnp.ones((MLA_NOPE_DIM,), f32), jnp.full((MLA_V_DIM,), DEEPNORM_BETA, f32)])
    w_ukv = (nrm(ks[5], (DEPTH, MLA_KV_RANK, MLA_HEADS, MLA_NOPE_DIM + MLA_V_DIM)) * MLA_KV_RANK ** -0.5
             * kv_scale).reshape(DEPTH, MLA_KV_RANK, MLA_HEADS * (MLA_NOPE_DIM + MLA_V_DIM))
    w_o = nrm(ks[6], (DEPTH, D_MIX, D_MODEL)) * D_MIX ** -0.5 * DEEPNORM_BETA
    ln1_g = 1.0 + 0.02 * nrm(ks[7], (DEPTH, D_MODEL))
    ln1_b = 0.02 * nrm(ks[8], (DEPTH, D_MODEL))
    peer_wq = nrm(ks[9], (DEPTH, D_MODEL, PEER_HEADS * PEER_KEY_DIM)) * D_MODEL ** -0.5
    peer_keys = nrm(ks[10], (DEPTH, PEER_HEADS, 2, PEER_N_KEYS, PEER_HALF)) * PEER_HALF ** -0.5
    peer_u = nrm(ks[11], (DEPTH, PEER_N_EXPERTS, D_MODEL)) * D_MODEL ** -0.5
    peer_v = nrm(ks[12], (DEPTH, PEER_N_EXPERTS, D_MODEL)) * DEEPNORM_BETA
    ln2_g = 1.0 + 0.02 * nrm(ks[13], (DEPTH, D_MODEL))
    ln2_b = 0.02 * nrm(ks[14], (DEPTH, D_MODEL))
    return {"x": x, "w_in": w_in, "g_cq": g_cq, "w_uq": w_uq, "g_ckv": g_ckv, "w_ukv": w_ukv,
            "w_o": w_o, "ln1_g": ln1_g, "ln1_b": ln1_b, "peer_wq": peer_wq, "peer_keys": peer_keys,
            "peer_u": peer_u, "peer_v": peer_v, "ln2_g": ln2_g, "ln2_b": ln2_b}


def reference(x, w_in, g_cq, w_uq, g_ckv, w_ukv, w_o, ln1_g, ln1_b, peer_wq, peer_keys,
              peer_u, peer_v, ln2_g, ln2_b):
    S = x.shape[1]
    pos = jnp.arange(S, dtype=jnp.float32)
    inv_freq = ROPE_THETA ** (-jnp.arange(0, MLA_ROPE_DIM, 2, dtype=jnp.float32) / MLA_ROPE_DIM)
    ang = pos[:, None] * inv_freq[None, :]
    cos, sin = jnp.cos(ang), jnp.sin(ang)
    for l in range(DEPTH):
        mix = hybrid_mixer(x, w_in[l], g_cq[l], w_uq[l], g_ckv[l], w_ukv[l], w_o[l], cos, sin)
        x = layer_norm(DEEPNORM_ALPHA * x + mix, ln1_g[l], ln1_b[l])
        ffn = peer_ffn(x, peer_wq[l], peer_keys[l], peer_u[l], peer_v[l])
        x = layer_norm(DEEPNORM_ALPHA * x + ffn, ln2_g[l], ln2_b[l])
    return x
```

```cpp
#include <hip/hip_runtime.h>
#include <math.h>
#include <stdio.h>

constexpr int DM = 1024, NB = 4, SEQ = 4096, DEPTH = 2, NTOK = NB * SEQ;
constexpr int DIN = 1952, NEXP = 16384;
constexpr float ALPHA = 1.4142135623730951f;
constexpr float LN_EPS = 1e-5f, RMS_EPS = 1e-6f;

__global__ void __launch_bounds__(256) k_gemm(const float* __restrict__ A, int lda, const float* __restrict__ B, int ldb,
                                              float* __restrict__ C, int ldc, int M, int N, int K) {
    __shared__ float As[16][65];
    __shared__ float Bs[16][64];
    const int tid = threadIdx.x, tx = tid & 15, ty = tid >> 4;
    const int m0 = blockIdx.y * 64, n0 = blockIdx.x * 64;
    float acc[4][4];
#pragma unroll
    for (int i = 0; i < 4; ++i)
#pragma unroll
        for (int j = 0; j < 4; ++j) acc[i][j] = 0.f;
    for (int k0 = 0; k0 < K; k0 += 16) {
#pragma unroll
        for (int i = 0; i < 4; ++i) { const int idx = tid + i * 256, m = idx >> 4, k = idx & 15; As[k][m] = A[(size_t)(m0 + m) * lda + k0 + k]; }
#pragma unroll
        for (int i = 0; i < 4; ++i) { const int idx = tid + i * 256, k = idx >> 6, n = idx & 63; Bs[k][n] = (n0 + n < N) ? B[(size_t)(k0 + k) * ldb + n0 + n] : 0.f; }
        __syncthreads();
#pragma unroll
        for (int k = 0; k < 16; ++k) {
            float a[4], b[4];
#pragma unroll
            for (int i = 0; i < 4; ++i) { a[i] = As[k][ty * 4 + i]; b[i] = Bs[k][tx * 4 + i]; }
#pragma unroll
            for (int i = 0; i < 4; ++i)
#pragma unroll
                for (int j = 0; j < 4; ++j) acc[i][j] += a[i] * b[j];
        }
        __syncthreads();
    }
#pragma unroll
    for (int i = 0; i < 4; ++i)
#pragma unroll
        for (int j = 0; j < 4; ++j) { const int n = n0 + tx * 4 + j; if (n < N) C[(size_t)(m0 + ty * 4 + i) * ldc + n] = acc[i][j]; }
}

__device__ __forceinline__ float wave_sum(float v) {
#pragma unroll
    for (int o = 1; o < 64; o <<= 1) v += __shfl_xor(v, o);
    return v;
}
__device__ __forceinline__ float block_sum256(float v, float* red) {
    v = wave_sum(v);
    __syncthreads();
    if ((threadIdx.x & 63) == 0) red[threadIdx.x >> 6] = v;
    __syncthreads();
    return red[0] + red[1] + red[2] + red[3];
}

__global__ void __launch_bounds__(256) k_prep(const float* __restrict__ H, const float* __restrict__ gq, const float* __restrict__ gkv,
                                              float* __restrict__ CQN, float* __restrict__ CKVN, float* __restrict__ KR) {
    __shared__ float red[4];
    const int tok = blockIdx.x, tid = threadIdx.x, pos = tok % SEQ;
    const float* h = H + (size_t)tok * DIN;
    const float cq = h[1536 + tid];
    const float ssq = block_sum256(cq * cq, red);
    CQN[(size_t)tok * 256 + tid] = cq * rsqrtf(ssq * (1.f / 256.f) + RMS_EPS) * gq[tid];
    const float ckv = tid < 128 ? h[1792 + tid] : 0.f;
    const float ssk = block_sum256(ckv * ckv, red);
    if (tid < 128) CKVN[(size_t)tok * 128 + tid] = ckv * rsqrtf(ssk * (1.f / 128.f) + RMS_EPS) * gkv[tid];
    if (tid < 16) {
        const float inv_freq = (float)pow(10000.0, -(double)tid / 16.0);
        const float ang = (float)pos * inv_freq;
        const float c = (float)cos((double)ang), s = (float)sin((double)ang);
        const float x1 = h[1920 + tid], x2 = h[1936 + tid];
        KR[(size_t)tok * 32 + tid] = x1 * c - x2 * s;
        KR[(size_t)tok * 32 + 16 + tid] = x2 * c + x1 * s;
    }
}
__global__ void __launch_bounds__(128) k_ropeq(float* __restrict__ Q) {
    const int tok = blockIdx.x, tid = threadIdx.x, hh = tid >> 4, i = tid & 15, pos = tok % SEQ;
    const float inv_freq = (float)pow(10000.0, -(double)i / 16.0);
    const float ang = (float)pos * inv_freq;
    const float c = (float)cos((double)ang), s = (float)sin((double)ang);
    float* q = Q + (size_t)tok * 768 + hh * 96 + 64;
    const float x1 = q[i], x2 = q[16 + i];
    q[i] = x1 * c - x2 * s; q[16 + i] = x2 * c + x1 * s;
}

__global__ void __launch_bounds__(64) k_sb(const float* __restrict__ H, float* __restrict__ O) {
    const int t = blockIdx.x * 64 + threadIdx.x, hh = blockIdx.y, b = blockIdx.z;
    const float* base = H + (size_t)b * SEQ * DIN;
    float q[64], o[64];
#pragma unroll
    for (int d = 0; d < 64; ++d) { q[d] = base[(size_t)t * DIN + hh * 64 + d]; o[d] = 0.f; }
    float R = 0.f;
    for (int s = t - 1; s >= 0 && R > -88.f; --s) {
        const float* kr = base + (size_t)s * DIN + 512 + hh * 64;
        const float* vr = base + (size_t)s * DIN + 1024 + hh * 64;
        float z = 0.f;
#pragma unroll
        for (int d = 0; d < 64; ++d) z += q[d] * kr[d];
        z *= 0.125f;
        const float sp = fmaxf(z, 0.f) + log1pf(expf(-fabsf(z)));
        const float w = expf(z - sp + R);
        R -= sp;
#pragma unroll
        for (int d = 0; d < 64; ++d) o[d] += w * vr[d];
    }
#pragma unroll
    for (int d = 0; d < 64; ++d) O[((size_t)b * SEQ + t) * DM + hh * 64 + d] = o[d];
}

__global__ void __launch_bounds__(64) k_mla(const float* __restrict__ Q, const float* __restrict__ KV, const float* __restrict__ KR, float* __restrict__ O) {
    const int t = blockIdx.x * 64 + threadIdx.x, hh = blockIdx.y, b = blockIdx.z;
    const size_t tb = (size_t)b * SEQ;
    float q[96], o[64];
    const float scale = 0.10206207261596575f;
#pragma unroll
    for (int d = 0; d < 96; ++d) q[d] = Q[(tb + t) * 768 + hh * 96 + d] * scale;
#pragma unroll
    for (int d = 0; d < 64; ++d) o[d] = 0.f;
    float m = -INFINITY, l = 0.f;
    const int tmax = blockIdx.x * 64 + 63;
    for (int s = 0; s <= tmax; ++s) {
        const float* kn = KV + (tb + s) * 1024 + hh * 128;
        const float* kr = KR + (tb + s) * 32;
        float sc = 0.f;
#pragma unroll
        for (int d = 0; d < 64; ++d) sc += q[d] * kn[d];
#pragma unroll
        for (int d = 0; d < 32; ++d) sc += q[64 + d] * kr[d];
        if (s <= t) {
            const float mn = fmaxf(m, sc);
            const float f = expf(m - mn), p = expf(sc - mn);
            l = l * f + p;
#pragma unroll
            for (int d = 0; d < 64; ++d) o[d] = o[d] * f + p * kn[64 + d];
            m = mn;
        }
    }
    const float rl = 1.f / l;
#pragma unroll
    for (int d = 0; d < 64; ++d) O[(tb + t) * DM + 512 + hh * 64 + d] = o[d] * rl;
}

__global__ void __launch_bounds__(256) k_ln(const float* X, const float* Y, const float* __restrict__ g, const float* __restrict__ bb, float* out) {
    __shared__ float red[4];
    const int tok = blockIdx.x, tid = threadIdx.x;
    float v[4]; float s = 0.f;
#pragma unroll
    for (int j = 0; j < 4; ++j) { const int c = tid + 256 * j; v[j] = ALPHA * X[(size_t)tok * DM + c] + Y[(size_t)tok * DM + c]; s += v[j]; }
    const float mean = block_sum256(s, red) * (1.f / DM);
    float s2 = 0.f;
#pragma unroll
    for (int j = 0; j < 4; ++j) { v[j] -= mean; s2 += v[j] * v[j]; }
    const float rstd = rsqrtf(block_sum256(s2, red) * (1.f / DM) + LN_EPS);
#pragma unroll
    for (int j = 0; j < 4; ++j) { const int c = tid + 256 * j; out[(size_t)tok * DM + c] = v[j] * rstd * g[c] + bb[c]; }
}

__global__ void __launch_bounds__(256) k_peer_topk(const float* __restrict__ PQ, const float* __restrict__ keys, float* __restrict__ GATE, int* __restrict__ EIDX) {
    __shared__ float qs[256];
    __shared__ float ks[256][33];
    __shared__ float sc[256];
    __shared__ float s_half[2][16];
    __shared__ int i_half[2][16];
    __shared__ float cand[256];
    __shared__ float s_top[16];
    __shared__ int e_top[16];
    const int tok = blockIdx.x, hh = blockIdx.y, tid = threadIdx.x, c = tid >> 7, n = tid & 127;
    qs[tid] = PQ[(size_t)tok * 2048 + hh * 256 + tid];
    const float* kb = keys + (size_t)hh * 2 * 128 * 128;
    float score = 0.f;
    for (int d0 = 0; d0 < 128; d0 += 32) {
        __syncthreads();
#pragma unroll 4
        for (int i = 0; i < 32; ++i) { const int idx = i * 256 + tid, row = idx >> 5, col = idx & 31; ks[row][col] = kb[(size_t)row * 128 + d0 + col]; }
        __syncthreads();
#pragma unroll
        for (int dd = 0; dd < 32; ++dd) score += qs[c * 128 + d0 + dd] * ks[tid][dd];
    }
    sc[tid] = score;
    __syncthreads();
    int rank = 0;
    for (int j = 0; j < 128; ++j) { const float o = sc[c * 128 + j]; rank += (o > score || (o == score && j < n)) ? 1 : 0; }
    if (rank < 16) { s_half[c][rank] = score; i_half[c][rank] = n; }
    __syncthreads();
    const int a = tid >> 4, b = tid & 15;
    const float cv = s_half[0][a] + s_half[1][b];
    cand[tid] = cv;
    __syncthreads();
    int rank2 = 0;
    for (int j = 0; j < 256; ++j) { const float o = cand[j]; rank2 += (o > cv || (o == cv && j < tid)) ? 1 : 0; }
    if (rank2 < 16) { s_top[rank2] = cv; e_top[rank2] = i_half[0][a] * 128 + i_half[1][b]; }
    __syncthreads();
    if (tid < 16) {
        const float m = s_top[0];
        float sum = 0.f;
        for (int j = 0; j < 16; ++j) sum += expf(s_top[j] - m);
        GATE[(size_t)tok * 128 + hh * 16 + tid] = expf(s_top[tid] - m) / sum;
        EIDX[(size_t)tok * 128 + hh * 16 + tid] = e_top[tid];
    }
}

__global__ void __launch_bounds__(256) k_peer_ffn(const float* X1, const float* __restrict__ GATE, const int* __restrict__ EIDX,
                                                  const float* __restrict__ U, const float* __restrict__ V,
                                                  const float* __restrict__ g, const float* __restrict__ bb, float* out) {
    __shared__ float xs[1024];
    __shared__ float a_s[128];
    __shared__ int e_s[128];
    __shared__ float red[4];
    const int tok = blockIdx.x, tid = threadIdx.x, lane = tid & 63, w = tid >> 6;
#pragma unroll
    for (int j = 0; j < 4; ++j) xs[tid + 256 * j] = X1[(size_t)tok * DM + tid + 256 * j];
    if (tid < 128) e_s[tid] = EIDX[(size_t)tok * 128 + tid];
    __syncthreads();
    for (int kk = 0; kk < 32; ++kk) {
        const int k = w * 32 + kk;
        const float* ur = U + (size_t)e_s[k] * DM;
        float p = 0.f;
#pragma unroll
        for (int i = 0; i < 16; ++i) p += xs[lane + 64 * i] * ur[lane + 64 * i];
        p = wave_sum(p);
        if (lane == 0) a_s[k] = GATE[(size_t)tok * 128 + k] * 0.5f * p * (1.f + erff(p * 0.70710678118654752f));
    }
    __syncthreads();
    float acc[4] = {0.f, 0.f, 0.f, 0.f};
    for (int k = 0; k < 128; ++k) {
        const float a = a_s[k];
        const float4 vv = *(const float4*)(V + (size_t)e_s[k] * DM + tid * 4);
        acc[0] += a * vv.x; acc[1] += a * vv.y; acc[2] += a * vv.z; acc[3] += a * vv.w;
    }
    float v[4]; float s = 0.f;
#pragma unroll
    for (int j = 0; j < 4; ++j) { v[j] = ALPHA * xs[tid * 4 + j] + acc[j]; s += v[j]; }
    const float mean = block_sum256(s, red) * (1.f / DM);
    float s2 = 0.f;
#pragma unroll
    for (int j = 0; j < 4; ++j) { v[j] -= mean; s2 += v[j] * v[j]; }
    const float rstd = rsqrtf(block_sum256(s2, red) * (1.f / DM) + LN_EPS);
#pragma unroll
    for (int j = 0; j < 4; ++j) { const int cidx = tid * 4 + j; out[(size_t)tok * DM + cidx] = v[j] * rstd * g[cidx] + bb[cidx]; }
}

extern "C" void kernel_launch(void* const* d_in, const int* in_sizes, int n_in, void* d_out, int out_size, void* d_ws, size_t ws_size, hipStream_t stream) {
    const float* x = (const float*)d_in[0];
    const float* w_in = (const float*)d_in[1];
    const float* g_cq = (const float*)d_in[2];
    const float* w_uq = (const float*)d_in[3];
    const float* g_ckv = (const float*)d_in[4];
    const float* w_ukv = (const float*)d_in[5];
    const float* w_o = (const float*)d_in[6];
    const float* ln1_g = (const float*)d_in[7];
    const float* ln1_b = (const float*)d_in[8];
    const float* peer_wq = (const float*)d_in[9];
    const float* peer_keys = (const float*)d_in[10];
    const float* peer_u = (const float*)d_in[11];
    const float* peer_v = (const float*)d_in[12];
    const float* ln2_g = (const float*)d_in[13];
    const float* ln2_b = (const float*)d_in[14];
    float* out = (float*)d_out;
    char* ws = (char*)d_ws;
    const size_t MiB = 1u << 20;
    float* H = (float*)(ws);
    float* PQ = H;
    float* CQN = (float*)(ws + 128 * MiB);
    float* CKVN = (float*)(ws + 144 * MiB);
    float* KR = (float*)(ws + 152 * MiB);
    float* Q = (float*)(ws + 160 * MiB);
    float* KV = (float*)(ws + 208 * MiB);
    float* O = (float*)(ws + 272 * MiB);
    float* MIX = (float*)(ws + 336 * MiB);
    float* X1 = (float*)(ws + 400 * MiB);
    float* GATE = (float*)(ws + 464 * MiB);
    int* EIDX = (int*)(ws + 472 * MiB);
    if (ws_size < 480 * MiB) { fprintf(stderr, "kernel_launch: workspace too small (%zu)\n", ws_size); return; }
    const float* xin = x;
    for (int l = 0; l < DEPTH; ++l) {
        k_gemm<<<dim3((DIN + 63) / 64, NTOK / 64), 256, 0, stream>>>(xin, DM, w_in + (size_t)l * DM * DIN, DIN, H, DIN, NTOK, DIN, DM);
        k_prep<<<NTOK, 256, 0, stream>>>(H, g_cq + l * 256, g_ckv + l * 128, CQN, CKVN, KR);
        k_gemm<<<dim3(768 / 64, NTOK / 64), 256, 0, stream>>>(CQN, 256, w_uq + (size_t)l * 256 * 768, 768, Q, 768, NTOK, 768, 256);
        k_ropeq<<<NTOK, 128, 0, stream>>>(Q);
        k_gemm<<<dim3(1024 / 64, NTOK / 64), 256, 0, stream>>>(CKVN, 128, w_ukv + (size_t)l * 128 * 1024, 1024, KV, 1024, NTOK, 1024, 128);
        k_sb<<<dim3(SEQ / 64, 8, NB), 64, 0, stream>>>(H, O);
        k_mla<<<dim3(SEQ / 64, 8, NB), 64, 0, stream>>>(Q, KV, KR, O);
        k_gemm<<<dim3(DM / 64, NTOK / 64), 256, 0, stream>>>(O, DM, w_o + (size_t)l * DM * DM, DM, MIX, DM, NTOK, DM, DM);
        k_ln<<<NTOK, 256, 0, stream>>>(xin, MIX, ln1_g + l * DM, ln1_b + l * DM, X1);
        k_gemm<<<dim3(2048 / 64, NTOK / 64), 256, 0, stream>>>(X1, DM, peer_wq + (size_t)l * DM * 2048, 2048, PQ, 2048, NTOK, 2048, DM);
        k_peer_topk<<<dim3(NTOK, 8), 256, 0, stream>>>(PQ, peer_keys + (size_t)l * 8 * 2 * 128 * 128, GATE, EIDX);
        k_peer_ffn<<<NTOK, 256, 0, stream>>>(X1, GATE, EIDX, peer_u + (size_t)l * NEXP * DM, peer_v + (size_t)l * NEXP * DM, ln2_g + l * DM, ln2_b + l * DM, out);
        xin = out;
    }
}
```

```cpp
#include <hip/hip_runtime.h>
#include <cstdio>
#include <cstdint>
#include <math.h>
namespace pg8 {
#define PG8_LAS __attribute__((address_space(3)))
typedef unsigned short bf16_t;
typedef short bf16x8 __attribute__((ext_vector_type(8)));
typedef float f32x4 __attribute__((ext_vector_type(4)));
typedef unsigned u32x4 __attribute__((ext_vector_type(4)));
constexpr int BM = 256, BK = 64, HALF = 128, HTB = HALF * BK * 2  , STAGE_BYTES = 8 * HTB, NXCD = 8, WGM = 8;

__host__ __device__ __forceinline__ int lds_byte(int r, int c) { const int st = (r >> 4) * 2 + (c >> 5), rr = r & 15, cc = c & 31, ob = rr * 64 + cc * 2; return st * 1024 + (ob ^ (((ob >> 9) & 1) << 5)); }
__host__ __device__ __forceinline__ void stage_rc(int b, int& R, int& C) { const int st = b / 1024, sb = b % 1024, swz = sb ^ (((sb >> 9) & 1) << 5); R = (st >> 1) * 16 + swz / 64; C = (st & 1) * 32 + (swz % 64) / 2; }
__host__ __device__ __forceinline__ int perm32(int rho) { const int n = rho >> 4, i = rho & 15; return 8 * (i >> 2) + 4 * n + (i & 3); }

struct Unit { int pm, pn; };
struct Gemm { const bf16_t* A; const bf16_t* Bt; int M, N, K; };

struct StaticOrder {
    int nM, nN, nwg, G, c;
    __host__ __device__ void init(int M, int N, int G_, int c_) { nM = M / BM; nN = N / BM; nwg = nM * nN; G = G_; c = c_; }
    __host__ __device__ bool next(int i, Unit& u) const {
        const long L = (long)i * G + c; if (L >= nwg) return false;
        int wgid = (int)L; { const int q = nwg / NXCD, r = nwg % NXCD, xcd = wgid % NXCD, off = wgid / NXCD; wgid = (xcd < r ? xcd * (q + 1) : r * (q + 1) + (xcd - r) * q) + off; }
        const int nig = WGM * nN, gid = wgid / nig, fm = gid * WGM, gsz = (nM - fm) < WGM ? (nM - fm) : WGM;
        u.pm = fm + ((wgid % nig) % gsz); u.pn = (wgid % nig) / gsz; return true;
    }
    __device__ __forceinline__ void a_ready(const Unit&) const {}
    __device__ __forceinline__ void done(const Unit&) const {}
};

__device__ __forceinline__ unsigned cvt_pk_bf16(float lo, float hi) { unsigned r; asm volatile("v_cvt_pk_bf16_f32 %0, %1, %2" : "=v"(r) : "v"(lo), "v"(hi)); return r; }
typedef float f32x2 __attribute__((ext_vector_type(2)));
__device__ __forceinline__ f32x2 gelu_pk(f32x2 v) {
    const f32x2 av = __builtin_elementwise_abs(v), d = av * 0.2316418882f + 1.0f;
    f32x2 t; t.x = __builtin_amdgcn_rcpf(d.x); t.y = __builtin_amdgcn_rcpf(d.y);
    f32x2 q = t * 0.5307027145f + (-0.7265760135f); q = q * t + 0.7107068705f; q = q * t + (-0.142248368f); q = q * t + 0.127414796f; q = q * t;
    const f32x2 s = (v * v) * (-0.72134752044f);
    f32x2 e; e.x = __builtin_amdgcn_exp2f(s.x); e.y = __builtin_amdgcn_exp2f(s.y);
    const f32x2 m = v * (q * e), r = v - m;
    f32x2 o; o.x = v.x < 0.f ? m.x : r.x; o.y = v.y < 0.f ? m.y : r.y; return o;
}

template <int ACT  > struct EpiBf16 {
    static constexpr bool PERM = true, AFTER_DRAIN = false; static_assert(ACT == 0 || ACT == 1, "EpiBf16: ACT is 0 (none) or 1 (gelu_pk)");
    bf16_t* O; int ldc; const float* bias; int split_cols; size_t split_stride; float scale0;
    __device__ __forceinline__ void operator()(const f32x4 (&acc)[2][2][4][2], const Unit& u, int wr, int wc, int fr, int fq) const {
        const int row0 = u.pm * BM + wr * 64 + fr; int colt = u.pn * BM; bf16_t* base = O;
        float sc = 1.f; if (split_cols) { const int t = colt / split_cols; base += (size_t)t * split_stride; colt -= t * split_cols; if (t == 0) sc = scale0; }
        const int col0 = colt + wc * 32 + 8 * fq, bcol0 = u.pn * BM + wc * 32 + 8 * fq;
        f32x4 bv[2][2];
#pragma unroll
        for (int bj = 0; bj < 2; ++bj)
#pragma unroll
            for (int n = 0; n < 2; ++n) bv[bj][n] = bias ? *(const f32x4*)(bias + bcol0 + bj * HALF + 4 * n) : (f32x4){0.f, 0.f, 0.f, 0.f};
#pragma unroll
        for (int ai = 0; ai < 2; ++ai)
#pragma unroll
            for (int m = 0; m < 4; ++m) { bf16_t* rowp = base + (size_t)(row0 + ai * HALF + m * 16) * ldc + col0;
#pragma unroll
                for (int bj = 0; bj < 2; ++bj) { f32x4 v0 = acc[ai][bj][m][0] + bv[bj][0], v1 = acc[ai][bj][m][1] + bv[bj][1];
                    if (ACT == 1) { f32x2 a = gelu_pk((f32x2){v0[0], v0[1]}), b = gelu_pk((f32x2){v0[2], v0[3]}), c = gelu_pk((f32x2){v1[0], v1[1]}), d = gelu_pk((f32x2){v1[2], v1[3]});
                        v0 = (f32x4){a.x, a.y, b.x, b.y}; v1 = (f32x4){c.x, c.y, d.x, d.y}; }
                    v0 = v0 * sc; v1 = v1 * sc; u32x4 w; w.x = cvt_pk_bf16(v0[0], v0[1]); w.y = cvt_pk_bf16(v0[2], v0[3]); w.z = cvt_pk_bf16(v1[0], v1[1]); w.w = cvt_pk_bf16(v1[2], v1[3]);
                    *(u32x4*)(rowp + bj * HALF) = w; } }
    }
};
struct EpiResF32 {
    static constexpr bool PERM = false, AFTER_DRAIN = false;
    const float* res; float* out; int ldc; float alpha;
    __device__ __forceinline__ void operator()(const f32x4 (&acc)[2][2][4][2], const Unit& u, int wr, int wc, int fr, int fq) const {
        const int row0 = u.pm * BM + wr * 64 + fr, col0 = u.pn * BM + wc * 32 + 4 * fq;
#pragma unroll
        for (int ai = 0; ai < 2; ++ai)
#pragma unroll
            for (int m = 0; m < 4; ++m) { const size_t off = (size_t)(row0 + ai * HALF + m * 16) * ldc + col0;
#pragma unroll
                for (int bj = 0; bj < 2; ++bj)
#pragma unroll
                    for (int n = 0; n < 2; ++n) { const f32x4 rs = *(const f32x4*)(res + off + bj * HALF + n * 16); *(f32x4*)(out + off + bj * HALF + n * 16) = rs * alpha + acc[ai][bj][m][n]; }
                if (m & 1) asm volatile("" ::: "memory"); }
    }
};
template <class Epi, class Sched, bool ALIGN_EPI = false, bool SP2 = false>
__device__ __forceinline__ void gemm_phase(PG8_LAS unsigned char* lds, const Gemm g, const Sched& S, const Epi& E) {
    int tid_ = threadIdx.x; asm volatile("" : "+v"(tid_));
    const int tid = tid_, wid = __builtin_amdgcn_readfirstlane(tid >> 6), lane = tid & 63, wr = wid >> 2, wc = wid & 3, fr = lane & 15, fq = lane >> 4;
    const int K = g.K, nt = K / BK;
    unsigned voffA[2], voffB[2];
#pragma unroll
    for (int i = 0; i < 2; ++i) { int R, C; stage_rc(tid * 16 + i * 8192, R, C); const int Rb = Epi::PERM ? ((R & ~31) + perm32(R & 31)) : R;
        voffA[i] = (unsigned)(R * K + C) * 2u; voffB[i] = (unsigned)(Rb * K + C) * 2u; }
    const size_t kstep = (size_t)(BK * 2);
    const size_t hstep = (size_t)HALF * K * 2;
    const size_t tstep = 2 * hstep;
    const unsigned ldsw = (unsigned)wid * 1024u;
    const int aoff = lds_byte(wr * 64 + fr, fq * 8), boff = lds_byte(wc * 32 + fr, fq * 8);
#define PG8_SA(b, h) (((b) * 2 + (h)) * HTB)
#define PG8_SB(b, h) ((4 + (b) * 2 + (h)) * HTB)
#define PG8_STAGE(bufoff, gbase, voff) do { _Pragma("unroll") for (int _i = 0; _i < 2; ++_i) \
        __builtin_amdgcn_global_load_lds((const unsigned*)((const char*)(gbase) + (voff)[_i]), (PG8_LAS unsigned*)(lds + (bufoff) + ldsw + _i * 8192), 16, 0, 0); } while (0)
#define PG8_LDA(dst, b, h) do { _Pragma("unroll") for (int m = 0; m < 4; ++m) _Pragma("unroll") for (int k = 0; k < 2; ++k) dst[m][k] = *(const PG8_LAS bf16x8*)(lds + PG8_SA(b, h) + aoff + m * 2048 + k * 1024); } while (0)
#define PG8_LDB(dst, b, h) do { _Pragma("unroll") for (int n = 0; n < 2; ++n) _Pragma("unroll") for (int k = 0; k < 2; ++k) dst[n][k] = *(const PG8_LAS bf16x8*)(lds + PG8_SB(b, h) + boff + n * 2048 + k * 1024); } while (0)
#define PG8_MMA(ai, bj, At, Bt) do { __builtin_amdgcn_s_setprio(1); _Pragma("unroll") for (int m = 0; m < 4; ++m) _Pragma("unroll") for (int n = 0; n < 2; ++n) _Pragma("unroll") for (int k = 0; k < 2; ++k) \
        acc[ai][bj][m][n] = __builtin_amdgcn_mfma_f32_16x16x32_bf16(Bt[n][k], At[m][k], acc[ai][bj][m][n], 0, 0, 0); __builtin_amdgcn_s_setprio(0); } while (0)
#define PG8_WAIT_V(n) asm volatile("s_waitcnt vmcnt(" #n ")" ::: "memory")
#define PG8_WAIT_L(n) asm volatile("s_waitcnt lgkmcnt(" #n ")" ::: "memory")
#define PG8_BAR __builtin_amdgcn_s_barrier()
#define PG8_SCHED __builtin_amdgcn_sched_barrier(0)
    Unit cur, nxt; int ui = 0;
    if (!S.next(0, cur)) return;
    f32x4 acc[2][2][4][2];
#pragma unroll
    for (int a = 0; a < 2; ++a)
#pragma unroll
        for (int b = 0; b < 2; ++b)
#pragma unroll
            for (int m = 0; m < 4; ++m)
#pragma unroll
                for (int n = 0; n < 2; ++n) acc[a][b][m][n] = (f32x4){0.f, 0.f, 0.f, 0.f};
    bf16x8 At[4][2], B0[2][2], B1[2][2];
    const char* cA = (const char*)g.A + (size_t)cur.pm * tstep; const char* cB = (const char*)g.Bt + (size_t)cur.pn * tstep;
    S.a_ready(cur);
    if constexpr (SP2) {
        PG8_STAGE(PG8_SB(0, 0), cB, voffB); PG8_STAGE(PG8_SB(0, 1), cB + hstep, voffB); PG8_STAGE(PG8_SA(0, 0), cA, voffA); PG8_STAGE(PG8_SA(0, 1), cA + hstep, voffA);
        if (wr == 1) PG8_BAR;
        PG8_WAIT_V(2); PG8_BAR;
        PG8_STAGE(PG8_SB(1, 0), cB + kstep, voffB); PG8_STAGE(PG8_SA(1, 0), cA + kstep, voffA); PG8_STAGE(PG8_SB(1, 1), cB + hstep + kstep, voffB);
        PG8_WAIT_V(6); PG8_BAR;
    } else {
        PG8_STAGE(PG8_SB(0, 0), cB, voffB); PG8_STAGE(PG8_SA(0, 0), cA, voffA); PG8_STAGE(PG8_SB(0, 1), cB + hstep, voffB); PG8_STAGE(PG8_SA(0, 1), cA + hstep, voffA);
        if (wr == 1) PG8_BAR;
        PG8_WAIT_V(4); PG8_BAR;
        PG8_STAGE(PG8_SB(1, 0), cB + kstep, voffB); PG8_STAGE(PG8_SA(1, 0), cA + kstep, voffA); PG8_STAGE(PG8_SB(1, 1), cB + hstep + kstep, voffB);
        PG8_WAIT_V(6); PG8_BAR;
    }
    for (;;) {
        const bool has_next = S.next(ui + 1, nxt);
        const char* nA = has_next ? (const char*)g.A + (size_t)nxt.pm * tstep : cA; const char* nB = has_next ? (const char*)g.Bt + (size_t)nxt.pn * tstep : cB;
        for (int t = 0; t < nt; t += 2) {
            const bool last = (t == nt - 2);
            const char* a1 = cA + (size_t)(t + 1) * kstep;
            const char* a2 = last ? nA : cA + (size_t)(t + 2) * kstep; const char* b2 = last ? nB : cB + (size_t)(t + 2) * kstep;
            const char* a3 = a2 + kstep; const char* b3 = b2 + kstep;
            if (last && has_next) S.a_ready(nxt);
            if constexpr (SP2) {
            PG8_LDB(B0, 0, 0); PG8_LDB(B1, 0, 1); PG8_SCHED; PG8_LDA(At, 0, 0); PG8_STAGE(PG8_SA(1, 1), a1 + hstep, voffA);
            PG8_WAIT_V(8); PG8_WAIT_L(0); PG8_BAR; PG8_MMA(0, 0, At, B0); PG8_MMA(0, 1, At, B1); PG8_BAR; PG8_SCHED;
            PG8_LDA(At, 0, 1); PG8_STAGE(PG8_SB(0, 0), b2, voffB); PG8_STAGE(PG8_SB(0, 1), b2 + hstep, voffB); PG8_STAGE(PG8_SA(0, 0), a2, voffA);
            PG8_WAIT_V(8); PG8_WAIT_L(0); PG8_BAR; PG8_MMA(1, 0, At, B0); PG8_MMA(1, 1, At, B1); PG8_BAR; PG8_SCHED;
            PG8_LDB(B0, 1, 0); PG8_LDB(B1, 1, 1); PG8_SCHED; PG8_LDA(At, 1, 0); PG8_STAGE(PG8_SA(0, 1), a2 + hstep, voffA);
            PG8_WAIT_V(8); PG8_WAIT_L(0); PG8_BAR; PG8_MMA(0, 0, At, B0); PG8_MMA(0, 1, At, B1); PG8_BAR; PG8_SCHED;
            PG8_LDA(At, 1, 1); PG8_STAGE(PG8_SB(1, 0), b3, voffB); PG8_STAGE(PG8_SB(1, 1), b3 + hstep, voffB); PG8_STAGE(PG8_SA(1, 0), a3, voffA);
            PG8_WAIT_V(8); PG8_WAIT_L(0); PG8_BAR; PG8_MMA(1, 0, At, B0); PG8_MMA(1, 1, At, B1); PG8_BAR; PG8_SCHED;
            } else {
            PG8_LDB(B0, 0, 0); PG8_SCHED; PG8_LDA(At, 0, 0); PG8_STAGE(PG8_SA(1, 1), a1 + hstep, voffA);
            PG8_WAIT_L(8); PG8_BAR; PG8_WAIT_L(0); PG8_MMA(0, 0, At, B0); PG8_BAR; PG8_SCHED;
            PG8_LDB(B1, 0, 1); PG8_STAGE(PG8_SB(0, 0), b2, voffB);
            PG8_BAR; PG8_WAIT_L(0); PG8_MMA(0, 1, At, B1); PG8_BAR;
            PG8_LDA(At, 0, 1); PG8_STAGE(PG8_SA(0, 0), a2, voffA);
            PG8_BAR; PG8_WAIT_L(0); PG8_MMA(1, 0, At, B0); PG8_BAR; PG8_SCHED;
            PG8_STAGE(PG8_SB(0, 1), b2 + hstep, voffB);
            PG8_WAIT_V(6); PG8_BAR; PG8_MMA(1, 1, At, B1); PG8_BAR;
            PG8_LDB(B0, 1, 0); PG8_SCHED; PG8_LDA(At, 1, 0); PG8_STAGE(PG8_SA(0, 1), a2 + hstep, voffA);
            PG8_WAIT_L(8); PG8_BAR; PG8_WAIT_L(0); PG8_MMA(0, 0, At, B0); PG8_BAR; PG8_SCHED;
            PG8_LDB(B1, 1, 1); PG8_STAGE(PG8_SB(1, 0), b3, voffB);
            PG8_BAR; PG8_WAIT_L(0); PG8_MMA(0, 1, At, B1); PG8_BAR;
            PG8_LDA(At, 1, 1); PG8_STAGE(PG8_SA(1, 0), a3, voffA);
            PG8_BAR; PG8_WAIT_L(0); PG8_MMA(1, 0, At, B0); PG8_BAR; PG8_SCHED;
            PG8_STAGE(PG8_SB(1, 1), b3 + hstep, voffB);
            PG8_WAIT_V(6); PG8_BAR; PG8_MMA(1, 1, At, B1); PG8_BAR;
            }
        }
        if constexpr (ALIGN_EPI) { if (wr == 0) PG8_BAR; }
        if constexpr (!Epi::AFTER_DRAIN) { E(acc, cur, wr, wc, fr, fq); S.done(cur); }
        if (!has_next) break;
#pragma unroll
        for (int a = 0; a < 2; ++a)
#pragma unroll
            for (int b = 0; b < 2; ++b)
#pragma unroll
                for (int m = 0; m < 4; ++m)
#pragma unroll
                    for (int n = 0; n < 2; ++n) acc[a][b][m][n] = (f32x4){0.f, 0.f, 0.f, 0.f};
        cur = nxt; cA = nA; cB = nB; ++ui;
        if constexpr (ALIGN_EPI) { if (wr == 1) PG8_BAR; }
    }
    PG8_WAIT_V(0);
    if constexpr (!ALIGN_EPI) { if (wr == 0) PG8_BAR; }
    PG8_BAR;
    if constexpr (Epi::AFTER_DRAIN) { E.fused(acc, cur, wr, wc, fr, fq, lds, wid, lane); S.done(cur); }
#undef PG8_SA
#undef PG8_SB
#undef PG8_STAGE
#undef PG8_LDA
#undef PG8_LDB
#undef PG8_MMA
#undef PG8_WAIT_V
#undef PG8_WAIT_L
#undef PG8_BAR
#undef PG8_SCHED
}
}

#ifndef PG8_SP2
#define PG8_SP2 true
#endif
#ifndef PG8_ALIGN
#define PG8_ALIGN true
#endif
#define GAS __attribute__((address_space(1)))
#define LAS __attribute__((address_space(3)))
typedef unsigned short bf16;
typedef unsigned v4u __attribute__((ext_vector_type(4)));
typedef float f32x4 __attribute__((ext_vector_type(4)));
typedef short bf16x8 __attribute__((ext_vector_type(8)));
typedef GAS unsigned gu32;
typedef GAS unsigned long long gu64;
#define RLX_AGENT __ATOMIC_RELAXED, __HIP_MEMORY_SCOPE_AGENT
#define LDS_WAIT() asm volatile("s_waitcnt lgkmcnt(0)" ::: "memory")
#define VM_WAIT() asm volatile("s_waitcnt vmcnt(0)" ::: "memory")
__device__ __forceinline__ unsigned long long rt() { return __builtin_amdgcn_s_memrealtime(); }
__device__ __forceinline__ unsigned f2bf(float f) { unsigned u = __builtin_bit_cast(unsigned, f); return (u + 0x7fffu + ((u >> 16) & 1u)) >> 16; }
__device__ __forceinline__ unsigned pk2(float lo, float hi) { return f2bf(lo) | (f2bf(hi) << 16); }

#define XB_TMO      128
#define XB_XCNT(j)  (256  + 64 * (j))
#define XB_XSUB(j)  (1280 + 64 * (j))
#define XB_XGEN(j)  (2304 + 64 * (j))
#define XB_TOP      3328
#define XB_TOPGEN   3392
#define XCD_BAR_WORDS 3456
#define XB_SPIN_CAP (1u << 18)

__device__ __forceinline__ unsigned xb_ld(unsigned* p)              { return __hip_atomic_load(p, __ATOMIC_RELAXED, __HIP_MEMORY_SCOPE_AGENT); }
__device__ __forceinline__ unsigned xb_add(unsigned* p, unsigned v) { return __hip_atomic_fetch_add(p, v, __ATOMIC_RELAXED, __HIP_MEMORY_SCOPE_AGENT); }
__device__ __forceinline__ unsigned xb_xcc_id() { return (unsigned)__builtin_amdgcn_s_getreg((3 << 11) | 20) & 0xFu; }
#define XB_SPIN(cond, bar) do { unsigned _sp = 0; while (cond) { __builtin_amdgcn_s_sleep(1); \
    if ((++_sp & 255u) == 0u) { if (xb_ld(&(bar)[XB_TMO])) break; if (_sp > XB_SPIN_CAP) { atomicAdd(&(bar)[XB_TMO], 1u); break; } } } } while (0)

struct XcdBarrier {
    unsigned* bar; unsigned x;
    volatile LAS unsigned* st;
};

__device__ __forceinline__ XcdBarrier xcd_barrier_post(unsigned* bar, volatile LAS unsigned* st) {
    XcdBarrier b; b.bar = bar; b.x = xb_xcc_id(); b.st = st;
    if (threadIdx.x == 0) (void)xb_add(&bar[XB_XCNT(b.x)], 1u);
    return b;
}
__device__ __forceinline__ void xcd_barrier_complete(unsigned* bar, unsigned x, unsigned& nloc, unsigned& nx) {
    const unsigned G = gridDim.x * gridDim.y * gridDim.z;
    unsigned sum, cnt, mine, sp = 0u;
    for (;;) {
        sum = 0u; cnt = 0u; mine = 0u;
#pragma unroll
        for (unsigned j = 0; j < 16; ++j) { const unsigned c = xb_ld(&bar[XB_XCNT(j)]); sum += c; cnt += (c > 0u) ? 1u : 0u; mine = (j == x) ? c : mine; }
        if (sum == G) break;
        __builtin_amdgcn_s_sleep(1);
        if ((++sp & 255u) == 0u) { if (xb_ld(&bar[XB_TMO])) break; if (sp > XB_SPIN_CAP) { atomicAdd(&bar[XB_TMO], 1u); break; } }
    }
    nloc = mine > 0u ? mine : 1u; nx = cnt > 0u ? cnt : 1u;
}

__device__ __forceinline__ void xcd_barrier(const XcdBarrier& b) {
    asm volatile("s_waitcnt vmcnt(0)" ::: "memory");
    __syncthreads();
    if (threadIdx.x == 0) {
        unsigned* bar = b.bar;
        __builtin_amdgcn_s_waitcnt(0);
        unsigned nloc = b.st[0], nx = b.st[1];
        if (nloc == 0u) { xcd_barrier_complete(bar, b.x, nloc, nx); b.st[0] = nloc; b.st[1] = nx; }
        const unsigned old = xb_add(&bar[XB_XSUB(b.x)], 1u);
        const unsigned gen = old / nloc;
        if (old + 1u == (gen + 1u) * nloc) {
            __builtin_amdgcn_fence(__ATOMIC_RELEASE, "agent");
            asm volatile("s_waitcnt vmcnt(0)" ::: "memory");
            const unsigned og = xb_add(&bar[XB_TOP], 1u);
            const unsigned tg = og / nx;
            if (og + 1u == (tg + 1u) * nx) xb_add(&bar[XB_TOPGEN], 1u);
            else XB_SPIN(xb_ld(&bar[XB_TOPGEN]) == tg, bar);
            __builtin_amdgcn_fence(__ATOMIC_ACQUIRE, "agent");
            xb_add(&bar[XB_XGEN(b.x)], 1u);
            asm volatile("s_waitcnt vmcnt(0)" ::: "memory");
        } else {
            XB_SPIN(xb_ld(&bar[XB_XGEN(b.x)]) == gen, bar);
            __builtin_amdgcn_fence(__ATOMIC_ACQUIRE, "agent");
            asm volatile("s_waitcnt vmcnt(0)" ::: "memory");
        }
    }
    __syncthreads();
}

constexpr int NWAVES = 8, NTHREADS = 512;
constexpr int DM = 1024, NB = 4, SEQ = 4096, DEPTH = 2, NTOK = NB * SEQ, NEXP = 16384;
constexpr int DIN = 1952, DINP = 2048;
constexpr float ALPHA = 1.4142135623730951f;
constexpr float LN_EPS = 1e-5f, RMS_EPS = 1e-6f;
constexpr float QSCALE = 0.10206207261596575f * 1.4426950408889634f;
constexpr int NPHASE = 1 + 8 * DEPTH;
constexpr size_t MiB = 1u << 20;
constexpr size_t WS_CTL = 0, CTL_ZERO_BYTES = 64 * 1024;
constexpr size_t WS_WIT = 2 * MiB;
constexpr size_t WS_WQT = 10 * MiB;
constexpr size_t WS_WOT = 18 * MiB;
constexpr size_t WS_WUQT = 22 * MiB;
constexpr size_t WS_WUKVT = 23 * MiB;
constexpr size_t WS_KEYS = 24 * MiB;
constexpr size_t WS_ROPE = 25 * MiB;
constexpr size_t WS_UT = 32 * MiB;
constexpr size_t WS_VT = 96 * MiB;
constexpr size_t WS_XB = 160 * MiB;
constexpr size_t WS_HB = 192 * MiB;
constexpr size_t WS_QM = 256 * MiB;
constexpr size_t WS_KM = 280 * MiB;
constexpr size_t WS_VMT = 304 * MiB;
constexpr size_t WS_VST = 320 * MiB;
constexpr size_t WS_OB = 336 * MiB;
constexpr size_t WS_TOPK = 368 * MiB;
constexpr size_t WS_END = 384 * MiB;
constexpr int CW_BAR = 1024;
static_assert((CW_BAR + XCD_BAR_WORDS) * 4 <= (int)CTL_ZERO_BYTES, "barrier words inside the memset region");
constexpr int RING_OFF = 0, RING_BYTES = 131072;
constexpr int LDSCTL_OFF = RING_BYTES, MISC_OFF = LDSCTL_OFF + 320;
constexpr int LDS_BYTES = 147456;
static_assert(MISC_OFF + 128 <= LDS_BYTES, "LDS map");

typedef float f32x16 __attribute__((ext_vector_type(16)));
typedef float f32x2 __attribute__((ext_vector_type(2)));
typedef unsigned v2u __attribute__((ext_vector_type(2)));
typedef __bf16 bf2_t __attribute__((ext_vector_type(2)));

struct Args { const float* in[15]; float* out; unsigned char* ws; int ph_lo, ph_hi; };
typedef const __attribute__((address_space(4))) Args* kap_t;
__device__ __forceinline__ kap_t ka_fresh() { kap_t p = (kap_t)__builtin_amdgcn_kernarg_segment_ptr(); asm volatile("" : "+s"(p)); return p; }
enum { I_X = 0, I_WIN, I_GCQ, I_WUQ, I_GCKV, I_WUKV, I_WO, I_LN1G, I_LN1B, I_WQ, I_KEYS, I_U, I_V, I_LN2G, I_LN2B };
struct Frame {
    LAS unsigned char* lds;
    volatile LAS unsigned* MISC;
    int tid, lane, wave, vcu, G;
};
template <class T> __device__ __forceinline__ T* wsp(kap_t ka, size_t off) { return (T*)(ka->ws + off); }

__device__ __forceinline__ float bflo(unsigned w) { return __uint_as_float(w << 16); }
__device__ __forceinline__ float bfhi(unsigned w) { return __uint_as_float(w & 0xffff0000u); }
__device__ __forceinline__ float bf1(short s) { return __uint_as_float(((unsigned)(unsigned short)s) << 16); }
__device__ __forceinline__ int crow(int r, int hi) { return (r & 3) + 8 * (r >> 2) + 4 * hi; }
__device__ __forceinline__ int kperm(int s) { return (s & ~15) | (((s >> 2) & 1) << 3) | (((s >> 3) & 1) << 2) | (s & 3); }
template <int CTRL> __device__ __forceinline__ float dpp_f(float v) { return __builtin_bit_cast(float, __builtin_amdgcn_update_dpp(0, __builtin_bit_cast(int, v), CTRL, 0xF, 0xF, true)); }
__device__ __forceinline__ float wave_sum_all(float v) {
    v += dpp_f<0xB1>(v);
    v += dpp_f<0x4E>(v);
    v += dpp_f<0x141>(v);
    v += dpp_f<0x140>(v);
    v += __shfl_xor(v, 16);
    v += __shfl_xor(v, 32);
    return v;
}
__device__ __forceinline__ float wave_max_all(float v) {
    v = fmaxf(v, dpp_f<0xB1>(v)); v = fmaxf(v, dpp_f<0x4E>(v)); v = fmaxf(v, dpp_f<0x141>(v)); v = fmaxf(v, dpp_f<0x140>(v));
    v = fmaxf(v, __shfl_xor(v, 16)); v = fmaxf(v, __shfl_xor(v, 32));
    return v;
}
__device__ __forceinline__ bf16x8 pack8(float a0, float a1, float a2, float a3, float a4, float a5, float a6, float a7) {
    v4u w; w.x = pk2(a0, a1); w.y = pk2(a2, a3); w.z = pk2(a4, a5); w.w = pk2(a6, a7); return __builtin_bit_cast(bf16x8, w);
}

__device__ __forceinline__ void p0_transpose_item(const float* W, int K, int N, bf16* WT, const float* gs, LAS float* scr, int item, int lane) {
    const int nblk = N / 32, kb = item / nblk, nb = item % nblk, k0 = 64 * kb, n0 = 32 * nb;
#pragma unroll 8
    for (int i = 0; i < 32; ++i) { const int kk = 2 * i + (lane >> 5); float w = W[(size_t)(k0 + kk) * N + n0 + (lane & 31)]; if (gs) w *= gs[k0 + kk]; scr[kk * 33 + (lane & 31)] = w; }
    LDS_WAIT(); asm volatile("" ::: "memory");
    const int c = lane & 7;
#pragma unroll
    for (int j = 0; j < 4; ++j) { const int n = (lane >> 3) + 8 * j; const LAS float* s = scr + (8 * c) * 33 + n;
        v4u o; o.x = pk2(s[0 * 33], s[1 * 33]); o.y = pk2(s[2 * 33], s[3 * 33]); o.z = pk2(s[4 * 33], s[5 * 33]); o.w = pk2(s[6 * 33], s[7 * 33]);
        *(GAS v4u*)(WT + (size_t)(n0 + n) * K + k0 + 8 * c) = o; }
    LDS_WAIT(); asm volatile("" ::: "memory");
}
__device__ __forceinline__ void cvt8_range(Frame& F, const float* src, bf16* dst, size_t n8) {
    const size_t gt = (size_t)blockIdx.x * NTHREADS + F.tid, nt = (size_t)F.G * NTHREADS;
    for (size_t i = gt; i < n8; i += nt) { const f32x4 a = *(const f32x4*)(src + i * 8), b = *(const f32x4*)(src + i * 8 + 4);
        v4u o; o.x = pk2(a.x, a.y); o.y = pk2(a.z, a.w); o.z = pk2(b.x, b.y); o.w = pk2(b.z, b.w); *(v4u*)(dst + i * 8) = o; }
}
__device__ __forceinline__ void p0_prologue(Frame& F, kap_t ka) {
    LAS float* scr = (LAS float*)(F.lds + RING_OFF + F.wave * 16384);
    const int gw = F.vcu * NWAVES + F.wave, NGW = F.G * NWAVES;
    constexpr int I_IN = 16 * 61, I_Q = 16 * 64, I_O = 16 * 32, I_UQ = 4 * 24, I_UKV = 2 * 32, I_L = I_IN + I_Q + I_O + I_UQ + I_UKV;
    for (int it = gw; it < DEPTH * I_L; it += NGW) {
        const int l = it / I_L; int r = it % I_L;
        if (r < I_IN) { p0_transpose_item(ka->in[I_WIN] + (size_t)l * DM * DIN, DM, DIN, wsp<bf16>(ka, WS_WIT) + (size_t)l * DINP * DM, nullptr, scr, r, F.lane); continue; } r -= I_IN;
        if (r < I_Q) { p0_transpose_item(ka->in[I_WQ] + (size_t)l * DM * 2048, DM, 2048, wsp<bf16>(ka, WS_WQT) + (size_t)l * 2048 * DM, nullptr, scr, r, F.lane); continue; } r -= I_Q;
        if (r < I_O) { p0_transpose_item(ka->in[I_WO] + (size_t)l * DM * DM, DM, DM, wsp<bf16>(ka, WS_WOT) + (size_t)l * DM * DM, nullptr, scr, r, F.lane); continue; } r -= I_O;
        if (r < I_UQ) { p0_transpose_item(ka->in[I_WUQ] + (size_t)l * 256 * 768, 256, 768, wsp<bf16>(ka, WS_WUQT) + (size_t)l * 768 * 256, ka->in[I_GCQ] + l * 256, scr, r, F.lane); continue; } r -= I_UQ;
        p0_transpose_item(ka->in[I_WUKV] + (size_t)l * 128 * 1024, 128, 1024, wsp<bf16>(ka, WS_WUKVT) + (size_t)l * 1024 * 128, ka->in[I_GCKV] + l * 128, scr, r, F.lane);
    }
    const size_t gt = (size_t)blockIdx.x * NTHREADS + F.tid, nt = (size_t)F.G * NTHREADS;
    for (size_t i = gt; i < 2 * 12288; i += nt) { const size_t l = i / 12288, j = i % 12288; *(v4u*)(wsp<bf16>(ka, WS_WIT) + l * DINP * DM + (size_t)DIN * DM + j * 8) = (v4u){0u, 0u, 0u, 0u}; }
    for (size_t i = gt; i < (size_t)SEQ * 16; i += nt) { const int pos = (int)(i >> 4), k = (int)(i & 15);
        const float inv_freq = (float)pow(10000.0, -(double)k / 16.0); const float ang = (float)pos * inv_freq;
        wsp<f32x2>(ka, WS_ROPE)[i] = (f32x2){(float)cos((double)ang), (float)sin((double)ang)}; }
    cvt8_range(F, ka->in[I_KEYS], wsp<bf16>(ka, WS_KEYS), (size_t)DEPTH * 8 * 2 * 128 * 128 / 8);
    cvt8_range(F, ka->in[I_X], wsp<bf16>(ka, WS_XB), (size_t)NTOK * DM / 8);
#ifdef MK_DBG_L0
    cvt8_range(F, ka->in[I_U], wsp<bf16>(ka, WS_UT), (size_t)NEXP * DM / 8);
    cvt8_range(F, ka->in[I_V], wsp<bf16>(ka, WS_VT), (size_t)NEXP * DM / 8);
#else
    cvt8_range(F, ka->in[I_U], wsp<bf16>(ka, WS_UT), (size_t)DEPTH * NEXP * DM / 8);
    cvt8_range(F, ka->in[I_V], wsp<bf16>(ka, WS_VT), (size_t)DEPTH * NEXP * DM / 8);
#endif
}

__device__ __forceinline__ void p2_unit(Frame& F, kap_t ka, int l, int tb, int part) {
    const int lane = F.lane, r32 = lane & 31, hi = lane >> 5;
    const int tok = tb * 32 + r32, b = tok / SEQ, s = tok % SEQ;
    const bf16* hrow = wsp<bf16>(ka, WS_HB) + (size_t)tok * DINP;
    if (part < 2) {
        bf16x8 xf[16]; float ssq = 0.f;
#pragma unroll
        for (int ks = 0; ks < 16; ++ks) { xf[ks] = *(const bf16x8*)(hrow + 1536 + ks * 16 + 8 * hi);
#pragma unroll
            for (int e = 0; e < 8; ++e) { const float v = bf1(xf[ks][e]); ssq += v * v; } }
        ssq += __shfl_xor(ssq, 32);
        const float rstd = rsqrtf(ssq * (1.f / 256.f) + RMS_EPS) * QSCALE;
        const bf16* W = wsp<bf16>(ka, WS_WUQT) + (size_t)l * 768 * 256;
        for (int j = part * 12; j < part * 12 + 12; ++j) {
            const int head = j / 3, sub = j % 3;
            const bf16* wrow = W + (size_t)(j * 32 + r32) * 256 + 8 * hi;
            f32x16 acc = {};
#pragma unroll
            for (int ks = 0; ks < 16; ++ks) acc = __builtin_amdgcn_mfma_f32_32x32x16_bf16(*(const bf16x8*)(wrow + ks * 16), xf[ks], acc, 0, 0, 0);
            float v[16];
#pragma unroll
            for (int r = 0; r < 16; ++r) v[r] = acc[r] * rstd;
            if (sub == 2) {
#pragma unroll
                for (int r = 0; r < 8; ++r) { const f32x2 cs = wsp<f32x2>(ka, WS_ROPE)[s * 16 + crow(r, hi)]; const float x1 = v[r], x2 = v[r + 8]; v[r] = x1 * cs.x - x2 * cs.y; v[r + 8] = x2 * cs.x + x1 * cs.y; }
            }
            bf16* dst = wsp<bf16>(ka, WS_QM) + ((size_t)(b * 8 + head) * SEQ + s) * 96 + sub * 32 + 4 * hi;
#pragma unroll
            for (int g = 0; g < 4; ++g) { v2u w; w.x = pk2(v[4 * g], v[4 * g + 1]); w.y = pk2(v[4 * g + 2], v[4 * g + 3]); *(v2u*)(dst + 8 * g) = w; }
        }
    } else {
        const int h0 = (part - 2) * 4;
        bf16x8 xf[8]; float ssq = 0.f;
#pragma unroll
        for (int ks = 0; ks < 8; ++ks) { xf[ks] = *(const bf16x8*)(hrow + 1792 + ks * 16 + 8 * hi);
#pragma unroll
            for (int e = 0; e < 8; ++e) { const float v = bf1(xf[ks][e]); ssq += v * v; } }
        ssq += __shfl_xor(ssq, 32);
        const float rstd = rsqrtf(ssq * (1.f / 128.f) + RMS_EPS);
        const bf16* W = wsp<bf16>(ka, WS_WUKVT) + (size_t)l * 1024 * 128;
        const int sp = kperm(s);
        for (int j = h0 * 4; j < h0 * 4 + 16; ++j) {
            const int head = j >> 2, sub = j & 3;
            const bf16* wrow = W + (size_t)(j * 32 + r32) * 128 + 8 * hi;
            f32x16 acc = {};
#pragma unroll
            for (int ks = 0; ks < 8; ++ks) acc = __builtin_amdgcn_mfma_f32_32x32x16_bf16(*(const bf16x8*)(wrow + ks * 16), xf[ks], acc, 0, 0, 0);
            if (sub < 2) {
                bf16* dst = wsp<bf16>(ka, WS_KM) + ((size_t)(b * 8 + head) * SEQ + s) * 96 + sub * 32 + 4 * hi;
#pragma unroll
                for (int g = 0; g < 4; ++g) { v2u w; w.x = pk2(acc[4 * g] * rstd, acc[4 * g + 1] * rstd); w.y = pk2(acc[4 * g + 2] * rstd, acc[4 * g + 3] * rstd); *(v2u*)(dst + 8 * g) = w; }
            } else {
                bf16* dst = wsp<bf16>(ka, WS_VMT) + ((size_t)(b * 8 + head) * 64 + (sub - 2) * 32) * SEQ + sp;
#pragma unroll
                for (int r = 0; r < 16; ++r) dst[(size_t)crow(r, hi) * SEQ] = (bf16)f2bf(acc[r] * rstd);
            }
        }
        { const bf16x8 a1 = *(const bf16x8*)(hrow + 1920 + 8 * hi), a2 = *(const bf16x8*)(hrow + 1936 + 8 * hi);
          float o1[8], o2[8];
#pragma unroll
          for (int e = 0; e < 8; ++e) { const f32x2 cs = wsp<f32x2>(ka, WS_ROPE)[s * 16 + 8 * hi + e]; const float x1 = bf1(a1[e]), x2 = bf1(a2[e]); o1[e] = x1 * cs.x - x2 * cs.y; o2[e] = x2 * cs.x + x1 * cs.y; }
          const bf16x8 p1 = pack8(o1[0], o1[1], o1[2], o1[3], o1[4], o1[5], o1[6], o1[7]), p2 = pack8(o2[0], o2[1], o2[2], o2[3], o2[4], o2[5], o2[6], o2[7]);
#pragma unroll
          for (int hh = 0; hh < 4; ++hh) { bf16* dst = wsp<bf16>(ka, WS_KM) + ((size_t)(b * 8 + h0 + hh) * SEQ + s) * 96 + 64 + 8 * hi; *(bf16x8*)dst = p1; *(bf16x8*)(dst + 16) = p2; } }
#pragma unroll
        for (int hh = 0; hh < 4; ++hh) {
            const int head = h0 + hh;
#pragma unroll
            for (int c4 = 0; c4 < 4; ++c4) { const bf16x8 a = *(const bf16x8*)(hrow + 1024 + head * 64 + 32 * hi + c4 * 8);
                bf16* dst = wsp<bf16>(ka, WS_VST) + ((size_t)(b * 8 + head) * 64 + 32 * hi + c4 * 8) * SEQ + sp;
#pragma unroll
                for (int e = 0; e < 8; ++e) dst[(size_t)e * SEQ] = (bf16)a[e]; }
        }
    }
}

__device__ __forceinline__ void mla_unit(Frame& F, kap_t ka, int bh, int qb) {
    const int lane = F.lane, r32 = lane & 31, hi = lane >> 5, q0 = qb * 32;
    const bf16* Qp = wsp<bf16>(ka, WS_QM) + ((size_t)bh * SEQ + q0 + r32) * 96 + 8 * hi;
    bf16x8 qf[6];
#pragma unroll
    for (int ks = 0; ks < 6; ++ks) qf[ks] = *(const bf16x8*)(Qp + ks * 16);
    f32x16 o0 = {}, o1 = {};
    float m = -1e30f, l = 0.f;
    const bf16* Kp = wsp<bf16>(ka, WS_KM) + ((size_t)bh * SEQ + r32) * 96 + 8 * hi;
    const bf16* Vp = wsp<bf16>(ka, WS_VMT) + ((size_t)bh * 64 + r32) * SEQ + 8 * hi;
    for (int kt = 0; kt <= qb; ++kt) {
        const int k0 = kt * 32;
        bf16x8 kf[6], vf[4];
#pragma unroll
        for (int ks = 0; ks < 6; ++ks) kf[ks] = *(const bf16x8*)(Kp + (size_t)k0 * 96 + ks * 16);
#pragma unroll
        for (int i = 0; i < 4; ++i) vf[i] = *(const bf16x8*)(Vp + (size_t)(i >> 1) * 32 * SEQ + k0 + 16 * (i & 1));
        f32x16 sa = {};
#pragma unroll
        for (int ks = 0; ks < 6; ++ks) sa = __builtin_amdgcn_mfma_f32_32x32x16_bf16(kf[ks], qf[ks], sa, 0, 0, 0);
        if (kt == qb) {
#pragma unroll
            for (int r = 0; r < 16; ++r) if (crow(r, hi) > r32) sa[r] = -1e30f;
        }
        float mx = sa[0];
#pragma unroll
        for (int r = 1; r < 16; ++r) mx = fmaxf(mx, sa[r]);
        mx = fmaxf(mx, __shfl_xor(mx, 32));
        const float mn = fmaxf(m, mx), alpha = __builtin_amdgcn_exp2f(m - mn);
        float p[16], rs = 0.f;
#pragma unroll
        for (int r = 0; r < 16; ++r) { p[r] = __builtin_amdgcn_exp2f(sa[r] - mn); rs += p[r]; }
        l = l * alpha + rs; m = mn;
#pragma unroll
        for (int r = 0; r < 16; ++r) { o0[r] *= alpha; o1[r] *= alpha; }
        const bf16x8 pf0 = pack8(p[0], p[1], p[2], p[3], p[4], p[5], p[6], p[7]), pf1 = pack8(p[8], p[9], p[10], p[11], p[12], p[13], p[14], p[15]);
        o0 = __builtin_amdgcn_mfma_f32_32x32x16_bf16(vf[0], pf0, o0, 0, 0, 0);
        o0 = __builtin_amdgcn_mfma_f32_32x32x16_bf16(vf[1], pf1, o0, 0, 0, 0);
        o1 = __builtin_amdgcn_mfma_f32_32x32x16_bf16(vf[2], pf0, o1, 0, 0, 0);
        o1 = __builtin_amdgcn_mfma_f32_32x32x16_bf16(vf[3], pf1, o1, 0, 0, 0);
    }
    l += __shfl_xor(l, 32);
    const float rl = 1.f / l;
    const int b = bh >> 3, h = bh & 7;
    bf16* dst = wsp<bf16>(ka, WS_OB) + ((size_t)b * SEQ + q0 + r32) * DM + 512 + h * 64 + 4 * hi;
#pragma unroll
    for (int g = 0; g < 4; ++g) {
        v2u w; w.x = pk2(o0[4 * g] * rl, o0[4 * g + 1] * rl); w.y = pk2(o0[4 * g + 2] * rl, o0[4 * g + 3] * rl); *(v2u*)(dst + 8 * g) = w;
        v2u u; u.x = pk2(o1[4 * g] * rl, o1[4 * g + 1] * rl); u.y = pk2(o1[4 * g + 2] * rl, o1[4 * g + 3] * rl); *(v2u*)(dst + 32 + 8 * g) = u;
    }
}

__device__ __forceinline__ void sb_unit(Frame& F, kap_t ka, int bh, int qb) {
    const int lane = F.lane, r32 = lane & 31, hi = lane >> 5, q0 = qb * 32;
    const int b = bh >> 3, h = bh & 7;
    const bf16* Hb = wsp<bf16>(ka, WS_HB) + (size_t)b * SEQ * DINP + h * 64 + 8 * hi;
    bf16x8 qf[4];
#pragma unroll
    for (int ks = 0; ks < 4; ++ks) qf[ks] = *(const bf16x8*)(Hb + (size_t)(q0 + r32) * DINP + ks * 16);
    f32x16 o0 = {}, o1 = {};
    float R = 0.f;
    const bf16* Vp = wsp<bf16>(ka, WS_VST) + ((size_t)bh * 64 + r32) * SEQ + 8 * hi;
    for (int k0 = q0; k0 >= 0; k0 -= 32) {
        bf16x8 kf[4], vf[4];
#pragma unroll
        for (int ks = 0; ks < 4; ++ks) kf[ks] = *(const bf16x8*)(Hb + (size_t)(k0 + r32) * DINP + 512 + ks * 16);
#pragma unroll
        for (int i = 0; i < 4; ++i) vf[i] = *(const bf16x8*)(Vp + (size_t)(i >> 1) * 32 * SEQ + k0 + 16 * (i & 1));
        f32x16 za = {};
#pragma unroll
        for (int ks = 0; ks < 4; ++ks) za = __builtin_amdgcn_mfma_f32_32x32x16_bf16(kf[ks], qf[ks], za, 0, 0, 0);
        const bool diag = (k0 == q0);
        float L[16], lw[16];
#pragma unroll
        for (int r = 0; r < 16; ++r) {
            const float z = za[r] * 0.125f;
            const float sp = fmaxf(z, 0.f) + __logf(1.f + __expf(-fabsf(z)));
            const bool valid = !diag || (crow(r, hi) < r32);
            L[r] = valid ? -sp : 0.f;
            lw[r] = valid ? (z - sp) : -1e30f;
        }
        float e[16], T[4], U[4];
#pragma unroll
        for (int g = 0; g < 4; ++g) { e[4 * g + 3] = 0.f; e[4 * g + 2] = L[4 * g + 3]; e[4 * g + 1] = e[4 * g + 2] + L[4 * g + 2]; e[4 * g] = e[4 * g + 1] + L[4 * g + 1]; T[g] = e[4 * g] + L[4 * g]; }
#pragma unroll
        for (int g = 0; g < 4; ++g) U[g] = __shfl_xor(T[g], 32);
        float sT[4], sUge[4];
        sT[3] = 0.f; sT[2] = T[3]; sT[1] = T[3] + T[2]; sT[0] = sT[1] + T[1];
        sUge[3] = U[3]; sUge[2] = U[3] + U[2]; sUge[1] = sUge[2] + U[1]; sUge[0] = sUge[1] + U[0];
        float w[16];
#pragma unroll
        for (int g = 0; g < 4; ++g) {
            const float sfx = R + sT[g] + (hi ? (sUge[g] - U[g]) : sUge[g]);
#pragma unroll
            for (int i = 0; i < 4; ++i) w[4 * g + i] = __expf(lw[4 * g + i] + sfx + e[4 * g + i]);
        }
        R += (sT[0] + T[0]) + sUge[0];
        const bf16x8 pf0 = pack8(w[0], w[1], w[2], w[3], w[4], w[5], w[6], w[7]), pf1 = pack8(w[8], w[9], w[10], w[11], w[12], w[13], w[14], w[15]);
        o0 = __builtin_amdgcn_mfma_f32_32x32x16_bf16(vf[0], pf0, o0, 0, 0, 0);
        o0 = __builtin_amdgcn_mfma_f32_32x32x16_bf16(vf[1], pf1, o0, 0, 0, 0);
        o1 = __builtin_amdgcn_mfma_f32_32x32x16_bf16(vf[2], pf0, o1, 0, 0, 0);
        o1 = __builtin_amdgcn_mfma_f32_32x32x16_bf16(vf[3], pf1, o1, 0, 0, 0);
        if (__all(R < -88.f)) break;
    }
    bf16* dst = wsp<bf16>(ka, WS_OB) + ((size_t)b * SEQ + q0 + r32) * DM + h * 64 + 4 * hi;
#pragma unroll
    for (int g = 0; g < 4; ++g) {
        v2u wv; wv.x = pk2(o0[4 * g], o0[4 * g + 1]); wv.y = pk2(o0[4 * g + 2], o0[4 * g + 3]); *(v2u*)(dst + 8 * g) = wv;
        v2u u; u.x = pk2(o1[4 * g], o1[4 * g + 1]); u.y = pk2(o1[4 * g + 2], o1[4 * g + 3]); *(v2u*)(dst + 32 + 8 * g) = u;
    }
}

__device__ __forceinline__ void ln1_row(Frame& F, kap_t ka, int row, const float* g, const float* bb) {
    float* yr = ka->out + (size_t)row * DM;
    f32x4 v[4]; float s = 0.f;
#pragma unroll
    for (int j = 0; j < 4; ++j) { v[j] = *(const f32x4*)(yr + 4 * F.lane + 256 * j); s += (v[j].x + v[j].y) + (v[j].z + v[j].w); }
    const float mean = wave_sum_all(s) * (1.f / DM); float s2 = 0.f;
#pragma unroll
    for (int j = 0; j < 4; ++j) { v[j] = v[j] - mean; s2 += (v[j].x * v[j].x + v[j].y * v[j].y) + (v[j].z * v[j].z + v[j].w * v[j].w); }
    const float rstd = rsqrtf(wave_sum_all(s2) * (1.f / DM) + LN_EPS);
#pragma unroll
    for (int j = 0; j < 4; ++j) { const int c = 4 * F.lane + 256 * j; const f32x4 gg = *(const f32x4*)(g + c), bv = *(const f32x4*)(bb + c);
        const f32x4 o = v[j] * rstd * gg + bv; *(f32x4*)(yr + c) = o;
        v2u w; w.x = pk2(o.x, o.y); w.y = pk2(o.z, o.w); *(v2u*)(wsp<bf16>(ka, WS_XB) + (size_t)row * DM + c) = w; }
}

template <int N, int K, int J, bool FLIP> __device__ __forceinline__ void bitonic_stage(unsigned (&v)[N]) {
#pragma unroll
    for (int i = 0; i < N; ++i) { const int p = i ^ J; if (p > i) { const bool desc = (((i & K) == 0) != FLIP); const unsigned a = v[i], c = v[p]; const unsigned mx = a > c ? a : c, mn = a > c ? c : a; v[i] = desc ? mx : mn; v[p] = desc ? mn : mx; } }
}
template <bool FLIP> __device__ __forceinline__ void bitonic_merge16(unsigned (&v)[16]) {
    bitonic_stage<16, 16, 8, FLIP>(v); bitonic_stage<16, 16, 4, FLIP>(v); bitonic_stage<16, 16, 2, FLIP>(v); bitonic_stage<16, 16, 1, FLIP>(v);
}
__device__ __forceinline__ unsigned ord_key(float f, unsigned idx) { const unsigned u = __float_as_uint(f); const unsigned o = u ^ ((unsigned)((int)u >> 31) | 0x80000000u); return (o & 0xFFFFFF80u) | idx; }
__device__ __forceinline__ float key_val(unsigned k) { const unsigned o = (k & 0xFFFFFF80u) | 0x40u; const unsigned u = (o & 0x80000000u) ? (o ^ 0x80000000u) : ~o; return __uint_as_float(u); }
__device__ __forceinline__ void p7_unit(Frame& F, kap_t ka, int l, int tb, int h) {
    const int lane = F.lane, r32 = lane & 31, hi = lane >> 5;
    const int tok = tb * 32 + r32;
    for (int c = 0; c < 2; ++c) {
        const bf16* qrow = wsp<bf16>(ka, WS_HB) + (size_t)tok * 2048 + h * 256 + c * 128 + 8 * hi;
        bf16x8 qf[8];
#pragma unroll
        for (int ks = 0; ks < 8; ++ks) qf[ks] = *(const bf16x8*)(qrow + ks * 16);
        const bf16* kb = wsp<bf16>(ka, WS_KEYS) + ((size_t)((l * 8 + h) * 2 + c) * 128 + r32) * 128 + 8 * hi;
        unsigned key[64];
#pragma unroll
        for (int ch = 0; ch < 4; ++ch) {
            f32x16 acc = {};
#pragma unroll
            for (int ks = 0; ks < 8; ++ks) acc = __builtin_amdgcn_mfma_f32_32x32x16_bf16(*(const bf16x8*)(kb + (size_t)ch * 32 * 128 + ks * 16), qf[ks], acc, 0, 0, 0);
#pragma unroll
            for (int r = 0; r < 16; ++r) key[ch * 16 + r] = ord_key(acc[r], (unsigned)(ch * 32 + crow(r, hi)));
        }
        bitonic_stage<64, 2, 1, false>(key);
        bitonic_stage<64, 4, 2, false>(key); bitonic_stage<64, 4, 1, false>(key);
        bitonic_stage<64, 8, 4, false>(key); bitonic_stage<64, 8, 2, false>(key); bitonic_stage<64, 8, 1, false>(key);
        bitonic_stage<64, 16, 8, false>(key); bitonic_stage<64, 16, 4, false>(key); bitonic_stage<64, 16, 2, false>(key); bitonic_stage<64, 16, 1, false>(key);
        unsigned A[16], B[16];
#pragma unroll
        for (int i = 0; i < 16; ++i) { A[i] = key[i] > key[16 + i] ? key[i] : key[16 + i]; B[i] = key[32 + i] > key[48 + i] ? key[32 + i] : key[48 + i]; }
        bitonic_merge16<false>(A);
        bitonic_merge16<true>(B);
#pragma unroll
        for (int i = 0; i < 16; ++i) A[i] = A[i] > B[i] ? A[i] : B[i];
        bitonic_merge16<false>(A);
#pragma unroll
        for (int i = 0; i < 16; ++i) B[i] = (unsigned)__shfl_xor((int)A[i], 32);
        unsigned Cc[16];
#pragma unroll
        for (int i = 0; i < 16; ++i) Cc[i] = A[i] > B[15 - i] ? A[i] : B[15 - i];
        bitonic_merge16<false>(Cc);
        if (hi == 0) {
            unsigned* dst = wsp<unsigned>(ka, WS_TOPK) + ((size_t)(tok * 8 + h) * 2 + c) * 16;
#pragma unroll
            for (int g = 0; g < 4; ++g) *(v4u*)(dst + 4 * g) = (v4u){Cc[4 * g], Cc[4 * g + 1], Cc[4 * g + 2], Cc[4 * g + 3]};
        }
    }
}

__device__ __forceinline__ float dot2_bf16(unsigned w, unsigned x, float acc) { return __builtin_amdgcn_fdot2_f32_bf16(__builtin_bit_cast(bf2_t, w), __builtin_bit_cast(bf2_t, x), acc, false); }
__device__ __forceinline__ float gelu_erf(float x) { return 0.5f * x * (1.f + erff(x * 0.70710678118654752f)); }
__device__ __forceinline__ void p8_token(Frame& F, kap_t ka, int l, int tok, int ca, int cb, bool cvalid, LAS unsigned* elist, LAS float* glist) {
    const int lane = F.lane;
#ifdef MK_DBG_L0
    unsigned char* dbg_ws = ka->ws;
#endif
    for (int h = 0; h < 8; ++h) {
        const unsigned kv = wsp<unsigned>(ka, WS_TOPK)[(size_t)tok * 256 + h * 32 + (lane & 31)];
        const unsigned ka = (unsigned)__shfl((int)kv, ca), kb2 = (unsigned)__shfl((int)kv, 16 + cb);
        const float sum = cvalid ? (key_val(ka) + key_val(kb2)) : -3.0e38f;
        int rank = 0;
#pragma unroll 2
        for (int j = 0; j < 50; ++j) { const float o = __builtin_bit_cast(float, __builtin_amdgcn_readlane(__builtin_bit_cast(int, sum), j)); rank += (o > sum || (o == sum && j < lane)) ? 1 : 0; }
        const bool sel = cvalid && rank < 16;
        const float mx = __builtin_bit_cast(float, __builtin_amdgcn_readlane(__builtin_bit_cast(int, sum), 0));
        const float ex = sel ? __expf(sum - mx) : 0.f;
        const float den = wave_sum_all(ex);
        if (sel) { elist[h * 16 + rank] = (ka & 127u) * 128u + (kb2 & 127u); glist[h * 16 + rank] = ex / den; }
#ifdef MK_DBG_L0
        if (sel) { ((float*)(dbg_ws + 86 * MiB))[(size_t)tok * 128 + h * 16 + rank] = (float)((ka & 127u) * 128u + (kb2 & 127u)); ((float*)(dbg_ws + 128 * MiB))[(size_t)tok * 128 + h * 16 + rank] = ex / den; }
#endif
    }
    LDS_WAIT(); asm volatile("" ::: "memory");
    float* xrow = ka->out + (size_t)tok * DM;
    float xr[16];
    { const f32x4 a = *(const f32x4*)(xrow + 8 * lane), bq = *(const f32x4*)(xrow + 8 * lane + 4), c = *(const f32x4*)(xrow + 512 + 8 * lane), d = *(const f32x4*)(xrow + 512 + 8 * lane + 4);
      xr[0] = a.x; xr[1] = a.y; xr[2] = a.z; xr[3] = a.w; xr[4] = bq.x; xr[5] = bq.y; xr[6] = bq.z; xr[7] = bq.w;
      xr[8] = c.x; xr[9] = c.y; xr[10] = c.z; xr[11] = c.w; xr[12] = d.x; xr[13] = d.y; xr[14] = d.z; xr[15] = d.w; }
    unsigned xp[8];
#pragma unroll
    for (int i = 0; i < 8; ++i) xp[i] = pk2(xr[2 * i], xr[2 * i + 1]);
    float acc[16];
#pragma unroll
    for (int i = 0; i < 16; ++i) acc[i] = 0.f;
    const bf16* UT = wsp<bf16>(ka, WS_UT) + (size_t)l * NEXP * DM + 8 * lane;
    const bf16* VT = wsp<bf16>(ka, WS_VT) + (size_t)l * NEXP * DM + 8 * lane;
    for (int kb = 0; kb < 128; kb += 8) {
        v4u u0[8], u1[8], v0[8], v1[8]; float gt[8];
#pragma unroll
        for (int j = 0; j < 8; ++j) {
            const unsigned e = (unsigned)__builtin_amdgcn_readfirstlane((int)elist[kb + j]); gt[j] = glist[kb + j];
            const bf16* ur = UT + (size_t)e * DM; const bf16* vr = VT + (size_t)e * DM;
            u0[j] = *(const v4u*)ur; u1[j] = *(const v4u*)(ur + 512); v0[j] = *(const v4u*)vr; v1[j] = *(const v4u*)(vr + 512);
        }
#pragma unroll
        for (int j = 0; j < 8; ++j) {
            float p = 0.f;
            p = dot2_bf16(u0[j].x, xp[0], p);
            p = dot2_bf16(u0[j].y, xp[1], p);
            p = dot2_bf16(u0[j].z, xp[2], p);
            p = dot2_bf16(u0[j].w, xp[3], p);
            p = dot2_bf16(u1[j].x, xp[4], p);
            p = dot2_bf16(u1[j].y, xp[5], p);
            p = dot2_bf16(u1[j].z, xp[6], p);
            p = dot2_bf16(u1[j].w, xp[7], p);
            const float hk = wave_sum_all(p);
#ifdef MK_DBG_L0
            if (lane == 0) ((float*)(dbg_ws + 136 * MiB))[(size_t)tok * 128 + kb + j] = hk;
#endif
            const float a = gt[j] * gelu_erf(hk);
            acc[0] += a * bflo(v0[j].x); acc[1] += a * bfhi(v0[j].x); acc[2] += a * bflo(v0[j].y); acc[3] += a * bfhi(v0[j].y);
            acc[4] += a * bflo(v0[j].z); acc[5] += a * bfhi(v0[j].z); acc[6] += a * bflo(v0[j].w); acc[7] += a * bfhi(v0[j].w);
            acc[8] += a * bflo(v1[j].x); acc[9] += a * bfhi(v1[j].x); acc[10] += a * bflo(v1[j].y); acc[11] += a * bfhi(v1[j].y);
            acc[12] += a * bflo(v1[j].z); acc[13] += a * bfhi(v1[j].z); acc[14] += a * bflo(v1[j].w); acc[15] += a * bfhi(v1[j].w);
        }
    }
    float s = 0.f;
#pragma unroll
    for (int i = 0; i < 16; ++i) { acc[i] = ALPHA * xr[i] + acc[i]; s += acc[i]; }
    const float mean = wave_sum_all(s) * (1.f / DM); float s2 = 0.f;
#pragma unroll
    for (int i = 0; i < 16; ++i) { acc[i] -= mean; s2 += acc[i] * acc[i]; }
    const float rstd = rsqrtf(wave_sum_all(s2) * (1.f / DM) + LN_EPS);
    const float* g = ka->in[I_LN2G] + l * DM; const float* bb = ka->in[I_LN2B] + l * DM;
#pragma unroll
    for (int hf = 0; hf < 2; ++hf) {
        const int c0 = 512 * hf + 8 * lane;
        const f32x4 g0 = *(const f32x4*)(g + c0), g1 = *(const f32x4*)(g + c0 + 4), b0 = *(const f32x4*)(bb + c0), b1 = *(const f32x4*)(bb + c0 + 4);
        f32x4 o0, o1;
        o0.x = acc[8 * hf + 0] * rstd * g0.x + b0.x; o0.y = acc[8 * hf + 1] * rstd * g0.y + b0.y; o0.z = acc[8 * hf + 2] * rstd * g0.z + b0.z; o0.w = acc[8 * hf + 3] * rstd * g0.w + b0.w;
        o1.x = acc[8 * hf + 4] * rstd * g1.x + b1.x; o1.y = acc[8 * hf + 5] * rstd * g1.y + b1.y; o1.z = acc[8 * hf + 6] * rstd * g1.z + b1.z; o1.w = acc[8 * hf + 7] * rstd * g1.w + b1.w;
        *(f32x4*)(xrow + c0) = o0; *(f32x4*)(xrow + c0 + 4) = o1;
        v4u w; w.x = pk2(o0.x, o0.y); w.y = pk2(o0.z, o0.w); w.z = pk2(o1.x, o1.y); w.w = pk2(o1.z, o1.w);
        *(v4u*)(wsp<bf16>(ka, WS_XB) + (size_t)tok * DM + c0) = w;
    }
    LDS_WAIT(); asm volatile("" ::: "memory");
}

__global__ void __launch_bounds__(NTHREADS, 2) mk_fwd(Args args) {
    extern __shared__ __attribute__((aligned(16))) unsigned char lds[];
    Frame F;
    F.lds = (LAS unsigned char*)lds;
    F.MISC = (volatile LAS unsigned*)(F.lds + MISC_OFF);
    F.tid = threadIdx.x; F.lane = F.tid & 63; F.wave = __builtin_amdgcn_readfirstlane(F.tid >> 6);
    F.G = gridDim.x; { const int bx = blockIdx.x; F.vcu = (F.G % 8 == 0) ? (bx % 8) * (F.G / 8) + bx / 8 : bx; }
    for (int u = F.tid; u < (LDS_BYTES - LDSCTL_OFF) / 4; u += NTHREADS) ((LAS unsigned*)(F.lds + LDSCTL_OFF))[u] = 0u;
    __syncthreads();
    const int lo = args.ph_lo, hi = args.ph_hi;
    unsigned* const barw = (unsigned*)(args.ws + WS_CTL) + CW_BAR;
    const bool one_phase = (hi - lo) == 1;
    XcdBarrier bar; bar.bar = barw; bar.x = 0; bar.st = nullptr;
    if (!one_phase) bar = xcd_barrier_post(barw, F.MISC + 8);
#ifndef MK_EN
#define MK_EN 0x1ff
#endif
#define EN(n) (((MK_EN) >> (n)) & 1)
#define IN(k) (lo <= (k) && (k) < hi)
#define PHASE_IDS() do { int t_ = threadIdx.x; asm volatile("" : "+v"(t_)); F.tid = t_; F.lane = t_ & 63; } while (0)
#define SEAM(k) do { if (IN((k) + 1)) xcd_barrier(bar); } while (0)
    const int gw = F.vcu * NWAVES + F.wave, NGW = F.G * NWAVES;

    if (EN(0) && IN(0)) { PHASE_IDS(); p0_prologue(F, ka_fresh()); SEAM(0); }
    for (int l = 0; l < DEPTH; ++l) {
        const int pb = 1 + 8 * l;
        if (EN(1) && IN(pb + 0)) { const kap_t ka = ka_fresh(); PHASE_IDS();
            pg8::Gemm g{wsp<bf16>(ka, WS_XB), wsp<bf16>(ka, WS_WIT) + (size_t)l * DINP * DM, NTOK, DINP, DM}; pg8::StaticOrder S; S.init(NTOK, DINP, F.G, (int)blockIdx.x);
            pg8::EpiBf16<0> E{wsp<bf16>(ka, WS_HB), DINP, nullptr, 0, 0, 1.f};
            pg8::gemm_phase<pg8::EpiBf16<0>, pg8::StaticOrder, PG8_ALIGN, PG8_SP2>(F.lds + RING_OFF, g, S, E);
            SEAM(pb + 0);
        }
        if (EN(2) && IN(pb + 1)) { const kap_t ka = ka_fresh(); PHASE_IDS();
            for (int u = gw; u < (NTOK / 32) * 4; u += NGW) p2_unit(F, ka, l, u >> 2, u & 3);
            SEAM(pb + 1);
        }
        if (EN(3) && IN(pb + 2)) { const kap_t ka = ka_fresh(); PHASE_IDS();
            for (int u = gw; u < 32 * 64; u += NGW) {
                const int bh = u >> 6, pi = u & 63;
                mla_unit(F, ka, bh, 127 - pi); sb_unit(F, ka, bh, 127 - pi);
                mla_unit(F, ka, bh, pi); sb_unit(F, ka, bh, pi);
            }
            SEAM(pb + 2);
        }
        if (EN(4) && IN(pb + 3)) { const kap_t ka = ka_fresh(); PHASE_IDS();
            pg8::Gemm g{wsp<bf16>(ka, WS_OB), wsp<bf16>(ka, WS_WOT) + (size_t)l * DM * DM, NTOK, DM, DM}; pg8::StaticOrder S; S.init(NTOK, DM, F.G, (int)blockIdx.x);
            pg8::EpiResF32 E{l == 0 ? ka->in[I_X] : ka->out, ka->out, DM, ALPHA};
            pg8::gemm_phase<pg8::EpiResF32, pg8::StaticOrder, PG8_ALIGN, PG8_SP2>(F.lds + RING_OFF, g, S, E);
            SEAM(pb + 3);
        }
        if (EN(5) && IN(pb + 4)) { const kap_t ka = ka_fresh(); PHASE_IDS();
            for (int r = gw; r < NTOK; r += NGW) ln1_row(F, ka, r, ka->in[I_LN1G] + l * DM, ka->in[I_LN1B] + l * DM);
            SEAM(pb + 4);
        }
        if (EN(6) && IN(pb + 5)) { const kap_t ka = ka_fresh(); PHASE_IDS();
            pg8::Gemm g{wsp<bf16>(ka, WS_XB), wsp<bf16>(ka, WS_WQT) + (size_t)l * 2048 * DM, NTOK, 2048, DM}; pg8::StaticOrder S; S.init(NTOK, 2048, F.G, (int)blockIdx.x);
            pg8::EpiBf16<0> E{wsp<bf16>(ka, WS_HB), 2048, nullptr, 0, 0, 1.f};
            pg8::gemm_phase<pg8::EpiBf16<0>, pg8::StaticOrder, PG8_ALIGN, PG8_SP2>(F.lds + RING_OFF, g, S, E);
            SEAM(pb + 5);
        }
        if (EN(7) && IN(pb + 6)) { const kap_t ka = ka_fresh(); PHASE_IDS();
            for (int u = gw; u < (NTOK / 32) * 8; u += NGW) p7_unit(F, ka, l, u >> 3, u & 7);
            SEAM(pb + 6);
        }
        if (EN(8) && IN(pb + 7)) { const kap_t ka = ka_fresh(); PHASE_IDS();
            int ca = 0, cb = 0;
            { int cnt = 0;
#pragma unroll
              for (int a = 0; a < 16; ++a) { const int nb = 16 / (a + 1); if (F.lane >= cnt && F.lane < cnt + nb) { ca = a; cb = F.lane - cnt; } cnt += nb; } }
            const bool cvalid = F.lane < 50;
            LAS unsigned* elist = (LAS unsigned*)(F.lds + RING_OFF + F.wave * 1024);
            LAS float* glist = (LAS float*)(F.lds + RING_OFF + F.wave * 1024 + 512);
            for (int t = gw; t < NTOK; t += NGW) p8_token(F, ka, l, t, ca, cb, cvalid, elist, glist);
            if (l + 1 < DEPTH) SEAM(pb + 7);
        }
    }
#undef IN
#undef SEAM
}

#ifndef MK_PER_PHASE
#define MK_PER_PHASE 1
#endif
extern "C" void kernel_launch(void* const* d_in, const int* in_sizes, int n_in, void* d_out, int out_size, void* d_ws, size_t ws_size, hipStream_t stream) {
    static int grid = 0;
    if (grid == 0) {
        if (n_in != 15 || out_size != NTOK * DM || ws_size < WS_END) { fprintf(stderr, "kernel_launch: unexpected shapes (n_in %d, out %d, ws %zu); nothing launched\n", n_in, out_size, ws_size); grid = -1; return; }
        int dev = 0, cus = 0, per_cu = 0;
        if (hipGetDevice(&dev) != hipSuccess || hipDeviceGetAttribute(&cus, hipDeviceAttributeMultiprocessorCount, dev) != hipSuccess) { fprintf(stderr, "kernel_launch: device query failed\n"); grid = -1; return; }
        if (hipFuncSetAttribute((const void*)mk_fwd, hipFuncAttributeMaxDynamicSharedMemorySize, LDS_BYTES) != hipSuccess) { fprintf(stderr, "kernel_launch: hipFuncSetAttribute failed\n"); grid = -1; return; }
        if (hipOccupancyMaxActiveBlocksPerMultiprocessor(&per_cu, (const void*)mk_fwd, NTHREADS, LDS_BYTES) != hipSuccess || per_cu < 1) { fprintf(stderr, "kernel_launch: occupancy query says %d blocks per CU\n", per_cu); per_cu = 1; }
        (void)hipGetLastError();
        grid = cus;
        fprintf(stderr, "kernel_launch: grid %d (occupancy query %d per CU)\n", grid, per_cu);
    }
    if (grid < 0) return;
    (void)hipMemsetAsync((char*)d_ws + WS_CTL, 0, CTL_ZERO_BYTES, stream);
    Args a{};
    for (int i = 0; i < 15; ++i) a.in[i] = (const float*)d_in[i];
    a.out = (float*)d_out; a.ws = (unsigned char*)d_ws;
#if MK_PER_PHASE
    for (int p = 0; p < NPHASE; ++p) { a.ph_lo = p; a.ph_hi = p + 1; hipLaunchKernelGGL(mk_fwd, dim3(grid), dim3(NTHREADS), LDS_BYTES, stream, a); }
#else
    a.ph_lo = 0; a.ph_hi = NPHASE;
    void* kargs[] = {&a};
    const hipError_t e = hipLaunchCooperativeKernel((const void*)mk_fwd, dim3(grid), dim3(NTHREADS), kargs, LDS_BYTES, stream);
    if (e != hipSuccess) fprintf(stderr, "kernel_launch: cooperative launch failed: %s (grid %d)\n", hipGetErrorString(e), grid);
#endif
}
```

```cpp
#define MK_MLA_REP 2
#include <hip/hip_runtime.h>
#include <cstdio>
#include <cstdint>
#include <math.h>
namespace pg8 {
#define PG8_LAS __attribute__((address_space(3)))
typedef unsigned short bf16_t;
typedef short bf16x8 __attribute__((ext_vector_type(8)));
typedef float f32x4 __attribute__((ext_vector_type(4)));
typedef unsigned u32x4 __attribute__((ext_vector_type(4)));
constexpr int BM = 256, BK = 64, HALF = 128, HTB = HALF * BK * 2  , STAGE_BYTES = 8 * HTB, NXCD = 8, WGM = 8;

__host__ __device__ __forceinline__ int lds_byte(int r, int c) { const int st = (r >> 4) * 2 + (c >> 5), rr = r & 15, cc = c & 31, ob = rr * 64 + cc * 2; return st * 1024 + (ob ^ (((ob >> 9) & 1) << 5)); }
__host__ __device__ __forceinline__ void stage_rc(int b, int& R, int& C) { const int st = b / 1024, sb = b % 1024, swz = sb ^ (((sb >> 9) & 1) << 5); R = (st >> 1) * 16 + swz / 64; C = (st & 1) * 32 + (swz % 64) / 2; }
__host__ __device__ __forceinline__ int perm32(int rho) { const int n = rho >> 4, i = rho & 15; return 8 * (i >> 2) + 4 * n + (i & 3); }

struct Unit { int pm, pn; };
struct Gemm { const bf16_t* A; const bf16_t* Bt; int M, N, K; };

struct StaticOrder {
    int nM, nN, nwg, G, c;
    __host__ __device__ void init(int M, int N, int G_, int c_) { nM = M / BM; nN = N / BM; nwg = nM * nN; G = G_; c = c_; }
    __host__ __device__ bool next(int i, Unit& u) const {
        const long L = (long)i * G + c; if (L >= nwg) return false;
        int wgid = (int)L; { const int q = nwg / NXCD, r = nwg % NXCD, xcd = wgid % NXCD, off = wgid / NXCD; wgid = (xcd < r ? xcd * (q + 1) : r * (q + 1) + (xcd - r) * q) + off; }
        const int nig = WGM * nN, gid = wgid / nig, fm = gid * WGM, gsz = (nM - fm) < WGM ? (nM - fm) : WGM;
        u.pm = fm + ((wgid % nig) % gsz); u.pn = (wgid % nig) / gsz; return true;
    }
    __device__ __forceinline__ void a_ready(const Unit&) const {}
    __device__ __forceinline__ void done(const Unit&) const {}
};

__device__ __forceinline__ unsigned cvt_pk_bf16(float lo, float hi) { unsigned r; asm volatile("v_cvt_pk_bf16_f32 %0, %1, %2" : "=v"(r) : "v"(lo), "v"(hi)); return r; }
typedef float f32x2 __attribute__((ext_vector_type(2)));
__device__ __forceinline__ f32x2 gelu_pk(f32x2 v) {
    const f32x2 av = __builtin_elementwise_abs(v), d = av * 0.2316418882f + 1.0f;
    f32x2 t; t.x = __builtin_amdgcn_rcpf(d.x); t.y = __builtin_amdgcn_rcpf(d.y);
    f32x2 q = t * 0.5307027145f + (-0.7265760135f); q = q * t + 0.7107068705f; q = q * t + (-0.142248368f); q = q * t + 0.127414796f; q = q * t;
    const f32x2 s = (v * v) * (-0.72134752044f);
    f32x2 e; e.x = __builtin_amdgcn_exp2f(s.x); e.y = __builtin_amdgcn_exp2f(s.y);
    const f32x2 m = v * (q * e), r = v - m;
    f32x2 o; o.x = v.x < 0.f ? m.x : r.x; o.y = v.y < 0.f ? m.y : r.y; return o;
}

template <int ACT  > struct EpiBf16 {
    static constexpr bool PERM = true, AFTER_DRAIN = false; static_assert(ACT == 0 || ACT == 1, "EpiBf16: ACT is 0 (none) or 1 (gelu_pk)");
    bf16_t* O; int ldc; const float* bias; int split_cols; size_t split_stride; float scale0;
    __device__ __forceinline__ void operator()(const f32x4 (&acc)[2][2][4][2], const Unit& u, int wr, int wc, int fr, int fq) const {
        const int row0 = u.pm * BM + wr * 64 + fr; int colt = u.pn * BM; bf16_t* base = O;
        float sc = 1.f; if (split_cols) { const int t = colt / split_cols; base += (size_t)t * split_stride; colt -= t * split_cols; if (t == 0) sc = scale0; }
        const int col0 = colt + wc * 32 + 8 * fq, bcol0 = u.pn * BM + wc * 32 + 8 * fq;
        f32x4 bv[2][2];
#pragma unroll
        for (int bj = 0; bj < 2; ++bj)
#pragma unroll
            for (int n = 0; n < 2; ++n) bv[bj][n] = bias ? *(const f32x4*)(bias + bcol0 + bj * HALF + 4 * n) : (f32x4){0.f, 0.f, 0.f, 0.f};
#pragma unroll
        for (int ai = 0; ai < 2; ++ai)
#pragma unroll
            for (int m = 0; m < 4; ++m) { bf16_t* rowp = base + (size_t)(row0 + ai * HALF + m * 16) * ldc + col0;
#pragma unroll
                for (int bj = 0; bj < 2; ++bj) { f32x4 v0 = acc[ai][bj][m][0] + bv[bj][0], v1 = acc[ai][bj][m][1] + bv[bj][1];
                    if (ACT == 1) { f32x2 a = gelu_pk((f32x2){v0[0], v0[1]}), b = gelu_pk((f32x2){v0[2], v0[3]}), c = gelu_pk((f32x2){v1[0], v1[1]}), d = gelu_pk((f32x2){v1[2], v1[3]});
                        v0 = (f32x4){a.x, a.y, b.x, b.y}; v1 = (f32x4){c.x, c.y, d.x, d.y}; }
                    v0 = v0 * sc; v1 = v1 * sc; u32x4 w; w.x = cvt_pk_bf16(v0[0], v0[1]); w.y = cvt_pk_bf16(v0[2], v0[3]); w.z = cvt_pk_bf16(v1[0], v1[1]); w.w = cvt_pk_bf16(v1[2], v1[3]);
                    *(u32x4*)(rowp + bj * HALF) = w; } }
    }
};
struct EpiResF32 {
    static constexpr bool PERM = false, AFTER_DRAIN = false;
    const float* res; float* out; int ldc; float alpha;
    __device__ __forceinline__ void operator()(const f32x4 (&acc)[2][2][4][2], const Unit& u, int wr, int wc, int fr, int fq) const {
        const int row0 = u.pm * BM + wr * 64 + fr, col0 = u.pn * BM + wc * 32 + 4 * fq;
#pragma unroll
        for (int ai = 0; ai < 2; ++ai)
#pragma unroll
            for (int m = 0; m < 4; ++m) { const size_t off = (size_t)(row0 + ai * HALF + m * 16) * ldc + col0;
#pragma unroll
                for (int bj = 0; bj < 2; ++bj)
#pragma unroll
                    for (int n = 0; n < 2; ++n) { const f32x4 rs = *(const f32x4*)(res + off + bj * HALF + n * 16); *(f32x4*)(out + off + bj * HALF + n * 16) = rs * alpha + acc[ai][bj][m][n]; }
                if (m & 1) asm volatile("" ::: "memory"); }
    }
};
template <class Epi, class Sched, bool ALIGN_EPI = false, bool SP2 = false>
__device__ __forceinline__ void gemm_phase(PG8_LAS unsigned char* lds, const Gemm g, const Sched& S, const Epi& E) {
    int tid_ = threadIdx.x; asm volatile("" : "+v"(tid_));
    const int tid = tid_, wid = __builtin_amdgcn_readfirstlane(tid >> 6), lane = tid & 63, wr = wid >> 2, wc = wid & 3, fr = lane & 15, fq = lane >> 4;
    const int K = g.K, nt = K / BK;
    unsigned voffA[2], voffB[2];
#pragma unroll
    for (int i = 0; i < 2; ++i) { int R, C; stage_rc(tid * 16 + i * 8192, R, C); const int Rb = Epi::PERM ? ((R & ~31) + perm32(R & 31)) : R;
        voffA[i] = (unsigned)(R * K + C) * 2u; voffB[i] = (unsigned)(Rb * K + C) * 2u; }
    const size_t kstep = (size_t)(BK * 2);
    const size_t hstep = (size_t)HALF * K * 2;
    const size_t tstep = 2 * hstep;
    const unsigned ldsw = (unsigned)wid * 1024u;
    const int aoff = lds_byte(wr * 64 + fr, fq * 8), boff = lds_byte(wc * 32 + fr, fq * 8);
#define PG8_SA(b, h) (((b) * 2 + (h)) * HTB)
#define PG8_SB(b, h) ((4 + (b) * 2 + (h)) * HTB)
#define PG8_STAGE(bufoff, gbase, voff) do { _Pragma("unroll") for (int _i = 0; _i < 2; ++_i) \
        __builtin_amdgcn_global_load_lds((const unsigned*)((const char*)(gbase) + (voff)[_i]), (PG8_LAS unsigned*)(lds + (bufoff) + ldsw + _i * 8192), 16, 0, 0); } while (0)
#define PG8_LDA(dst, b, h) do { _Pragma("unroll") for (int m = 0; m < 4; ++m) _Pragma("unroll") for (int k = 0; k < 2; ++k) dst[m][k] = *(const PG8_LAS bf16x8*)(lds + PG8_SA(b, h) + aoff + m * 2048 + k * 1024); } while (0)
#define PG8_LDB(dst, b, h) do { _Pragma("unroll") for (int n = 0; n < 2; ++n) _Pragma("unroll") for (int k = 0; k < 2; ++k) dst[n][k] = *(const PG8_LAS bf16x8*)(lds + PG8_SB(b, h) + boff + n * 2048 + k * 1024); } while (0)
#define PG8_MMA(ai, bj, At, Bt) do { __builtin_amdgcn_s_setprio(1); _Pragma("unroll") for (int m = 0; m < 4; ++m) _Pragma("unroll") for (int n = 0; n < 2; ++n) _Pragma("unroll") for (int k = 0; k < 2; ++k) \
        acc[ai][bj][m][n] = __builtin_amdgcn_mfma_f32_16x16x32_bf16(Bt[n][k], At[m][k], acc[ai][bj][m][n], 0, 0, 0); __builtin_amdgcn_s_setprio(0); } while (0)
#define PG8_WAIT_V(n) asm volatile("s_waitcnt vmcnt(" #n ")" ::: "memory")
#define PG8_WAIT_L(n) asm volatile("s_waitcnt lgkmcnt(" #n ")" ::: "memory")
#define PG8_BAR __builtin_amdgcn_s_barrier()
#define PG8_SCHED __builtin_amdgcn_sched_barrier(0)
    Unit cur, nxt; int ui = 0;
    if (!S.next(0, cur)) return;
    f32x4 acc[2][2][4][2];
#pragma unroll
    for (int a = 0; a < 2; ++a)
#pragma unroll
        for (int b = 0; b < 2; ++b)
#pragma unroll
            for (int m = 0; m < 4; ++m)
#pragma unroll
                for (int n = 0; n < 2; ++n) acc[a][b][m][n] = (f32x4){0.f, 0.f, 0.f, 0.f};
    bf16x8 At[4][2], B0[2][2], B1[2][2];
    const char* cA = (const char*)g.A + (size_t)cur.pm * tstep; const char* cB = (const char*)g.Bt + (size_t)cur.pn * tstep;
    S.a_ready(cur);
    if constexpr (SP2) {
        PG8_STAGE(PG8_SB(0, 0), cB, voffB); PG8_STAGE(PG8_SB(0, 1), cB + hstep, voffB); PG8_STAGE(PG8_SA(0, 0), cA, voffA); PG8_STAGE(PG8_SA(0, 1), cA + hstep, voffA);
        if (wr == 1) PG8_BAR;
        PG8_WAIT_V(2); PG8_BAR;
        PG8_STAGE(PG8_SB(1, 0), cB + kstep, voffB); PG8_STAGE(PG8_SA(1, 0), cA + kstep, voffA); PG8_STAGE(PG8_SB(1, 1), cB + hstep + kstep, voffB);
        PG8_WAIT_V(6); PG8_BAR;
    } else {
        PG8_STAGE(PG8_SB(0, 0), cB, voffB); PG8_STAGE(PG8_SA(0, 0), cA, voffA); PG8_STAGE(PG8_SB(0, 1), cB + hstep, voffB); PG8_STAGE(PG8_SA(0, 1), cA + hstep, voffA);
        if (wr == 1) PG8_BAR;
        PG8_WAIT_V(4); PG8_BAR;
        PG8_STAGE(PG8_SB(1, 0), cB + kstep, voffB); PG8_STAGE(PG8_SA(1, 0), cA + kstep, voffA); PG8_STAGE(PG8_SB(1, 1), cB + hstep + kstep, voffB);
        PG8_WAIT_V(6); PG8_BAR;
    }
    for (;;) {
        const bool has_next = S.next(ui + 1, nxt);
        const char* nA = has_next ? (const char*)g.A + (size_t)nxt.pm * tstep : cA; const char* nB = has_next ? (const char*)g.Bt + (size_t)nxt.pn * tstep : cB;
        for (int t = 0; t < nt; t += 2) {
            const bool last = (t == nt - 2);
            const char* a1 = cA + (size_t)(t + 1) * kstep;
            const char* a2 = last ? nA : cA + (size_t)(t + 2) * kstep; const char* b2 = last ? nB : cB + (size_t)(t + 2) * kstep;
            const char* a3 = a2 + kstep; const char* b3 = b2 + kstep;
            if (last && has_next) S.a_ready(nxt);
            if constexpr (SP2) {
            PG8_LDB(B0, 0, 0); PG8_LDB(B1, 0, 1); PG8_SCHED; PG8_LDA(At, 0, 0); PG8_STAGE(PG8_SA(1, 1), a1 + hstep, voffA);
            PG8_WAIT_V(8); PG8_WAIT_L(0); PG8_BAR; PG8_MMA(0, 0, At, B0); PG8_MMA(0, 1, At, B1); PG8_BAR; PG8_SCHED;
            PG8_LDA(At, 0, 1); PG8_STAGE(PG8_SB(0, 0), b2, voffB); PG8_STAGE(PG8_SB(0, 1), b2 + hstep, voffB); PG8_STAGE(PG8_SA(0, 0), a2, voffA);
            PG8_WAIT_V(8); PG8_WAIT_L(0); PG8_BAR; PG8_MMA(1, 0, At, B0); PG8_MMA(1, 1, At, B1); PG8_BAR; PG8_SCHED;
            PG8_LDB(B0, 1, 0); PG8_LDB(B1, 1, 1); PG8_SCHED; PG8_LDA(At, 1, 0); PG8_STAGE(PG8_SA(0, 1), a2 + hstep, voffA);
            PG8_WAIT_V(8); PG8_WAIT_L(0); PG8_BAR; PG8_MMA(0, 0, At, B0); PG8_MMA(0, 1, At, B1); PG8_BAR; PG8_SCHED;
            PG8_LDA(At, 1, 1); PG8_STAGE(PG8_SB(1, 0), b3, voffB); PG8_STAGE(PG8_SB(1, 1), b3 + hstep, voffB); PG8_STAGE(PG8_SA(1, 0), a3, voffA);
            PG8_WAIT_V(8); PG8_WAIT_L(0); PG8_BAR; PG8_MMA(1, 0, At, B0); PG8_MMA(1, 1, At, B1); PG8_BAR; PG8_SCHED;
            } else {
            PG8_LDB(B0, 0, 0); PG8_SCHED; PG8_LDA(At, 0, 0); PG8_STAGE(PG8_SA(1, 1), a1 + hstep, voffA);
            PG8_WAIT_L(8); PG8_BAR; PG8_WAIT_L(0); PG8_MMA(0, 0, At, B0); PG8_BAR; PG8_SCHED;
            PG8_LDB(B1, 0, 1); PG8_STAGE(PG8_SB(0, 0), b2, voffB);
            PG8_BAR; PG8_WAIT_L(0); PG8_MMA(0, 1, At, B1); PG8_BAR;
            PG8_LDA(At, 0, 1); PG8_STAGE(PG8_SA(0, 0), a2, voffA);
            PG8_BAR; PG8_WAIT_L(0); PG8_MMA(1, 0, At, B0); PG8_BAR; PG8_SCHED;
            PG8_STAGE(PG8_SB(0, 1), b2 + hstep, voffB);
            PG8_WAIT_V(6); PG8_BAR; PG8_MMA(1, 1, At, B1); PG8_BAR;
            PG8_LDB(B0, 1, 0); PG8_SCHED; PG8_LDA(At, 1, 0); PG8_STAGE(PG8_SA(0, 1), a2 + hstep, voffA);
            PG8_WAIT_L(8); PG8_BAR; PG8_WAIT_L(0); PG8_MMA(0, 0, At, B0); PG8_BAR; PG8_SCHED;
            PG8_LDB(B1, 1, 1); PG8_STAGE(PG8_SB(1, 0), b3, voffB);
            PG8_BAR; PG8_WAIT_L(0); PG8_MMA(0, 1, At, B1); PG8_BAR;
            PG8_LDA(At, 1, 1); PG8_STAGE(PG8_SA(1, 0), a3, voffA);
            PG8_BAR; PG8_WAIT_L(0); PG8_MMA(1, 0, At, B0); PG8_BAR; PG8_SCHED;
            PG8_STAGE(PG8_SB(1, 1), b3 + hstep, voffB);
            PG8_WAIT_V(6); PG8_BAR; PG8_MMA(1, 1, At, B1); PG8_BAR;
            }
        }
        if constexpr (ALIGN_EPI) { if (wr == 0) PG8_BAR; }
        if constexpr (!Epi::AFTER_DRAIN) { E(acc, cur, wr, wc, fr, fq); S.done(cur); }
        if (!has_next) break;
#pragma unroll
        for (int a = 0; a < 2; ++a)
#pragma unroll
            for (int b = 0; b < 2; ++b)
#pragma unroll
                for (int m = 0; m < 4; ++m)
#pragma unroll
                    for (int n = 0; n < 2; ++n) acc[a][b][m][n] = (f32x4){0.f, 0.f, 0.f, 0.f};
        cur = nxt; cA = nA; cB = nB; ++ui;
        if constexpr (ALIGN_EPI) { if (wr == 1) PG8_BAR; }
    }
    PG8_WAIT_V(0);
    if constexpr (!ALIGN_EPI) { if (wr == 0) PG8_BAR; }
    PG8_BAR;
    if constexpr (Epi::AFTER_DRAIN) { E.fused(acc, cur, wr, wc, fr, fq, lds, wid, lane); S.done(cur); }
#undef PG8_SA
#undef PG8_SB
#undef PG8_STAGE
#undef PG8_LDA
#undef PG8_LDB
#undef PG8_MMA
#undef PG8_WAIT_V
#undef PG8_WAIT_L
#undef PG8_BAR
#undef PG8_SCHED
}
}

#ifndef PG8_SP2
#define PG8_SP2 true
#endif
#ifndef PG8_ALIGN
#define PG8_ALIGN true
#endif
#define GAS __attribute__((address_space(1)))
#define LAS __attribute__((address_space(3)))
typedef unsigned short bf16;
typedef unsigned v4u __attribute__((ext_vector_type(4)));
typedef float f32x4 __attribute__((ext_vector_type(4)));
typedef short bf16x8 __attribute__((ext_vector_type(8)));
typedef GAS unsigned gu32;
typedef GAS unsigned long long gu64;
#define RLX_AGENT __ATOMIC_RELAXED, __HIP_MEMORY_SCOPE_AGENT
#define LDS_WAIT() asm volatile("s_waitcnt lgkmcnt(0)" ::: "memory")
#define VM_WAIT() asm volatile("s_waitcnt vmcnt(0)" ::: "memory")
__device__ __forceinline__ unsigned long long rt() { return __builtin_amdgcn_s_memrealtime(); }
__device__ __forceinline__ unsigned f2bf(float f) { unsigned u = __builtin_bit_cast(unsigned, f); return (u + 0x7fffu + ((u >> 16) & 1u)) >> 16; }
typedef float pk2_f32x2_t __attribute__((ext_vector_type(2))); typedef __bf16 pk2_bf16x2_t __attribute__((ext_vector_type(2)));
__device__ __forceinline__ unsigned pk2(float lo, float hi) { const pk2_f32x2_t v = {lo, hi}; return __builtin_bit_cast(unsigned, __builtin_convertvector(v, pk2_bf16x2_t)); }

#define XB_TMO      128
#define XB_XCNT(j)  (256  + 64 * (j))
#define XB_XSUB(j)  (1280 + 64 * (j))
#define XB_XGEN(j)  (2304 + 64 * (j))
#define XB_TOP      3328
#define XB_TOPGEN   3392
#define XCD_BAR_WORDS 3456
#define XB_SPIN_CAP (1u << 18)

__device__ __forceinline__ unsigned xb_ld(unsigned* p)              { return __hip_atomic_load(p, __ATOMIC_RELAXED, __HIP_MEMORY_SCOPE_AGENT); }
__device__ __forceinline__ unsigned xb_add(unsigned* p, unsigned v) { return __hip_atomic_fetch_add(p, v, __ATOMIC_RELAXED, __HIP_MEMORY_SCOPE_AGENT); }
__device__ __forceinline__ unsigned xb_xcc_id() { return (unsigned)__builtin_amdgcn_s_getreg((3 << 11) | 20) & 0xFu; }
#define XB_SPIN(cond, bar) do { unsigned _sp = 0; while (cond) { __builtin_amdgcn_s_sleep(1); \
    if ((++_sp & 255u) == 0u) { if (xb_ld(&(bar)[XB_TMO])) break; if (_sp > XB_SPIN_CAP) { atomicAdd(&(bar)[XB_TMO], 1u); break; } } } } while (0)

struct XcdBarrier {
    unsigned* bar; unsigned x;
    volatile LAS unsigned* st;
};

__device__ __forceinline__ XcdBarrier xcd_barrier_post(unsigned* bar, volatile LAS unsigned* st) {
    XcdBarrier b; b.bar = bar; b.x = xb_xcc_id(); b.st = st;
    if (threadIdx.x == 0) (void)xb_add(&bar[XB_XCNT(b.x)], 1u);
    return b;
}
__device__ __forceinline__ void xcd_barrier_complete(unsigned* bar, unsigned x, unsigned& nloc, unsigned& nx) {
    const unsigned G = gridDim.x * gridDim.y * gridDim.z;
    unsigned sum, cnt, mine, sp = 0u;
    for (;;) {
        sum = 0u; cnt = 0u; mine = 0u;
#pragma unroll
        for (unsigned j = 0; j < 16; ++j) { const unsigned c = xb_ld(&bar[XB_XCNT(j)]); sum += c; cnt += (c > 0u) ? 1u : 0u; mine = (j == x) ? c : mine; }
        if (sum == G) break;
        __builtin_amdgcn_s_sleep(1);
        if ((++sp & 255u) == 0u) { if (xb_ld(&bar[XB_TMO])) break; if (sp > XB_SPIN_CAP) { atomicAdd(&bar[XB_TMO], 1u); break; } }
    }
    nloc = mine > 0u ? mine : 1u; nx = cnt > 0u ? cnt : 1u;
}

__device__ __forceinline__ void xcd_barrier(const XcdBarrier& b) {
    asm volatile("s_waitcnt vmcnt(0)" ::: "memory");
    __syncthreads();
    if (threadIdx.x == 0) {
        unsigned* bar = b.bar;
        __builtin_amdgcn_s_waitcnt(0);
        unsigned nloc = b.st[0], nx = b.st[1];
        if (nloc == 0u) { xcd_barrier_complete(bar, b.x, nloc, nx); b.st[0] = nloc; b.st[1] = nx; }
        const unsigned old = xb_add(&bar[XB_XSUB(b.x)], 1u);
        const unsigned gen = old / nloc;
        if (old + 1u == (gen + 1u) * nloc) {
            __builtin_amdgcn_fence(__ATOMIC_RELEASE, "agent");
            asm volatile("s_waitcnt vmcnt(0)" ::: "memory");
            const unsigned og = xb_add(&bar[XB_TOP], 1u);
            const unsigned tg = og / nx;
            if (og + 1u == (tg + 1u) * nx) xb_add(&bar[XB_TOPGEN], 1u);
            else XB_SPIN(xb_ld(&bar[XB_TOPGEN]) == tg, bar);
            __builtin_amdgcn_fence(__ATOMIC_ACQUIRE, "agent");
            xb_add(&bar[XB_XGEN(b.x)], 1u);
            asm volatile("s_waitcnt vmcnt(0)" ::: "memory");
        } else {
            XB_SPIN(xb_ld(&bar[XB_XGEN(b.x)]) == gen, bar);
            __builtin_amdgcn_fence(__ATOMIC_ACQUIRE, "agent");
            asm volatile("s_waitcnt vmcnt(0)" ::: "memory");
        }
    }
    __syncthreads();
}

constexpr int NWAVES = 8, NTHREADS = 512;
constexpr int DM = 1024, NB = 4, SEQ = 4096, DEPTH = 2, NTOK = NB * SEQ, NEXP = 16384;
constexpr int DIN = 1952, DINP = 2048;
constexpr float ALPHA = 1.4142135623730951f;
constexpr float LN_EPS = 1e-5f, RMS_EPS = 1e-6f;
constexpr float QSCALE = 0.10206207261596575f * 1.4426950408889634f;
constexpr int NPHASE = 1 + 8 * DEPTH;
constexpr size_t MiB = 1u << 20;
constexpr size_t WS_CTL = 0, CTL_ZERO_BYTES = 64 * 1024;
constexpr size_t WS_WIT = 2 * MiB;
constexpr size_t WS_WQT = 10 * MiB;
constexpr size_t WS_WOT = 18 * MiB;
constexpr size_t WS_WUQT = 22 * MiB;
constexpr size_t WS_WUKVT = 23 * MiB;
constexpr size_t WS_KEYS = 24 * MiB;
constexpr size_t WS_ROPE = 25 * MiB;
constexpr size_t WS_SUV = 26 * MiB;
constexpr size_t WS_UT = 32 * MiB;
constexpr size_t WS_VT = 96 * MiB;
constexpr size_t WS_XB = 160 * MiB;
constexpr size_t WS_HB = 192 * MiB;
constexpr size_t WS_QM = 256 * MiB;
constexpr size_t WS_KM = 280 * MiB;
constexpr size_t WS_VMT = 304 * MiB;
constexpr size_t WS_VST = 320 * MiB;
constexpr size_t WS_OB = 336 * MiB;
constexpr size_t WS_EL = 368 * MiB;
constexpr size_t WS_GL = 376 * MiB;
constexpr size_t WS_END = 384 * MiB;
constexpr int CW_BAR = 1024;
static_assert((CW_BAR + XCD_BAR_WORDS) * 4 <= (int)CTL_ZERO_BYTES, "barrier words inside the memset region");
constexpr int RING_OFF = 0, RING_BYTES = 131072;
constexpr int LDSCTL_OFF = RING_BYTES, MISC_OFF = LDSCTL_OFF + 320;
constexpr int LDS_BYTES = 147456;
static_assert(MISC_OFF + 128 <= LDS_BYTES, "LDS map");

typedef float f32x16 __attribute__((ext_vector_type(16)));
typedef float f32x2 __attribute__((ext_vector_type(2)));
typedef unsigned v2u __attribute__((ext_vector_type(2)));
typedef __bf16 bf2_t __attribute__((ext_vector_type(2)));

struct Args { const float* in[15]; float* out; unsigned char* ws; int ph_lo, ph_hi; };
typedef const __attribute__((address_space(4))) Args* kap_t;
__device__ __forceinline__ kap_t ka_fresh() { kap_t p = (kap_t)__builtin_amdgcn_kernarg_segment_ptr(); asm volatile("" : "+s"(p)); return p; }
enum { I_X = 0, I_WIN, I_GCQ, I_WUQ, I_GCKV, I_WUKV, I_WO, I_LN1G, I_LN1B, I_WQ, I_KEYS, I_U, I_V, I_LN2G, I_LN2B };
struct Frame {
    LAS unsigned char* lds;
    volatile LAS unsigned* MISC;
    int tid, lane, wave, vcu, G;
};
template <class T> __device__ __forceinline__ T* wsp(kap_t ka, size_t off) { return (T*)(ka->ws + off); }

__device__ __forceinline__ float bflo(unsigned w) { return __uint_as_float(w << 16); }
__device__ __forceinline__ float bfhi(unsigned w) { return __uint_as_float(w & 0xffff0000u); }
__device__ __forceinline__ float bf1(short s) { return __uint_as_float(((unsigned)(unsigned short)s) << 16); }
__device__ __forceinline__ int crow(int r, int hi) { return (r & 3) + 8 * (r >> 2) + 4 * hi; }
__device__ __forceinline__ int kperm(int s) { return (s & ~15) | (((s >> 2) & 1) << 3) | (((s >> 3) & 1) << 2) | (s & 3); }
template <int CTRL> __device__ __forceinline__ float dpp_f(float v) { return __builtin_bit_cast(float, __builtin_amdgcn_update_dpp(0, __builtin_bit_cast(int, v), CTRL, 0xF, 0xF, true)); }
__device__ __forceinline__ float wave_sum_all(float v) {
    v += dpp_f<0xB1>(v);
    v += dpp_f<0x4E>(v);
    v += dpp_f<0x141>(v);
    v += dpp_f<0x140>(v);
    v += __shfl_xor(v, 16);
    v += __shfl_xor(v, 32);
    return v;
}
__device__ __forceinline__ int wave_sum_all_i(int v) {
    v += __builtin_amdgcn_update_dpp(0, v, 0xB1, 0xF, 0xF, true); v += __builtin_amdgcn_update_dpp(0, v, 0x4E, 0xF, 0xF, true);
    v += __builtin_amdgcn_update_dpp(0, v, 0x141, 0xF, 0xF, true); v += __builtin_amdgcn_update_dpp(0, v, 0x140, 0xF, 0xF, true);
    v += __shfl_xor(v, 16); v += __shfl_xor(v, 32);
    return v;
}
__device__ __forceinline__ float wave_max_all(float v) {
    v = fmaxf(v, dpp_f<0xB1>(v)); v = fmaxf(v, dpp_f<0x4E>(v)); v = fmaxf(v, dpp_f<0x141>(v)); v = fmaxf(v, dpp_f<0x140>(v));
    v = fmaxf(v, __shfl_xor(v, 16)); v = fmaxf(v, __shfl_xor(v, 32));
    return v;
}
__device__ __forceinline__ bf16x8 pack8(float a0, float a1, float a2, float a3, float a4, float a5, float a6, float a7) {
    v4u w; w.x = pk2(a0, a1); w.y = pk2(a2, a3); w.z = pk2(a4, a5); w.w = pk2(a6, a7); return __builtin_bit_cast(bf16x8, w);
}

__device__ __forceinline__ void p0_transpose_item(const float* W, int K, int N, bf16* WT, const float* gs, LAS float* scr, int item, int lane) {
    const int nblk = N / 32, kb = item / nblk, nb = item % nblk, k0 = 64 * kb, n0 = 32 * nb;
#pragma unroll 8
    for (int i = 0; i < 32; ++i) { const int kk = 2 * i + (lane >> 5); float w = W[(size_t)(k0 + kk) * N + n0 + (lane & 31)]; if (gs) w *= gs[k0 + kk]; scr[kk * 33 + (lane & 31)] = w; }
    LDS_WAIT(); asm volatile("" ::: "memory");
    const int c = lane & 7;
#pragma unroll
    for (int j = 0; j < 4; ++j) { const int n = (lane >> 3) + 8 * j; const LAS float* s = scr + (8 * c) * 33 + n;
        v4u o; o.x = pk2(s[0 * 33], s[1 * 33]); o.y = pk2(s[2 * 33], s[3 * 33]); o.z = pk2(s[4 * 33], s[5 * 33]); o.w = pk2(s[6 * 33], s[7 * 33]);
        *(GAS v4u*)(WT + (size_t)(n0 + n) * K + k0 + 8 * c) = o; }
    LDS_WAIT(); asm volatile("" ::: "memory");
}
__device__ __forceinline__ void cvt8_range(Frame& F, const float* src, bf16* dst, size_t n8) {
    const size_t gt = (size_t)blockIdx.x * NTHREADS + F.tid, nt = (size_t)F.G * NTHREADS;
    for (size_t i = gt; i < n8; i += nt) { const f32x4 a = *(const f32x4*)(src + i * 8), b = *(const f32x4*)(src + i * 8 + 4);
        v4u o; o.x = pk2(a.x, a.y); o.y = pk2(a.z, a.w); o.z = pk2(b.x, b.y); o.w = pk2(b.z, b.w); *(v4u*)(dst + i * 8) = o; }
}
__device__ __forceinline__ void p0_prologue(Frame& F, kap_t ka) {
    LAS float* scr = (LAS float*)(F.lds + RING_OFF + F.wave * 16384);
    const int gw = F.vcu * NWAVES + F.wave, NGW = F.G * NWAVES;
    constexpr int I_IN = 16 * 61, I_Q = 16 * 64, I_O = 16 * 32, I_UQ = 4 * 24, I_UKV = 2 * 32, I_L = I_IN + I_Q + I_O + I_UQ + I_UKV;
    for (int it = gw; it < DEPTH * I_L; it += NGW) {
        const int l = it / I_L; int r = it % I_L;
        if (r < I_IN) { p0_transpose_item(ka->in[I_WIN] + (size_t)l * DM * DIN, DM, DIN, wsp<bf16>(ka, WS_WIT) + (size_t)l * DINP * DM, nullptr, scr, r, F.lane); continue; } r -= I_IN;
        if (r < I_Q) { p0_transpose_item(ka->in[I_WQ] + (size_t)l * DM * 2048, DM, 2048, wsp<bf16>(ka, WS_WQT) + (size_t)l * 2048 * DM, nullptr, scr, r, F.lane); continue; } r -= I_Q;
        if (r < I_O) { p0_transpose_item(ka->in[I_WO] + (size_t)l * DM * DM, DM, DM, wsp<bf16>(ka, WS_WOT) + (size_t)l * DM * DM, nullptr, scr, r, F.lane); continue; } r -= I_O;
        if (r < I_UQ) { p0_transpose_item(ka->in[I_WUQ] + (size_t)l * 256 * 768, 256, 768, wsp<bf16>(ka, WS_WUQT) + (size_t)l * 768 * 256, ka->in[I_GCQ] + l * 256, scr, r, F.lane); continue; } r -= I_UQ;
        p0_transpose_item(ka->in[I_WUKV] + (size_t)l * 128 * 1024, 128, 1024, wsp<bf16>(ka, WS_WUKVT) + (size_t)l * 1024 * 128, ka->in[I_GCKV] + l * 128, scr, r, F.lane);
    }
    const size_t gt = (size_t)blockIdx.x * NTHREADS + F.tid, nt = (size_t)F.G * NTHREADS;
    for (size_t i = gt; i < 2 * 12288; i += nt) { const size_t l = i / 12288, j = i % 12288; *(v4u*)(wsp<bf16>(ka, WS_WIT) + l * DINP * DM + (size_t)DIN * DM + j * 8) = (v4u){0u, 0u, 0u, 0u}; }
    for (size_t i = gt; i < (size_t)SEQ * 16; i += nt) { const int pos = (int)(i >> 4), k = (int)(i & 15);
        const float inv_freq = (float)pow(10000.0, -(double)k / 16.0); const float ang = (float)pos * inv_freq;
        wsp<f32x2>(ka, WS_ROPE)[i] = (f32x2){(float)cos((double)ang), (float)sin((double)ang)}; }
    for (size_t i = gt; i < (size_t)DEPTH * 8 * 2 * 128 * 16; i += nt) {
        const size_t lhc = i >> 11; const int n = (int)(i >> 4) & 127, dg = (int)i & 15;
        const float* src = ka->in[I_KEYS] + i * 8; const f32x4 a = *(const f32x4*)src, b = *(const f32x4*)(src + 4);
        v4u o; o.x = pk2(a.x, a.y); o.y = pk2(a.z, a.w); o.z = pk2(b.x, b.y); o.w = pk2(b.z, b.w);
        *(v4u*)(wsp<bf16>(ka, WS_KEYS) + (lhc * 2048 + (size_t)(((n >> 5) * 8 + (dg >> 1)) * 64 + (dg & 1) * 32 + (n & 31))) * 8) = o;
    }
    cvt8_range(F, ka->in[I_X], wsp<bf16>(ka, WS_XB), (size_t)NTOK * DM / 8);
    {
#ifdef MK_DBG_L0
        constexpr int NL = 1;
#else
        constexpr int NL = DEPTH;
#endif
        unsigned char* UQ = wsp<unsigned char>(ka, WS_UT); unsigned char* VQ = wsp<unsigned char>(ka, WS_VT); float* SUV = wsp<float>(ka, WS_SUV);
        for (int row = gw; row < 2 * NL * NEXP; row += NGW) {
            const int tbl = row / (NL * NEXP), r = row % (NL * NEXP);
            const float* src = (tbl ? ka->in[I_V] : ka->in[I_U]) + (size_t)r * DM + 16 * F.lane;
            f32x4 v[4]; float m = 0.f;
#pragma unroll
            for (int j = 0; j < 4; ++j) { v[j] = *(const f32x4*)(src + 4 * j); m = fmaxf(m, fmaxf(fmaxf(fabsf(v[j].x), fabsf(v[j].y)), fmaxf(fabsf(v[j].z), fabsf(v[j].w)))); }
            m = wave_max_all(m);
            const float inv = m > 0.f ? 127.f / m : 0.f;
            const int off = tbl ? 128 : 0;
            v4u o;
#pragma unroll
            for (int j = 0; j < 4; ++j) {
                const unsigned b0 = (unsigned)((int)rintf(v[j].x * inv) + off) & 0xffu, b1 = (unsigned)((int)rintf(v[j].y * inv) + off) & 0xffu, b2 = (unsigned)((int)rintf(v[j].z * inv) + off) & 0xffu, b3 = (unsigned)((int)rintf(v[j].w * inv) + off) & 0xffu;
                o[j] = b0 | (b1 << 8) | (b2 << 16) | (b3 << 24);
            }
            *(v4u*)((tbl ? VQ : UQ) + (size_t)r * DM + 16 * F.lane) = o;
            if (F.lane == 0) SUV[2 * (size_t)r + tbl] = m * (1.f / 127.f);
        }
    }
}

__device__ __forceinline__ void p2_unit(Frame& F, kap_t ka, int l, int tb, int part) {
    const int lane = F.lane, r32 = lane & 31, hi = lane >> 5;
    const int tok = tb * 32 + r32, b = tok / SEQ, s = tok % SEQ;
    const bf16* hrow = wsp<bf16>(ka, WS_HB) + (size_t)tok * DINP;
    if (part < 2) {
        bf16x8 xf[16]; float ssq = 0.f;
#pragma unroll
        for (int ks = 0; ks < 16; ++ks) { xf[ks] = *(const bf16x8*)(hrow + 1536 + ks * 16 + 8 * hi);
#pragma unroll
            for (int e = 0; e < 8; ++e) { const float v = bf1(xf[ks][e]); ssq += v * v; } }
        ssq += __shfl_xor(ssq, 32);
        const float rstd = rsqrtf(ssq * (1.f / 256.f) + RMS_EPS) * QSCALE;
        const bf16* W = wsp<bf16>(ka, WS_WUQT) + (size_t)l * 768 * 256;
        for (int j = part * 12; j < part * 12 + 12; ++j) {
            const int head = j / 3, sub = j % 3;
            const bf16* wrow = W + (size_t)(j * 32 + r32) * 256 + 8 * hi;
            f32x16 acc = {};
#pragma unroll
            for (int ks = 0; ks < 16; ++ks) acc = __builtin_amdgcn_mfma_f32_32x32x16_bf16(*(const bf16x8*)(wrow + ks * 16), xf[ks], acc, 0, 0, 0);
            float v[16];
#pragma unroll
            for (int r = 0; r < 16; ++r) v[r] = acc[r] * rstd;
            if (sub == 2) {
#pragma unroll
                for (int r = 0; r < 8; ++r) { const f32x2 cs = wsp<f32x2>(ka, WS_ROPE)[s * 16 + crow(r, hi)]; const float x1 = v[r], x2 = v[r + 8]; v[r] = x1 * cs.x - x2 * cs.y; v[r + 8] = x2 * cs.x + x1 * cs.y; }
            }
            bf16* dst = wsp<bf16>(ka, WS_QM) + ((size_t)(b * 8 + head) * SEQ + s) * 96 + sub * 32 + 4 * hi;
#pragma unroll
            for (int g = 0; g < 4; ++g) { v2u w; w.x = pk2(v[4 * g], v[4 * g + 1]); w.y = pk2(v[4 * g + 2], v[4 * g + 3]); *(v2u*)(dst + 8 * g) = w; }
        }
    } else {
        const int h0 = (part - 2) * 4;
        bf16x8 xf[8]; float ssq = 0.f;
#pragma unroll
        for (int ks = 0; ks < 8; ++ks) { xf[ks] = *(const bf16x8*)(hrow + 1792 + ks * 16 + 8 * hi);
#pragma unroll
            for (int e = 0; e < 8; ++e) { const float v = bf1(xf[ks][e]); ssq += v * v; } }
        ssq += __shfl_xor(ssq, 32);
        const float rstd = rsqrtf(ssq * (1.f / 128.f) + RMS_EPS);
        const bf16* W = wsp<bf16>(ka, WS_WUKVT) + (size_t)l * 1024 * 128;
        const int sp = kperm(s);
        for (int j = h0 * 4; j < h0 * 4 + 16; ++j) {
            const int head = j >> 2, sub = j & 3;
            const bf16* wrow = W + (size_t)(j * 32 + r32) * 128 + 8 * hi;
            f32x16 acc = {};
#pragma unroll
            for (int ks = 0; ks < 8; ++ks) acc = __builtin_amdgcn_mfma_f32_32x32x16_bf16(*(const bf16x8*)(wrow + ks * 16), xf[ks], acc, 0, 0, 0);
            if (sub < 2) {
                bf16* dst = wsp<bf16>(ka, WS_KM) + (size_t)(b * 8 + head) * SEQ * 96 + (size_t)(s >> 5) * (6 * 512) + (size_t)r32 * 8 + 4 * hi;
#pragma unroll
                for (int g = 0; g < 4; ++g) { v2u w; w.x = pk2(acc[4 * g] * rstd, acc[4 * g + 1] * rstd); w.y = pk2(acc[4 * g + 2] * rstd, acc[4 * g + 3] * rstd); *(v2u*)(dst + (2 * sub + (g >> 1)) * 512 + (g & 1) * 256) = w; }
            } else {
                bf16* dst = wsp<bf16>(ka, WS_VMT) + (size_t)(b * 8 + head) * 64 * SEQ + (size_t)(s >> 5) * (4 * 512) + ((sub - 2) * 2 + ((s >> 4) & 1)) * 512 + ((sp >> 3) & 1) * 256 + (sp & 7);
#pragma unroll
                for (int r = 0; r < 16; ++r) dst[crow(r, hi) * 8] = (bf16)f2bf(acc[r] * rstd);
            }
        }
        { const bf16x8 a1 = *(const bf16x8*)(hrow + 1920 + 8 * hi), a2 = *(const bf16x8*)(hrow + 1936 + 8 * hi);
          float o1[8], o2[8];
#pragma unroll
          for (int e = 0; e < 8; ++e) { const f32x2 cs = wsp<f32x2>(ka, WS_ROPE)[s * 16 + 8 * hi + e]; const float x1 = bf1(a1[e]), x2 = bf1(a2[e]); o1[e] = x1 * cs.x - x2 * cs.y; o2[e] = x2 * cs.x + x1 * cs.y; }
          const bf16x8 p1 = pack8(o1[0], o1[1], o1[2], o1[3], o1[4], o1[5], o1[6], o1[7]), p2 = pack8(o2[0], o2[1], o2[2], o2[3], o2[4], o2[5], o2[6], o2[7]);
#pragma unroll
          for (int hh = 0; hh < 4; ++hh) { bf16* dst = wsp<bf16>(ka, WS_KM) + (size_t)(b * 8 + h0 + hh) * SEQ * 96 + (size_t)(s >> 5) * (6 * 512) + 4 * 512 + hi * 256 + (size_t)r32 * 8; *(bf16x8*)dst = p1; *(bf16x8*)(dst + 512) = p2; } }
#pragma unroll
        for (int hh = 0; hh < 4; ++hh) {
            const int head = h0 + hh;
#pragma unroll
            for (int c4 = 0; c4 < 4; ++c4) { const bf16x8 a = *(const bf16x8*)(hrow + 1024 + head * 64 + 32 * hi + c4 * 8);
                bf16* dst = wsp<bf16>(ka, WS_VST) + ((size_t)(b * 8 + head) * 64 + 32 * hi + c4 * 8) * SEQ + sp;
#pragma unroll
                for (int e = 0; e < 8; ++e) dst[(size_t)e * SEQ] = (bf16)a[e]; }
        }
    }
}

__device__ __forceinline__ float xhalf_max(float v) { auto rr = __builtin_amdgcn_permlane32_swap(__float_as_uint(v), __float_as_uint(v), false, false); return fmaxf(__uint_as_float(rr[0]), __uint_as_float(rr[1])); }
__device__ __forceinline__ float xhalf_sum(float v) { auto rr = __builtin_amdgcn_permlane32_swap(__float_as_uint(v), __float_as_uint(v), false, false); return __uint_as_float(rr[0]) + __uint_as_float(rr[1]); }
constexpr float MLA_THR = 8.f;
__device__ __forceinline__ void mla_unit(Frame& F, kap_t ka, int bh, int qb) {
    const int lane = F.lane, r32 = lane & 31, hi = lane >> 5, q0 = qb * 32;
    const bf16* Qp = wsp<bf16>(ka, WS_QM) + ((size_t)bh * SEQ + q0 + r32) * 96 + 8 * hi;
    bf16x8 qf[6];
#pragma unroll
    for (int ks = 0; ks < 6; ++ks) qf[ks] = *(const bf16x8*)(Qp + ks * 16);
    f32x16 o0 = {}, o1 = {};
    float m = -1e30f, l = 0.f;
    const bf16* Kp = wsp<bf16>(ka, WS_KM) + (size_t)bh * SEQ * 96 + 8 * lane;
    const bf16* Vp = wsp<bf16>(ka, WS_VMT) + (size_t)bh * 64 * SEQ + 8 * lane;
#define MLA_LOADK(KF, kt) do { _Pragma("unroll") for (int ks = 0; ks < 6; ++ks) KF[ks] = *(const bf16x8*)(Kp + (size_t)((kt) * 6 + ks) * 512); } while (0)
#define MLA_LOADV(VF, kt) do { _Pragma("unroll") for (int i = 0; i < 4; ++i) VF[i] = *(const bf16x8*)(Vp + (size_t)((kt) * 4 + i) * 512); } while (0)
#define MLA_QK(S, KF) do { S = (f32x16){}; _Pragma("unroll") for (int ks = 0; ks < 6; ++ks) S = __builtin_amdgcn_mfma_f32_32x32x16_bf16(KF[ks], qf[ks], S, 0, 0, 0); } while (0)
#define MLA_SMPV(S, VF, kt) do { \
        if ((kt) == qb) { _Pragma("unroll") for (int r = 0; r < 16; ++r) if (crow(r, hi) > r32) S[r] = -1e30f; } \
        float mx = fmaxf(fmaxf(S[0], S[1]), fmaxf(S[2], S[3])); \
        _Pragma("unroll") for (int r = 4; r < 16; r += 4) mx = fmaxf(mx, fmaxf(fmaxf(S[r], S[r + 1]), fmaxf(S[r + 2], S[r + 3]))); \
        mx = xhalf_max(mx); \
        if (__any(mx - m > MLA_THR)) { const float mn = fmaxf(m, mx), alpha = __builtin_amdgcn_exp2f(m - mn); l *= alpha; m = mn; \
            _Pragma("unroll") for (int r = 0; r < 16; ++r) { o0[r] *= alpha; o1[r] *= alpha; } } \
        float p[16], rs0 = 0.f, rs1 = 0.f; \
        _Pragma("unroll") for (int r = 0; r < 16; r += 2) { p[r] = __builtin_amdgcn_exp2f(S[r] - m); p[r + 1] = __builtin_amdgcn_exp2f(S[r + 1] - m); rs0 += p[r]; rs1 += p[r + 1]; } \
        l += rs0 + rs1; \
        const bf16x8 pf0 = pack8(p[0], p[1], p[2], p[3], p[4], p[5], p[6], p[7]), pf1 = pack8(p[8], p[9], p[10], p[11], p[12], p[13], p[14], p[15]); \
        o0 = __builtin_amdgcn_mfma_f32_32x32x16_bf16(VF[0], pf0, o0, 0, 0, 0); \
        o1 = __builtin_amdgcn_mfma_f32_32x32x16_bf16(VF[2], pf0, o1, 0, 0, 0); \
        o0 = __builtin_amdgcn_mfma_f32_32x32x16_bf16(VF[1], pf1, o0, 0, 0, 0); \
        o1 = __builtin_amdgcn_mfma_f32_32x32x16_bf16(VF[3], pf1, o1, 0, 0, 0); } while (0)
    bf16x8 kA[6], kB[6], vA[4], vB[4];
    f32x16 sA, sB;
    MLA_LOADK(kA, 0); MLA_LOADV(vA, 0); MLA_LOADK(kB, 1);
    MLA_QK(sA, kA);
    for (int kt = 0; kt <= qb; kt += 2) {
        MLA_LOADK(kA, kt + 2); MLA_LOADV(vB, kt + 1);
        MLA_QK(sB, kB);
        MLA_SMPV(sA, vA, kt);
        if (kt + 1 > qb) break;
        MLA_LOADK(kB, kt + 3); MLA_LOADV(vA, kt + 2);
        MLA_QK(sA, kA);
        MLA_SMPV(sB, vB, kt + 1);
    }
#undef MLA_LOADK
#undef MLA_LOADV
#undef MLA_QK
#undef MLA_SMPV
    l = xhalf_sum(l);
    const float rl = 1.f / l;
    const int b = bh >> 3, h = bh & 7;
    bf16* dst = wsp<bf16>(ka, WS_OB) + ((size_t)b * SEQ + q0 + r32) * DM + 512 + h * 64 + 4 * hi;
#pragma unroll
    for (int g = 0; g < 4; ++g) {
        v2u w; w.x = pk2(o0[4 * g] * rl, o0[4 * g + 1] * rl); w.y = pk2(o0[4 * g + 2] * rl, o0[4 * g + 3] * rl); *(v2u*)(dst + 8 * g) = w;
        v2u u; u.x = pk2(o1[4 * g] * rl, o1[4 * g + 1] * rl); u.y = pk2(o1[4 * g + 2] * rl, o1[4 * g + 3] * rl); *(v2u*)(dst + 32 + 8 * g) = u;
    }
}

__device__ __forceinline__ void mla_block(Frame& F, kap_t ka, int bh, int J) {
    const int tid = F.tid, lane = F.lane, r32 = lane & 31, hi = lane >> 5, wave = F.wave;
    const int qb = 8 * J + wave, q0 = qb * 32, T = 8 * J + 8;
    const bf16* Qp = wsp<bf16>(ka, WS_QM) + ((size_t)bh * SEQ + q0 + r32) * 96 + 8 * hi;
    bf16x8 qf[6];
#pragma unroll
    for (int ks = 0; ks < 6; ++ks) qf[ks] = *(const bf16x8*)(Qp + ks * 16);
    f32x16 o0 = {}, o1 = {};
    float m = -1e30f, l = 0.f;
    const unsigned char* Kt = (const unsigned char*)(wsp<bf16>(ka, WS_KM) + (size_t)bh * SEQ * 96);
    const unsigned char* Vt = (const unsigned char*)(wsp<bf16>(ka, WS_VMT) + (size_t)bh * 64 * SEQ);
    LAS unsigned char* ring = F.lds + RING_OFF;
    const bool c0k = tid < 384;
    const size_t off0 = c0k ? (size_t)tid * 16 : (size_t)(tid - 384) * 16, off1 = (size_t)(128 + tid) * 16;
#define MB_GLOAD(t) do { r0 = *(const v4u*)((c0k ? Kt + (size_t)(t) * 6144 : Vt + (size_t)(t) * 4096) + off0); if (tid < 128) r1 = *(const v4u*)(Vt + (size_t)(t) * 4096 + off1); } while (0)
#define MB_LWRITE(s) do { *(LAS v4u*)(ring + (s) * 10240 + tid * 16) = r0; if (tid < 128) *(LAS v4u*)(ring + (s) * 10240 + 8192 + tid * 16) = r1; } while (0)
    v4u r0 = {}, r1 = {};
    MB_GLOAD(0); MB_LWRITE(0);
    if (T > 1) MB_GLOAD(1);
    for (int t = 0; t < T; ++t) {
        __syncthreads();
        const bool active = t <= qb;
        bf16x8 kf[6], vf[4];
        if (active) { const LAS unsigned char* sl = ring + (t & 1) * 10240 + lane * 16;
#pragma unroll
            for (int ks = 0; ks < 6; ++ks) kf[ks] = *(const LAS bf16x8*)(sl + ks * 1024);
#pragma unroll
            for (int i = 0; i < 4; ++i) vf[i] = *(const LAS bf16x8*)(sl + 6144 + i * 1024); }
        if (t + 1 < T) MB_LWRITE((t + 1) & 1);
        if (t + 2 < T) MB_GLOAD(t + 2);
        if (active) {
            f32x16 sa = {};
#pragma unroll
            for (int ks = 0; ks < 6; ++ks) sa = __builtin_amdgcn_mfma_f32_32x32x16_bf16(kf[ks], qf[ks], sa, 0, 0, 0);
            if (t == qb) {
#pragma unroll
                for (int r = 0; r < 16; ++r) if (crow(r, hi) > r32) sa[r] = -1e30f;
            }
            float mx = fmaxf(fmaxf(sa[0], sa[1]), fmaxf(sa[2], sa[3]));
#pragma unroll
            for (int r = 4; r < 16; r += 4) mx = fmaxf(mx, fmaxf(fmaxf(sa[r], sa[r + 1]), fmaxf(sa[r + 2], sa[r + 3])));
            mx = xhalf_max(mx);
            if (__any(mx - m > MLA_THR)) { const float mn = fmaxf(m, mx), alpha = __builtin_amdgcn_exp2f(m - mn); l *= alpha; m = mn;
#pragma unroll
                for (int r = 0; r < 16; ++r) { o0[r] *= alpha; o1[r] *= alpha; } }
            float p[16], rs = 0.f;
#pragma unroll
            for (int r = 0; r < 16; ++r) { p[r] = __builtin_amdgcn_exp2f(sa[r] - m); rs += p[r]; }
            l += rs;
            const bf16x8 pf0 = pack8(p[0], p[1], p[2], p[3], p[4], p[5], p[6], p[7]), pf1 = pack8(p[8], p[9], p[10], p[11], p[12], p[13], p[14], p[15]);
            o0 = __builtin_amdgcn_mfma_f32_32x32x16_bf16(vf[0], pf0, o0, 0, 0, 0);
            o0 = __builtin_amdgcn_mfma_f32_32x32x16_bf16(vf[1], pf1, o0, 0, 0, 0);
            o1 = __builtin_amdgcn_mfma_f32_32x32x16_bf16(vf[2], pf0, o1, 0, 0, 0);
            o1 = __builtin_amdgcn_mfma_f32_32x32x16_bf16(vf[3], pf1, o1, 0, 0, 0);
        }
    }
#undef MB_GLOAD
#undef MB_LWRITE
    __syncthreads();
    l = xhalf_sum(l);
    const float rl = 1.f / l;
    const int b = bh >> 3, h = bh & 7;
    bf16* dst = wsp<bf16>(ka, WS_OB) + ((size_t)b * SEQ + q0 + r32) * DM + 512 + h * 64 + 4 * hi;
#pragma unroll
    for (int g = 0; g < 4; ++g) {
        v2u w; w.x = pk2(o0[4 * g] * rl, o0[4 * g + 1] * rl); w.y = pk2(o0[4 * g + 2] * rl, o0[4 * g + 3] * rl); *(v2u*)(dst + 8 * g) = w;
        v2u u; u.x = pk2(o1[4 * g] * rl, o1[4 * g + 1] * rl); u.y = pk2(o1[4 * g + 2] * rl, o1[4 * g + 3] * rl); *(v2u*)(dst + 32 + 8 * g) = u;
    }
}

__device__ __forceinline__ void sb_unit(Frame& F, kap_t ka, int bh, int qb) {
    const int lane = F.lane, r32 = lane & 31, hi = lane >> 5, q0 = qb * 32;
    const int b = bh >> 3, h = bh & 7;
    const bf16* Hb = wsp<bf16>(ka, WS_HB) + (size_t)b * SEQ * DINP + h * 64 + 8 * hi;
    bf16x8 qf[4];
#pragma unroll
    for (int ks = 0; ks < 4; ++ks) qf[ks] = *(const bf16x8*)(Hb + (size_t)(q0 + r32) * DINP + ks * 16);
    f32x16 o0 = {}, o1 = {};
    float R = 0.f;
    const bf16* Vp = wsp<bf16>(ka, WS_VST) + ((size_t)bh * 64 + r32) * SEQ + 8 * hi;
    for (int k0 = q0; k0 >= 0; k0 -= 32) {
        bf16x8 kf[4], vf[4];
#pragma unroll
        for (int ks = 0; ks < 4; ++ks) kf[ks] = *(const bf16x8*)(Hb + (size_t)(k0 + r32) * DINP + 512 + ks * 16);
#pragma unroll
        for (int i = 0; i < 4; ++i) vf[i] = *(const bf16x8*)(Vp + (size_t)(i >> 1) * 32 * SEQ + k0 + 16 * (i & 1));
        f32x16 za = {};
#pragma unroll
        for (int ks = 0; ks < 4; ++ks) za = __builtin_amdgcn_mfma_f32_32x32x16_bf16(kf[ks], qf[ks], za, 0, 0, 0);
        const bool diag = (k0 == q0);
        float L[16], lw[16];
#pragma unroll
        for (int r = 0; r < 16; ++r) {
            const float z = za[r] * 0.125f;
            const float sp = fmaxf(z, 0.f) + __logf(1.f + __expf(-fabsf(z)));
            const bool valid = !diag || (crow(r, hi) < r32);
            L[r] = valid ? -sp : 0.f;
            lw[r] = valid ? (z - sp) : -1e30f;
        }
        float e[16], T[4], U[4];
#pragma unroll
        for (int g = 0; g < 4; ++g) { e[4 * g + 3] = 0.f; e[4 * g + 2] = L[4 * g + 3]; e[4 * g + 1] = e[4 * g + 2] + L[4 * g + 2]; e[4 * g] = e[4 * g + 1] + L[4 * g + 1]; T[g] = e[4 * g] + L[4 * g]; }
#pragma unroll
        for (int g = 0; g < 4; ++g) U[g] = __shfl_xor(T[g], 32);
        float sT[4], sUge[4];
        sT[3] = 0.f; sT[2] = T[3]; sT[1] = T[3] + T[2]; sT[0] = sT[1] + T[1];
        sUge[3] = U[3]; sUge[2] = U[3] + U[2]; sUge[1] = sUge[2] + U[1]; sUge[0] = sUge[1] + U[0];
        float w[16];
#pragma unroll
        for (int g = 0; g < 4; ++g) {
            const float sfx = R + sT[g] + (hi ? (sUge[g] - U[g]) : sUge[g]);
#pragma unroll
            for (int i = 0; i < 4; ++i) w[4 * g + i] = __expf(lw[4 * g + i] + sfx + e[4 * g + i]);
        }
        R += (sT[0] + T[0]) + sUge[0];
        const bf16x8 pf0 = pack8(w[0], w[1], w[2], w[3], w[4], w[5], w[6], w[7]), pf1 = pack8(w[8], w[9], w[10], w[11], w[12], w[13], w[14], w[15]);
        o0 = __builtin_amdgcn_mfma_f32_32x32x16_bf16(vf[0], pf0, o0, 0, 0, 0);
        o0 = __builtin_amdgcn_mfma_f32_32x32x16_bf16(vf[1], pf1, o0, 0, 0, 0);
        o1 = __builtin_amdgcn_mfma_f32_32x32x16_bf16(vf[2], pf0, o1, 0, 0, 0);
        o1 = __builtin_amdgcn_mfma_f32_32x32x16_bf16(vf[3], pf1, o1, 0, 0, 0);
        if (__all(R < -88.f)) break;
    }
    bf16* dst = wsp<bf16>(ka, WS_OB) + ((size_t)b * SEQ + q0 + r32) * DM + h * 64 + 4 * hi;
#pragma unroll
    for (int g = 0; g < 4; ++g) {
        v2u wv; wv.x = pk2(o0[4 * g], o0[4 * g + 1]); wv.y = pk2(o0[4 * g + 2], o0[4 * g + 3]); *(v2u*)(dst + 8 * g) = wv;
        v2u u; u.x = pk2(o1[4 * g], o1[4 * g + 1]); u.y = pk2(o1[4 * g + 2], o1[4 * g + 3]); *(v2u*)(dst + 32 + 8 * g) = u;
    }
}

__device__ __forceinline__ void ln1_row(Frame& F, kap_t ka, int row, const float* g, const float* bb) {
    float* yr = ka->out + (size_t)row * DM;
    f32x4 v[4]; float s = 0.f;
#pragma unroll
    for (int j = 0; j < 4; ++j) { v[j] = *(const f32x4*)(yr + 4 * F.lane + 256 * j); s += (v[j].x + v[j].y) + (v[j].z + v[j].w); }
    const float mean = wave_sum_all(s) * (1.f / DM); float s2 = 0.f;
#pragma unroll
    for (int j = 0; j < 4; ++j) { v[j] = v[j] - mean; s2 += (v[j].x * v[j].x + v[j].y * v[j].y) + (v[j].z * v[j].z + v[j].w * v[j].w); }
    const float rstd = rsqrtf(wave_sum_all(s2) * (1.f / DM) + LN_EPS);
#pragma unroll
    for (int j = 0; j < 4; ++j) { const int c = 4 * F.lane + 256 * j; const f32x4 gg = *(const f32x4*)(g + c), bv = *(const f32x4*)(bb + c);
        const f32x4 o = v[j] * rstd * gg + bv; *(f32x4*)(yr + c) = o;
        v2u w; w.x = pk2(o.x, o.y); w.y = pk2(o.z, o.w); *(v2u*)(wsp<bf16>(ka, WS_XB) + (size_t)row * DM + c) = w; }
}

template <int N, int K, int J, bool FLIP> __device__ __forceinline__ void bitonic_stage(unsigned (&v)[N]) {
#pragma unroll
    for (int i = 0; i < N; ++i) { const int p = i ^ J; if (p > i) { const bool desc = (((i & K) == 0) != FLIP); const unsigned a = v[i], c = v[p]; const unsigned mx = a > c ? a : c, mn = a > c ? c : a; v[i] = desc ? mx : mn; v[p] = desc ? mn : mx; } }
}
template <bool FLIP> __device__ __forceinline__ void bitonic_merge16(unsigned (&v)[16]) {
    bitonic_stage<16, 16, 8, FLIP>(v); bitonic_stage<16, 16, 4, FLIP>(v); bitonic_stage<16, 16, 2, FLIP>(v); bitonic_stage<16, 16, 1, FLIP>(v);
}
__device__ __forceinline__ unsigned ord_key(float f, unsigned idx) { const unsigned u = __float_as_uint(f); const unsigned o = u ^ ((unsigned)((int)u >> 31) | 0x80000000u); return (o & 0xFFFFFF80u) | idx; }
__device__ __forceinline__ float key_val(unsigned k) { const unsigned o = (k & 0xFFFFFF80u) | 0x40u; const unsigned u = (o & 0x80000000u) ? (o ^ 0x80000000u) : ~o; return __uint_as_float(u); }
template <int N, int K, int J, bool FLIP> __device__ __forceinline__ void bitonic_stage_kv(unsigned (&k)[N], unsigned (&p)[N]) {
#pragma unroll
    for (int i = 0; i < N; ++i) { const int q = i ^ J; if (q > i) { const bool desc = (((i & K) == 0) != FLIP); const bool sw = desc ? (k[i] < k[q]) : (k[i] > k[q]);
        const unsigned ki = sw ? k[q] : k[i], kq = sw ? k[i] : k[q], pi = sw ? p[q] : p[i], pq = sw ? p[i] : p[q]; k[i] = ki; k[q] = kq; p[i] = pi; p[q] = pq; } }
}
template <bool FLIP> __device__ __forceinline__ void bitonic_merge16_kv(unsigned (&k)[16], unsigned (&p)[16]) {
    bitonic_stage_kv<16, 16, 8, FLIP>(k, p); bitonic_stage_kv<16, 16, 4, FLIP>(k, p); bitonic_stage_kv<16, 16, 2, FLIP>(k, p); bitonic_stage_kv<16, 16, 1, FLIP>(k, p);
}
__device__ __forceinline__ void p7_half(Frame& F, kap_t ka, int l, int tok, int h, int c, unsigned (&Cc)[16]) {
    const int lane = F.lane, hi = lane >> 5;
    const bf16* qrow = wsp<bf16>(ka, WS_HB) + (size_t)tok * 2048 + h * 256 + c * 128 + 8 * hi;
    bf16x8 qf[8];
#pragma unroll
    for (int ks = 0; ks < 8; ++ks) qf[ks] = *(const bf16x8*)(qrow + ks * 16);
    const bf16* kb = wsp<bf16>(ka, WS_KEYS) + (size_t)((l * 8 + h) * 2 + c) * 16384 + 8 * lane;
    unsigned key[64];
#pragma unroll
    for (int ch = 0; ch < 4; ++ch) {
        f32x16 acc = {};
#pragma unroll
        for (int ks = 0; ks < 8; ++ks) acc = __builtin_amdgcn_mfma_f32_32x32x16_bf16(*(const bf16x8*)(kb + (ch * 8 + ks) * 512), qf[ks], acc, 0, 0, 0);
#pragma unroll
        for (int r = 0; r < 16; ++r) key[ch * 16 + r] = ord_key(acc[r], (unsigned)(ch * 32 + crow(r, hi)));
    }
    bitonic_stage<64, 2, 1, false>(key);
    bitonic_stage<64, 4, 2, false>(key); bitonic_stage<64, 4, 1, false>(key);
    bitonic_stage<64, 8, 4, false>(key); bitonic_stage<64, 8, 2, false>(key); bitonic_stage<64, 8, 1, false>(key);
    bitonic_stage<64, 16, 8, false>(key); bitonic_stage<64, 16, 4, false>(key); bitonic_stage<64, 16, 2, false>(key); bitonic_stage<64, 16, 1, false>(key);
    unsigned A[16], B[16];
#pragma unroll
    for (int i = 0; i < 16; ++i) { A[i] = key[i] > key[16 + i] ? key[i] : key[16 + i]; B[i] = key[32 + i] > key[48 + i] ? key[32 + i] : key[48 + i]; }
    bitonic_merge16<false>(A);
    bitonic_merge16<true>(B);
#pragma unroll
    for (int i = 0; i < 16; ++i) A[i] = A[i] > B[i] ? A[i] : B[i];
    bitonic_merge16<false>(A);
#pragma unroll
    for (int i = 0; i < 16; ++i) B[i] = (unsigned)__shfl_xor((int)A[i], 32);
#pragma unroll
    for (int i = 0; i < 16; ++i) Cc[i] = A[i] > B[15 - i] ? A[i] : B[15 - i];
    bitonic_merge16<false>(Cc);
}
__device__ __forceinline__ void p7_unit(Frame& F, kap_t ka, int l, int tb, int h) {
    const int lane = F.lane, r32 = lane & 31, hi = lane >> 5;
    const int tok = tb * 32 + r32;
    unsigned L0[16], L1[16];
#pragma unroll
    for (int i = 0; i < 16; ++i) { L0[i] = 0u; L1[i] = 0u; }
#pragma unroll 1
    for (int c = 0; c < 2; ++c) {
        unsigned Cc[16];
        p7_half(F, ka, l, tok, h, c, Cc);
#pragma unroll
        for (int i = 0; i < 16; ++i) { L0[i] = c == 0 ? Cc[i] : L0[i]; L1[i] = c == 0 ? L1[i] : Cc[i]; }
    }
    __builtin_amdgcn_sched_barrier(0);
    unsigned key[64];
    {
        float v0[16], v1[16];
#pragma unroll
        for (int i = 0; i < 16; ++i) { v0[i] = key_val(L0[i]); v1[i] = key_val(L1[i]); }
#define P7_ROW(a, off, nb) { _Pragma("unroll") for (int b2 = 0; b2 < (nb); ++b2) { \
            const float sum = v0[a] + v1[b2]; const unsigned u = __float_as_uint(sum); const unsigned o = u ^ ((unsigned)((int)u >> 31) | 0x80000000u); \
            key[(off) + b2] = (o & 0xFFFFFF00u) | (unsigned)(255 - (16 * (a) + b2)); } }
        P7_ROW(0, 0, 16) P7_ROW(1, 16, 8) P7_ROW(2, 24, 5) P7_ROW(3, 29, 4) P7_ROW(4, 33, 3) P7_ROW(5, 36, 2) P7_ROW(6, 38, 2) P7_ROW(7, 40, 2)
        P7_ROW(8, 42, 1) P7_ROW(9, 43, 1) P7_ROW(10, 44, 1) P7_ROW(11, 45, 1) P7_ROW(12, 46, 1) P7_ROW(13, 47, 1) P7_ROW(14, 48, 1) P7_ROW(15, 49, 1)
#undef P7_ROW
#pragma unroll
        for (int i = 50; i < 64; ++i) key[i] = 0u;
    }
    LAS unsigned char* slot = F.lds + RING_OFF + F.wave * 2304 + lane * 36;
#pragma unroll
    for (int q = 0; q < 4; ++q) {
        ((LAS unsigned*)slot)[q] = (L0[4 * q] & 127u) | ((L0[4 * q + 1] & 127u) << 8) | ((L0[4 * q + 2] & 127u) << 16) | ((L0[4 * q + 3] & 127u) << 24);
        ((LAS unsigned*)slot)[4 + q] = (L1[4 * q] & 127u) | ((L1[4 * q + 1] & 127u) << 8) | ((L1[4 * q + 2] & 127u) << 16) | ((L1[4 * q + 3] & 127u) << 24);
    }
    bitonic_stage<64, 2, 1, false>(key);
    bitonic_stage<64, 4, 2, false>(key); bitonic_stage<64, 4, 1, false>(key);
    bitonic_stage<64, 8, 4, false>(key); bitonic_stage<64, 8, 2, false>(key); bitonic_stage<64, 8, 1, false>(key);
    bitonic_stage<64, 16, 8, false>(key); bitonic_stage<64, 16, 4, false>(key); bitonic_stage<64, 16, 2, false>(key); bitonic_stage<64, 16, 1, false>(key);
    unsigned A[16], B[16];
#pragma unroll
    for (int i = 0; i < 16; ++i) { A[i] = key[i] > key[16 + i] ? key[i] : key[16 + i]; B[i] = key[32 + i] > key[48 + i] ? key[32 + i] : key[48 + i]; }
    bitonic_merge16<false>(A);
    bitonic_merge16<true>(B);
#pragma unroll
    for (int i = 0; i < 16; ++i) A[i] = A[i] > B[i] ? A[i] : B[i];
    bitonic_merge16<false>(A);
    LDS_WAIT(); asm volatile("" ::: "memory");
    unsigned PA[16]; float g[16], den = 0.f;
    { const unsigned o0 = (A[0] & 0xFFFFFF00u) | 128u; const float m = __uint_as_float((o0 & 0x80000000u) ? (o0 ^ 0x80000000u) : ~o0);
#pragma unroll
      for (int i = 0; i < 16; ++i) { const unsigned o = (A[i] & 0xFFFFFF00u) | 128u; const float sv = __uint_as_float((o & 0x80000000u) ? (o ^ 0x80000000u) : ~o); g[i] = __expf(sv - m); den += g[i];
          const unsigned flat = 255u - (A[i] & 255u); PA[i] = (unsigned)slot[flat >> 4] * 128u + (unsigned)slot[16 + (flat & 15u)]; } }
    LDS_WAIT(); asm volatile("" ::: "memory");
    const float rden = 1.f / den;
    if (hi == 0) {
        unsigned* de = wsp<unsigned>(ka, WS_EL) + (size_t)tok * 128 + h * 16; float* dg = wsp<float>(ka, WS_GL) + (size_t)tok * 128 + h * 16;
#pragma unroll
        for (int q = 0; q < 4; ++q) { *(v4u*)(de + 4 * q) = (v4u){PA[4 * q], PA[4 * q + 1], PA[4 * q + 2], PA[4 * q + 3]};
            *(f32x4*)(dg + 4 * q) = (f32x4){g[4 * q] * rden, g[4 * q + 1] * rden, g[4 * q + 2] * rden, g[4 * q + 3] * rden}; }
    }
}

__device__ __forceinline__ float dot2_bf16(unsigned w, unsigned x, float acc) { return __builtin_amdgcn_fdot2_f32_bf16(__builtin_bit_cast(bf2_t, w), __builtin_bit_cast(bf2_t, x), acc, false); }
__device__ __forceinline__ float gelu_erf(float x) { return 0.5f * x * (1.f + erff(x * 0.70710678118654752f)); }
__device__ __forceinline__ void p8_token(Frame& F, kap_t ka, int l, int tok, const unsigned ev0, const unsigned ev1, const float gv0, const float gv1) {
    const int lane = F.lane;
#ifdef MK_DBG_L0
    unsigned char* dbg_ws = ka->ws;
    ((float*)(dbg_ws + 86 * MiB))[(size_t)tok * 128 + lane] = (float)ev0; ((float*)(dbg_ws + 86 * MiB))[(size_t)tok * 128 + 64 + lane] = (float)ev1;
    ((float*)(dbg_ws + 128 * MiB))[(size_t)tok * 128 + lane] = gv0; ((float*)(dbg_ws + 128 * MiB))[(size_t)tok * 128 + 64 + lane] = gv1;
#endif
    float* xrow = ka->out + (size_t)tok * DM + 16 * lane;
    f32x4 xv[4];
#pragma unroll
    for (int j = 0; j < 4; ++j) xv[j] = *(const f32x4*)(xrow + 4 * j);
    const f32x2* SUV = wsp<f32x2>(ka, WS_SUV) + (size_t)l * NEXP;
    const f32x2 sc0 = SUV[ev0], sc1 = SUV[ev1];
    float xr[16]; float xm = 0.f;
#pragma unroll
    for (int j = 0; j < 4; ++j) { const f32x4 a = xv[j]; xr[4 * j] = a.x; xr[4 * j + 1] = a.y; xr[4 * j + 2] = a.z; xr[4 * j + 3] = a.w;
        xm = fmaxf(xm, fmaxf(fmaxf(fabsf(a.x), fabsf(a.y)), fmaxf(fabsf(a.z), fabsf(a.w)))); }
    xm = wave_max_all(xm);
    const float sx = xm * (1.f / 127.f), invx = xm > 0.f ? 127.f / xm : 0.f;
    int xq[4];
#pragma unroll
    for (int j = 0; j < 4; ++j) xq[j] = (int)(((unsigned)(int)rintf(xr[4 * j] * invx) & 0xffu) | (((unsigned)(int)rintf(xr[4 * j + 1] * invx) & 0xffu) << 8) | (((unsigned)(int)rintf(xr[4 * j + 2] * invx) & 0xffu) << 16) | (((unsigned)(int)rintf(xr[4 * j + 3] * invx) & 0xffu) << 24));
    float acc[16];
#pragma unroll
    for (int i = 0; i < 16; ++i) acc[i] = 0.f;
    const unsigned char* UQ = wsp<unsigned char>(ka, WS_UT) + (size_t)l * NEXP * DM + 16 * lane;
    const unsigned char* VQ = wsp<unsigned char>(ka, WS_VT) + (size_t)l * NEXP * DM + 16 * lane;
    constexpr int PB = 8, NBH = 64 / PB;
    v4u A[PB], B[PB];
    int hqc = 0, hq0 = 0;
#define P8_LOAD(BUF, TAB, bb) do { const unsigned evs_ = (bb) < NBH ? ev0 : ev1; _Pragma("unroll") for (int j = 0; j < PB; ++j) { \
        const unsigned e_ = (unsigned)__builtin_amdgcn_readlane((int)evs_, (PB * (bb) + j) & 63); BUF[j] = *(const v4u*)(TAB + (size_t)e_ * DM); } } while (0)
#define P8_COMPU(BUF, bb) do { const int lrel_ = lane - ((PB * (bb)) & 63); _Pragma("unroll") for (int j = 0; j < PB; ++j) { \
        int p_ = __builtin_amdgcn_sdot4((int)BUF[j].x, xq[0], 0, false); p_ = __builtin_amdgcn_sdot4((int)BUF[j].y, xq[1], p_, false); \
        p_ = __builtin_amdgcn_sdot4((int)BUF[j].z, xq[2], p_, false); p_ = __builtin_amdgcn_sdot4((int)BUF[j].w, xq[3], p_, false); \
        p_ += __builtin_amdgcn_update_dpp(0, p_, 0xB1, 0xF, 0xF, true); p_ += __builtin_amdgcn_update_dpp(0, p_, 0x4E, 0xF, 0xF, true); \
        p_ += __builtin_amdgcn_update_dpp(0, p_, 0x141, 0xF, 0xF, true); p_ += __builtin_amdgcn_update_dpp(0, p_, 0x140, 0xF, 0xF, true);     \
        p_ += __builtin_amdgcn_update_dpp(0, p_, 0x142, 0xA, 0xF, false);     \
        p_ += __builtin_amdgcn_update_dpp(0, p_, 0x143, 0xC, 0xF, false);     \
        int s_ = __builtin_amdgcn_readlane(p_, 63); asm volatile("" : "+s"(s_));     \
        hqc = (lrel_ == j) ? s_ : hqc; } } while (0)
#define P8_COMPV(BUF, bb) do { const float avs_ = (bb) < NBH ? av0 : av1; _Pragma("unroll") for (int j = 0; j < PB; ++j) { \
        const float a_ = __builtin_bit_cast(float, __builtin_amdgcn_readlane(__builtin_bit_cast(int, avs_), (PB * (bb) + j) & 63)); \
        _Pragma("unroll") for (int c = 0; c < 4; ++c) { const unsigned w_ = BUF[j][c]; \
            acc[4 * c] += a_ * (float)(w_ & 0xffu); acc[4 * c + 1] += a_ * (float)((w_ >> 8) & 0xffu); acc[4 * c + 2] += a_ * (float)((w_ >> 16) & 0xffu); acc[4 * c + 3] += a_ * (float)(w_ >> 24); } } } while (0)
    P8_LOAD(A, UQ, 0);
#pragma unroll 1
    for (int i = 0; i < NBH; ++i) {
        P8_LOAD(B, UQ, 2 * i + 1);
        if (2 * i == NBH) hq0 = hqc;
        P8_COMPU(A, 2 * i);
        if (i < NBH - 1) P8_LOAD(A, UQ, 2 * i + 2); else P8_LOAD(A, VQ, 0);
        P8_COMPU(B, 2 * i + 1);
    }
    const int hq1 = hqc;
    const float hk0 = (float)hq0 * (sc0.x * sx), hk1 = (float)hq1 * (sc1.x * sx);
#ifdef MK_DBG_L0
    ((float*)(dbg_ws + 136 * MiB))[(size_t)tok * 128 + lane] = hk0; ((float*)(dbg_ws + 136 * MiB))[(size_t)tok * 128 + 64 + lane] = hk1;
#endif
    const float av0 = gv0 * gelu_erf(hk0) * sc0.y, av1 = gv1 * gelu_erf(hk1) * sc1.y;
    const float atot = wave_sum_all(av0 + av1);
#pragma unroll 1
    for (int i = 0; i < NBH; ++i) {
        P8_LOAD(B, VQ, 2 * i + 1);
        P8_COMPV(A, 2 * i);
        if (i < NBH - 1) P8_LOAD(A, VQ, 2 * i + 2);
        P8_COMPV(B, 2 * i + 1);
    }
#undef P8_LOAD
#undef P8_COMPU
#undef P8_COMPV
    float s = 0.f;
#pragma unroll
    for (int i = 0; i < 16; ++i) { acc[i] = ALPHA * xr[i] + (acc[i] - 128.f * atot); s += acc[i]; }
    const float mean = wave_sum_all(s) * (1.f / DM); float s2 = 0.f;
#pragma unroll
    for (int i = 0; i < 16; ++i) { acc[i] -= mean; s2 += acc[i] * acc[i]; }
    const float rstd = rsqrtf(wave_sum_all(s2) * (1.f / DM) + LN_EPS);
    const float* g = ka->in[I_LN2G] + l * DM + 16 * lane; const float* bb = ka->in[I_LN2B] + l * DM + 16 * lane;
    float o[16];
#pragma unroll
    for (int j = 0; j < 4; ++j) { const f32x4 gg = *(const f32x4*)(g + 4 * j), bv = *(const f32x4*)(bb + 4 * j);
        o[4 * j] = acc[4 * j] * rstd * gg.x + bv.x; o[4 * j + 1] = acc[4 * j + 1] * rstd * gg.y + bv.y; o[4 * j + 2] = acc[4 * j + 2] * rstd * gg.z + bv.z; o[4 * j + 3] = acc[4 * j + 3] * rstd * gg.w + bv.w;
        *(f32x4*)(xrow + 4 * j) = (f32x4){o[4 * j], o[4 * j + 1], o[4 * j + 2], o[4 * j + 3]}; }
    { bf16* xb = wsp<bf16>(ka, WS_XB) + (size_t)tok * DM + 16 * lane;
      *(v4u*)xb = (v4u){pk2(o[0], o[1]), pk2(o[2], o[3]), pk2(o[4], o[5]), pk2(o[6], o[7])};
      *(v4u*)(xb + 8) = (v4u){pk2(o[8], o[9]), pk2(o[10], o[11]), pk2(o[12], o[13]), pk2(o[14], o[15])}; }
}

__global__ void __launch_bounds__(NTHREADS, 2) mk_fwd(Args args) {
    extern __shared__ __attribute__((aligned(16))) unsigned char lds[];
    Frame F;
    F.lds = (LAS unsigned char*)lds;
    F.MISC = (volatile LAS unsigned*)(F.lds + MISC_OFF);
    F.tid = threadIdx.x; F.lane = F.tid & 63; F.wave = __builtin_amdgcn_readfirstlane(F.tid >> 6);
    F.G = gridDim.x; { const int bx = blockIdx.x; F.vcu = (F.G % 8 == 0) ? (bx % 8) * (F.G / 8) + bx / 8 : bx; }
    for (int u = F.tid; u < (LDS_BYTES - LDSCTL_OFF) / 4; u += NTHREADS) ((LAS unsigned*)(F.lds + LDSCTL_OFF))[u] = 0u;
    __syncthreads();
    const int lo = args.ph_lo, hi = args.ph_hi;
    unsigned* const barw = (unsigned*)(args.ws + WS_CTL) + CW_BAR;
    const bool one_phase = (hi - lo) == 1;
    XcdBarrier bar; bar.bar = barw; bar.x = 0; bar.st = nullptr;
    if (!one_phase) bar = xcd_barrier_post(barw, F.MISC + 8);
#ifndef MK_EN
#define MK_EN 0x1ff
#endif
#ifndef MK_MLA_LDS
#define MK_MLA_LDS 0
#endif
#ifndef MK_MLA_REP
#define MK_MLA_REP 1
#endif
#ifndef MK_SB_REP
#define MK_SB_REP 1
#endif
#define EN(n) (((MK_EN) >> (n)) & 1)
#ifndef MK_REP
#define MK_REP 0
#endif
#define PHASE_REP(n) for (int rep_ = 0; rep_ < ((((MK_REP) >> (n)) & 1) + 1); ++rep_)
#define IN(k) (lo <= (k) && (k) < hi)
#define PHASE_IDS() do { int t_ = threadIdx.x; asm volatile("" : "+v"(t_)); F.tid = t_; F.lane = t_ & 63; } while (0)
#define SEAM(k) do { if (IN((k) + 1)) xcd_barrier(bar); } while (0)
    const int gw = F.vcu * NWAVES + F.wave, NGW = F.G * NWAVES;

    if (EN(0) && IN(0)) PHASE_REP(0) { PHASE_IDS(); p0_prologue(F, ka_fresh()); SEAM(0); }
    for (int l = 0; l < DEPTH; ++l) {
        const int pb = 1 + 8 * l;
        if (EN(1) && IN(pb + 0)) PHASE_REP(1) { const kap_t ka = ka_fresh(); PHASE_IDS();
            pg8::Gemm g{wsp<bf16>(ka, WS_XB), wsp<bf16>(ka, WS_WIT) + (size_t)l * DINP * DM, NTOK, DINP, DM}; pg8::StaticOrder S; S.init(NTOK, DINP, F.G, (int)blockIdx.x);
            pg8::EpiBf16<0> E{wsp<bf16>(ka, WS_HB), DINP, nullptr, 0, 0, 1.f};
            pg8::gemm_phase<pg8::EpiBf16<0>, pg8::StaticOrder, PG8_ALIGN, PG8_SP2>(F.lds + RING_OFF, g, S, E);
            SEAM(pb + 0);
        }
        if (EN(2) && IN(pb + 1)) PHASE_REP(2) { const kap_t ka = ka_fresh(); PHASE_IDS();
            for (int u = gw; u < (NTOK / 32) * 4; u += NGW) p2_unit(F, ka, l, u >> 2, u & 3);
            SEAM(pb + 1);
        }
        if (EN(3) && IN(pb + 2)) PHASE_REP(3) { const kap_t ka = ka_fresh(); PHASE_IDS();
#if MK_MLA_LDS
            for (int u = F.vcu; u < 32 * 8; u += F.G) {
                const int bh = u >> 3, j = u & 7;
                mla_block(F, ka, bh, 15 - j); sb_unit(F, ka, bh, 8 * (15 - j) + F.wave);
                mla_block(F, ka, bh, j); sb_unit(F, ka, bh, 8 * j + F.wave);
            }
#else
            for (int u = gw; u < 32 * 64; u += NGW) {
                const int bh = u >> 6, pi = u & 63;
                for (int r_ = 0; r_ < MK_MLA_REP; ++r_) mla_unit(F, ka, bh, 127 - pi);
                for (int r_ = 0; r_ < MK_SB_REP; ++r_) sb_unit(F, ka, bh, 127 - pi);
                for (int r_ = 0; r_ < MK_MLA_REP; ++r_) mla_unit(F, ka, bh, pi);
                for (int r_ = 0; r_ < MK_SB_REP; ++r_) sb_unit(F, ka, bh, pi);
            }
#endif
            SEAM(pb + 2);
        }
        if (EN(4) && IN(pb + 3)) PHASE_REP(4) { const kap_t ka = ka_fresh(); PHASE_IDS();
            pg8::Gemm g{wsp<bf16>(ka, WS_OB), wsp<bf16>(ka, WS_WOT) + (size_t)l * DM * DM, NTOK, DM, DM}; pg8::StaticOrder S; S.init(NTOK, DM, F.G, (int)blockIdx.x);
            pg8::EpiResF32 E{l == 0 ? ka->in[I_X] : ka->out, ka->out, DM, ALPHA};
            pg8::gemm_phase<pg8::EpiResF32, pg8::StaticOrder, PG8_ALIGN, PG8_SP2>(F.lds + RING_OFF, g, S, E);
            SEAM(pb + 3);
        }
        if (EN(5) && IN(pb + 4)) PHASE_REP(5) { const kap_t ka = ka_fresh(); PHASE_IDS();
            for (int r = gw; r < NTOK; r += NGW) ln1_row(F, ka, r, ka->in[I_LN1G] + l * DM, ka->in[I_LN1B] + l * DM);
            SEAM(pb + 4);
        }
        if (EN(6) && IN(pb + 5)) PHASE_REP(6) { const kap_t ka = ka_fresh(); PHASE_IDS();
            pg8::Gemm g{wsp<bf16>(ka, WS_XB), wsp<bf16>(ka, WS_WQT) + (size_t)l * 2048 * DM, NTOK, 2048, DM}; pg8::StaticOrder S; S.init(NTOK, 2048, F.G, (int)blockIdx.x);
            pg8::EpiBf16<0> E{wsp<bf16>(ka, WS_HB), 2048, nullptr, 0, 0, 1.f};
            pg8::gemm_phase<pg8::EpiBf16<0>, pg8::StaticOrder, PG8_ALIGN, PG8_SP2>(F.lds + RING_OFF, g, S, E);
            SEAM(pb + 5);
        }
        if (EN(7) && IN(pb + 6)) PHASE_REP(7) { const kap_t ka = ka_fresh(); PHASE_IDS();
            for (int u = gw; u < (NTOK / 32) * 8; u += NGW) p7_unit(F, ka, l, u >> 3, u & 7);
            SEAM(pb + 6);
        }
        if (EN(8) && IN(pb + 7)) PHASE_REP(8) { const kap_t ka = ka_fresh(); PHASE_IDS();
            const unsigned* EL = wsp<unsigned>(ka, WS_EL) + F.lane; const float* GL = wsp<float>(ka, WS_GL) + F.lane;
            unsigned e0 = 0u, e1 = 0u; float g0 = 0.f, g1 = 0.f;
            if (gw < NTOK) { e0 = EL[(size_t)gw * 128]; e1 = EL[(size_t)gw * 128 + 64]; g0 = GL[(size_t)gw * 128]; g1 = GL[(size_t)gw * 128 + 64]; }
            for (int t = gw; t < NTOK; t += NGW) {
                unsigned ne0 = 0u, ne1 = 0u; float ng0 = 0.f, ng1 = 0.f;
                if (t + NGW < NTOK) { const size_t o = (size_t)(t + NGW) * 128; ne0 = EL[o]; ne1 = EL[o + 64]; ng0 = GL[o]; ng1 = GL[o + 64]; }
                p8_token(F, ka, l, t, e0, e1, g0, g1);
                e0 = ne0; e1 = ne1; g0 = ng0; g1 = ng1;
            }
            if (l + 1 < DEPTH) SEAM(pb + 7);
        }
    }
#undef IN
#undef SEAM
}

#ifndef MK_PER_PHASE
#define MK_PER_PHASE 0
#endif
extern "C" void kernel_launch(void* const* d_in, const int* in_sizes, int n_in, void* d_out, int out_size, void* d_ws, size_t ws_size, hipStream_t stream) {
    static int grid = 0;
    if (grid == 0) {
        if (n_in != 15 || out_size != NTOK * DM || ws_size < WS_END) { fprintf(stderr, "kernel_launch: unexpected shapes (n_in %d, out %d, ws %zu); nothing launched\n", n_in, out_size, ws_size); grid = -1; return; }
        int dev = 0, cus = 0, per_cu = 0;
        if (hipGetDevice(&dev) != hipSuccess || hipDeviceGetAttribute(&cus, hipDeviceAttributeMultiprocessorCount, dev) != hipSuccess) { fprintf(stderr, "kernel_launch: device query failed\n"); grid = -1; return; }
        if (hipFuncSetAttribute((const void*)mk_fwd, hipFuncAttributeMaxDynamicSharedMemorySize, LDS_BYTES) != hipSuccess) { fprintf(stderr, "kernel_launch: hipFuncSetAttribute failed\n"); grid = -1; return; }
        if (hipOccupancyMaxActiveBlocksPerMultiprocessor(&per_cu, (const void*)mk_fwd, NTHREADS, LDS_BYTES) != hipSuccess || per_cu < 1) { fprintf(stderr, "kernel_launch: occupancy query says %d blocks per CU\n", per_cu); per_cu = 1; }
        (void)hipGetLastError();
        grid = cus;
        fprintf(stderr, "kernel_launch: grid %d (occupancy query %d per CU)\n", grid, per_cu);
    }
    if (grid < 0) return;
    (void)hipMemsetAsync((char*)d_ws + WS_CTL, 0, CTL_ZERO_BYTES, stream);
    Args a{};
    for (int i = 0; i < 15; ++i) a.in[i] = (const float*)d_in[i];
    a.out = (float*)d_out; a.ws = (unsigned char*)d_ws;
#if MK_PER_PHASE
    for (int p = 0; p < NPHASE; ++p) { a.ph_lo = p; a.ph_hi = p + 1; hipLaunchKernelGGL(mk_fwd, dim3(grid), dim3(NTHREADS), LDS_BYTES, stream, a); }
#else
    a.ph_lo = 0; a.ph_hi = NPHASE;
    void* kargs[] = {&a};
    const hipError_t e = hipLaunchCooperativeKernel((const void*)mk_fwd, dim3(grid), dim3(NTHREADS), kargs, LDS_BYTES, stream);
    if (e != hipSuccess) fprintf(stderr, "kernel_launch: cooperative launch failed: %s (grid %d)\n", hipGetErrorString(e), grid);
#endif
}
```

```cpp
#include <hip/hip_runtime.h>
#include <cstdio>
#include <cstdint>
#include <math.h>
namespace pg8 {
#define PG8_LAS __attribute__((address_space(3)))
typedef unsigned short bf16_t;
typedef short bf16x8 __attribute__((ext_vector_type(8)));
typedef float f32x4 __attribute__((ext_vector_type(4)));
typedef unsigned u32x4 __attribute__((ext_vector_type(4)));
constexpr int BM = 256, BK = 64, HALF = 128, HTB = HALF * BK * 2  , STAGE_BYTES = 8 * HTB, NXCD = 8, WGM = 8;

__host__ __device__ __forceinline__ int lds_byte(int r, int c) { const int st = (r >> 4) * 2 + (c >> 5), rr = r & 15, cc = c & 31, ob = rr * 64 + cc * 2; return st * 1024 + (ob ^ (((ob >> 9) & 1) << 5)); }
__host__ __device__ __forceinline__ void stage_rc(int b, int& R, int& C) { const int st = b / 1024, sb = b % 1024, swz = sb ^ (((sb >> 9) & 1) << 5); R = (st >> 1) * 16 + swz / 64; C = (st & 1) * 32 + (swz % 64) / 2; }
__host__ __device__ __forceinline__ int perm32(int rho) { const int n = rho >> 4, i = rho & 15; return 8 * (i >> 2) + 4 * n + (i & 3); }

struct Unit { int pm, pn; };
struct Gemm { const bf16_t* A; const bf16_t* Bt; int M, N, K; };

struct StaticOrder {
    int nM, nN, nwg, G, c;
    __host__ __device__ void init(int M, int N, int G_, int c_) { nM = M / BM; nN = N / BM; nwg = nM * nN; G = G_; c = c_; }
    __host__ __device__ bool next(int i, Unit& u) const {
        const long L = (long)i * G + c; if (L >= nwg) return false;
        int wgid = (int)L; { const int q = nwg / NXCD, r = nwg % NXCD, xcd = wgid % NXCD, off = wgid / NXCD; wgid = (xcd < r ? xcd * (q + 1) : r * (q + 1) + (xcd - r) * q) + off; }
        const int nig = WGM * nN, gid = wgid / nig, fm = gid * WGM, gsz = (nM - fm) < WGM ? (nM - fm) : WGM;
        u.pm = fm + ((wgid % nig) % gsz); u.pn = (wgid % nig) / gsz; return true;
    }
    __device__ __forceinline__ void a_ready(const Unit&) const {}
    __device__ __forceinline__ void done(const Unit&) const {}
};

__device__ __forceinline__ unsigned cvt_pk_bf16(float lo, float hi) { unsigned r; asm volatile("v_cvt_pk_bf16_f32 %0, %1, %2" : "=v"(r) : "v"(lo), "v"(hi)); return r; }
typedef float f32x2 __attribute__((ext_vector_type(2)));
__device__ __forceinline__ f32x2 gelu_pk(f32x2 v) {
    const f32x2 av = __builtin_elementwise_abs(v), d = av * 0.2316418882f + 1.0f;
    f32x2 t; t.x = __builtin_amdgcn_rcpf(d.x); t.y = __builtin_amdgcn_rcpf(d.y);
    f32x2 q = t * 0.5307027145f + (-0.7265760135f); q = q * t + 0.7107068705f; q = q * t + (-0.142248368f); q = q * t + 0.127414796f; q = q * t;
    const f32x2 s = (v * v) * (-0.72134752044f);
    f32x2 e; e.x = __builtin_amdgcn_exp2f(s.x); e.y = __builtin_amdgcn_exp2f(s.y);
    const f32x2 m = v * (q * e), r = v - m;
    f32x2 o; o.x = v.x < 0.f ? m.x : r.x; o.y = v.y < 0.f ? m.y : r.y; return o;
}

template <int ACT  > struct EpiBf16 {
    static constexpr bool PERM = true, AFTER_DRAIN = false; static_assert(ACT == 0 || ACT == 1, "EpiBf16: ACT is 0 (none) or 1 (gelu_pk)");
    bf16_t* O; int ldc; const float* bias; int split_cols; size_t split_stride; float scale0;
    __device__ __forceinline__ void operator()(const f32x4 (&acc)[2][2][4][2], const Unit& u, int wr, int wc, int fr, int fq) const {
        const int row0 = u.pm * BM + wr * 64 + fr; int colt = u.pn * BM; bf16_t* base = O;
        float sc = 1.f; if (split_cols) { const int t = colt / split_cols; base += (size_t)t * split_stride; colt -= t * split_cols; if (t == 0) sc = scale0; }
        const int col0 = colt + wc * 32 + 8 * fq, bcol0 = u.pn * BM + wc * 32 + 8 * fq;
        f32x4 bv[2][2];
#pragma unroll
        for (int bj = 0; bj < 2; ++bj)
#pragma unroll
            for (int n = 0; n < 2; ++n) bv[bj][n] = bias ? *(const f32x4*)(bias + bcol0 + bj * HALF + 4 * n) : (f32x4){0.f, 0.f, 0.f, 0.f};
#pragma unroll
        for (int ai = 0; ai < 2; ++ai)
#pragma unroll
            for (int m = 0; m < 4; ++m) { bf16_t* rowp = base + (size_t)(row0 + ai * HALF + m * 16) * ldc + col0;
#pragma unroll
                for (int bj = 0; bj < 2; ++bj) { f32x4 v0 = acc[ai][bj][m][0] + bv[bj][0], v1 = acc[ai][bj][m][1] + bv[bj][1];
                    if (ACT == 1) { f32x2 a = gelu_pk((f32x2){v0[0], v0[1]}), b = gelu_pk((f32x2){v0[2], v0[3]}), c = gelu_pk((f32x2){v1[0], v1[1]}), d = gelu_pk((f32x2){v1[2], v1[3]});
                        v0 = (f32x4){a.x, a.y, b.x, b.y}; v1 = (f32x4){c.x, c.y, d.x, d.y}; }
                    v0 = v0 * sc; v1 = v1 * sc; u32x4 w; w.x = cvt_pk_bf16(v0[0], v0[1]); w.y = cvt_pk_bf16(v0[2], v0[3]); w.z = cvt_pk_bf16(v1[0], v1[1]); w.w = cvt_pk_bf16(v1[2], v1[3]);
                    *(u32x4*)(rowp + bj * HALF) = w; } }
    }
};
struct EpiResF32 {
    static constexpr bool PERM = false, AFTER_DRAIN = false;
    const float* res; float* out; int ldc; float alpha;
    __device__ __forceinline__ void operator()(const f32x4 (&acc)[2][2][4][2], const Unit& u, int wr, int wc, int fr, int fq) const {
        const int row0 = u.pm * BM + wr * 64 + fr, col0 = u.pn * BM + wc * 32 + 4 * fq;
#pragma unroll
        for (int ai = 0; ai < 2; ++ai)
#pragma unroll
            for (int m = 0; m < 4; ++m) { const size_t off = (size_t)(row0 + ai * HALF + m * 16) * ldc + col0;
#pragma unroll
                for (int bj = 0; bj < 2; ++bj)
#pragma unroll
                    for (int n = 0; n < 2; ++n) { const f32x4 rs = *(const f32x4*)(res + off + bj * HALF + n * 16); *(f32x4*)(out + off + bj * HALF + n * 16) = rs * alpha + acc[ai][bj][m][n]; }
                if (m & 1) asm volatile("" ::: "memory"); }
    }
};
template <class Epi, class Sched, bool ALIGN_EPI = false, bool SP2 = false>
__device__ __forceinline__ void gemm_phase(PG8_LAS unsigned char* lds, const Gemm g, const Sched& S, const Epi& E) {
    int tid_ = threadIdx.x; asm volatile("" : "+v"(tid_));
    const int tid = tid_, wid = __builtin_amdgcn_readfirstlane(tid >> 6), lane = tid & 63, wr = wid >> 2, wc = wid & 3, fr = lane & 15, fq = lane >> 4;
    const int K = g.K, nt = K / BK;
    unsigned voffA[2], voffB[2];
#pragma unroll
    for (int i = 0; i < 2; ++i) { int R, C; stage_rc(tid * 16 + i * 8192, R, C); const int Rb = Epi::PERM ? ((R & ~31) + perm32(R & 31)) : R;
        voffA[i] = (unsigned)(R * K + C) * 2u; voffB[i] = (unsigned)(Rb * K + C) * 2u; }
    const size_t kstep = (size_t)(BK * 2);
    const size_t hstep = (size_t)HALF * K * 2;
    const size_t tstep = 2 * hstep;
    const unsigned ldsw = (unsigned)wid * 1024u;
    const int aoff = lds_byte(wr * 64 + fr, fq * 8), boff = lds_byte(wc * 32 + fr, fq * 8);
#define PG8_SA(b, h) (((b) * 2 + (h)) * HTB)
#define PG8_SB(b, h) ((4 + (b) * 2 + (h)) * HTB)
#define PG8_STAGE(bufoff, gbase, voff) do { _Pragma("unroll") for (int _i = 0; _i < 2; ++_i) \
        __builtin_amdgcn_global_load_lds((const unsigned*)((const char*)(gbase) + (voff)[_i]), (PG8_LAS unsigned*)(lds + (bufoff) + ldsw + _i * 8192), 16, 0, 0); } while (0)
#define PG8_LDA(dst, b, h) do { _Pragma("unroll") for (int m = 0; m < 4; ++m) _Pragma("unroll") for (int k = 0; k < 2; ++k) dst[m][k] = *(const PG8_LAS bf16x8*)(lds + PG8_SA(b, h) + aoff + m * 2048 + k * 1024); } while (0)
#define PG8_LDB(dst, b, h) do { _Pragma("unroll") for (int n = 0; n < 2; ++n) _Pragma("unroll") for (int k = 0; k < 2; ++k) dst[n][k] = *(const PG8_LAS bf16x8*)(lds + PG8_SB(b, h) + boff + n * 2048 + k * 1024); } while (0)
#define PG8_MMA(ai, bj, At, Bt) do { __builtin_amdgcn_s_setprio(1); _Pragma("unroll") for (int m = 0; m < 4; ++m) _Pragma("unroll") for (int n = 0; n < 2; ++n) _Pragma("unroll") for (int k = 0; k < 2; ++k) \
        acc[ai][bj][m][n] = __builtin_amdgcn_mfma_f32_16x16x32_bf16(Bt[n][k], At[m][k], acc[ai][bj][m][n], 0, 0, 0); __builtin_amdgcn_s_setprio(0); } while (0)
#define PG8_WAIT_V(n) asm volatile("s_waitcnt vmcnt(" #n ")" ::: "memory")
#define PG8_WAIT_L(n) asm volatile("s_waitcnt lgkmcnt(" #n ")" ::: "memory")
#define PG8_BAR __builtin_amdgcn_s_barrier()
#define PG8_SCHED __builtin_amdgcn_sched_barrier(0)
    Unit cur, nxt; int ui = 0;
    if (!S.next(0, cur)) return;
    f32x4 acc[2][2][4][2];
#pragma unroll
    for (int a = 0; a < 2; ++a)
#pragma unroll
        for (int b = 0; b < 2; ++b)
#pragma unroll
            for (int m = 0; m < 4; ++m)
#pragma unroll
                for (int n = 0; n < 2; ++n) acc[a][b][m][n] = (f32x4){0.f, 0.f, 0.f, 0.f};
    bf16x8 At[4][2], B0[2][2], B1[2][2];
    const char* cA = (const char*)g.A + (size_t)cur.pm * tstep; const char* cB = (const char*)g.Bt + (size_t)cur.pn * tstep;
    S.a_ready(cur);
    if constexpr (SP2) {
        PG8_STAGE(PG8_SB(0, 0), cB, voffB); PG8_STAGE(PG8_SB(0, 1), cB + hstep, voffB); PG8_STAGE(PG8_SA(0, 0), cA, voffA); PG8_STAGE(PG8_SA(0, 1), cA + hstep, voffA);
        if (wr == 1) PG8_BAR;
        PG8_WAIT_V(2); PG8_BAR;
        PG8_STAGE(PG8_SB(1, 0), cB + kstep, voffB); PG8_STAGE(PG8_SA(1, 0), cA + kstep, voffA); PG8_STAGE(PG8_SB(1, 1), cB + hstep + kstep, voffB);
        PG8_WAIT_V(6); PG8_BAR;
    } else {
        PG8_STAGE(PG8_SB(0, 0), cB, voffB); PG8_STAGE(PG8_SA(0, 0), cA, voffA); PG8_STAGE(PG8_SB(0, 1), cB + hstep, voffB); PG8_STAGE(PG8_SA(0, 1), cA + hstep, voffA);
        if (wr == 1) PG8_BAR;
        PG8_WAIT_V(4); PG8_BAR;
        PG8_STAGE(PG8_SB(1, 0), cB + kstep, voffB); PG8_STAGE(PG8_SA(1, 0), cA + kstep, voffA); PG8_STAGE(PG8_SB(1, 1), cB + hstep + kstep, voffB);
        PG8_WAIT_V(6); PG8_BAR;
    }
    for (;;) {
        const bool has_next = S.next(ui + 1, nxt);
        const char* nA = has_next ? (const char*)g.A + (size_t)nxt.pm * tstep : cA; const char* nB = has_next ? (const char*)g.Bt + (size_t)nxt.pn * tstep : cB;
        for (int t = 0; t < nt; t += 2) {
            const bool last = (t == nt - 2);
            const char* a1 = cA + (size_t)(t + 1) * kstep;
            const char* a2 = last ? nA : cA + (size_t)(t + 2) * kstep; const char* b2 = last ? nB : cB + (size_t)(t + 2) * kstep;
            const char* a3 = a2 + kstep; const char* b3 = b2 + kstep;
            if (last && has_next) S.a_ready(nxt);
            if constexpr (SP2) {
            PG8_LDB(B0, 0, 0); PG8_LDB(B1, 0, 1); PG8_SCHED; PG8_LDA(At, 0, 0); PG8_STAGE(PG8_SA(1, 1), a1 + hstep, voffA);
            PG8_WAIT_V(8); PG8_WAIT_L(0); PG8_BAR; PG8_MMA(0, 0, At, B0); PG8_MMA(0, 1, At, B1); PG8_BAR; PG8_SCHED;
            PG8_LDA(At, 0, 1); PG8_STAGE(PG8_SB(0, 0), b2, voffB); PG8_STAGE(PG8_SB(0, 1), b2 + hstep, voffB); PG8_STAGE(PG8_SA(0, 0), a2, voffA);
            PG8_WAIT_V(8); PG8_WAIT_L(0); PG8_BAR; PG8_MMA(1, 0, At, B0); PG8_MMA(1, 1, At, B1); PG8_BAR; PG8_SCHED;
            PG8_LDB(B0, 1, 0); PG8_LDB(B1, 1, 1); PG8_SCHED; PG8_LDA(At, 1, 0); PG8_STAGE(PG8_SA(0, 1), a2 + hstep, voffA);
            PG8_WAIT_V(8); PG8_WAIT_L(0); PG8_BAR; PG8_MMA(0, 0, At, B0); PG8_MMA(0, 1, At, B1); PG8_BAR; PG8_SCHED;
            PG8_LDA(At, 1, 1); PG8_STAGE(PG8_SB(1, 0), b3, voffB); PG8_STAGE(PG8_SB(1, 1), b3 + hstep, voffB); PG8_STAGE(PG8_SA(1, 0), a3, voffA);
            PG8_WAIT_V(8); PG8_WAIT_L(0); PG8_BAR; PG8_MMA(1, 0, At, B0); PG8_MMA(1, 1, At, B1); PG8_BAR; PG8_SCHED;
            } else {
            PG8_LDB(B0, 0, 0); PG8_SCHED; PG8_LDA(At, 0, 0); PG8_STAGE(PG8_SA(1, 1), a1 + hstep, voffA);
            PG8_WAIT_L(8); PG8_BAR; PG8_WAIT_L(0); PG8_MMA(0, 0, At, B0); PG8_BAR; PG8_SCHED;
            PG8_LDB(B1, 0, 1); PG8_STAGE(PG8_SB(0, 0), b2, voffB);
            PG8_BAR; PG8_WAIT_L(0); PG8_MMA(0, 1, At, B1); PG8_BAR;
            PG8_LDA(At, 0, 1); PG8_STAGE(PG8_SA(0, 0), a2, voffA);
            PG8_BAR; PG8_WAIT_L(0); PG8_MMA(1, 0, At, B0); PG8_BAR; PG8_SCHED;
            PG8_STAGE(PG8_SB(0, 1), b2 + hstep, voffB);
            PG8_WAIT_V(6); PG8_BAR; PG8_MMA(1, 1, At, B1); PG8_BAR;
            PG8_LDB(B0, 1, 0); PG8_SCHED; PG8_LDA(At, 1, 0); PG8_STAGE(PG8_SA(0, 1), a2 + hstep, voffA);
            PG8_WAIT_L(8); PG8_BAR; PG8_WAIT_L(0); PG8_MMA(0, 0, At, B0); PG8_BAR; PG8_SCHED;
            PG8_LDB(B1, 1, 1); PG8_STAGE(PG8_SB(1, 0), b3, voffB);
            PG8_BAR; PG8_WAIT_L(0); PG8_MMA(0, 1, At, B1); PG8_BAR;
            PG8_LDA(At, 1, 1); PG8_STAGE(PG8_SA(1, 0), a3, voffA);
            PG8_BAR; PG8_WAIT_L(0); PG8_MMA(1, 0, At, B0); PG8_BAR; PG8_SCHED;
            PG8_STAGE(PG8_SB(1, 1), b3 + hstep, voffB);
            PG8_WAIT_V(6); PG8_BAR; PG8_MMA(1, 1, At, B1); PG8_BAR;
            }
        }
        if constexpr (ALIGN_EPI) { if (wr == 0) PG8_BAR; }
        if constexpr (!Epi::AFTER_DRAIN) { E(acc, cur, wr, wc, fr, fq); S.done(cur); }
        if (!has_next) break;
#pragma unroll
        for (int a = 0; a < 2; ++a)
#pragma unroll
            for (int b = 0; b < 2; ++b)
#pragma unroll
                for (int m = 0; m < 4; ++m)
#pragma unroll
                    for (int n = 0; n < 2; ++n) acc[a][b][m][n] = (f32x4){0.f, 0.f, 0.f, 0.f};
        cur = nxt; cA = nA; cB = nB; ++ui;
        if constexpr (ALIGN_EPI) { if (wr == 1) PG8_BAR; }
    }
    PG8_WAIT_V(0);
    if constexpr (!ALIGN_EPI) { if (wr == 0) PG8_BAR; }
    PG8_BAR;
    if constexpr (Epi::AFTER_DRAIN) { E.fused(acc, cur, wr, wc, fr, fq, lds, wid, lane); S.done(cur); }
#undef PG8_SA
#undef PG8_SB
#undef PG8_STAGE
#undef PG8_LDA
#undef PG8_LDB
#undef PG8_MMA
#undef PG8_WAIT_V
#undef PG8_WAIT_L
#undef PG8_BAR
#undef PG8_SCHED
}
}

#ifndef PG8_SP2
#define PG8_SP2 true
#endif
#ifndef PG8_ALIGN
#define PG8_ALIGN true
#endif
#define GAS __attribute__((address_space(1)))
#define LAS __attribute__((address_space(3)))
typedef unsigned short bf16;
typedef unsigned v4u __attribute__((ext_vector_type(4)));
typedef float f32x4 __attribute__((ext_vector_type(4)));
typedef short bf16x8 __attribute__((ext_vector_type(8)));
typedef GAS unsigned gu32;
typedef GAS unsigned long long gu64;
#define RLX_AGENT __ATOMIC_RELAXED, __HIP_MEMORY_SCOPE_AGENT
#define LDS_WAIT() asm volatile("s_waitcnt lgkmcnt(0)" ::: "memory")
#define VM_WAIT() asm volatile("s_waitcnt vmcnt(0)" ::: "memory")
__device__ __forceinline__ unsigned long long rt() { return __builtin_amdgcn_s_memrealtime(); }
__device__ __forceinline__ unsigned f2bf(float f) { unsigned u = __builtin_bit_cast(unsigned, f); return (u + 0x7fffu + ((u >> 16) & 1u)) >> 16; }
typedef float pk2_f32x2_t __attribute__((ext_vector_type(2))); typedef __bf16 pk2_bf16x2_t __attribute__((ext_vector_type(2)));
__device__ __forceinline__ unsigned pk2(float lo, float hi) { const pk2_f32x2_t v = {lo, hi}; return __builtin_bit_cast(unsigned, __builtin_convertvector(v, pk2_bf16x2_t)); }

#define XB_TMO      128
#define XB_XCNT(j)  (256  + 64 * (j))
#define XB_XSUB(j)  (1280 + 64 * (j))
#define XB_XGEN(j)  (2304 + 64 * (j))
#define XB_TOP      3328
#define XB_TOPGEN   3392
#define XCD_BAR_WORDS 3456
#define XB_SPIN_CAP (1u << 18)

__device__ __forceinline__ unsigned xb_ld(unsigned* p)              { return __hip_atomic_load(p, __ATOMIC_RELAXED, __HIP_MEMORY_SCOPE_AGENT); }
__device__ __forceinline__ unsigned xb_add(unsigned* p, unsigned v) { return __hip_atomic_fetch_add(p, v, __ATOMIC_RELAXED, __HIP_MEMORY_SCOPE_AGENT); }
__device__ __forceinline__ unsigned xb_xcc_id() { return (unsigned)__builtin_amdgcn_s_getreg((3 << 11) | 20) & 0xFu; }
#define XB_SPIN(cond, bar) do { unsigned _sp = 0; while (cond) { __builtin_amdgcn_s_sleep(1); \
    if ((++_sp & 255u) == 0u) { if (xb_ld(&(bar)[XB_TMO])) break; if (_sp > XB_SPIN_CAP) { atomicAdd(&(bar)[XB_TMO], 1u); break; } } } } while (0)

struct XcdBarrier {
    unsigned* bar; unsigned x;
    volatile LAS unsigned* st;
};

__device__ __forceinline__ XcdBarrier xcd_barrier_post(unsigned* bar, volatile LAS unsigned* st) {
    XcdBarrier b; b.bar = bar; b.x = xb_xcc_id(); b.st = st;
    if (threadIdx.x == 0) (void)xb_add(&bar[XB_XCNT(b.x)], 1u);
    return b;
}
__device__ __forceinline__ void xcd_barrier_complete(unsigned* bar, unsigned x, unsigned& nloc, unsigned& nx) {
    const unsigned G = gridDim.x * gridDim.y * gridDim.z;
    unsigned sum, cnt, mine, sp = 0u;
    for (;;) {
        sum = 0u; cnt = 0u; mine = 0u;
#pragma unroll
        for (unsigned j = 0; j < 16; ++j) { const unsigned c = xb_ld(&bar[XB_XCNT(j)]); sum += c; cnt += (c > 0u) ? 1u : 0u; mine = (j == x) ? c : mine; }
        if (sum == G) break;
        __builtin_amdgcn_s_sleep(1);
        if ((++sp & 255u) == 0u) { if (xb_ld(&bar[XB_TMO])) break; if (sp > XB_SPIN_CAP) { atomicAdd(&bar[XB_TMO], 1u); break; } }
    }
    nloc = mine > 0u ? mine : 1u; nx = cnt > 0u ? cnt : 1u;
}

__device__ __forceinline__ void xcd_barrier(const XcdBarrier& b) {
    asm volatile("s_waitcnt vmcnt(0)" ::: "memory");
    __syncthreads();
    if (threadIdx.x == 0) {
        unsigned* bar = b.bar;
        __builtin_amdgcn_s_waitcnt(0);
        unsigned nloc = b.st[0], nx = b.st[1];
        if (nloc == 0u) { xcd_barrier_complete(bar, b.x, nloc, nx); b.st[0] = nloc; b.st[1] = nx; }
        const unsigned old = xb_add(&bar[XB_XSUB(b.x)], 1u);
        const unsigned gen = old / nloc;
        if (old + 1u == (gen + 1u) * nloc) {
            __builtin_amdgcn_fence(__ATOMIC_RELEASE, "agent");
            asm volatile("s_waitcnt vmcnt(0)" ::: "memory");
            const unsigned og = xb_add(&bar[XB_TOP], 1u);
            const unsigned tg = og / nx;
            if (og + 1u == (tg + 1u) * nx) xb_add(&bar[XB_TOPGEN], 1u);
            else XB_SPIN(xb_ld(&bar[XB_TOPGEN]) == tg, bar);
            __builtin_amdgcn_fence(__ATOMIC_ACQUIRE, "agent");
            xb_add(&bar[XB_XGEN(b.x)], 1u);
            asm volatile("s_waitcnt vmcnt(0)" ::: "memory");
        } else {
            XB_SPIN(xb_ld(&bar[XB_XGEN(b.x)]) == gen, bar);
            __builtin_amdgcn_fence(__ATOMIC_ACQUIRE, "agent");
            asm volatile("s_waitcnt vmcnt(0)" ::: "memory");
        }
    }
    __syncthreads();
}

constexpr int NWAVES = 8, NTHREADS = 512;
constexpr int DM = 1024, NB = 4, SEQ = 4096, DEPTH = 2, NTOK = NB * SEQ, NEXP = 16384;
constexpr int DIN = 1952, DINP = 2048;
constexpr float ALPHA = 1.4142135623730951f;
constexpr float LN_EPS = 1e-5f, RMS_EPS = 1e-6f;
constexpr float QSCALE = 0.10206207261596575f * 1.4426950408889634f;
constexpr int NPHASE = 1 + 8 * DEPTH;
constexpr size_t MiB = 1u << 20;
constexpr size_t WS_CTL = 0, CTL_ZERO_BYTES = 64 * 1024;
constexpr size_t WS_WIT = 2 * MiB;
constexpr size_t WS_WQT = 10 * MiB;
constexpr size_t WS_WOT = 18 * MiB;
constexpr size_t WS_WUQT = 22 * MiB;
constexpr size_t WS_WUKVT = 23 * MiB;
constexpr size_t WS_KEYS = 24 * MiB;
constexpr size_t WS_ROPE = 25 * MiB;
constexpr size_t WS_SUV = 26 * MiB;
constexpr size_t WS_UT = 32 * MiB;
constexpr size_t WS_VT = 96 * MiB;
constexpr size_t WS_XB = 160 * MiB;
constexpr size_t WS_HB = 192 * MiB;
constexpr size_t WS_QM = 256 * MiB;
constexpr size_t WS_KM = 280 * MiB;
constexpr size_t WS_VMT = 304 * MiB;
constexpr size_t WS_VST = 320 * MiB;
constexpr size_t WS_OB = 336 * MiB;
constexpr size_t WS_EL = 368 * MiB;
constexpr size_t WS_GL = 376 * MiB;
constexpr size_t WS_END = 384 * MiB;
constexpr int CW_BAR = 1024;
static_assert((CW_BAR + XCD_BAR_WORDS) * 4 <= (int)CTL_ZERO_BYTES, "barrier words inside the memset region");
constexpr int RING_OFF = 0, RING_BYTES = 131072;
constexpr int LDSCTL_OFF = RING_BYTES, MISC_OFF = LDSCTL_OFF + 320;
constexpr int LDS_BYTES = 147456;
static_assert(MISC_OFF + 128 <= LDS_BYTES, "LDS map");

typedef float f32x16 __attribute__((ext_vector_type(16)));
typedef float f32x2 __attribute__((ext_vector_type(2)));
typedef unsigned v2u __attribute__((ext_vector_type(2)));
typedef __bf16 bf2_t __attribute__((ext_vector_type(2)));

struct Args { const float* in[15]; float* out; unsigned char* ws; int ph_lo, ph_hi; };
typedef const __attribute__((address_space(4))) Args* kap_t;
__device__ __forceinline__ kap_t ka_fresh() { kap_t p = (kap_t)__builtin_amdgcn_kernarg_segment_ptr(); asm volatile("" : "+s"(p)); return p; }
enum { I_X = 0, I_WIN, I_GCQ, I_WUQ, I_GCKV, I_WUKV, I_WO, I_LN1G, I_LN1B, I_WQ, I_KEYS, I_U, I_V, I_LN2G, I_LN2B };
struct Frame {
    LAS unsigned char* lds;
    volatile LAS unsigned* MISC;
    int tid, lane, wave, vcu, G;
};
template <class T> __device__ __forceinline__ T* wsp(kap_t ka, size_t off) { return (T*)(ka->ws + off); }

__device__ __forceinline__ float bflo(unsigned w) { return __uint_as_float(w << 16); }
__device__ __forceinline__ float bfhi(unsigned w) { return __uint_as_float(w & 0xffff0000u); }
__device__ __forceinline__ float bf1(short s) { return __uint_as_float(((unsigned)(unsigned short)s) << 16); }
__device__ __forceinline__ int crow(int r, int hi) { return (r & 3) + 8 * (r >> 2) + 4 * hi; }
__device__ __forceinline__ int kperm(int s) { return (s & ~15) | (((s >> 2) & 1) << 3) | (((s >> 3) & 1) << 2) | (s & 3); }
template <int CTRL> __device__ __forceinline__ float dpp_f(float v) { return __builtin_bit_cast(float, __builtin_amdgcn_update_dpp(0, __builtin_bit_cast(int, v), CTRL, 0xF, 0xF, true)); }
__device__ __forceinline__ float wave_sum_all(float v) {
    v += dpp_f<0xB1>(v);
    v += dpp_f<0x4E>(v);
    v += dpp_f<0x141>(v);
    v += dpp_f<0x140>(v);
    v += __shfl_xor(v, 16);
    v += __shfl_xor(v, 32);
    return v;
}
__device__ __forceinline__ int wave_sum_all_i(int v) {
    v += __builtin_amdgcn_update_dpp(0, v, 0xB1, 0xF, 0xF, true); v += __builtin_amdgcn_update_dpp(0, v, 0x4E, 0xF, 0xF, true);
    v += __builtin_amdgcn_update_dpp(0, v, 0x141, 0xF, 0xF, true); v += __builtin_amdgcn_update_dpp(0, v, 0x140, 0xF, 0xF, true);
    v += __shfl_xor(v, 16); v += __shfl_xor(v, 32);
    return v;
}
__device__ __forceinline__ float wave_max_all(float v) {
    v = fmaxf(v, dpp_f<0xB1>(v)); v = fmaxf(v, dpp_f<0x4E>(v)); v = fmaxf(v, dpp_f<0x141>(v)); v = fmaxf(v, dpp_f<0x140>(v));
    v = fmaxf(v, __shfl_xor(v, 16)); v = fmaxf(v, __shfl_xor(v, 32));
    return v;
}
__device__ __forceinline__ bf16x8 pack8(float a0, float a1, float a2, float a3, float a4, float a5, float a6, float a7) {
    v4u w; w.x = pk2(a0, a1); w.y = pk2(a2, a3); w.z = pk2(a4, a5); w.w = pk2(a6, a7); return __builtin_bit_cast(bf16x8, w);
}

__device__ __forceinline__ void p0_transpose_item(const float* W, int K, int N, bf16* WT, const float* gs, LAS float* scr, int item, int lane) {
    const int nblk = N / 32, kb = item / nblk, nb = item % nblk, k0 = 64 * kb, n0 = 32 * nb;
#pragma unroll 8
    for (int i = 0; i < 32; ++i) { const int kk = 2 * i + (lane >> 5); float w = W[(size_t)(k0 + kk) * N + n0 + (lane & 31)]; if (gs) w *= gs[k0 + kk]; scr[kk * 33 + (lane & 31)] = w; }
    LDS_WAIT(); asm volatile("" ::: "memory");
    const int c = lane & 7;
#pragma unroll
    for (int j = 0; j < 4; ++j) { const int n = (lane >> 3) + 8 * j; const LAS float* s = scr + (8 * c) * 33 + n;
        v4u o; o.x = pk2(s[0 * 33], s[1 * 33]); o.y = pk2(s[2 * 33], s[3 * 33]); o.z = pk2(s[4 * 33], s[5 * 33]); o.w = pk2(s[6 * 33], s[7 * 33]);
        *(GAS v4u*)(WT + (size_t)(n0 + n) * K + k0 + 8 * c) = o; }
    LDS_WAIT(); asm volatile("" ::: "memory");
}
__device__ __forceinline__ void cvt8_range(Frame& F, const float* src, bf16* dst, size_t n8) {
    const size_t gt = (size_t)blockIdx.x * NTHREADS + F.tid, nt = (size_t)F.G * NTHREADS;
    for (size_t i = gt; i < n8; i += nt) { const f32x4 a = *(const f32x4*)(src + i * 8), b = *(const f32x4*)(src + i * 8 + 4);
        v4u o; o.x = pk2(a.x, a.y); o.y = pk2(a.z, a.w); o.z = pk2(b.x, b.y); o.w = pk2(b.z, b.w); *(v4u*)(dst + i * 8) = o; }
}
__device__ __forceinline__ void p0_prologue(Frame& F, kap_t ka) {
    LAS float* scr = (LAS float*)(F.lds + RING_OFF + F.wave * 16384);
    const int gw = F.vcu * NWAVES + F.wave, NGW = F.G * NWAVES;
    constexpr int I_IN = 16 * 61, I_Q = 16 * 64, I_O = 16 * 32, I_UQ = 4 * 24, I_UKV = 2 * 32, I_L = I_IN + I_Q + I_O + I_UQ + I_UKV;
    for (int it = gw; it < DEPTH * I_L; it += NGW) {
        const int l = it / I_L; int r = it % I_L;
        if (r < I_IN) { p0_transpose_item(ka->in[I_WIN] + (size_t)l * DM * DIN, DM, DIN, wsp<bf16>(ka, WS_WIT) + (size_t)l * DINP * DM, nullptr, scr, r, F.lane); continue; } r -= I_IN;
        if (r < I_Q) { p0_transpose_item(ka->in[I_WQ] + (size_t)l * DM * 2048, DM, 2048, wsp<bf16>(ka, WS_WQT) + (size_t)l * 2048 * DM, nullptr, scr, r, F.lane); continue; } r -= I_Q;
        if (r < I_O) { p0_transpose_item(ka->in[I_WO] + (size_t)l * DM * DM, DM, DM, wsp<bf16>(ka, WS_WOT) + (size_t)l * DM * DM, nullptr, scr, r, F.lane); continue; } r -= I_O;
        if (r < I_UQ) { p0_transpose_item(ka->in[I_WUQ] + (size_t)l * 256 * 768, 256, 768, wsp<bf16>(ka, WS_WUQT) + (size_t)l * 768 * 256, ka->in[I_GCQ] + l * 256, scr, r, F.lane); continue; } r -= I_UQ;
        p0_transpose_item(ka->in[I_WUKV] + (size_t)l * 128 * 1024, 128, 1024, wsp<bf16>(ka, WS_WUKVT) + (size_t)l * 1024 * 128, ka->in[I_GCKV] + l * 128, scr, r, F.lane);
    }
    const size_t gt = (size_t)blockIdx.x * NTHREADS + F.tid, nt = (size_t)F.G * NTHREADS;
    for (size_t i = gt; i < 2 * 12288; i += nt) { const size_t l = i / 12288, j = i % 12288; *(v4u*)(wsp<bf16>(ka, WS_WIT) + l * DINP * DM + (size_t)DIN * DM + j * 8) = (v4u){0u, 0u, 0u, 0u}; }
    for (size_t i = gt; i < (size_t)SEQ * 16; i += nt) { const int pos = (int)(i >> 4), k = (int)(i & 15);
        const float inv_freq = (float)pow(10000.0, -(double)k / 16.0); const float ang = (float)pos * inv_freq;
        wsp<f32x2>(ka, WS_ROPE)[i] = (f32x2){(float)cos((double)ang), (float)sin((double)ang)}; }
    for (size_t i = gt; i < (size_t)DEPTH * 8 * 2 * 128 * 16; i += nt) {
        const size_t lhc = i >> 11; const int n = (int)(i >> 4) & 127, dg = (int)i & 15;
        const float* src = ka->in[I_KEYS] + i * 8; const f32x4 a = *(const f32x4*)src, b = *(const f32x4*)(src + 4);
        v4u o; o.x = pk2(a.x, a.y); o.y = pk2(a.z, a.w); o.z = pk2(b.x, b.y); o.w = pk2(b.z, b.w);
        *(v4u*)(wsp<bf16>(ka, WS_KEYS) + (lhc * 2048 + (size_t)(((n >> 5) * 8 + (dg >> 1)) * 64 + (dg & 1) * 32 + (n & 31))) * 8) = o;
    }
    cvt8_range(F, ka->in[I_X], wsp<bf16>(ka, WS_XB), (size_t)NTOK * DM / 8);
    {
#ifdef MK_DBG_L0
        constexpr int NL = 1;
#else
        constexpr int NL = DEPTH;
#endif
        unsigned char* UQ = wsp<unsigned char>(ka, WS_UT); unsigned char* VQ = wsp<unsigned char>(ka, WS_VT); float* SUV = wsp<float>(ka, WS_SUV);
        for (int row = gw; row < 2 * NL * NEXP; row += NGW) {
            const int tbl = row / (NL * NEXP), r = row % (NL * NEXP);
            const float* src = (tbl ? ka->in[I_V] : ka->in[I_U]) + (size_t)r * DM + 16 * F.lane;
            f32x4 v[4]; float m = 0.f;
#pragma unroll
            for (int j = 0; j < 4; ++j) { v[j] = *(const f32x4*)(src + 4 * j); m = fmaxf(m, fmaxf(fmaxf(fabsf(v[j].x), fabsf(v[j].y)), fmaxf(fabsf(v[j].z), fabsf(v[j].w)))); }
            m = wave_max_all(m);
            const float inv = m > 0.f ? 127.f / m : 0.f;
            const int off = tbl ? 128 : 0;
            v4u o;
#pragma unroll
            for (int j = 0; j < 4; ++j) {
                const unsigned b0 = (unsigned)((int)rintf(v[j].x * inv) + off) & 0xffu, b1 = (unsigned)((int)rintf(v[j].y * inv) + off) & 0xffu, b2 = (unsigned)((int)rintf(v[j].z * inv) + off) & 0xffu, b3 = (unsigned)((int)rintf(v[j].w * inv) + off) & 0xffu;
                o[j] = b0 | (b1 << 8) | (b2 << 16) | (b3 << 24);
            }
            *(v4u*)((tbl ? VQ : UQ) + (size_t)r * DM + 16 * F.lane) = o;
            if (F.lane == 0) SUV[2 * (size_t)r + tbl] = m * (1.f / 127.f);
        }
    }
}

__device__ __forceinline__ void p2_unit(Frame& F, kap_t ka, int l, int tb, int part) {
    const int lane = F.lane, r32 = lane & 31, hi = lane >> 5;
    const int tok = tb * 32 + r32, b = tok / SEQ, s = tok % SEQ;
    const bf16* hrow = wsp<bf16>(ka, WS_HB) + (size_t)tok * DINP;
    if (part < 2) {
        bf16x8 xf[16]; float ssq = 0.f;
#pragma unroll
        for (int ks = 0; ks < 16; ++ks) { xf[ks] = *(const bf16x8*)(hrow + 1536 + ks * 16 + 8 * hi);
#pragma unroll
            for (int e = 0; e < 8; ++e) { const float v = bf1(xf[ks][e]); ssq += v * v; } }
        ssq += __shfl_xor(ssq, 32);
        const float rstd = rsqrtf(ssq * (1.f / 256.f) + RMS_EPS) * QSCALE;
        const bf16* W = wsp<bf16>(ka, WS_WUQT) + (size_t)l * 768 * 256;
        for (int j = part * 12; j < part * 12 + 12; ++j) {
            const int head = j / 3, sub = j % 3;
            const bf16* wrow = W + (size_t)(j * 32 + r32) * 256 + 8 * hi;
            f32x16 acc = {};
#pragma unroll
            for (int ks = 0; ks < 16; ++ks) acc = __builtin_amdgcn_mfma_f32_32x32x16_bf16(*(const bf16x8*)(wrow + ks * 16), xf[ks], acc, 0, 0, 0);
            float v[16];
#pragma unroll
            for (int r = 0; r < 16; ++r) v[r] = acc[r] * rstd;
            if (sub == 2) {
#pragma unroll
                for (int r = 0; r < 8; ++r) { const f32x2 cs = wsp<f32x2>(ka, WS_ROPE)[s * 16 + crow(r, hi)]; const float x1 = v[r], x2 = v[r + 8]; v[r] = x1 * cs.x - x2 * cs.y; v[r + 8] = x2 * cs.x + x1 * cs.y; }
            }
            bf16* dst = wsp<bf16>(ka, WS_QM) + ((size_t)(b * 8 + head) * SEQ + s) * 96 + sub * 32 + 4 * hi;
#pragma unroll
            for (int g = 0; g < 4; ++g) { v2u w; w.x = pk2(v[4 * g], v[4 * g + 1]); w.y = pk2(v[4 * g + 2], v[4 * g + 3]); *(v2u*)(dst + 8 * g) = w; }
        }
    } else {
        const int h0 = (part - 2) * 4;
        bf16x8 xf[8]; float ssq = 0.f;
#pragma unroll
        for (int ks = 0; ks < 8; ++ks) { xf[ks] = *(const bf16x8*)(hrow + 1792 + ks * 16 + 8 * hi);
#pragma unroll
            for (int e = 0; e < 8; ++e) { const float v = bf1(xf[ks][e]); ssq += v * v; } }
        ssq += __shfl_xor(ssq, 32);
        const float rstd = rsqrtf(ssq * (1.f / 128.f) + RMS_EPS);
        const bf16* W = wsp<bf16>(ka, WS_WUKVT) + (size_t)l * 1024 * 128;
        const int sp = kperm(s);
        for (int j = h0 * 4; j < h0 * 4 + 16; ++j) {
            const int head = j >> 2, sub = j & 3;
            const bf16* wrow = W + (size_t)(j * 32 + r32) * 128 + 8 * hi;
            f32x16 acc = {};
#pragma unroll
            for (int ks = 0; ks < 8; ++ks) acc = __builtin_amdgcn_mfma_f32_32x32x16_bf16(*(const bf16x8*)(wrow + ks * 16), xf[ks], acc, 0, 0, 0);
            if (sub < 2) {
                bf16* dst = wsp<bf16>(ka, WS_KM) + (size_t)(b * 8 + head) * SEQ * 96 + (size_t)(s >> 5) * (6 * 512) + (size_t)r32 * 8 + 4 * hi;
#pragma unroll
                for (int g = 0; g < 4; ++g) { v2u w; w.x = pk2(acc[4 * g] * rstd, acc[4 * g + 1] * rstd); w.y = pk2(acc[4 * g + 2] * rstd, acc[4 * g + 3] * rstd); *(v2u*)(dst + (2 * sub + (g >> 1)) * 512 + (g & 1) * 256) = w; }
            } else {
                bf16* dst = wsp<bf16>(ka, WS_VMT) + (size_t)(b * 8 + head) * 64 * SEQ + (size_t)(s >> 5) * (4 * 512) + ((sub - 2) * 2 + ((s >> 4) & 1)) * 512 + ((sp >> 3) & 1) * 256 + (sp & 7);
#pragma unroll
                for (int r = 0; r < 16; ++r) dst[crow(r, hi) * 8] = (bf16)f2bf(acc[r] * rstd);
            }
        }
        { const bf16x8 a1 = *(const bf16x8*)(hrow + 1920 + 8 * hi), a2 = *(const bf16x8*)(hrow + 1936 + 8 * hi);
          float o1[8], o2[8];
#pragma unroll
          for (int e = 0; e < 8; ++e) { const f32x2 cs = wsp<f32x2>(ka, WS_ROPE)[s * 16 + 8 * hi + e]; const float x1 = bf1(a1[e]), x2 = bf1(a2[e]); o1[e] = x1 * cs.x - x2 * cs.y; o2[e] = x2 * cs.x + x1 * cs.y; }
          const bf16x8 p1 = pack8(o1[0], o1[1], o1[2], o1[3], o1[4], o1[5], o1[6], o1[7]), p2 = pack8(o2[0], o2[1], o2[2], o2[3], o2[4], o2[5], o2[6], o2[7]);
#pragma unroll
          for (int hh = 0; hh < 4; ++hh) { bf16* dst = wsp<bf16>(ka, WS_KM) + (size_t)(b * 8 + h0 + hh) * SEQ * 96 + (size_t)(s >> 5) * (6 * 512) + 4 * 512 + hi * 256 + (size_t)r32 * 8; *(bf16x8*)dst = p1; *(bf16x8*)(dst + 512) = p2; } }
#pragma unroll
        for (int hh = 0; hh < 4; ++hh) {
            const int head = h0 + hh;
#pragma unroll
            for (int c4 = 0; c4 < 4; ++c4) { const bf16x8 a = *(const bf16x8*)(hrow + 1024 + head * 64 + 32 * hi + c4 * 8);
                bf16* dst = wsp<bf16>(ka, WS_VST) + ((size_t)(b * 8 + head) * 64 + 32 * hi + c4 * 8) * SEQ + sp;
#pragma unroll
                for (int e = 0; e < 8; ++e) dst[(size_t)e * SEQ] = (bf16)a[e]; }
        }
    }
}

__device__ __forceinline__ float xhalf_max(float v) { auto rr = __builtin_amdgcn_permlane32_swap(__float_as_uint(v), __float_as_uint(v), false, false); return fmaxf(__uint_as_float(rr[0]), __uint_as_float(rr[1])); }
__device__ __forceinline__ float xhalf_sum(float v) { auto rr = __builtin_amdgcn_permlane32_swap(__float_as_uint(v), __float_as_uint(v), false, false); return __uint_as_float(rr[0]) + __uint_as_float(rr[1]); }
constexpr float MLA_THR = 8.f;
__device__ __forceinline__ void mla_unit(Frame& F, kap_t ka, int bh, int qb) {
    const int lane = F.lane, r32 = lane & 31, hi = lane >> 5, q0 = qb * 32;
    const bf16* Qp = wsp<bf16>(ka, WS_QM) + ((size_t)bh * SEQ + q0 + r32) * 96 + 8 * hi;
    bf16x8 qf[6];
#pragma unroll
    for (int ks = 0; ks < 6; ++ks) qf[ks] = *(const bf16x8*)(Qp + ks * 16);
    f32x16 o0 = {}, o1 = {};
    float m = -1e30f, l = 0.f;
    const bf16* Kp = wsp<bf16>(ka, WS_KM) + (size_t)bh * SEQ * 96 + 8 * lane;
    const bf16* Vp = wsp<bf16>(ka, WS_VMT) + (size_t)bh * 64 * SEQ + 8 * lane;
#define MLA_LOADK(KF, kt) do { _Pragma("unroll") for (int ks = 0; ks < 6; ++ks) KF[ks] = *(const bf16x8*)(Kp + (size_t)((kt) * 6 + ks) * 512); } while (0)
#define MLA_LOADV(VF, kt) do { _Pragma("unroll") for (int i = 0; i < 4; ++i) VF[i] = *(const bf16x8*)(Vp + (size_t)((kt) * 4 + i) * 512); } while (0)
#define MLA_QK(S, KF) do { S = (f32x16){}; _Pragma("unroll") for (int ks = 0; ks < 6; ++ks) S = __builtin_amdgcn_mfma_f32_32x32x16_bf16(KF[ks], qf[ks], S, 0, 0, 0); } while (0)
#define MLA_SMPV(S, VF, kt) do { \
        if ((kt) == qb) { _Pragma("unroll") for (int r = 0; r < 16; ++r) if (crow(r, hi) > r32) S[r] = -1e30f; } \
        float mx = fmaxf(fmaxf(S[0], S[1]), fmaxf(S[2], S[3])); \
        _Pragma("unroll") for (int r = 4; r < 16; r += 4) mx = fmaxf(mx, fmaxf(fmaxf(S[r], S[r + 1]), fmaxf(S[r + 2], S[r + 3]))); \
        mx = xhalf_max(mx); \
        if (__any(mx - m > MLA_THR)) { const float mn = fmaxf(m, mx), alpha = __builtin_amdgcn_exp2f(m - mn); l *= alpha; m = mn; \
            _Pragma("unroll") for (int r = 0; r < 16; ++r) { o0[r] *= alpha; o1[r] *= alpha; } } \
        float p[16], rs0 = 0.f, rs1 = 0.f; \
        _Pragma("unroll") for (int r = 0; r < 16; r += 2) { p[r] = __builtin_amdgcn_exp2f(S[r] - m); p[r + 1] = __builtin_amdgcn_exp2f(S[r + 1] - m); rs0 += p[r]; rs1 += p[r + 1]; } \
        l += rs0 + rs1; \
        const bf16x8 pf0 = pack8(p[0], p[1], p[2], p[3], p[4], p[5], p[6], p[7]), pf1 = pack8(p[8], p[9], p[10], p[11], p[12], p[13], p[14], p[15]); \
        o0 = __builtin_amdgcn_mfma_f32_32x32x16_bf16(VF[0], pf0, o0, 0, 0, 0); \
        o1 = __builtin_amdgcn_mfma_f32_32x32x16_bf16(VF[2], pf0, o1, 0, 0, 0); \
        o0 = __builtin_amdgcn_mfma_f32_32x32x16_bf16(VF[1], pf1, o0, 0, 0, 0); \
        o1 = __builtin_amdgcn_mfma_f32_32x32x16_bf16(VF[3], pf1, o1, 0, 0, 0); } while (0)
    bf16x8 kA[6], kB[6], vA[4], vB[4];
    f32x16 sA, sB;
    MLA_LOADK(kA, 0); MLA_LOADV(vA, 0); MLA_LOADK(kB, 1);
    MLA_QK(sA, kA);
    for (int kt = 0; kt <= qb; kt += 2) {
        MLA_LOADK(kA, kt + 2); MLA_LOADV(vB, kt + 1);
        MLA_QK(sB, kB);
        MLA_SMPV(sA, vA, kt);
        if (kt + 1 > qb) break;
        MLA_LOADK(kB, kt + 3); MLA_LOADV(vA, kt + 2);
        MLA_QK(sA, kA);
        MLA_SMPV(sB, vB, kt + 1);
    }
#undef MLA_LOADK
#undef MLA_LOADV
#undef MLA_QK
#undef MLA_SMPV
    l = xhalf_sum(l);
    const float rl = 1.f / l;
    const int b = bh >> 3, h = bh & 7;
    bf16* dst = wsp<bf16>(ka, WS_OB) + ((size_t)b * SEQ + q0 + r32) * DM + 512 + h * 64 + 4 * hi;
#pragma unroll
    for (int g = 0; g < 4; ++g) {
        v2u w; w.x = pk2(o0[4 * g] * rl, o0[4 * g + 1] * rl); w.y = pk2(o0[4 * g + 2] * rl, o0[4 * g + 3] * rl); *(v2u*)(dst + 8 * g) = w;
        v2u u; u.x = pk2(o1[4 * g] * rl, o1[4 * g + 1] * rl); u.y = pk2(o1[4 * g + 2] * rl, o1[4 * g + 3] * rl); *(v2u*)(dst + 32 + 8 * g) = u;
    }
}

__device__ __forceinline__ void mla_block(Frame& F, kap_t ka, int bh, int J) {
    const int tid = F.tid, lane = F.lane, r32 = lane & 31, hi = lane >> 5, wave = F.wave;
    const int qb = 8 * J + wave, q0 = qb * 32, T = 8 * J + 8;
    const bf16* Qp = wsp<bf16>(ka, WS_QM) + ((size_t)bh * SEQ + q0 + r32) * 96 + 8 * hi;
    bf16x8 qf[6];
#pragma unroll
    for (int ks = 0; ks < 6; ++ks) qf[ks] = *(const bf16x8*)(Qp + ks * 16);
    f32x16 o0 = {}, o1 = {};
    float m = -1e30f, l = 0.f;
    const unsigned char* Kt = (const unsigned char*)(wsp<bf16>(ka, WS_KM) + (size_t)bh * SEQ * 96);
    const unsigned char* Vt = (const unsigned char*)(wsp<bf16>(ka, WS_VMT) + (size_t)bh * 64 * SEQ);
    LAS unsigned char* ring = F.lds + RING_OFF;
    const bool c0k = tid < 384;
    const size_t off0 = c0k ? (size_t)tid * 16 : (size_t)(tid - 384) * 16, off1 = (size_t)(128 + tid) * 16;
#define MB_GLOAD(t) do { r0 = *(const v4u*)((c0k ? Kt + (size_t)(t) * 6144 : Vt + (size_t)(t) * 4096) + off0); if (tid < 128) r1 = *(const v4u*)(Vt + (size_t)(t) * 4096 + off1); } while (0)
#define MB_LWRITE(s) do { *(LAS v4u*)(ring + (s) * 10240 + tid * 16) = r0; if (tid < 128) *(LAS v4u*)(ring + (s) * 10240 + 8192 + tid * 16) = r1; } while (0)
    v4u r0 = {}, r1 = {};
    MB_GLOAD(0); MB_LWRITE(0);
    if (T > 1) MB_GLOAD(1);
    for (int t = 0; t < T; ++t) {
        __syncthreads();
        const bool active = t <= qb;
        bf16x8 kf[6], vf[4];
        if (active) { const LAS unsigned char* sl = ring + (t & 1) * 10240 + lane * 16;
#pragma unroll
            for (int ks = 0; ks < 6; ++ks) kf[ks] = *(const LAS bf16x8*)(sl + ks * 1024);
#pragma unroll
            for (int i = 0; i < 4; ++i) vf[i] = *(const LAS bf16x8*)(sl + 6144 + i * 1024); }
        if (t + 1 < T) MB_LWRITE((t + 1) & 1);
        if (t + 2 < T) MB_GLOAD(t + 2);
        if (active) {
            f32x16 sa = {};
#pragma unroll
            for (int ks = 0; ks < 6; ++ks) sa = __builtin_amdgcn_mfma_f32_32x32x16_bf16(kf[ks], qf[ks], sa, 0, 0, 0);
            if (t == qb) {
#pragma unroll
                for (int r = 0; r < 16; ++r) if (crow(r, hi) > r32) sa[r] = -1e30f;
            }
            float mx = fmaxf(fmaxf(sa[0], sa[1]), fmaxf(sa[2], sa[3]));
#pragma unroll
            for (int r = 4; r < 16; r += 4) mx = fmaxf(mx, fmaxf(fmaxf(sa[r], sa[r + 1]), fmaxf(sa[r + 2], sa[r + 3])));
            mx = xhalf_max(mx);
            if (__any(mx - m > MLA_THR)) { const float mn = fmaxf(m, mx), alpha = __builtin_amdgcn_exp2f(m - mn); l *= alpha; m = mn;
#pragma unroll
                for (int r = 0; r < 16; ++r) { o0[r] *= alpha; o1[r] *= alpha; } }
            float p[16], rs = 0.f;
#pragma unroll
            for (int r = 0; r < 16; ++r) { p[r] = __builtin_amdgcn_exp2f(sa[r] - m); rs += p[r]; }
            l += rs;
            const bf16x8 pf0 = pack8(p[0], p[1], p[2], p[3], p[4], p[5], p[6], p[7]), pf1 = pack8(p[8], p[9], p[10], p[11], p[12], p[13], p[14], p[15]);
            o0 = __builtin_amdgcn_mfma_f32_32x32x16_bf16(vf[0], pf0, o0, 0, 0, 0);
            o0 = __builtin_amdgcn_mfma_f32_32x32x16_bf16(vf[1], pf1, o0, 0, 0, 0);
            o1 = __builtin_amdgcn_mfma_f32_32x32x16_bf16(vf[2], pf0, o1, 0, 0, 0);
            o1 = __builtin_amdgcn_mfma_f32_32x32x16_bf16(vf[3], pf1, o1, 0, 0, 0);
        }
    }
#undef MB_GLOAD
#undef MB_LWRITE
    __syncthreads();
    l = xhalf_sum(l);
    const float rl = 1.f / l;
    const int b = bh >> 3, h = bh & 7;
    bf16* dst = wsp<bf16>(ka, WS_OB) + ((size_t)b * SEQ + q0 + r32) * DM + 512 + h * 64 + 4 * hi;
#pragma unroll
    for (int g = 0; g < 4; ++g) {
        v2u w; w.x = pk2(o0[4 * g] * rl, o0[4 * g + 1] * rl); w.y = pk2(o0[4 * g + 2] * rl, o0[4 * g + 3] * rl); *(v2u*)(dst + 8 * g) = w;
        v2u u; u.x = pk2(o1[4 * g] * rl, o1[4 * g + 1] * rl); u.y = pk2(o1[4 * g + 2] * rl, o1[4 * g + 3] * rl); *(v2u*)(dst + 32 + 8 * g) = u;
    }
}

__device__ __forceinline__ void sb_unit(Frame& F, kap_t ka, int bh, int qb) {
    const int lane = F.lane, r32 = lane & 31, hi = lane >> 5, q0 = qb * 32;
    const int b = bh >> 3, h = bh & 7;
    const bf16* Hb = wsp<bf16>(ka, WS_HB) + (size_t)b * SEQ * DINP + h * 64 + 8 * hi;
    bf16x8 qf[4];
#pragma unroll
    for (int ks = 0; ks < 4; ++ks) qf[ks] = *(const bf16x8*)(Hb + (size_t)(q0 + r32) * DINP + ks * 16);
    f32x16 o0 = {}, o1 = {};
    float R = 0.f;
    const bf16* Vp = wsp<bf16>(ka, WS_VST) + ((size_t)bh * 64 + r32) * SEQ + 8 * hi;
    for (int k0 = q0; k0 >= 0; k0 -= 32) {
        bf16x8 kf[4], vf[4];
#pragma unroll
        for (int ks = 0; ks < 4; ++ks) kf[ks] = *(const bf16x8*)(Hb + (size_t)(k0 + r32) * DINP + 512 + ks * 16);
#pragma unroll
        for (int i = 0; i < 4; ++i) vf[i] = *(const bf16x8*)(Vp + (size_t)(i >> 1) * 32 * SEQ + k0 + 16 * (i & 1));
        f32x16 za = {};
#pragma unroll
        for (int ks = 0; ks < 4; ++ks) za = __builtin_amdgcn_mfma_f32_32x32x16_bf16(kf[ks], qf[ks], za, 0, 0, 0);
        const bool diag = (k0 == q0);
        float L[16], lw[16];
#pragma unroll
        for (int r = 0; r < 16; ++r) {
            const float z = za[r] * 0.125f;
            const float sp = fmaxf(z, 0.f) + __logf(1.f + __expf(-fabsf(z)));
            const bool valid = !diag || (crow(r, hi) < r32);
            L[r] = valid ? -sp : 0.f;
            lw[r] = valid ? (z - sp) : -1e30f;
        }
        float e[16], T[4], U[4];
#pragma unroll
        for (int g = 0; g < 4; ++g) { e[4 * g + 3] = 0.f; e[4 * g + 2] = L[4 * g + 3]; e[4 * g + 1] = e[4 * g + 2] + L[4 * g + 2]; e[4 * g] = e[4 * g + 1] + L[4 * g + 1]; T[g] = e[4 * g] + L[4 * g]; }
#pragma unroll
        for (int g = 0; g < 4; ++g) U[g] = __shfl_xor(T[g], 32);
        float sT[4], sUge[4];
        sT[3] = 0.f; sT[2] = T[3]; sT[1] = T[3] + T[2]; sT[0] = sT[1] + T[1];
        sUge[3] = U[3]; sUge[2] = U[3] + U[2]; sUge[1] = sUge[2] + U[1]; sUge[0] = sUge[1] + U[0];
        float w[16];
#pragma unroll
        for (int g = 0; g < 4; ++g) {
            const float sfx = R + sT[g] + (hi ? (sUge[g] - U[g]) : sUge[g]);
#pragma unroll
            for (int i = 0; i < 4; ++i) w[4 * g + i] = __expf(lw[4 * g + i] + sfx + e[4 * g + i]);
        }
        R += (sT[0] + T[0]) + sUge[0];
        const bf16x8 pf0 = pack8(w[0], w[1], w[2], w[3], w[4], w[5], w[6], w[7]), pf1 = pack8(w[8], w[9], w[10], w[11], w[12], w[13], w[14], w[15]);
        o0 = __builtin_amdgcn_mfma_f32_32x32x16_bf16(vf[0], pf0, o0, 0, 0, 0);
        o0 = __builtin_amdgcn_mfma_f32_32x32x16_bf16(vf[1], pf1, o0, 0, 0, 0);
        o1 = __builtin_amdgcn_mfma_f32_32x32x16_bf16(vf[2], pf0, o1, 0, 0, 0);
        o1 = __builtin_amdgcn_mfma_f32_32x32x16_bf16(vf[3], pf1, o1, 0, 0, 0);
        if (__all(R < -88.f)) break;
    }
    bf16* dst = wsp<bf16>(ka, WS_OB) + ((size_t)b * SEQ + q0 + r32) * DM + h * 64 + 4 * hi;
#pragma unroll
    for (int g = 0; g < 4; ++g) {
        v2u wv; wv.x = pk2(o0[4 * g], o0[4 * g + 1]); wv.y = pk2(o0[4 * g + 2], o0[4 * g + 3]); *(v2u*)(dst + 8 * g) = wv;
        v2u u; u.x = pk2(o1[4 * g], o1[4 * g + 1]); u.y = pk2(o1[4 * g + 2], o1[4 * g + 3]); *(v2u*)(dst + 32 + 8 * g) = u;
    }
}

__device__ __forceinline__ void ln1_row(Frame& F, kap_t ka, int row, const float* g, const float* bb) {
    float* yr = ka->out + (size_t)row * DM;
    f32x4 v[4]; float s = 0.f;
#pragma unroll
    for (int j = 0; j < 4; ++j) { v[j] = *(const f32x4*)(yr + 4 * F.lane + 256 * j); s += (v[j].x + v[j].y) + (v[j].z + v[j].w); }
    const float mean = wave_sum_all(s) * (1.f / DM); float s2 = 0.f;
#pragma unroll
    for (int j = 0; j < 4; ++j) { v[j] = v[j] - mean; s2 += (v[j].x * v[j].x + v[j].y * v[j].y) + (v[j].z * v[j].z + v[j].w * v[j].w); }
    const float rstd = rsqrtf(wave_sum_all(s2) * (1.f / DM) + LN_EPS);
#pragma unroll
    for (int j = 0; j < 4; ++j) { const int c = 4 * F.lane + 256 * j; const f32x4 gg = *(const f32x4*)(g + c), bv = *(const f32x4*)(bb + c);
        const f32x4 o = v[j] * rstd * gg + bv; *(f32x4*)(yr + c) = o;
        v2u w; w.x = pk2(o.x, o.y); w.y = pk2(o.z, o.w); *(v2u*)(wsp<bf16>(ka, WS_XB) + (size_t)row * DM + c) = w; }
}

template <int N, int K, int J, bool FLIP> __device__ __forceinline__ void bitonic_stage(unsigned (&v)[N]) {
#pragma unroll
    for (int i = 0; i < N; ++i) { const int p = i ^ J; if (p > i) { const bool desc = (((i & K) == 0) != FLIP); const unsigned a = v[i], c = v[p]; const unsigned mx = a > c ? a : c, mn = a > c ? c : a; v[i] = desc ? mx : mn; v[p] = desc ? mn : mx; } }
}
template <bool FLIP> __device__ __forceinline__ void bitonic_merge16(unsigned (&v)[16]) {
    bitonic_stage<16, 16, 8, FLIP>(v); bitonic_stage<16, 16, 4, FLIP>(v); bitonic_stage<16, 16, 2, FLIP>(v); bitonic_stage<16, 16, 1, FLIP>(v);
}
__device__ __forceinline__ unsigned ord_key(float f, unsigned idx) { const unsigned u = __float_as_uint(f); const unsigned o = u ^ ((unsigned)((int)u >> 31) | 0x80000000u); return (o & 0xFFFFFF80u) | idx; }
__device__ __forceinline__ float key_val(unsigned k) { const unsigned o = (k & 0xFFFFFF80u) | 0x40u; const unsigned u = (o & 0x80000000u) ? (o ^ 0x80000000u) : ~o; return __uint_as_float(u); }
template <int N, int K, int J, bool FLIP> __device__ __forceinline__ void bitonic_stage_kv(unsigned (&k)[N], unsigned (&p)[N]) {
#pragma unroll
    for (int i = 0; i < N; ++i) { const int q = i ^ J; if (q > i) { const bool desc = (((i & K) == 0) != FLIP); const bool sw = desc ? (k[i] < k[q]) : (k[i] > k[q]);
        const unsigned ki = sw ? k[q] : k[i], kq = sw ? k[i] : k[q], pi = sw ? p[q] : p[i], pq = sw ? p[i] : p[q]; k[i] = ki; k[q] = kq; p[i] = pi; p[q] = pq; } }
}
template <bool FLIP> __device__ __forceinline__ void bitonic_merge16_kv(unsigned (&k)[16], unsigned (&p)[16]) {
    bitonic_stage_kv<16, 16, 8, FLIP>(k, p); bitonic_stage_kv<16, 16, 4, FLIP>(k, p); bitonic_stage_kv<16, 16, 2, FLIP>(k, p); bitonic_stage_kv<16, 16, 1, FLIP>(k, p);
}
__device__ __forceinline__ void p7_half(Frame& F, kap_t ka, int l, int tok, int h, int c, unsigned (&Cc)[16]) {
    const int lane = F.lane, hi = lane >> 5;
    const bf16* qrow = wsp<bf16>(ka, WS_HB) + (size_t)tok * 2048 + h * 256 + c * 128 + 8 * hi;
    bf16x8 qf[8];
#pragma unroll
    for (int ks = 0; ks < 8; ++ks) qf[ks] = *(const bf16x8*)(qrow + ks * 16);
    const bf16* kb = wsp<bf16>(ka, WS_KEYS) + (size_t)((l * 8 + h) * 2 + c) * 16384 + 8 * lane;
    unsigned key[64];
#pragma unroll
    for (int ch = 0; ch < 4; ++ch) {
        f32x16 acc = {};
#pragma unroll
        for (int ks = 0; ks < 8; ++ks) acc = __builtin_amdgcn_mfma_f32_32x32x16_bf16(*(const bf16x8*)(kb + (ch * 8 + ks) * 512), qf[ks], acc, 0, 0, 0);
#pragma unroll
        for (int r = 0; r < 16; ++r) key[ch * 16 + r] = ord_key(acc[r], (unsigned)(ch * 32 + crow(r, hi)));
    }
    bitonic_stage<64, 2, 1, false>(key);
    bitonic_stage<64, 4, 2, false>(key); bitonic_stage<64, 4, 1, false>(key);
    bitonic_stage<64, 8, 4, false>(key); bitonic_stage<64, 8, 2, false>(key); bitonic_stage<64, 8, 1, false>(key);
    bitonic_stage<64, 16, 8, false>(key); bitonic_stage<64, 16, 4, false>(key); bitonic_stage<64, 16, 2, false>(key); bitonic_stage<64, 16, 1, false>(key);
    unsigned A[16], B[16];
#pragma unroll
    for (int i = 0; i < 16; ++i) { A[i] = key[i] > key[16 + i] ? key[i] : key[16 + i]; B[i] = key[32 + i] > key[48 + i] ? key[32 + i] : key[48 + i]; }
    bitonic_merge16<false>(A);
    bitonic_merge16<true>(B);
#pragma unroll
    for (int i = 0; i < 16; ++i) A[i] = A[i] > B[i] ? A[i] : B[i];
    bitonic_merge16<false>(A);
#pragma unroll
    for (int i = 0; i < 16; ++i) B[i] = (unsigned)__shfl_xor((int)A[i], 32);
#pragma unroll
    for (int i = 0; i < 16; ++i) Cc[i] = A[i] > B[15 - i] ? A[i] : B[15 - i];
    bitonic_merge16<false>(Cc);
}
__device__ __forceinline__ void p7_unit(Frame& F, kap_t ka, int l, int tb, int h) {
    const int lane = F.lane, r32 = lane & 31, hi = lane >> 5;
    const int tok = tb * 32 + r32;
    unsigned L0[16], L1[16];
#pragma unroll
    for (int i = 0; i < 16; ++i) { L0[i] = 0u; L1[i] = 0u; }
#pragma unroll 1
    for (int c = 0; c < 2; ++c) {
        unsigned Cc[16];
        p7_half(F, ka, l, tok, h, c, Cc);
#pragma unroll
        for (int i = 0; i < 16; ++i) { L0[i] = c == 0 ? Cc[i] : L0[i]; L1[i] = c == 0 ? L1[i] : Cc[i]; }
    }
    __builtin_amdgcn_sched_barrier(0);
    unsigned key[64];
    {
        float v0[16], v1[16];
#pragma unroll
        for (int i = 0; i < 16; ++i) { v0[i] = key_val(L0[i]); v1[i] = key_val(L1[i]); }
#define P7_ROW(a, off, nb) { _Pragma("unroll") for (int b2 = 0; b2 < (nb); ++b2) { \
            const float sum = v0[a] + v1[b2]; const unsigned u = __float_as_uint(sum); const unsigned o = u ^ ((unsigned)((int)u >> 31) | 0x80000000u); \
            key[(off) + b2] = (o & 0xFFFFFF00u) | (unsigned)(255 - (16 * (a) + b2)); } }
        P7_ROW(0, 0, 16) P7_ROW(1, 16, 8) P7_ROW(2, 24, 5) P7_ROW(3, 29, 4) P7_ROW(4, 33, 3) P7_ROW(5, 36, 2) P7_ROW(6, 38, 2) P7_ROW(7, 40, 2)
        P7_ROW(8, 42, 1) P7_ROW(9, 43, 1) P7_ROW(10, 44, 1) P7_ROW(11, 45, 1) P7_ROW(12, 46, 1) P7_ROW(13, 47, 1) P7_ROW(14, 48, 1) P7_ROW(15, 49, 1)
#undef P7_ROW
#pragma unroll
        for (int i = 50; i < 64; ++i) key[i] = 0u;
    }
    LAS unsigned char* slot = F.lds + RING_OFF + F.wave * 2304 + lane * 36;
#pragma unroll
    for (int q = 0; q < 4; ++q) {
        ((LAS unsigned*)slot)[q] = (L0[4 * q] & 127u) | ((L0[4 * q + 1] & 127u) << 8) | ((L0[4 * q + 2] & 127u) << 16) | ((L0[4 * q + 3] & 127u) << 24);
        ((LAS unsigned*)slot)[4 + q] = (L1[4 * q] & 127u) | ((L1[4 * q + 1] & 127u) << 8) | ((L1[4 * q + 2] & 127u) << 16) | ((L1[4 * q + 3] & 127u) << 24);
    }
    bitonic_stage<64, 2, 1, false>(key);
    bitonic_stage<64, 4, 2, false>(key); bitonic_stage<64, 4, 1, false>(key);
    bitonic_stage<64, 8, 4, false>(key); bitonic_stage<64, 8, 2, false>(key); bitonic_stage<64, 8, 1, false>(key);
    bitonic_stage<64, 16, 8, false>(key); bitonic_stage<64, 16, 4, false>(key); bitonic_stage<64, 16, 2, false>(key); bitonic_stage<64, 16, 1, false>(key);
    unsigned A[16], B[16];
#pragma unroll
    for (int i = 0; i < 16; ++i) { A[i] = key[i] > key[16 + i] ? key[i] : key[16 + i]; B[i] = key[32 + i] > key[48 + i] ? key[32 + i] : key[48 + i]; }
    bitonic_merge16<false>(A);
    bitonic_merge16<true>(B);
#pragma unroll
    for (int i = 0; i < 16; ++i) A[i] = A[i] > B[i] ? A[i] : B[i];
    bitonic_merge16<false>(A);
    LDS_WAIT(); asm volatile("" ::: "memory");
    unsigned PA[16]; float g[16], den = 0.f;
    { const unsigned o0 = (A[0] & 0xFFFFFF00u) | 128u; const float m = __uint_as_float((o0 & 0x80000000u) ? (o0 ^ 0x80000000u) : ~o0);
#pragma unroll
      for (int i = 0; i < 16; ++i) { const unsigned o = (A[i] & 0xFFFFFF00u) | 128u; const float sv = __uint_as_float((o & 0x80000000u) ? (o ^ 0x80000000u) : ~o); g[i] = __expf(sv - m); den += g[i];
          const unsigned flat = 255u - (A[i] & 255u); PA[i] = (unsigned)slot[flat >> 4] * 128u + (unsigned)slot[16 + (flat & 15u)]; } }
    LDS_WAIT(); asm volatile("" ::: "memory");
    const float rden = 1.f / den;
    if (hi == 0) {
        unsigned* de = wsp<unsigned>(ka, WS_EL) + (size_t)tok * 128 + h * 16; float* dg = wsp<float>(ka, WS_GL) + (size_t)tok * 128 + h * 16;
#pragma unroll
        for (int q = 0; q < 4; ++q) { *(v4u*)(de + 4 * q) = (v4u){PA[4 * q], PA[4 * q + 1], PA[4 * q + 2], PA[4 * q + 3]};
            *(f32x4*)(dg + 4 * q) = (f32x4){g[4 * q] * rden, g[4 * q + 1] * rden, g[4 * q + 2] * rden, g[4 * q + 3] * rden}; }
    }
}

__device__ __forceinline__ float dot2_bf16(unsigned w, unsigned x, float acc) { return __builtin_amdgcn_fdot2_f32_bf16(__builtin_bit_cast(bf2_t, w), __builtin_bit_cast(bf2_t, x), acc, false); }
__device__ __forceinline__ float gelu_erf(float x) { return 0.5f * x * (1.f + erff(x * 0.70710678118654752f)); }
__device__ __forceinline__ void p8_token(Frame& F, kap_t ka, int l, int tok, const unsigned ev0, const unsigned ev1, const float gv0, const float gv1) {
    const int lane = F.lane;
#ifdef MK_DBG_L0
    unsigned char* dbg_ws = ka->ws;
    ((float*)(dbg_ws + 86 * MiB))[(size_t)tok * 128 + lane] = (float)ev0; ((float*)(dbg_ws + 86 * MiB))[(size_t)tok * 128 + 64 + lane] = (float)ev1;
    ((float*)(dbg_ws + 128 * MiB))[(size_t)tok * 128 + lane] = gv0; ((float*)(dbg_ws + 128 * MiB))[(size_t)tok * 128 + 64 + lane] = gv1;
#endif
    float* xrow = ka->out + (size_t)tok * DM + 16 * lane;
    f32x4 xv[4];
#pragma unroll
    for (int j = 0; j < 4; ++j) xv[j] = *(const f32x4*)(xrow + 4 * j);
    const f32x2* SUV = wsp<f32x2>(ka, WS_SUV) + (size_t)l * NEXP;
    const f32x2 sc0 = SUV[ev0], sc1 = SUV[ev1];
    float xr[16]; float xm = 0.f;
#pragma unroll
    for (int j = 0; j < 4; ++j) { const f32x4 a = xv[j]; xr[4 * j] = a.x; xr[4 * j + 1] = a.y; xr[4 * j + 2] = a.z; xr[4 * j + 3] = a.w;
        xm = fmaxf(xm, fmaxf(fmaxf(fabsf(a.x), fabsf(a.y)), fmaxf(fabsf(a.z), fabsf(a.w)))); }
    xm = wave_max_all(xm);
    const float sx = xm * (1.f / 127.f), invx = xm > 0.f ? 127.f / xm : 0.f;
    int xq[4];
#pragma unroll
    for (int j = 0; j < 4; ++j) xq[j] = (int)(((unsigned)(int)rintf(xr[4 * j] * invx) & 0xffu) | (((unsigned)(int)rintf(xr[4 * j + 1] * invx) & 0xffu) << 8) | (((unsigned)(int)rintf(xr[4 * j + 2] * invx) & 0xffu) << 16) | (((unsigned)(int)rintf(xr[4 * j + 3] * invx) & 0xffu) << 24));
    float acc[16];
#pragma unroll
    for (int i = 0; i < 16; ++i) acc[i] = 0.f;
    const unsigned char* UQ = wsp<unsigned char>(ka, WS_UT) + (size_t)l * NEXP * DM + 16 * lane;
    const unsigned char* VQ = wsp<unsigned char>(ka, WS_VT) + (size_t)l * NEXP * DM + 16 * lane;
    constexpr int PB = 8, NBH = 64 / PB;
    v4u A[PB], B[PB];
    int hqc = 0, hq0 = 0;
#define P8_LOAD(BUF, TAB, bb) do { const unsigned evs_ = (bb) < NBH ? ev0 : ev1; _Pragma("unroll") for (int j = 0; j < PB; ++j) { \
        const unsigned e_ = (unsigned)__builtin_amdgcn_readlane((int)evs_, (PB * (bb) + j) & 63); BUF[j] = *(const v4u*)(TAB + (size_t)e_ * DM); } } while (0)
#define P8_COMPU(BUF, bb) do { const int lrel_ = lane - ((PB * (bb)) & 63); _Pragma("unroll") for (int j = 0; j < PB; ++j) { \
        int p_ = __builtin_amdgcn_sdot4((int)BUF[j].x, xq[0], 0, false); p_ = __builtin_amdgcn_sdot4((int)BUF[j].y, xq[1], p_, false); \
        p_ = __builtin_amdgcn_sdot4((int)BUF[j].z, xq[2], p_, false); p_ = __builtin_amdgcn_sdot4((int)BUF[j].w, xq[3], p_, false); \
        p_ += __builtin_amdgcn_update_dpp(0, p_, 0xB1, 0xF, 0xF, true); p_ += __builtin_amdgcn_update_dpp(0, p_, 0x4E, 0xF, 0xF, true); \
        p_ += __builtin_amdgcn_update_dpp(0, p_, 0x141, 0xF, 0xF, true); p_ += __builtin_amdgcn_update_dpp(0, p_, 0x140, 0xF, 0xF, true);     \
        p_ += __builtin_amdgcn_update_dpp(0, p_, 0x142, 0xA, 0xF, false);     \
        p_ += __builtin_amdgcn_update_dpp(0, p_, 0x143, 0xC, 0xF, false);     \
        int s_ = __builtin_amdgcn_readlane(p_, 63); asm volatile("" : "+s"(s_));     \
        hqc = (lrel_ == j) ? s_ : hqc; } } while (0)
#define P8_COMPV(BUF, bb) do { const float avs_ = (bb) < NBH ? av0 : av1; _Pragma("unroll") for (int j = 0; j < PB; ++j) { \
        const float a_ = __builtin_bit_cast(float, __builtin_amdgcn_readlane(__builtin_bit_cast(int, avs_), (PB * (bb) + j) & 63)); \
        _Pragma("unroll") for (int c = 0; c < 4; ++c) { const unsigned w_ = BUF[j][c]; \
            acc[4 * c] += a_ * (float)(w_ & 0xffu); acc[4 * c + 1] += a_ * (float)((w_ >> 8) & 0xffu); acc[4 * c + 2] += a_ * (float)((w_ >> 16) & 0xffu); acc[4 * c + 3] += a_ * (float)(w_ >> 24); } } } while (0)
    P8_LOAD(A, UQ, 0);
#pragma unroll 1
    for (int i = 0; i < NBH; ++i) {
        P8_LOAD(B, UQ, 2 * i + 1);
        if (2 * i == NBH) hq0 = hqc;
        P8_COMPU(A, 2 * i);
        if (i < NBH - 1) P8_LOAD(A, UQ, 2 * i + 2); else P8_LOAD(A, VQ, 0);
        P8_COMPU(B, 2 * i + 1);
    }
    const int hq1 = hqc;
    const float hk0 = (float)hq0 * (sc0.x * sx), hk1 = (float)hq1 * (sc1.x * sx);
#ifdef MK_DBG_L0
    ((float*)(dbg_ws + 136 * MiB))[(size_t)tok * 128 + lane] = hk0; ((float*)(dbg_ws + 136 * MiB))[(size_t)tok * 128 + 64 + lane] = hk1;
#endif
    const float av0 = gv0 * gelu_erf(hk0) * sc0.y, av1 = gv1 * gelu_erf(hk1) * sc1.y;
    const float atot = wave_sum_all(av0 + av1);
#pragma unroll 1
    for (int i = 0; i < NBH; ++i) {
        P8_LOAD(B, VQ, 2 * i + 1);
        P8_COMPV(A, 2 * i);
        if (i < NBH - 1) P8_LOAD(A, VQ, 2 * i + 2);
        P8_COMPV(B, 2 * i + 1);
    }
#undef P8_LOAD
#undef P8_COMPU
#undef P8_COMPV
    float s = 0.f;
#pragma unroll
    for (int i = 0; i < 16; ++i) { acc[i] = ALPHA * xr[i] + (acc[i] - 128.f * atot); s += acc[i]; }
    const float mean = wave_sum_all(s) * (1.f / DM); float s2 = 0.f;
#pragma unroll
    for (int i = 0; i < 16; ++i) { acc[i] -= mean; s2 += acc[i] * acc[i]; }
    const float rstd = rsqrtf(wave_sum_all(s2) * (1.f / DM) + LN_EPS);
    const float* g = ka->in[I_LN2G] + l * DM + 16 * lane; const float* bb = ka->in[I_LN2B] + l * DM + 16 * lane;
    float o[16];
#pragma unroll
    for (int j = 0; j < 4; ++j) { const f32x4 gg = *(const f32x4*)(g + 4 * j), bv = *(const f32x4*)(bb + 4 * j);
        o[4 * j] = acc[4 * j] * rstd * gg.x + bv.x; o[4 * j + 1] = acc[4 * j + 1] * rstd * gg.y + bv.y; o[4 * j + 2] = acc[4 * j + 2] * rstd * gg.z + bv.z; o[4 * j + 3] = acc[4 * j + 3] * rstd * gg.w + bv.w;
        *(f32x4*)(xrow + 4 * j) = (f32x4){o[4 * j], o[4 * j + 1], o[4 * j + 2], o[4 * j + 3]}; }
    { bf16* xb = wsp<bf16>(ka, WS_XB) + (size_t)tok * DM + 16 * lane;
      *(v4u*)xb = (v4u){pk2(o[0], o[1]), pk2(o[2], o[3]), pk2(o[4], o[5]), pk2(o[6], o[7])};
      *(v4u*)(xb + 8) = (v4u){pk2(o[8], o[9]), pk2(o[10], o[11]), pk2(o[12], o[13]), pk2(o[14], o[15])}; }
}

__global__ void __launch_bounds__(NTHREADS, 2) mk_fwd(Args args) {
    extern __shared__ __attribute__((aligned(16))) unsigned char lds[];
    Frame F;
    F.lds = (LAS unsigned char*)lds;
    F.MISC = (volatile LAS unsigned*)(F.lds + MISC_OFF);
    F.tid = threadIdx.x; F.lane = F.tid & 63; F.wave = __builtin_amdgcn_readfirstlane(F.tid >> 6);
    F.G = gridDim.x; { const int bx = blockIdx.x; F.vcu = (F.G % 8 == 0) ? (bx % 8) * (F.G / 8) + bx / 8 : bx; }
    for (int u = F.tid; u < (LDS_BYTES - LDSCTL_OFF) / 4; u += NTHREADS) ((LAS unsigned*)(F.lds + LDSCTL_OFF))[u] = 0u;
    __syncthreads();
    const int lo = args.ph_lo, hi = args.ph_hi;
    unsigned* const barw = (unsigned*)(args.ws + WS_CTL) + CW_BAR;
    const bool one_phase = (hi - lo) == 1;
    XcdBarrier bar; bar.bar = barw; bar.x = 0; bar.st = nullptr;
    if (!one_phase) bar = xcd_barrier_post(barw, F.MISC + 8);
#ifndef MK_EN
#define MK_EN 0x1ff
#endif
#ifndef MK_MLA_LDS
#define MK_MLA_LDS 0
#endif
#ifndef MK_MLA_REP
#define MK_MLA_REP 1
#endif
#ifndef MK_SB_REP
#define MK_SB_REP 1
#endif
#define EN(n) (((MK_EN) >> (n)) & 1)
#ifndef MK_REP
#define MK_REP 0
#endif
#define PHASE_REP(n) for (int rep_ = 0; rep_ < ((((MK_REP) >> (n)) & 1) + 1); ++rep_)
#define IN(k) (lo <= (k) && (k) < hi)
#define PHASE_IDS() do { int t_ = threadIdx.x; asm volatile("" : "+v"(t_)); F.tid = t_; F.lane = t_ & 63; } while (0)
#define SEAM(k) do { if (IN((k) + 1)) xcd_barrier(bar); } while (0)
    const int gw = F.vcu * NWAVES + F.wave, NGW = F.G * NWAVES;

    if (EN(0) && IN(0)) PHASE_REP(0) { PHASE_IDS(); p0_prologue(F, ka_fresh()); SEAM(0); }
    for (int l = 0; l < DEPTH; ++l) {
        const int pb = 1 + 8 * l;
        if (EN(1) && IN(pb + 0)) PHASE_REP(1) { const kap_t ka = ka_fresh(); PHASE_IDS();
            pg8::Gemm g{wsp<bf16>(ka, WS_XB), wsp<bf16>(ka, WS_WIT) + (size_t)l * DINP * DM, NTOK, DINP, DM}; pg8::StaticOrder S; S.init(NTOK, DINP, F.G, (int)blockIdx.x);
            pg8::EpiBf16<0> E{wsp<bf16>(ka, WS_HB), DINP, nullptr, 0, 0, 1.f};
            pg8::gemm_phase<pg8::EpiBf16<0>, pg8::StaticOrder, PG8_ALIGN, PG8_SP2>(F.lds + RING_OFF, g, S, E);
            SEAM(pb + 0);
        }
        if (EN(2) && IN(pb + 1)) PHASE_REP(2) { const kap_t ka = ka_fresh(); PHASE_IDS();
            for (int u = gw; u < (NTOK / 32) * 4; u += NGW) p2_unit(F, ka, l, u >> 2, u & 3);
            SEAM(pb + 1);
        }
        if (EN(3) && IN(pb + 2)) PHASE_REP(3) { const kap_t ka = ka_fresh(); PHASE_IDS();
#if MK_MLA_LDS
            for (int u = F.vcu; u < 32 * 8; u += F.G) {
                const int bh = u >> 3, j = u & 7;
                mla_block(F, ka, bh, 15 - j); sb_unit(F, ka, bh, 8 * (15 - j) + F.wave);
                mla_block(F, ka, bh, j); sb_unit(F, ka, bh, 8 * j + F.wave);
            }
#else
            for (int u = gw; u < 32 * 64; u += NGW) {
                const int bh = u >> 6, pi = u & 63;
                for (int r_ = 0; r_ < MK_MLA_REP; ++r_) mla_unit(F, ka, bh, 127 - pi);
                for (int r_ = 0; r_ < MK_SB_REP; ++r_) sb_unit(F, ka, bh, 127 - pi);
                for (int r_ = 0; r_ < MK_MLA_REP; ++r_) mla_unit(F, ka, bh, pi);
                for (int r_ = 0; r_ < MK_SB_REP; ++r_) sb_unit(F, ka, bh, pi);
            }
#endif
            SEAM(pb + 2);
        }
        if (EN(4) && IN(pb + 3)) PHASE_REP(4) { const kap_t ka = ka_fresh(); PHASE_IDS();
            pg8::Gemm g{wsp<bf16>(ka, WS_OB), wsp<bf16>(ka, WS_WOT) + (size_t)l * DM * DM, NTOK, DM, DM}; pg8::StaticOrder S; S.init(NTOK, DM, F.G, (int)blockIdx.x);
            pg8::EpiResF32 E{l == 0 ? ka->in[I_X] : ka->out, ka->out, DM, ALPHA};
            pg8::gemm_phase<pg8::EpiResF32, pg8::StaticOrder, PG8_ALIGN, PG8_SP2>(F.lds + RING_OFF, g, S, E);
            SEAM(pb + 3);
        }
        if (EN(5) && IN(pb + 4)) PHASE_REP(5) { const kap_t ka = ka_fresh(); PHASE_IDS();
            for (int r = gw; r < NTOK; r += NGW) ln1_row(F, ka, r, ka->in[I_LN1G] + l * DM, ka->in[I_LN1B] + l * DM);
            SEAM(pb + 4);
        }
        if (EN(6) && IN(pb + 5)) PHASE_REP(6) { const kap_t ka = ka_fresh(); PHASE_IDS();
            pg8::Gemm g{wsp<bf16>(ka, WS_XB), wsp<bf16>(ka, WS_WQT) + (size_t)l * 2048 * DM, NTOK, 2048, DM}; pg8::StaticOrder S; S.init(NTOK, 2048, F.G, (int)blockIdx.x);
            pg8::EpiBf16<0> E{wsp<bf16>(ka, WS_HB), 2048, nullptr, 0, 0, 1.f};
            pg8::gemm_phase<pg8::EpiBf16<0>, pg8::StaticOrder, PG8_ALIGN, PG8_SP2>(F.lds + RING_OFF, g, S, E);
            SEAM(pb + 5);
        }
        if (EN(7) && IN(pb + 6)) PHASE_REP(7) { const kap_t ka = ka_fresh(); PHASE_IDS();
            for (int u = gw; u < (NTOK / 32) * 8; u += NGW) p7_unit(F, ka, l, u >> 3, u & 7);
            SEAM(pb + 6);
        }
        if (EN(8) && IN(pb + 7)) PHASE_REP(8) { const kap_t ka = ka_fresh(); PHASE_IDS();
            const unsigned* EL = wsp<unsigned>(ka, WS_EL) + F.lane; const float* GL = wsp<float>(ka, WS_GL) + F.lane;
            unsigned e0 = 0u, e1 = 0u; float g0 = 0.f, g1 = 0.f;
            if (gw < NTOK) { e0 = EL[(size_t)gw * 128]; e1 = EL[(size_t)gw * 128 + 64]; g0 = GL[(size_t)gw * 128]; g1 = GL[(size_t)gw * 128 + 64]; }
            for (int t = gw; t < NTOK; t += NGW) {
                unsigned ne0 = 0u, ne1 = 0u; float ng0 = 0.f, ng1 = 0.f;
                if (t + NGW < NTOK) { const size_t o = (size_t)(t + NGW) * 128; ne0 = EL[o]; ne1 = EL[o + 64]; ng0 = GL[o]; ng1 = GL[o + 64]; }
                p8_token(F, ka, l, t, e0, e1, g0, g1);
                e0 = ne0; e1 = ne1; g0 = ng0; g1 = ng1;
            }
            if (l + 1 < DEPTH) SEAM(pb + 7);
        }
    }
#undef IN
#undef SEAM
}

#ifndef MK_PER_PHASE
#define MK_PER_PHASE 0
#endif
extern "C" void kernel_launch(void* const* d_in, const int* in_sizes, int n_in, void* d_out, int out_size, void* d_ws, size_t ws_size, hipStream_t stream) {
    static int grid = 0;
    if (grid == 0) {
        if (n_in != 15 || out_size != NTOK * DM || ws_size < WS_END) { fprintf(stderr, "kernel_launch: unexpected shapes (n_in %d, out %d, ws %zu); nothing launched\n", n_in, out_size, ws_size); grid = -1; return; }
        int dev = 0, cus = 0, per_cu = 0;
        if (hipGetDevice(&dev) != hipSuccess || hipDeviceGetAttribute(&cus, hipDeviceAttributeMultiprocessorCount, dev) != hipSuccess) { fprintf(stderr, "kernel_launch: device query failed\n"); grid = -1; return; }
        if (hipFuncSetAttribute((const void*)mk_fwd, hipFuncAttributeMaxDynamicSharedMemorySize, LDS_BYTES) != hipSuccess) { fprintf(stderr, "kernel_launch: hipFuncSetAttribute failed\n"); grid = -1; return; }
        if (hipOccupancyMaxActiveBlocksPerMultiprocessor(&per_cu, (const void*)mk_fwd, NTHREADS, LDS_BYTES) != hipSuccess || per_cu < 1) { fprintf(stderr, "kernel_launch: occupancy query says %d blocks per CU\n", per_cu); per_cu = 1; }
        (void)hipGetLastError();
        grid = cus;
        fprintf(stderr, "kernel_launch: grid %d (occupancy query %d per CU)\n", grid, per_cu);
    }
    if (grid < 0) return;
    (void)hipMemsetAsync((char*)d_ws + WS_CTL, 0, CTL_ZERO_BYTES, stream);
    Args a{};
    for (int i = 0; i < 15; ++i) a.in[i] = (const float*)d_in[i];
    a.out = (float*)d_out; a.ws = (unsigned char*)d_ws;
#if MK_PER_PHASE
    for (int p = 0; p < NPHASE; ++p) { a.ph_lo = p; a.ph_hi = p + 1; hipLaunchKernelGGL(mk_fwd, dim3(grid), dim3(NTHREADS), LDS_BYTES, stream, a); }
#else
    a.ph_lo = 0; a.ph_hi = NPHASE;
    void* kargs[] = {&a};
    const hipError_t e = hipLaunchCooperativeKernel((const void*)mk_fwd, dim3(grid), dim3(NTHREADS), kargs, LDS_BYTES, stream);
    if (e != hipSuccess) fprintf(stderr, "kernel_launch: cooperative launch failed: %s (grid %d)\n", hipGetErrorString(e), grid);
#endif
}
```

```cpp
#include <hip/hip_runtime.h>
#include <cstdio>
#include <cstdint>
#include <math.h>
namespace pg8 {
#define PG8_LAS __attribute__((address_space(3)))
typedef unsigned short bf16_t;
typedef short bf16x8 __attribute__((ext_vector_type(8)));
typedef float f32x4 __attribute__((ext_vector_type(4)));
typedef unsigned u32x4 __attribute__((ext_vector_type(4)));
constexpr int BM = 256, BK = 64, HALF = 128, HTB = HALF * BK * 2  , STAGE_BYTES = 8 * HTB, NXCD = 8, WGM = 8;

__host__ __device__ __forceinline__ int lds_byte(int r, int c) { const int st = (r >> 4) * 2 + (c >> 5), rr = r & 15, cc = c & 31, ob = rr * 64 + cc * 2; return st * 1024 + (ob ^ (((ob >> 9) & 1) << 5)); }
__host__ __device__ __forceinline__ void stage_rc(int b, int& R, int& C) { const int st = b / 1024, sb = b % 1024, swz = sb ^ (((sb >> 9) & 1) << 5); R = (st >> 1) * 16 + swz / 64; C = (st & 1) * 32 + (swz % 64) / 2; }
__host__ __device__ __forceinline__ int perm32(int rho) { const int n = rho >> 4, i = rho & 15; return 8 * (i >> 2) + 4 * n + (i & 3); }

struct Unit { int pm, pn; };
struct Gemm { const bf16_t* A; const bf16_t* Bt; int M, N, K; };

struct StaticOrder {
    int nM, nN, nwg, G, c;
    __host__ __device__ void init(int M, int N, int G_, int c_) { nM = M / BM; nN = N / BM; nwg = nM * nN; G = G_; c = c_; }
    __host__ __device__ bool next(int i, Unit& u) const {
        const long L = (long)i * G + c; if (L >= nwg) return false;
        int wgid = (int)L; { const int q = nwg / NXCD, r = nwg % NXCD, xcd = wgid % NXCD, off = wgid / NXCD; wgid = (xcd < r ? xcd * (q + 1) : r * (q + 1) + (xcd - r) * q) + off; }
        const int nig = WGM * nN, gid = wgid / nig, fm = gid * WGM, gsz = (nM - fm) < WGM ? (nM - fm) : WGM;
        u.pm = fm + ((wgid % nig) % gsz); u.pn = (wgid % nig) / gsz; return true;
    }
    __device__ __forceinline__ void a_ready(const Unit&) const {}
    __device__ __forceinline__ void done(const Unit&) const {}
};

__device__ __forceinline__ unsigned cvt_pk_bf16(float lo, float hi) { unsigned r; asm volatile("v_cvt_pk_bf16_f32 %0, %1, %2" : "=v"(r) : "v"(lo), "v"(hi)); return r; }
typedef float f32x2 __attribute__((ext_vector_type(2)));
__device__ __forceinline__ f32x2 gelu_pk(f32x2 v) {
    const f32x2 av = __builtin_elementwise_abs(v), d = av * 0.2316418882f + 1.0f;
    f32x2 t; t.x = __builtin_amdgcn_rcpf(d.x); t.y = __builtin_amdgcn_rcpf(d.y);
    f32x2 q = t * 0.5307027145f + (-0.7265760135f); q = q * t + 0.7107068705f; q = q * t + (-0.142248368f); q = q * t + 0.127414796f; q = q * t;
    const f32x2 s = (v * v) * (-0.72134752044f);
    f32x2 e; e.x = __builtin_amdgcn_exp2f(s.x); e.y = __builtin_amdgcn_exp2f(s.y);
    const f32x2 m = v * (q * e), r = v - m;
    f32x2 o; o.x = v.x < 0.f ? m.x : r.x; o.y = v.y < 0.f ? m.y : r.y; return o;
}

template <int ACT  > struct EpiBf16 {
    static constexpr bool PERM = true, AFTER_DRAIN = false; static_assert(ACT == 0 || ACT == 1, "EpiBf16: ACT is 0 (none) or 1 (gelu_pk)");
    bf16_t* O; int ldc; const float* bias; int split_cols; size_t split_stride; float scale0;
    __device__ __forceinline__ void operator()(const f32x4 (&acc)[2][2][4][2], const Unit& u, int wr, int wc, int fr, int fq) const {
        const int row0 = u.pm * BM + wr * 64 + fr; int colt = u.pn * BM; bf16_t* base = O;
        float sc = 1.f; if (split_cols) { const int t = colt / split_cols; base += (size_t)t * split_stride; colt -= t * split_cols; if (t == 0) sc = scale0; }
        const int col0 = colt + wc * 32 + 8 * fq, bcol0 = u.pn * BM + wc * 32 + 8 * fq;
        f32x4 bv[2][2];
#pragma unroll
        for (int bj = 0; bj < 2; ++bj)
#pragma unroll
            for (int n = 0; n < 2; ++n) bv[bj][n] = bias ? *(const f32x4*)(bias + bcol0 + bj * HALF + 4 * n) : (f32x4){0.f, 0.f, 0.f, 0.f};
#pragma unroll
        for (int ai = 0; ai < 2; ++ai)
#pragma unroll
            for (int m = 0; m < 4; ++m) { bf16_t* rowp = base + (size_t)(row0 + ai * HALF + m * 16) * ldc + col0;
#pragma unroll
                for (int bj = 0; bj < 2; ++bj) { f32x4 v0 = acc[ai][bj][m][0] + bv[bj][0], v1 = acc[ai][bj][m][1] + bv[bj][1];
                    if (ACT == 1) { f32x2 a = gelu_pk((f32x2){v0[0], v0[1]}), b = gelu_pk((f32x2){v0[2], v0[3]}), c = gelu_pk((f32x2){v1[0], v1[1]}), d = gelu_pk((f32x2){v1[2], v1[3]});
                        v0 = (f32x4){a.x, a.y, b.x, b.y}; v1 = (f32x4){c.x, c.y, d.x, d.y}; }
                    v0 = v0 * sc; v1 = v1 * sc; u32x4 w; w.x = cvt_pk_bf16(v0[0], v0[1]); w.y = cvt_pk_bf16(v0[2], v0[3]); w.z = cvt_pk_bf16(v1[0], v1[1]); w.w = cvt_pk_bf16(v1[2], v1[3]);
                    *(u32x4*)(rowp + bj * HALF) = w; } }
    }
};
struct EpiResF32 {
    static constexpr bool PERM = false, AFTER_DRAIN = false;
    const float* res; float* out; int ldc; float alpha;
    __device__ __forceinline__ void operator()(const f32x4 (&acc)[2][2][4][2], const Unit& u, int wr, int wc, int fr, int fq) const {
        const int row0 = u.pm * BM + wr * 64 + fr, col0 = u.pn * BM + wc * 32 + 4 * fq;
#pragma unroll
        for (int ai = 0; ai < 2; ++ai)
#pragma unroll
            for (int m = 0; m < 4; ++m) { const size_t off = (size_t)(row0 + ai * HALF + m * 16) * ldc + col0;
#pragma unroll
                for (int bj = 0; bj < 2; ++bj)
#pragma unroll
                    for (int n = 0; n < 2; ++n) { const f32x4 rs = *(const f32x4*)(res + off + bj * HALF + n * 16); *(f32x4*)(out + off + bj * HALF + n * 16) = rs * alpha + acc[ai][bj][m][n]; }
                if (m & 1) asm volatile("" ::: "memory"); }
    }
};
template <class Epi, class Sched, bool ALIGN_EPI = false, bool SP2 = false>
__device__ __forceinline__ void gemm_phase(PG8_LAS unsigned char* lds, const Gemm g, const Sched& S, const Epi& E) {
    int tid_ = threadIdx.x; asm volatile("" : "+v"(tid_));
    const int tid = tid_, wid = __builtin_amdgcn_readfirstlane(tid >> 6), lane = tid & 63, wr = wid >> 2, wc = wid & 3, fr = lane & 15, fq = lane >> 4;
    const int K = g.K, nt = K / BK;
    unsigned voffA[2], voffB[2];
#pragma unroll
    for (int i = 0; i < 2; ++i) { int R, C; stage_rc(tid * 16 + i * 8192, R, C); const int Rb = Epi::PERM ? ((R & ~31) + perm32(R & 31)) : R;
        voffA[i] = (unsigned)(R * K + C) * 2u; voffB[i] = (unsigned)(Rb * K + C) * 2u; }
    const size_t kstep = (size_t)(BK * 2);
    const size_t hstep = (size_t)HALF * K * 2;
    const size_t tstep = 2 * hstep;
    const unsigned ldsw = (unsigned)wid * 1024u;
    const int aoff = lds_byte(wr * 64 + fr, fq * 8), boff = lds_byte(wc * 32 + fr, fq * 8);
#define PG8_SA(b, h) (((b) * 2 + (h)) * HTB)
#define PG8_SB(b, h) ((4 + (b) * 2 + (h)) * HTB)
#define PG8_STAGE(bufoff, gbase, voff) do { _Pragma("unroll") for (int _i = 0; _i < 2; ++_i) \
        __builtin_amdgcn_global_load_lds((const unsigned*)((const char*)(gbase) + (voff)[_i]), (PG8_LAS unsigned*)(lds + (bufoff) + ldsw + _i * 8192), 16, 0, 0); } while (0)
#define PG8_LDA(dst, b, h) do { _Pragma("unroll") for (int m = 0; m < 4; ++m) _Pragma("unroll") for (int k = 0; k < 2; ++k) dst[m][k] = *(const PG8_LAS bf16x8*)(lds + PG8_SA(b, h) + aoff + m * 2048 + k * 1024); } while (0)
#define PG8_LDB(dst, b, h) do { _Pragma("unroll") for (int n = 0; n < 2; ++n) _Pragma("unroll") for (int k = 0; k < 2; ++k) dst[n][k] = *(const PG8_LAS bf16x8*)(lds + PG8_SB(b, h) + boff + n * 2048 + k * 1024); } while (0)
#define PG8_MMA(ai, bj, At, Bt) do { __builtin_amdgcn_s_setprio(1); _Pragma("unroll") for (int m = 0; m < 4; ++m) _Pragma("unroll") for (int n = 0; n < 2; ++n) _Pragma("unroll") for (int k = 0; k < 2; ++k) \
        acc[ai][bj][m][n] = __builtin_amdgcn_mfma_f32_16x16x32_bf16(Bt[n][k], At[m][k], acc[ai][bj][m][n], 0, 0, 0); __builtin_amdgcn_s_setprio(0); } while (0)
#define PG8_WAIT_V(n) asm volatile("s_waitcnt vmcnt(" #n ")" ::: "memory")
#define PG8_WAIT_L(n) asm volatile("s_waitcnt lgkmcnt(" #n ")" ::: "memory")
#define PG8_BAR __builtin_amdgcn_s_barrier()
#define PG8_SCHED __builtin_amdgcn_sched_barrier(0)
    Unit cur, nxt; int ui = 0;
    if (!S.next(0, cur)) return;
    f32x4 acc[2][2][4][2];
#pragma unroll
    for (int a = 0; a < 2; ++a)
#pragma unroll
        for (int b = 0; b < 2; ++b)
#pragma unroll
            for (int m = 0; m < 4; ++m)
#pragma unroll
                for (int n = 0; n < 2; ++n) acc[a][b][m][n] = (f32x4){0.f, 0.f, 0.f, 0.f};
    bf16x8 At[4][2], B0[2][2], B1[2][2];
    const char* cA = (const char*)g.A + (size_t)cur.pm * tstep; const char* cB = (const char*)g.Bt + (size_t)cur.pn * tstep;
    S.a_ready(cur);
    if constexpr (SP2) {
        PG8_STAGE(PG8_SB(0, 0), cB, voffB); PG8_STAGE(PG8_SB(0, 1), cB + hstep, voffB); PG8_STAGE(PG8_SA(0, 0), cA, voffA); PG8_STAGE(PG8_SA(0, 1), cA + hstep, voffA);
        if (wr == 1) PG8_BAR;
        PG8_WAIT_V(2); PG8_BAR;
        PG8_STAGE(PG8_SB(1, 0), cB + kstep, voffB); PG8_STAGE(PG8_SA(1, 0), cA + kstep, voffA); PG8_STAGE(PG8_SB(1, 1), cB + hstep + kstep, voffB);
        PG8_WAIT_V(6); PG8_BAR;
    } else {
        PG8_STAGE(PG8_SB(0, 0), cB, voffB); PG8_STAGE(PG8_SA(0, 0), cA, voffA); PG8_STAGE(PG8_SB(0, 1), cB + hstep, voffB); PG8_STAGE(PG8_SA(0, 1), cA + hstep, voffA);
        if (wr == 1) PG8_BAR;
        PG8_WAIT_V(4); PG8_BAR;
        PG8_STAGE(PG8_SB(1, 0), cB + kstep, voffB); PG8_STAGE(PG8_SA(1, 0), cA + kstep, voffA); PG8_STAGE(PG8_SB(1, 1), cB + hstep + kstep, voffB);
        PG8_WAIT_V(6); PG8_BAR;
    }
    for (;;) {
        const bool has_next = S.next(ui + 1, nxt);
        const char* nA = has_next ? (const char*)g.A + (size_t)nxt.pm * tstep : cA; const char* nB = has_next ? (const char*)g.Bt + (size_t)nxt.pn * tstep : cB;
        for (int t = 0; t < nt; t += 2) {
            const bool last = (t == nt - 2);
            const char* a1 = cA + (size_t)(t + 1) * kstep;
            const char* a2 = last ? nA : cA + (size_t)(t + 2) * kstep; const char* b2 = last ? nB : cB + (size_t)(t + 2) * kstep;
            const char* a3 = a2 + kstep; const char* b3 = b2 + kstep;
            if (last && has_next) S.a_ready(nxt);
            if constexpr (SP2) {
            PG8_LDB(B0, 0, 0); PG8_LDB(B1, 0, 1); PG8_SCHED; PG8_LDA(At, 0, 0); PG8_STAGE(PG8_SA(1, 1), a1 + hstep, voffA);
            PG8_WAIT_V(8); PG8_WAIT_L(0); PG8_BAR; PG8_MMA(0, 0, At, B0); PG8_MMA(0, 1, At, B1); PG8_BAR; PG8_SCHED;
            PG8_LDA(At, 0, 1); PG8_STAGE(PG8_SB(0, 0), b2, voffB); PG8_STAGE(PG8_SB(0, 1), b2 + hstep, voffB); PG8_STAGE(PG8_SA(0, 0), a2, voffA);
            PG8_WAIT_V(8); PG8_WAIT_L(0); PG8_BAR; PG8_MMA(1, 0, At, B0); PG8_MMA(1, 1, At, B1); PG8_BAR; PG8_SCHED;
            PG8_LDB(B0, 1, 0); PG8_LDB(B1, 1, 1); PG8_SCHED; PG8_LDA(At, 1, 0); PG8_STAGE(PG8_SA(0, 1), a2 + hstep, voffA);
            PG8_WAIT_V(8); PG8_WAIT_L(0); PG8_BAR; PG8_MMA(0, 0, At, B0); PG8_MMA(0, 1, At, B1); PG8_BAR; PG8_SCHED;
            PG8_LDA(At, 1, 1); PG8_STAGE(PG8_SB(1, 0), b3, voffB); PG8_STAGE(PG8_SB(1, 1), b3 + hstep, voffB); PG8_STAGE(PG8_SA(1, 0), a3, voffA);
            PG8_WAIT_V(8); PG8_WAIT_L(0); PG8_BAR; PG8_MMA(1, 0, At, B0); PG8_MMA(1, 1, At, B1); PG8_BAR; PG8_SCHED;
            } else {
            PG8_LDB(B0, 0, 0); PG8_SCHED; PG8_LDA(At, 0, 0); PG8_STAGE(PG8_SA(1, 1), a1 + hstep, voffA);
            PG8_WAIT_L(8); PG8_BAR; PG8_WAIT_L(0); PG8_MMA(0, 0, At, B0); PG8_BAR; PG8_SCHED;
            PG8_LDB(B1, 0, 1); PG8_STAGE(PG8_SB(0, 0), b2, voffB);
            PG8_BAR; PG8_WAIT_L(0); PG8_MMA(0, 1, At, B1); PG8_BAR;
            PG8_LDA(At, 0, 1); PG8_STAGE(PG8_SA(0, 0), a2, voffA);
            PG8_BAR; PG8_WAIT_L(0); PG8_MMA(1, 0, At, B0); PG8_BAR; PG8_SCHED;
            PG8_STAGE(PG8_SB(0, 1), b2 + hstep, voffB);
            PG8_WAIT_V(6); PG8_BAR; PG8_MMA(1, 1, At, B1); PG8_BAR;
            PG8_LDB(B0, 1, 0); PG8_SCHED; PG8_LDA(At, 1, 0); PG8_STAGE(PG8_SA(0, 1), a2 + hstep, voffA);
            PG8_WAIT_L(8); PG8_BAR; PG8_WAIT_L(0); PG8_MMA(0, 0, At, B0); PG8_BAR; PG8_SCHED;
            PG8_LDB(B1, 1, 1); PG8_STAGE(PG8_SB(1, 0), b3, voffB);
            PG8_BAR; PG8_WAIT_L(0); PG8_MMA(0, 1, At, B1); PG8_BAR;
            PG8_LDA(At, 1, 1); PG8_STAGE(PG8_SA(1, 0), a3, voffA);
            PG8_BAR; PG8_WAIT_L(0); PG8_MMA(1, 0, At, B0); PG8_BAR; PG8_SCHED;
            PG8_STAGE(PG8_SB(1, 1), b3 + hstep, voffB);
            PG8_WAIT_V(6); PG8_BAR; PG8_MMA(1, 1, At, B1); PG8_BAR;
            }
        }
        if constexpr (ALIGN_EPI) { if (wr == 0) PG8_BAR; }
        if constexpr (!Epi::AFTER_DRAIN) { E(acc, cur, wr, wc, fr, fq); S.done(cur); }
        if (!has_next) break;
#pragma unroll
        for (int a = 0; a < 2; ++a)
#pragma unroll
            for (int b = 0; b < 2; ++b)
#pragma unroll
                for (int m = 0; m < 4; ++m)
#pragma unroll
                    for (int n = 0; n < 2; ++n) acc[a][b][m][n] = (f32x4){0.f, 0.f, 0.f, 0.f};
        cur = nxt; cA = nA; cB = nB; ++ui;
        if constexpr (ALIGN_EPI) { if (wr == 1) PG8_BAR; }
    }
    PG8_WAIT_V(0);
    if constexpr (!ALIGN_EPI) { if (wr == 0) PG8_BAR; }
    PG8_BAR;
    if constexpr (Epi::AFTER_DRAIN) { E.fused(acc, cur, wr, wc, fr, fq, lds, wid, lane); S.done(cur); }
#undef PG8_SA
#undef PG8_SB
#undef PG8_STAGE
#undef PG8_LDA
#undef PG8_LDB
#undef PG8_MMA
#undef PG8_WAIT_V
#undef PG8_WAIT_L
#undef PG8_BAR
#undef PG8_SCHED
}
}

#ifndef PG8_SP2
#define PG8_SP2 true
#endif
#ifndef PG8_ALIGN
#define PG8_ALIGN true
#endif
#define GAS __attribute__((address_space(1)))
#define LAS __attribute__((address_space(3)))
typedef unsigned short bf16;
typedef unsigned v4u __attribute__((ext_vector_type(4)));
typedef float f32x4 __attribute__((ext_vector_type(4)));
typedef short bf16x8 __attribute__((ext_vector_type(8)));
typedef GAS unsigned gu32;
typedef GAS unsigned long long gu64;
#define RLX_AGENT __ATOMIC_RELAXED, __HIP_MEMORY_SCOPE_AGENT
#define LDS_WAIT() asm volatile("s_waitcnt lgkmcnt(0)" ::: "memory")
#define VM_WAIT() asm volatile("s_waitcnt vmcnt(0)" ::: "memory")
__device__ __forceinline__ unsigned long long rt() { return __builtin_amdgcn_s_memrealtime(); }
__device__ __forceinline__ unsigned f2bf(float f) { unsigned u = __builtin_bit_cast(unsigned, f); return (u + 0x7fffu + ((u >> 16) & 1u)) >> 16; }
typedef float pk2_f32x2_t __attribute__((ext_vector_type(2))); typedef __bf16 pk2_bf16x2_t __attribute__((ext_vector_type(2)));
__device__ __forceinline__ unsigned pk2(float lo, float hi) { const pk2_f32x2_t v = {lo, hi}; return __builtin_bit_cast(unsigned, __builtin_convertvector(v, pk2_bf16x2_t)); }

#define XB_TMO      128
#define XB_XCNT(j)  (256  + 64 * (j))
#define XB_XSUB(j)  (1280 + 64 * (j))
#define XB_XGEN(j)  (2304 + 64 * (j))
#define XB_TOP      3328
#define XB_TOPGEN   3392
#define XCD_BAR_WORDS 3456
#define XB_SPIN_CAP (1u << 18)

__device__ __forceinline__ unsigned xb_ld(unsigned* p)              { return __hip_atomic_load(p, __ATOMIC_RELAXED, __HIP_MEMORY_SCOPE_AGENT); }
__device__ __forceinline__ unsigned xb_add(unsigned* p, unsigned v) { return __hip_atomic_fetch_add(p, v, __ATOMIC_RELAXED, __HIP_MEMORY_SCOPE_AGENT); }
__device__ __forceinline__ unsigned xb_xcc_id() { return (unsigned)__builtin_amdgcn_s_getreg((3 << 11) | 20) & 0xFu; }
#define XB_SPIN(cond, bar) do { unsigned _sp = 0; while (cond) { __builtin_amdgcn_s_sleep(1); \
    if ((++_sp & 255u) == 0u) { if (xb_ld(&(bar)[XB_TMO])) break; if (_sp > XB_SPIN_CAP) { atomicAdd(&(bar)[XB_TMO], 1u); break; } } } } while (0)

struct XcdBarrier {
    unsigned* bar; unsigned x;
    volatile LAS unsigned* st;
};

__device__ __forceinline__ XcdBarrier xcd_barrier_post(unsigned* bar, volatile LAS unsigned* st) {
    XcdBarrier b; b.bar = bar; b.x = xb_xcc_id(); b.st = st;
    if (threadIdx.x == 0) (void)xb_add(&bar[XB_XCNT(b.x)], 1u);
    return b;
}
__device__ __forceinline__ void xcd_barrier_complete(unsigned* bar, unsigned x, unsigned& nloc, unsigned& nx) {
    const unsigned G = gridDim.x * gridDim.y * gridDim.z;
    unsigned sum, cnt, mine, sp = 0u;
    for (;;) {
        sum = 0u; cnt = 0u; mine = 0u;
#pragma unroll
        for (unsigned j = 0; j < 16; ++j) { const unsigned c = xb_ld(&bar[XB_XCNT(j)]); sum += c; cnt += (c > 0u) ? 1u : 0u; mine = (j == x) ? c : mine; }
        if (sum == G) break;
        __builtin_amdgcn_s_sleep(1);
        if ((++sp & 255u) == 0u) { if (xb_ld(&bar[XB_TMO])) break; if (sp > XB_SPIN_CAP) { atomicAdd(&bar[XB_TMO], 1u); break; } }
    }
    nloc = mine > 0u ? mine : 1u; nx = cnt > 0u ? cnt : 1u;
}

__device__ __forceinline__ void xcd_barrier(const XcdBarrier& b) {
    asm volatile("s_waitcnt vmcnt(0)" ::: "memory");
    __syncthreads();
    if (threadIdx.x == 0) {
        unsigned* bar = b.bar;
        __builtin_amdgcn_s_waitcnt(0);
        unsigned nloc = b.st[0], nx = b.st[1];
        if (nloc == 0u) { xcd_barrier_complete(bar, b.x, nloc, nx); b.st[0] = nloc; b.st[1] = nx; }
        const unsigned old = xb_add(&bar[XB_XSUB(b.x)], 1u);
        const unsigned gen = old / nloc;
        if (old + 1u == (gen + 1u) * nloc) {
            __builtin_amdgcn_fence(__ATOMIC_RELEASE, "agent");
            asm volatile("s_waitcnt vmcnt(0)" ::: "memory");
            const unsigned og = xb_add(&bar[XB_TOP], 1u);
            const unsigned tg = og / nx;
            if (og + 1u == (tg + 1u) * nx) xb_add(&bar[XB_TOPGEN], 1u);
            else XB_SPIN(xb_ld(&bar[XB_TOPGEN]) == tg, bar);
            __builtin_amdgcn_fence(__ATOMIC_ACQUIRE, "agent");
            xb_add(&bar[XB_XGEN(b.x)], 1u);
            asm volatile("s_waitcnt vmcnt(0)" ::: "memory");
        } else {
            XB_SPIN(xb_ld(&bar[XB_XGEN(b.x)]) == gen, bar);
            __builtin_amdgcn_fence(__ATOMIC_ACQUIRE, "agent");
            asm volatile("s_waitcnt vmcnt(0)" ::: "memory");
        }
    }
    __syncthreads();
}

constexpr int NWAVES = 8, NTHREADS = 512;
constexpr int DM = 1024, NB = 4, SEQ = 4096, DEPTH = 2, NTOK = NB * SEQ, NEXP = 16384;
constexpr int DIN = 1952, DINP = 2048;
constexpr float ALPHA = 1.4142135623730951f;
constexpr float LN_EPS = 1e-5f, RMS_EPS = 1e-6f;
constexpr float QSCALE = 0.10206207261596575f * 1.4426950408889634f;
constexpr int NPL = 10;
constexpr int NPHASE = 1 + NPL * DEPTH;
constexpr size_t MiB = 1u << 20;
constexpr size_t WS_CTL = 0, CTL_ZERO_BYTES = 64 * 1024;
constexpr size_t WS_WIT = 2 * MiB;
constexpr size_t WS_WQT = 10 * MiB;
constexpr size_t WS_WOT = 18 * MiB;
constexpr size_t WS_WUQT = 22 * MiB;
constexpr size_t WS_WUKVT = 23 * MiB;
constexpr size_t WS_KEYS = 24 * MiB;
constexpr size_t WS_ROPE = 25 * MiB;
constexpr size_t WS_SUV = 26 * MiB;
constexpr size_t WS_UT = 32 * MiB;
constexpr size_t WS_VT = 96 * MiB;
constexpr size_t WS_XB = 160 * MiB;
constexpr size_t WS_HB = 192 * MiB;
constexpr size_t WS_QM = 256 * MiB;
constexpr size_t WS_KM = 280 * MiB;
constexpr size_t WS_VMT = 304 * MiB;
constexpr size_t WS_VST = 320 * MiB;
constexpr size_t WS_OB = 336 * MiB;
constexpr size_t WS_EL = 368 * MiB;
constexpr size_t WS_GL = 376 * MiB;
constexpr size_t WS_XQ = WS_KM;
constexpr size_t WS_SX = WS_VST;
constexpr size_t WS_AC = WS_QM;
constexpr size_t WS_END = 384 * MiB;
constexpr int CW_BAR = 1024;
static_assert((CW_BAR + XCD_BAR_WORDS) * 4 <= (int)CTL_ZERO_BYTES, "barrier words inside the memset region");
constexpr int RING_OFF = 0, RING_BYTES = 131072;
constexpr int LDSCTL_OFF = RING_BYTES, MISC_OFF = LDSCTL_OFF + 320;
constexpr int LDS_BYTES = 147456;
static_assert(MISC_OFF + 128 <= LDS_BYTES, "LDS map");

typedef float f32x16 __attribute__((ext_vector_type(16)));
typedef float f32x2 __attribute__((ext_vector_type(2)));
typedef unsigned v2u __attribute__((ext_vector_type(2)));
typedef __bf16 bf2_t __attribute__((ext_vector_type(2)));

struct Args { const float* in[15]; float* out; unsigned char* ws; int ph_lo, ph_hi; };
typedef const __attribute__((address_space(4))) Args* kap_t;
__device__ __forceinline__ kap_t ka_fresh() { kap_t p = (kap_t)__builtin_amdgcn_kernarg_segment_ptr(); asm volatile("" : "+s"(p)); return p; }
enum { I_X = 0, I_WIN, I_GCQ, I_WUQ, I_GCKV, I_WUKV, I_WO, I_LN1G, I_LN1B, I_WQ, I_KEYS, I_U, I_V, I_LN2G, I_LN2B };
struct Frame {
    LAS unsigned char* lds;
    volatile LAS unsigned* MISC;
    int tid, lane, wave, vcu, G;
};
template <class T> __device__ __forceinline__ T* wsp(kap_t ka, size_t off) { return (T*)(ka->ws + off); }

__device__ __forceinline__ float bflo(unsigned w) { return __uint_as_float(w << 16); }
__device__ __forceinline__ float bfhi(unsigned w) { return __uint_as_float(w & 0xffff0000u); }
__device__ __forceinline__ float bf1(short s) { return __uint_as_float(((unsigned)(unsigned short)s) << 16); }
__device__ __forceinline__ int crow(int r, int hi) { return (r & 3) + 8 * (r >> 2) + 4 * hi; }
__device__ __forceinline__ int kperm(int s) { return (s & ~15) | (((s >> 2) & 1) << 3) | (((s >> 3) & 1) << 2) | (s & 3); }
template <int CTRL> __device__ __forceinline__ float dpp_f(float v) { return __builtin_bit_cast(float, __builtin_amdgcn_update_dpp(0, __builtin_bit_cast(int, v), CTRL, 0xF, 0xF, true)); }
__device__ __forceinline__ float wave_sum_all(float v) {
    v += dpp_f<0xB1>(v);
    v += dpp_f<0x4E>(v);
    v += dpp_f<0x141>(v);
    v += dpp_f<0x140>(v);
    v += __shfl_xor(v, 16);
    v += __shfl_xor(v, 32);
    return v;
}
__device__ __forceinline__ int wave_sum_all_i(int v) {
    v += __builtin_amdgcn_update_dpp(0, v, 0xB1, 0xF, 0xF, true); v += __builtin_amdgcn_update_dpp(0, v, 0x4E, 0xF, 0xF, true);
    v += __builtin_amdgcn_update_dpp(0, v, 0x141, 0xF, 0xF, true); v += __builtin_amdgcn_update_dpp(0, v, 0x140, 0xF, 0xF, true);
    v += __shfl_xor(v, 16); v += __shfl_xor(v, 32);
    return v;
}
__device__ __forceinline__ float wave_max_all(float v) {
    v = fmaxf(v, dpp_f<0xB1>(v)); v = fmaxf(v, dpp_f<0x4E>(v)); v = fmaxf(v, dpp_f<0x141>(v)); v = fmaxf(v, dpp_f<0x140>(v));
    v = fmaxf(v, __shfl_xor(v, 16)); v = fmaxf(v, __shfl_xor(v, 32));
    return v;
}
__device__ __forceinline__ bf16x8 pack8(float a0, float a1, float a2, float a3, float a4, float a5, float a6, float a7) {
    v4u w; w.x = pk2(a0, a1); w.y = pk2(a2, a3); w.z = pk2(a4, a5); w.w = pk2(a6, a7); return __builtin_bit_cast(bf16x8, w);
}

__device__ __forceinline__ void p0_transpose_item(const float* W, int K, int N, bf16* WT, const float* gs, LAS float* scr, int item, int lane) {
    const int nblk = N / 32, kb = item / nblk, nb = item % nblk, k0 = 64 * kb, n0 = 32 * nb;
#pragma unroll 8
    for (int i = 0; i < 32; ++i) { const int kk = 2 * i + (lane >> 5); float w = W[(size_t)(k0 + kk) * N + n0 + (lane & 31)]; if (gs) w *= gs[k0 + kk]; scr[kk * 33 + (lane & 31)] = w; }
    LDS_WAIT(); asm volatile("" ::: "memory");
    const int c = lane & 7;
#pragma unroll
    for (int j = 0; j < 4; ++j) { const int n = (lane >> 3) + 8 * j; const LAS float* s = scr + (8 * c) * 33 + n;
        v4u o; o.x = pk2(s[0 * 33], s[1 * 33]); o.y = pk2(s[2 * 33], s[3 * 33]); o.z = pk2(s[4 * 33], s[5 * 33]); o.w = pk2(s[6 * 33], s[7 * 33]);
        *(GAS v4u*)(WT + (size_t)(n0 + n) * K + k0 + 8 * c) = o; }
    LDS_WAIT(); asm volatile("" ::: "memory");
}
__device__ __forceinline__ void cvt8_range(Frame& F, const float* src, bf16* dst, size_t n8) {
    const size_t gt = (size_t)blockIdx.x * NTHREADS + F.tid, nt = (size_t)F.G * NTHREADS;
    for (size_t i = gt; i < n8; i += nt) { const f32x4 a = *(const f32x4*)(src + i * 8), b = *(const f32x4*)(src + i * 8 + 4);
        v4u o; o.x = pk2(a.x, a.y); o.y = pk2(a.z, a.w); o.z = pk2(b.x, b.y); o.w = pk2(b.z, b.w); *(v4u*)(dst + i * 8) = o; }
}
__device__ __forceinline__ void p0_prologue(Frame& F, kap_t ka) {
    LAS float* scr = (LAS float*)(F.lds + RING_OFF + F.wave * 16384);
    const int gw = F.vcu * NWAVES + F.wave, NGW = F.G * NWAVES;
    constexpr int I_IN = 16 * 61, I_Q = 16 * 64, I_O = 16 * 32, I_UQ = 4 * 24, I_UKV = 2 * 32, I_L = I_IN + I_Q + I_O + I_UQ + I_UKV;
    for (int it = gw; it < DEPTH * I_L; it += NGW) {
        const int l = it / I_L; int r = it % I_L;
        if (r < I_IN) { p0_transpose_item(ka->in[I_WIN] + (size_t)l * DM * DIN, DM, DIN, wsp<bf16>(ka, WS_WIT) + (size_t)l * DINP * DM, nullptr, scr, r, F.lane); continue; } r -= I_IN;
        if (r < I_Q) { p0_transpose_item(ka->in[I_WQ] + (size_t)l * DM * 2048, DM, 2048, wsp<bf16>(ka, WS_WQT) + (size_t)l * 2048 * DM, nullptr, scr, r, F.lane); continue; } r -= I_Q;
        if (r < I_O) { p0_transpose_item(ka->in[I_WO] + (size_t)l * DM * DM, DM, DM, wsp<bf16>(ka, WS_WOT) + (size_t)l * DM * DM, nullptr, scr, r, F.lane); continue; } r -= I_O;
        if (r < I_UQ) { p0_transpose_item(ka->in[I_WUQ] + (size_t)l * 256 * 768, 256, 768, wsp<bf16>(ka, WS_WUQT) + (size_t)l * 768 * 256, ka->in[I_GCQ] + l * 256, scr, r, F.lane); continue; } r -= I_UQ;
        p0_transpose_item(ka->in[I_WUKV] + (size_t)l * 128 * 1024, 128, 1024, wsp<bf16>(ka, WS_WUKVT) + (size_t)l * 1024 * 128, ka->in[I_GCKV] + l * 128, scr, r, F.lane);
    }
    const size_t gt = (size_t)blockIdx.x * NTHREADS + F.tid, nt = (size_t)F.G * NTHREADS;
    for (size_t i = gt; i < 2 * 12288; i += nt) { const size_t l = i / 12288, j = i % 12288; *(v4u*)(wsp<bf16>(ka, WS_WIT) + l * DINP * DM + (size_t)DIN * DM + j * 8) = (v4u){0u, 0u, 0u, 0u}; }
    for (size_t i = gt; i < (size_t)SEQ * 16; i += nt) { const int pos = (int)(i >> 4), k = (int)(i & 15);
        const float inv_freq = (float)pow(10000.0, -(double)k / 16.0); const float ang = (float)pos * inv_freq;
        wsp<f32x2>(ka, WS_ROPE)[i] = (f32x2){(float)cos((double)ang), (float)sin((double)ang)}; }
    for (size_t i = gt; i < (size_t)DEPTH * 8 * 2 * 128 * 16; i += nt) {
        const size_t lhc = i >> 11; const int n = (int)(i >> 4) & 127, dg = (int)i & 15;
        const float* src = ka->in[I_KEYS] + i * 8; const f32x4 a = *(const f32x4*)src, b = *(const f32x4*)(src + 4);
        v4u o; o.x = pk2(a.x, a.y); o.y = pk2(a.z, a.w); o.z = pk2(b.x, b.y); o.w = pk2(b.z, b.w);
        *(v4u*)(wsp<bf16>(ka, WS_KEYS) + (lhc * 2048 + (size_t)(((n >> 5) * 8 + (dg >> 1)) * 64 + (dg & 1) * 32 + (n & 31))) * 8) = o;
    }
    cvt8_range(F, ka->in[I_X], wsp<bf16>(ka, WS_XB), (size_t)NTOK * DM / 8);
    {
#ifdef MK_DBG_L0
        constexpr int NL = 1;
#else
        constexpr int NL = DEPTH;
#endif
        unsigned char* UQ = wsp<unsigned char>(ka, WS_UT); unsigned char* VQ = wsp<unsigned char>(ka, WS_VT); float* SUV = wsp<float>(ka, WS_SUV);
        for (int row = gw; row < 2 * NL * NEXP; row += NGW) {
            const int tbl = row / (NL * NEXP), r = row % (NL * NEXP);
            const float* src = (tbl ? ka->in[I_V] : ka->in[I_U]) + (size_t)r * DM + 16 * F.lane;
            f32x4 v[4]; float m = 0.f;
#pragma unroll
            for (int j = 0; j < 4; ++j) { v[j] = *(const f32x4*)(src + 4 * j); m = fmaxf(m, fmaxf(fmaxf(fabsf(v[j].x), fabsf(v[j].y)), fmaxf(fabsf(v[j].z), fabsf(v[j].w)))); }
            m = wave_max_all(m);
            const float inv = m > 0.f ? 127.f / m : 0.f;
            const int off = tbl ? 128 : 0;
            v4u o;
#pragma unroll
            for (int j = 0; j < 4; ++j) {
                const unsigned b0 = (unsigned)((int)rintf(v[j].x * inv) + off) & 0xffu, b1 = (unsigned)((int)rintf(v[j].y * inv) + off) & 0xffu, b2 = (unsigned)((int)rintf(v[j].z * inv) + off) & 0xffu, b3 = (unsigned)((int)rintf(v[j].w * inv) + off) & 0xffu;
                o[j] = b0 | (b1 << 8) | (b2 << 16) | (b3 << 24);
            }
            *(v4u*)((tbl ? VQ : UQ) + (size_t)r * DM + 16 * F.lane) = o;
            if (F.lane == 0) SUV[2 * (size_t)r + tbl] = m * (1.f / 127.f);
        }
    }
}

__device__ __forceinline__ void p2_unit(Frame& F, kap_t ka, int l, int tb, int part) {
    const int lane = F.lane, r32 = lane & 31, hi = lane >> 5;
    const int tok = tb * 32 + r32, b = tok / SEQ, s = tok % SEQ;
    const bf16* hrow = wsp<bf16>(ka, WS_HB) + (size_t)tok * DINP;
    if (part < 2) {
        bf16x8 xf[16]; float ssq = 0.f;
#pragma unroll
        for (int ks = 0; ks < 16; ++ks) { xf[ks] = *(const bf16x8*)(hrow + 1536 + ks * 16 + 8 * hi);
#pragma unroll
            for (int e = 0; e < 8; ++e) { const float v = bf1(xf[ks][e]); ssq += v * v; } }
        ssq += __shfl_xor(ssq, 32);
        const float rstd = rsqrtf(ssq * (1.f / 256.f) + RMS_EPS) * QSCALE;
        const bf16* W = wsp<bf16>(ka, WS_WUQT) + (size_t)l * 768 * 256;
        for (int j = part * 12; j < part * 12 + 12; ++j) {
            const int head = j / 3, sub = j % 3;
            const bf16* wrow = W + (size_t)(j * 32 + r32) * 256 + 8 * hi;
            f32x16 acc = {};
#pragma unroll
            for (int ks = 0; ks < 16; ++ks) acc = __builtin_amdgcn_mfma_f32_32x32x16_bf16(*(const bf16x8*)(wrow + ks * 16), xf[ks], acc, 0, 0, 0);
            float v[16];
#pragma unroll
            for (int r = 0; r < 16; ++r) v[r] = acc[r] * rstd;
            if (sub == 2) {
#pragma unroll
                for (int r = 0; r < 8; ++r) { const f32x2 cs = wsp<f32x2>(ka, WS_ROPE)[s * 16 + crow(r, hi)]; const float x1 = v[r], x2 = v[r + 8]; v[r] = x1 * cs.x - x2 * cs.y; v[r + 8] = x2 * cs.x + x1 * cs.y; }
            }
            bf16* dst = wsp<bf16>(ka, WS_QM) + ((size_t)(b * 8 + head) * SEQ + s) * 96 + sub * 32 + 4 * hi;
#pragma unroll
            for (int g = 0; g < 4; ++g) { v2u w; w.x = pk2(v[4 * g], v[4 * g + 1]); w.y = pk2(v[4 * g + 2], v[4 * g + 3]); *(v2u*)(dst + 8 * g) = w; }
        }
    } else {
        const int h0 = (part - 2) * 4;
        bf16x8 xf[8]; float ssq = 0.f;
#pragma unroll
        for (int ks = 0; ks < 8; ++ks) { xf[ks] = *(const bf16x8*)(hrow + 1792 + ks * 16 + 8 * hi);
#pragma unroll
            for (int e = 0; e < 8; ++e) { const float v = bf1(xf[ks][e]); ssq += v * v; } }
        ssq += __shfl_xor(ssq, 32);
        const float rstd = rsqrtf(ssq * (1.f / 128.f) + RMS_EPS);
        const bf16* W = wsp<bf16>(ka, WS_WUKVT) + (size_t)l * 1024 * 128;
        const int sp = kperm(s);
        for (int j = h0 * 4; j < h0 * 4 + 16; ++j) {
            const int head = j >> 2, sub = j & 3;
            const bf16* wrow = W + (size_t)(j * 32 + r32) * 128 + 8 * hi;
            f32x16 acc = {};
#pragma unroll
            for (int ks = 0; ks < 8; ++ks) acc = __builtin_amdgcn_mfma_f32_32x32x16_bf16(*(const bf16x8*)(wrow + ks * 16), xf[ks], acc, 0, 0, 0);
            if (sub < 2) {
                bf16* dst = wsp<bf16>(ka, WS_KM) + (size_t)(b * 8 + head) * SEQ * 96 + (size_t)(s >> 5) * (6 * 512) + (size_t)r32 * 8 + 4 * hi;
#pragma unroll
                for (int g = 0; g < 4; ++g) { v2u w; w.x = pk2(acc[4 * g] * rstd, acc[4 * g + 1] * rstd); w.y = pk2(acc[4 * g + 2] * rstd, acc[4 * g + 3] * rstd); *(v2u*)(dst + (2 * sub + (g >> 1)) * 512 + (g & 1) * 256) = w; }
            } else {
                bf16* dst = wsp<bf16>(ka, WS_VMT) + (size_t)(b * 8 + head) * 64 * SEQ + (size_t)(s >> 5) * (4 * 512) + ((sub - 2) * 2 + ((s >> 4) & 1)) * 512 + ((sp >> 3) & 1) * 256 + (sp & 7);
#pragma unroll
                for (int r = 0; r < 16; ++r) dst[crow(r, hi) * 8] = (bf16)f2bf(acc[r] * rstd);
            }
        }
        { const bf16x8 a1 = *(const bf16x8*)(hrow + 1920 + 8 * hi), a2 = *(const bf16x8*)(hrow + 1936 + 8 * hi);
          float o1[8], o2[8];
#pragma unroll
          for (int e = 0; e < 8; ++e) { const f32x2 cs = wsp<f32x2>(ka, WS_ROPE)[s * 16 + 8 * hi + e]; const float x1 = bf1(a1[e]), x2 = bf1(a2[e]); o1[e] = x1 * cs.x - x2 * cs.y; o2[e] = x2 * cs.x + x1 * cs.y; }
          const bf16x8 p1 = pack8(o1[0], o1[1], o1[2], o1[3], o1[4], o1[5], o1[6], o1[7]), p2 = pack8(o2[0], o2[1], o2[2], o2[3], o2[4], o2[5], o2[6], o2[7]);
#pragma unroll
          for (int hh = 0; hh < 4; ++hh) { bf16* dst = wsp<bf16>(ka, WS_KM) + (size_t)(b * 8 + h0 + hh) * SEQ * 96 + (size_t)(s >> 5) * (6 * 512) + 4 * 512 + hi * 256 + (size_t)r32 * 8; *(bf16x8*)dst = p1; *(bf16x8*)(dst + 512) = p2; } }
#pragma unroll
        for (int hh = 0; hh < 4; ++hh) {
            const int head = h0 + hh;
#pragma unroll
            for (int c4 = 0; c4 < 4; ++c4) { const bf16x8 a = *(const bf16x8*)(hrow + 1024 + head * 64 + 32 * hi + c4 * 8);
                bf16* dst = wsp<bf16>(ka, WS_VST) + ((size_t)(b * 8 + head) * 64 + 32 * hi + c4 * 8) * SEQ + sp;
#pragma unroll
                for (int e = 0; e < 8; ++e) dst[(size_t)e * SEQ] = (bf16)a[e]; }
        }
    }
}

__device__ __forceinline__ float xhalf_max(float v) { auto rr = __builtin_amdgcn_permlane32_swap(__float_as_uint(v), __float_as_uint(v), false, false); return fmaxf(__uint_as_float(rr[0]), __uint_as_float(rr[1])); }
__device__ __forceinline__ float xhalf_sum(float v) { auto rr = __builtin_amdgcn_permlane32_swap(__float_as_uint(v), __float_as_uint(v), false, false); return __uint_as_float(rr[0]) + __uint_as_float(rr[1]); }
constexpr float MLA_THR = 8.f;
__device__ __forceinline__ void mla_unit(Frame& F, kap_t ka, int bh, int qb) {
    const int lane = F.lane, r32 = lane & 31, hi = lane >> 5, q0 = qb * 32;
    const bf16* Qp = wsp<bf16>(ka, WS_QM) + ((size_t)bh * SEQ + q0 + r32) * 96 + 8 * hi;
    bf16x8 qf[6];
#pragma unroll
    for (int ks = 0; ks < 6; ++ks) qf[ks] = *(const bf16x8*)(Qp + ks * 16);
    f32x16 o0 = {}, o1 = {};
    float m = -1e30f, l = 0.f;
    const bf16* Kp = wsp<bf16>(ka, WS_KM) + (size_t)bh * SEQ * 96 + 8 * lane;
    const bf16* Vp = wsp<bf16>(ka, WS_VMT) + (size_t)bh * 64 * SEQ + 8 * lane;
#define MLA_LOADK(KF, kt) do { _Pragma("unroll") for (int ks = 0; ks < 6; ++ks) KF[ks] = *(const bf16x8*)(Kp + (size_t)((kt) * 6 + ks) * 512); } while (0)
#define MLA_LOADV(VF, kt) do { _Pragma("unroll") for (int i = 0; i < 4; ++i) VF[i] = *(const bf16x8*)(Vp + (size_t)((kt) * 4 + i) * 512); } while (0)
#define MLA_QK(S, KF) do { S = (f32x16){}; _Pragma("unroll") for (int ks = 0; ks < 6; ++ks) S = __builtin_amdgcn_mfma_f32_32x32x16_bf16(KF[ks], qf[ks], S, 0, 0, 0); } while (0)
#define MLA_SMPV(S, VF, kt) do { \
        if ((kt) == qb) { _Pragma("unroll") for (int r = 0; r < 16; ++r) if (crow(r, hi) > r32) S[r] = -1e30f; } \
        float mx = fmaxf(fmaxf(S[0], S[1]), fmaxf(S[2], S[3])); \
        _Pragma("unroll") for (int r = 4; r < 16; r += 4) mx = fmaxf(mx, fmaxf(fmaxf(S[r], S[r + 1]), fmaxf(S[r + 2], S[r + 3]))); \
        mx = xhalf_max(mx); \
        if (__any(mx - m > MLA_THR)) { const float mn = fmaxf(m, mx), alpha = __builtin_amdgcn_exp2f(m - mn); l *= alpha; m = mn; \
            _Pragma("unroll") for (int r = 0; r < 16; ++r) { o0[r] *= alpha; o1[r] *= alpha; } } \
        float p[16], rs0 = 0.f, rs1 = 0.f; \
        _Pragma("unroll") for (int r = 0; r < 16; r += 2) { p[r] = __builtin_amdgcn_exp2f(S[r] - m); p[r + 1] = __builtin_amdgcn_exp2f(S[r + 1] - m); rs0 += p[r]; rs1 += p[r + 1]; } \
        l += rs0 + rs1; \
        const bf16x8 pf0 = pack8(p[0], p[1], p[2], p[3], p[4], p[5], p[6], p[7]), pf1 = pack8(p[8], p[9], p[10], p[11], p[12], p[13], p[14], p[15]); \
        o0 = __builtin_amdgcn_mfma_f32_32x32x16_bf16(VF[0], pf0, o0, 0, 0, 0); \
        o1 = __builtin_amdgcn_mfma_f32_32x32x16_bf16(VF[2], pf0, o1, 0, 0, 0); \
        o0 = __builtin_amdgcn_mfma_f32_32x32x16_bf16(VF[1], pf1, o0, 0, 0, 0); \
        o1 = __builtin_amdgcn_mfma_f32_32x32x16_bf16(VF[3], pf1, o1, 0, 0, 0); } while (0)
    bf16x8 kA[6], kB[6], vA[4], vB[4];
    f32x16 sA, sB;
    MLA_LOADK(kA, 0); MLA_LOADV(vA, 0); MLA_LOADK(kB, 1);
    MLA_QK(sA, kA);
    for (int kt = 0; kt <= qb; kt += 2) {
        MLA_LOADK(kA, kt + 2); MLA_LOADV(vB, kt + 1);
        MLA_QK(sB, kB);
        MLA_SMPV(sA, vA, kt);
        if (kt + 1 > qb) break;
        MLA_LOADK(kB, kt + 3); MLA_LOADV(vA, kt + 2);
        MLA_QK(sA, kA);
        MLA_SMPV(sB, vB, kt + 1);
    }
#undef MLA_LOADK
#undef MLA_LOADV
#undef MLA_QK
#undef MLA_SMPV
    l = xhalf_sum(l);
    const float rl = 1.f / l;
    const int b = bh >> 3, h = bh & 7;
    bf16* dst = wsp<bf16>(ka, WS_OB) + ((size_t)b * SEQ + q0 + r32) * DM + 512 + h * 64 + 4 * hi;
#pragma unroll
    for (int g = 0; g < 4; ++g) {
        v2u w; w.x = pk2(o0[4 * g] * rl, o0[4 * g + 1] * rl); w.y = pk2(o0[4 * g + 2] * rl, o0[4 * g + 3] * rl); *(v2u*)(dst + 8 * g) = w;
        v2u u; u.x = pk2(o1[4 * g] * rl, o1[4 * g + 1] * rl); u.y = pk2(o1[4 * g + 2] * rl, o1[4 * g + 3] * rl); *(v2u*)(dst + 32 + 8 * g) = u;
    }
}

__device__ __forceinline__ void mla_block(Frame& F, kap_t ka, int bh, int J) {
    const int tid = F.tid, lane = F.lane, r32 = lane & 31, hi = lane >> 5, wave = F.wave;
    const int qb = 8 * J + wave, q0 = qb * 32, T = 8 * J + 8;
    const bf16* Qp = wsp<bf16>(ka, WS_QM) + ((size_t)bh * SEQ + q0 + r32) * 96 + 8 * hi;
    bf16x8 qf[6];
#pragma unroll
    for (int ks = 0; ks < 6; ++ks) qf[ks] = *(const bf16x8*)(Qp + ks * 16);
    f32x16 o0 = {}, o1 = {};
    float m = -1e30f, l = 0.f;
    const unsigned char* Kt = (const unsigned char*)(wsp<bf16>(ka, WS_KM) + (size_t)bh * SEQ * 96);
    const unsigned char* Vt = (const unsigned char*)(wsp<bf16>(ka, WS_VMT) + (size_t)bh * 64 * SEQ);
    LAS unsigned char* ring = F.lds + RING_OFF;
    const bool c0k = tid < 384;
    const size_t off0 = c0k ? (size_t)tid * 16 : (size_t)(tid - 384) * 16, off1 = (size_t)(128 + tid) * 16;
#define MB_GLOAD(t) do { r0 = *(const v4u*)((c0k ? Kt + (size_t)(t) * 6144 : Vt + (size_t)(t) * 4096) + off0); if (tid < 128) r1 = *(const v4u*)(Vt + (size_t)(t) * 4096 + off1); } while (0)
#define MB_LWRITE(s) do { *(LAS v4u*)(ring + (s) * 10240 + tid * 16) = r0; if (tid < 128) *(LAS v4u*)(ring + (s) * 10240 + 8192 + tid * 16) = r1; } while (0)
    v4u r0 = {}, r1 = {};
    MB_GLOAD(0); MB_LWRITE(0);
    if (T > 1) MB_GLOAD(1);
    for (int t = 0; t < T; ++t) {
        __syncthreads();
        const bool active = t <= qb;
        bf16x8 kf[6], vf[4];
        if (active) { const LAS unsigned char* sl = ring + (t & 1) * 10240 + lane * 16;
#pragma unroll
            for (int ks = 0; ks < 6; ++ks) kf[ks] = *(const LAS bf16x8*)(sl + ks * 1024);
#pragma unroll
            for (int i = 0; i < 4; ++i) vf[i] = *(const LAS bf16x8*)(sl + 6144 + i * 1024); }
        if (t + 1 < T) MB_LWRITE((t + 1) & 1);
        if (t + 2 < T) MB_GLOAD(t + 2);
        if (active) {
            f32x16 sa = {};
#pragma unroll
            for (int ks = 0; ks < 6; ++ks) sa = __builtin_amdgcn_mfma_f32_32x32x16_bf16(kf[ks], qf[ks], sa, 0, 0, 0);
            if (t == qb) {
#pragma unroll
                for (int r = 0; r < 16; ++r) if (crow(r, hi) > r32) sa[r] = -1e30f;
            }
            float mx = fmaxf(fmaxf(sa[0], sa[1]), fmaxf(sa[2], sa[3]));
#pragma unroll
            for (int r = 4; r < 16; r += 4) mx = fmaxf(mx, fmaxf(fmaxf(sa[r], sa[r + 1]), fmaxf(sa[r + 2], sa[r + 3])));
            mx = xhalf_max(mx);
            if (__any(mx - m > MLA_THR)) { const float mn = fmaxf(m, mx), alpha = __builtin_amdgcn_exp2f(m - mn); l *= alpha; m = mn;
#pragma unroll
                for (int r = 0; r < 16; ++r) { o0[r] *= alpha; o1[r] *= alpha; } }
            float p[16], rs = 0.f;
#pragma unroll
            for (int r = 0; r < 16; ++r) { p[r] = __builtin_amdgcn_exp2f(sa[r] - m); rs += p[r]; }
            l += rs;
            const bf16x8 pf0 = pack8(p[0], p[1], p[2], p[3], p[4], p[5], p[6], p[7]), pf1 = pack8(p[8], p[9], p[10], p[11], p[12], p[13], p[14], p[15]);
            o0 = __builtin_amdgcn_mfma_f32_32x32x16_bf16(vf[0], pf0, o0, 0, 0, 0);
            o0 = __builtin_amdgcn_mfma_f32_32x32x16_bf16(vf[1], pf1, o0, 0, 0, 0);
            o1 = __builtin_amdgcn_mfma_f32_32x32x16_bf16(vf[2], pf0, o1, 0, 0, 0);
            o1 = __builtin_amdgcn_mfma_f32_32x32x16_bf16(vf[3], pf1, o1, 0, 0, 0);
        }
    }
#undef MB_GLOAD
#undef MB_LWRITE
    __syncthreads();
    l = xhalf_sum(l);
    const float rl = 1.f / l;
    const int b = bh >> 3, h = bh & 7;
    bf16* dst = wsp<bf16>(ka, WS_OB) + ((size_t)b * SEQ + q0 + r32) * DM + 512 + h * 64 + 4 * hi;
#pragma unroll
    for (int g = 0; g < 4; ++g) {
        v2u w; w.x = pk2(o0[4 * g] * rl, o0[4 * g + 1] * rl); w.y = pk2(o0[4 * g + 2] * rl, o0[4 * g + 3] * rl); *(v2u*)(dst + 8 * g) = w;
        v2u u; u.x = pk2(o1[4 * g] * rl, o1[4 * g + 1] * rl); u.y = pk2(o1[4 * g + 2] * rl, o1[4 * g + 3] * rl); *(v2u*)(dst + 32 + 8 * g) = u;
    }
}

__device__ __forceinline__ void sb_unit(Frame& F, kap_t ka, int bh, int qb) {
    const int lane = F.lane, r32 = lane & 31, hi = lane >> 5, q0 = qb * 32;
    const int b = bh >> 3, h = bh & 7;
    const bf16* Hb = wsp<bf16>(ka, WS_HB) + (size_t)b * SEQ * DINP + h * 64 + 8 * hi;
    bf16x8 qf[4];
#pragma unroll
    for (int ks = 0; ks < 4; ++ks) qf[ks] = *(const bf16x8*)(Hb + (size_t)(q0 + r32) * DINP + ks * 16);
    f32x16 o0 = {}, o1 = {};
    float R = 0.f;
    const bf16* Vp = wsp<bf16>(ka, WS_VST) + ((size_t)bh * 64 + r32) * SEQ + 8 * hi;
    for (int k0 = q0; k0 >= 0; k0 -= 32) {
        bf16x8 kf[4], vf[4];
#pragma unroll
        for (int ks = 0; ks < 4; ++ks) kf[ks] = *(const bf16x8*)(Hb + (size_t)(k0 + r32) * DINP + 512 + ks * 16);
#pragma unroll
        for (int i = 0; i < 4; ++i) vf[i] = *(const bf16x8*)(Vp + (size_t)(i >> 1) * 32 * SEQ + k0 + 16 * (i & 1));
        f32x16 za = {};
#pragma unroll
        for (int ks = 0; ks < 4; ++ks) za = __builtin_amdgcn_mfma_f32_32x32x16_bf16(kf[ks], qf[ks], za, 0, 0, 0);
        const bool diag = (k0 == q0);
        float L[16], lw[16];
#pragma unroll
        for (int r = 0; r < 16; ++r) {
            const float z = za[r] * 0.125f;
            const float sp = fmaxf(z, 0.f) + __logf(1.f + __expf(-fabsf(z)));
            const bool valid = !diag || (crow(r, hi) < r32);
            L[r] = valid ? -sp : 0.f;
            lw[r] = valid ? (z - sp) : -1e30f;
        }
        float e[16], T[4], U[4];
#pragma unroll
        for (int g = 0; g < 4; ++g) { e[4 * g + 3] = 0.f; e[4 * g + 2] = L[4 * g + 3]; e[4 * g + 1] = e[4 * g + 2] + L[4 * g + 2]; e[4 * g] = e[4 * g + 1] + L[4 * g + 1]; T[g] = e[4 * g] + L[4 * g]; }
#pragma unroll
        for (int g = 0; g < 4; ++g) U[g] = __shfl_xor(T[g], 32);
        float sT[4], sUge[4];
        sT[3] = 0.f; sT[2] = T[3]; sT[1] = T[3] + T[2]; sT[0] = sT[1] + T[1];
        sUge[3] = U[3]; sUge[2] = U[3] + U[2]; sUge[1] = sUge[2] + U[1]; sUge[0] = sUge[1] + U[0];
        float w[16];
#pragma unroll
        for (int g = 0; g < 4; ++g) {
            const float sfx = R + sT[g] + (hi ? (sUge[g] - U[g]) : sUge[g]);
#pragma unroll
            for (int i = 0; i < 4; ++i) w[4 * g + i] = __expf(lw[4 * g + i] + sfx + e[4 * g + i]);
        }
        R += (sT[0] + T[0]) + sUge[0];
        const bf16x8 pf0 = pack8(w[0], w[1], w[2], w[3], w[4], w[5], w[6], w[7]), pf1 = pack8(w[8], w[9], w[10], w[11], w[12], w[13], w[14], w[15]);
        o0 = __builtin_amdgcn_mfma_f32_32x32x16_bf16(vf[0], pf0, o0, 0, 0, 0);
        o0 = __builtin_amdgcn_mfma_f32_32x32x16_bf16(vf[1], pf1, o0, 0, 0, 0);
        o1 = __builtin_amdgcn_mfma_f32_32x32x16_bf16(vf[2], pf0, o1, 0, 0, 0);
        o1 = __builtin_amdgcn_mfma_f32_32x32x16_bf16(vf[3], pf1, o1, 0, 0, 0);
        if (__all(R < -88.f)) break;
    }
    bf16* dst = wsp<bf16>(ka, WS_OB) + ((size_t)b * SEQ + q0 + r32) * DM + h * 64 + 4 * hi;
#pragma unroll
    for (int g = 0; g < 4; ++g) {
        v2u wv; wv.x = pk2(o0[4 * g], o0[4 * g + 1]); wv.y = pk2(o0[4 * g + 2], o0[4 * g + 3]); *(v2u*)(dst + 8 * g) = wv;
        v2u u; u.x = pk2(o1[4 * g], o1[4 * g + 1]); u.y = pk2(o1[4 * g + 2], o1[4 * g + 3]); *(v2u*)(dst + 32 + 8 * g) = u;
    }
}

template <bool QUANT> __device__ __forceinline__ void ln_row(Frame& F, kap_t ka, int row, const float* g, const float* bb) {
    float* yr = ka->out + (size_t)row * DM;
    f32x4 v[4]; float s = 0.f;
#pragma unroll
    for (int j = 0; j < 4; ++j) { v[j] = *(const f32x4*)(yr + 4 * F.lane + 256 * j); s += (v[j].x + v[j].y) + (v[j].z + v[j].w); }
    const float mean = wave_sum_all(s) * (1.f / DM); float s2 = 0.f;
#pragma unroll
    for (int j = 0; j < 4; ++j) { v[j] = v[j] - mean; s2 += (v[j].x * v[j].x + v[j].y * v[j].y) + (v[j].z * v[j].z + v[j].w * v[j].w); }
    const float rstd = rsqrtf(wave_sum_all(s2) * (1.f / DM) + LN_EPS);
#pragma unroll
    for (int j = 0; j < 4; ++j) { const int c = 4 * F.lane + 256 * j; const f32x4 gg = *(const f32x4*)(g + c), bv = *(const f32x4*)(bb + c);
        const f32x4 o = v[j] * rstd * gg + bv; *(f32x4*)(yr + c) = o; v[j] = o;
        v2u w; w.x = pk2(o.x, o.y); w.y = pk2(o.z, o.w); *(v2u*)(wsp<bf16>(ka, WS_XB) + (size_t)row * DM + c) = w; }
    if (QUANT) {
        float xm = 0.f;
#pragma unroll
        for (int j = 0; j < 4; ++j) xm = fmaxf(xm, fmaxf(fmaxf(fabsf(v[j].x), fabsf(v[j].y)), fmaxf(fabsf(v[j].z), fabsf(v[j].w))));
        xm = wave_max_all(xm);
        const float inv = xm > 0.f ? 127.f / xm : 0.f;
        unsigned char* xq = wsp<unsigned char>(ka, WS_XQ) + (size_t)row * DM;
#pragma unroll
        for (int j = 0; j < 4; ++j) *(unsigned*)(xq + 4 * F.lane + 256 * j) = ((unsigned)(int)rintf(v[j].x * inv) & 0xffu) | (((unsigned)(int)rintf(v[j].y * inv) & 0xffu) << 8) | (((unsigned)(int)rintf(v[j].z * inv) & 0xffu) << 16) | (((unsigned)(int)rintf(v[j].w * inv) & 0xffu) << 24);
        if (F.lane == 0) wsp<float>(ka, WS_SX)[row] = xm * (1.f / 127.f);
    }
}

template <int N, int K, int J, bool FLIP> __device__ __forceinline__ void bitonic_stage(unsigned (&v)[N]) {
#pragma unroll
    for (int i = 0; i < N; ++i) { const int p = i ^ J; if (p > i) { const bool desc = (((i & K) == 0) != FLIP); const unsigned a = v[i], c = v[p]; const unsigned mx = a > c ? a : c, mn = a > c ? c : a; v[i] = desc ? mx : mn; v[p] = desc ? mn : mx; } }
}
template <bool FLIP> __device__ __forceinline__ void bitonic_merge16(unsigned (&v)[16]) {
    bitonic_stage<16, 16, 8, FLIP>(v); bitonic_stage<16, 16, 4, FLIP>(v); bitonic_stage<16, 16, 2, FLIP>(v); bitonic_stage<16, 16, 1, FLIP>(v);
}
__device__ __forceinline__ unsigned ord_key(float f, unsigned idx) { const unsigned u = __float_as_uint(f); const unsigned o = u ^ ((unsigned)((int)u >> 31) | 0x80000000u); return (o & 0xFFFFFF80u) | idx; }
__device__ __forceinline__ float key_val(unsigned k) { const unsigned o = (k & 0xFFFFFF80u) | 0x40u; const unsigned u = (o & 0x80000000u) ? (o ^ 0x80000000u) : ~o; return __uint_as_float(u); }
template <int N, int K, int J, bool FLIP> __device__ __forceinline__ void bitonic_stage_kv(unsigned (&k)[N], unsigned (&p)[N]) {
#pragma unroll
    for (int i = 0; i < N; ++i) { const int q = i ^ J; if (q > i) { const bool desc = (((i & K) == 0) != FLIP); const bool sw = desc ? (k[i] < k[q]) : (k[i] > k[q]);
        const unsigned ki = sw ? k[q] : k[i], kq = sw ? k[i] : k[q], pi = sw ? p[q] : p[i], pq = sw ? p[i] : p[q]; k[i] = ki; k[q] = kq; p[i] = pi; p[q] = pq; } }
}
template <bool FLIP> __device__ __forceinline__ void bitonic_merge16_kv(unsigned (&k)[16], unsigned (&p)[16]) {
    bitonic_stage_kv<16, 16, 8, FLIP>(k, p); bitonic_stage_kv<16, 16, 4, FLIP>(k, p); bitonic_stage_kv<16, 16, 2, FLIP>(k, p); bitonic_stage_kv<16, 16, 1, FLIP>(k, p);
}
__device__ __forceinline__ void p7_half(Frame& F, kap_t ka, int l, int tok, int h, int c, unsigned (&Cc)[16]) {
    const int lane = F.lane, hi = lane >> 5;
    const bf16* qrow = wsp<bf16>(ka, WS_HB) + (size_t)tok * 2048 + h * 256 + c * 128 + 8 * hi;
    bf16x8 qf[8];
#pragma unroll
    for (int ks = 0; ks < 8; ++ks) qf[ks] = *(const bf16x8*)(qrow + ks * 16);
    const bf16* kb = wsp<bf16>(ka, WS_KEYS) + (size_t)((l * 8 + h) * 2 + c) * 16384 + 8 * lane;
    unsigned key[64];
#pragma unroll
    for (int ch = 0; ch < 4; ++ch) {
        f32x16 acc = {};
#pragma unroll
        for (int ks = 0; ks < 8; ++ks) acc = __builtin_amdgcn_mfma_f32_32x32x16_bf16(*(const bf16x8*)(kb + (ch * 8 + ks) * 512), qf[ks], acc, 0, 0, 0);
#pragma unroll
        for (int r = 0; r < 16; ++r) key[ch * 16 + r] = ord_key(acc[r], (unsigned)(ch * 32 + crow(r, hi)));
    }
    bitonic_stage<64, 2, 1, false>(key);
    bitonic_stage<64, 4, 2, false>(key); bitonic_stage<64, 4, 1, false>(key);
    bitonic_stage<64, 8, 4, false>(key); bitonic_stage<64, 8, 2, false>(key); bitonic_stage<64, 8, 1, false>(key);
    bitonic_stage<64, 16, 8, false>(key); bitonic_stage<64, 16, 4, false>(key); bitonic_stage<64, 16, 2, false>(key); bitonic_stage<64, 16, 1, false>(key);
    unsigned A[16], B[16];
#pragma unroll
    for (int i = 0; i < 16; ++i) { A[i] = key[i] > key[16 + i] ? key[i] : key[16 + i]; B[i] = key[32 + i] > key[48 + i] ? key[32 + i] : key[48 + i]; }
    bitonic_merge16<false>(A);
    bitonic_merge16<true>(B);
#pragma unroll
    for (int i = 0; i < 16; ++i) A[i] = A[i] > B[i] ? A[i] : B[i];
    bitonic_merge16<false>(A);
#pragma unroll
    for (int i = 0; i < 16; ++i) B[i] = (unsigned)__shfl_xor((int)A[i], 32);
#pragma unroll
    for (int i = 0; i < 16; ++i) Cc[i] = A[i] > B[15 - i] ? A[i] : B[15 - i];
    bitonic_merge16<false>(Cc);
}
__device__ __forceinline__ void p7_unit(Frame& F, kap_t ka, int l, int tb, int h) {
    const int lane = F.lane, r32 = lane & 31, hi = lane >> 5;
    const int tok = tb * 32 + r32;
    unsigned L0[16], L1[16];
#pragma unroll
    for (int i = 0; i < 16; ++i) { L0[i] = 0u; L1[i] = 0u; }
#pragma unroll 1
    for (int c = 0; c < 2; ++c) {
        unsigned Cc[16];
        p7_half(F, ka, l, tok, h, c, Cc);
#pragma unroll
        for (int i = 0; i < 16; ++i) { L0[i] = c == 0 ? Cc[i] : L0[i]; L1[i] = c == 0 ? L1[i] : Cc[i]; }
    }
    __builtin_amdgcn_sched_barrier(0);
    unsigned key[64];
    {
        float v0[16], v1[16];
#pragma unroll
        for (int i = 0; i < 16; ++i) { v0[i] = key_val(L0[i]); v1[i] = key_val(L1[i]); }
#define P7_ROW(a, off, nb) { _Pragma("unroll") for (int b2 = 0; b2 < (nb); ++b2) { \
            const float sum = v0[a] + v1[b2]; const unsigned u = __float_as_uint(sum); const unsigned o = u ^ ((unsigned)((int)u >> 31) | 0x80000000u); \
            key[(off) + b2] = (o & 0xFFFFFF00u) | (unsigned)(255 - (16 * (a) + b2)); } }
        P7_ROW(0, 0, 16) P7_ROW(1, 16, 8) P7_ROW(2, 24, 5) P7_ROW(3, 29, 4) P7_ROW(4, 33, 3) P7_ROW(5, 36, 2) P7_ROW(6, 38, 2) P7_ROW(7, 40, 2)
        P7_ROW(8, 42, 1) P7_ROW(9, 43, 1) P7_ROW(10, 44, 1) P7_ROW(11, 45, 1) P7_ROW(12, 46, 1) P7_ROW(13, 47, 1) P7_ROW(14, 48, 1) P7_ROW(15, 49, 1)
#undef P7_ROW
#pragma unroll
        for (int i = 50; i < 64; ++i) key[i] = 0u;
    }
    LAS unsigned char* slot = F.lds + RING_OFF + F.wave * 2304 + lane * 36;
#pragma unroll
    for (int q = 0; q < 4; ++q) {
        ((LAS unsigned*)slot)[q] = (L0[4 * q] & 127u) | ((L0[4 * q + 1] & 127u) << 8) | ((L0[4 * q + 2] & 127u) << 16) | ((L0[4 * q + 3] & 127u) << 24);
        ((LAS unsigned*)slot)[4 + q] = (L1[4 * q] & 127u) | ((L1[4 * q + 1] & 127u) << 8) | ((L1[4 * q + 2] & 127u) << 16) | ((L1[4 * q + 3] & 127u) << 24);
    }
    bitonic_stage<64, 2, 1, false>(key);
    bitonic_stage<64, 4, 2, false>(key); bitonic_stage<64, 4, 1, false>(key);
    bitonic_stage<64, 8, 4, false>(key); bitonic_stage<64, 8, 2, false>(key); bitonic_stage<64, 8, 1, false>(key);
    bitonic_stage<64, 16, 8, false>(key); bitonic_stage<64, 16, 4, false>(key); bitonic_stage<64, 16, 2, false>(key); bitonic_stage<64, 16, 1, false>(key);
    unsigned A[16], B[16];
#pragma unroll
    for (int i = 0; i < 16; ++i) { A[i] = key[i] > key[16 + i] ? key[i] : key[16 + i]; B[i] = key[32 + i] > key[48 + i] ? key[32 + i] : key[48 + i]; }
    bitonic_merge16<false>(A);
    bitonic_merge16<true>(B);
#pragma unroll
    for (int i = 0; i < 16; ++i) A[i] = A[i] > B[i] ? A[i] : B[i];
    bitonic_merge16<false>(A);
    LDS_WAIT(); asm volatile("" ::: "memory");
    unsigned PA[16]; float g[16], den = 0.f;
    { const unsigned o0 = (A[0] & 0xFFFFFF00u) | 128u; const float m = __uint_as_float((o0 & 0x80000000u) ? (o0 ^ 0x80000000u) : ~o0);
#pragma unroll
      for (int i = 0; i < 16; ++i) { const unsigned o = (A[i] & 0xFFFFFF00u) | 128u; const float sv = __uint_as_float((o & 0x80000000u) ? (o ^ 0x80000000u) : ~o); g[i] = __expf(sv - m); den += g[i];
          const unsigned flat = 255u - (A[i] & 255u); PA[i] = (unsigned)slot[flat >> 4] * 128u + (unsigned)slot[16 + (flat & 15u)]; } }
    LDS_WAIT(); asm volatile("" ::: "memory");
    const float rden = 1.f / den;
    if (hi == 0) {
        unsigned* de = wsp<unsigned>(ka, WS_EL) + (size_t)tok * 128 + h * 16; float* dg = wsp<float>(ka, WS_GL) + (size_t)tok * 128 + h * 16;
#pragma unroll
        for (int q = 0; q < 4; ++q) { *(v4u*)(de + 4 * q) = (v4u){PA[4 * q], PA[4 * q + 1], PA[4 * q + 2], PA[4 * q + 3]};
            *(f32x4*)(dg + 4 * q) = (f32x4){g[4 * q] * rden, g[4 * q + 1] * rden, g[4 * q + 2] * rden, g[4 * q + 3] * rden}; }
    }
}

__device__ __forceinline__ float dot2_bf16(unsigned w, unsigned x, float acc) { return __builtin_amdgcn_fdot2_f32_bf16(__builtin_bit_cast(bf2_t, w), __builtin_bit_cast(bf2_t, x), acc, false); }
__device__ __forceinline__ float gelu_erf(float x) { return 0.5f * x * (1.f + erff(x * 0.70710678118654752f)); }
__device__ __forceinline__ void p8a_token(Frame& F, kap_t ka, int l, int tok, unsigned part, const unsigned ev0, const unsigned ev1, const float gv0, const float gv1) {
    const int lane = F.lane;
    const v4u xq4 = *(const v4u*)(wsp<unsigned char>(ka, WS_XQ) + (size_t)tok * DM + 16 * lane);
    const int xq0 = (int)xq4.x, xq1 = (int)xq4.y, xq2 = (int)xq4.z, xq3 = (int)xq4.w;
    const float sx = wsp<float>(ka, WS_SX)[tok];
    const f32x2* SUV = wsp<f32x2>(ka, WS_SUV) + (size_t)l * NEXP;
    const bool in0 = (ev0 & 7u) == part, in1 = (ev1 & 7u) == part;
    const f32x2 sc0 = SUV[ev0], sc1 = SUV[ev1];
    const unsigned char* UQ = wsp<unsigned char>(ka, WS_UT) + (size_t)l * NEXP * DM + 16 * lane;
    int hq0 = 0, hq1 = 0;
#define P8A_HALF(EV, MASK, HQ) do { unsigned long long mk_ = (MASK); \
        while (mk_) { v4u buf_[8]; int kk_[8]; \
            _Pragma("unroll") for (int j = 0; j < 8; ++j) { kk_[j] = -1; if (mk_) { kk_[j] = (int)__builtin_ctzll(mk_); mk_ &= mk_ - 1; \
                const unsigned e_ = (unsigned)__builtin_amdgcn_readlane((int)(EV), kk_[j]); buf_[j] = *(const v4u*)(UQ + (size_t)e_ * DM); } } \
            _Pragma("unroll") for (int j = 0; j < 8; ++j) { if (kk_[j] >= 0) { \
                int p_ = __builtin_amdgcn_sdot4((int)buf_[j].x, xq0, 0, false); p_ = __builtin_amdgcn_sdot4((int)buf_[j].y, xq1, p_, false); \
                p_ = __builtin_amdgcn_sdot4((int)buf_[j].z, xq2, p_, false); p_ = __builtin_amdgcn_sdot4((int)buf_[j].w, xq3, p_, false); \
                p_ += __builtin_amdgcn_update_dpp(0, p_, 0xB1, 0xF, 0xF, true); p_ += __builtin_amdgcn_update_dpp(0, p_, 0x4E, 0xF, 0xF, true); \
                p_ += __builtin_amdgcn_update_dpp(0, p_, 0x141, 0xF, 0xF, true); p_ += __builtin_amdgcn_update_dpp(0, p_, 0x140, 0xF, 0xF, true); \
                p_ += __builtin_amdgcn_update_dpp(0, p_, 0x142, 0xA, 0xF, false); p_ += __builtin_amdgcn_update_dpp(0, p_, 0x143, 0xC, 0xF, false); \
                int s_ = __builtin_amdgcn_readlane(p_, 63); asm volatile("" : "+s"(s_));     \
                HQ = (lane == kk_[j]) ? s_ : HQ; } } } } while (0)
    P8A_HALF(ev0, __ballot(in0), hq0);
    P8A_HALF(ev1, __ballot(in1), hq1);
#undef P8A_HALF
    float* AC = wsp<float>(ka, WS_AC) + (size_t)tok * 128;
    if (in0) AC[lane] = gv0 * gelu_erf((float)hq0 * (sc0.x * sx)) * sc0.y;
    if (in1) AC[64 + lane] = gv1 * gelu_erf((float)hq1 * (sc1.x * sx)) * sc1.y;
}
__device__ __forceinline__ void p8b_token(Frame& F, kap_t ka, int l, int tok, unsigned part, const unsigned ev0, const unsigned ev1, const float av0, const float av1, LAS unsigned* le, LAS float* la) {
    const int lane = F.lane, g = lane >> 3, c = lane & 7;
    le[lane] = ev0; le[64 + lane] = ev1; la[lane] = av0; la[64 + lane] = av1;
    LDS_WAIT(); asm volatile("" ::: "memory");
    const unsigned char* VQ = wsp<unsigned char>(ka, WS_VT) + (size_t)l * NEXP * DM + 128 * part + 16 * c;
    float acc[16], at = 0.f;
#pragma unroll
    for (int i = 0; i < 16; ++i) acc[i] = 0.f;
    v4u A[8], B[8]; float aA[8], aB[8];
#define P8B_LOAD(BUF, AA, b) do { _Pragma("unroll") for (int j = 0; j < 8; ++j) { const int k_ = 8 * (8 * (b) + j) + g; AA[j] = la[k_]; BUF[j] = *(const v4u*)(VQ + (size_t)le[k_] * DM); } } while (0)
#define P8B_COMP(BUF, AA) do { _Pragma("unroll") for (int j = 0; j < 8; ++j) { const float a_ = AA[j]; at += a_; \
        _Pragma("unroll") for (int q = 0; q < 4; ++q) { const unsigned w_ = BUF[j][q]; \
            acc[4 * q] += a_ * (float)(w_ & 0xffu); acc[4 * q + 1] += a_ * (float)((w_ >> 8) & 0xffu); acc[4 * q + 2] += a_ * (float)((w_ >> 16) & 0xffu); acc[4 * q + 3] += a_ * (float)(w_ >> 24); } } } while (0)
    P8B_LOAD(A, aA, 0); P8B_LOAD(B, aB, 1);
    P8B_COMP(A, aA); P8B_COMP(B, aB);
#undef P8B_LOAD
#undef P8B_COMP
#pragma unroll
    for (int i = 0; i < 16; ++i) { acc[i] += __shfl_xor(acc[i], 8); acc[i] += __shfl_xor(acc[i], 16); acc[i] += __shfl_xor(acc[i], 32); }
    at += __shfl_xor(at, 8); at += __shfl_xor(at, 16); at += __shfl_xor(at, 32);
    if (g == 0) {
        float* yrow = ka->out + (size_t)tok * DM + 128 * part + 16 * c;
#pragma unroll
        for (int q = 0; q < 4; ++q) { const f32x4 x = *(const f32x4*)(yrow + 4 * q);
            *(f32x4*)(yrow + 4 * q) = (f32x4){ALPHA * x.x + (acc[4 * q] - 128.f * at), ALPHA * x.y + (acc[4 * q + 1] - 128.f * at), ALPHA * x.z + (acc[4 * q + 2] - 128.f * at), ALPHA * x.w + (acc[4 * q + 3] - 128.f * at)}; }
    }
    LDS_WAIT(); asm volatile("" ::: "memory");
}

__global__ void __launch_bounds__(NTHREADS, 2) mk_fwd(Args args) {
    extern __shared__ __attribute__((aligned(16))) unsigned char lds[];
    Frame F;
    F.lds = (LAS unsigned char*)lds;
    F.MISC = (volatile LAS unsigned*)(F.lds + MISC_OFF);
    F.tid = threadIdx.x; F.lane = F.tid & 63; F.wave = __builtin_amdgcn_readfirstlane(F.tid >> 6);
    F.G = gridDim.x; { const int bx = blockIdx.x; F.vcu = (F.G % 8 == 0) ? (bx % 8) * (F.G / 8) + bx / 8 : bx; }
    for (int u = F.tid; u < (LDS_BYTES - LDSCTL_OFF) / 4; u += NTHREADS) ((LAS unsigned*)(F.lds + LDSCTL_OFF))[u] = 0u;
    __syncthreads();
    const int lo = args.ph_lo, hi = args.ph_hi;
    unsigned* const barw = (unsigned*)(args.ws + WS_CTL) + CW_BAR;
    const bool one_phase = (hi - lo) == 1;
    XcdBarrier bar; bar.bar = barw; bar.x = 0; bar.st = nullptr;
    if (!one_phase) bar = xcd_barrier_post(barw, F.MISC + 8);
#ifndef MK_EN
#define MK_EN 0x7ff
#endif
#ifndef MK_MLA_LDS
#define MK_MLA_LDS 0
#endif
#ifndef MK_MLA_REP
#define MK_MLA_REP 1
#endif
#ifndef MK_SB_REP
#define MK_SB_REP 1
#endif
#define EN(n) (((MK_EN) >> (n)) & 1)
#ifndef MK_REP
#define MK_REP 0
#endif
#define PHASE_REP(n) for (int rep_ = 0; rep_ < ((((MK_REP) >> (n)) & 1) + 1); ++rep_)
#define IN(k) (lo <= (k) && (k) < hi)
#define PHASE_IDS() do { int t_ = threadIdx.x; asm volatile("" : "+v"(t_)); F.tid = t_; F.lane = t_ & 63; } while (0)
#define SEAM(k) do { if (IN((k) + 1)) xcd_barrier(bar); } while (0)
    const int gw = F.vcu * NWAVES + F.wave, NGW = F.G * NWAVES;

    if (EN(0) && IN(0)) PHASE_REP(0) { PHASE_IDS(); p0_prologue(F, ka_fresh()); SEAM(0); }
    for (int l = 0; l < DEPTH; ++l) {
        const int pb = 1 + NPL * l;
        if (EN(1) && IN(pb + 0)) PHASE_REP(1) { const kap_t ka = ka_fresh(); PHASE_IDS();
            pg8::Gemm g{wsp<bf16>(ka, WS_XB), wsp<bf16>(ka, WS_WIT) + (size_t)l * DINP * DM, NTOK, DINP, DM}; pg8::StaticOrder S; S.init(NTOK, DINP, F.G, (int)blockIdx.x);
            pg8::EpiBf16<0> E{wsp<bf16>(ka, WS_HB), DINP, nullptr, 0, 0, 1.f};
            pg8::gemm_phase<pg8::EpiBf16<0>, pg8::StaticOrder, PG8_ALIGN, PG8_SP2>(F.lds + RING_OFF, g, S, E);
            SEAM(pb + 0);
        }
        if (EN(2) && IN(pb + 1)) PHASE_REP(2) { const kap_t ka = ka_fresh(); PHASE_IDS();
            for (int u = gw; u < (NTOK / 32) * 4; u += NGW) p2_unit(F, ka, l, u >> 2, u & 3);
            SEAM(pb + 1);
        }
        if (EN(3) && IN(pb + 2)) PHASE_REP(3) { const kap_t ka = ka_fresh(); PHASE_IDS();
#if MK_MLA_LDS
            for (int u = F.vcu; u < 32 * 8; u += F.G) {
                const int bh = u >> 3, j = u & 7;
                mla_block(F, ka, bh, 15 - j); sb_unit(F, ka, bh, 8 * (15 - j) + F.wave);
                mla_block(F, ka, bh, j); sb_unit(F, ka, bh, 8 * j + F.wave);
            }
#else
            for (int u = gw; u < 32 * 64; u += NGW) {
                const int bh = u >> 6, pi = u & 63;
                for (int r_ = 0; r_ < MK_MLA_REP; ++r_) mla_unit(F, ka, bh, 127 - pi);
                for (int r_ = 0; r_ < MK_SB_REP; ++r_) sb_unit(F, ka, bh, 127 - pi);
                for (int r_ = 0; r_ < MK_MLA_REP; ++r_) mla_unit(F, ka, bh, pi);
                for (int r_ = 0; r_ < MK_SB_REP; ++r_) sb_unit(F, ka, bh, pi);
            }
#endif
            SEAM(pb + 2);
        }
        if (EN(4) && IN(pb + 3)) PHASE_REP(4) { const kap_t ka = ka_fresh(); PHASE_IDS();
            pg8::Gemm g{wsp<bf16>(ka, WS_OB), wsp<bf16>(ka, WS_WOT) + (size_t)l * DM * DM, NTOK, DM, DM}; pg8::StaticOrder S; S.init(NTOK, DM, F.G, (int)blockIdx.x);
            pg8::EpiResF32 E{l == 0 ? ka->in[I_X] : ka->out, ka->out, DM, ALPHA};
            pg8::gemm_phase<pg8::EpiResF32, pg8::StaticOrder, PG8_ALIGN, PG8_SP2>(F.lds + RING_OFF, g, S, E);
            SEAM(pb + 3);
        }
        if (EN(5) && IN(pb + 4)) PHASE_REP(5) { const kap_t ka = ka_fresh(); PHASE_IDS();
            for (int r = gw; r < NTOK; r += NGW) ln_row<true>(F, ka, r, ka->in[I_LN1G] + l * DM, ka->in[I_LN1B] + l * DM);
            SEAM(pb + 4);
        }
        if (EN(6) && IN(pb + 5)) PHASE_REP(6) { const kap_t ka = ka_fresh(); PHASE_IDS();
            pg8::Gemm g{wsp<bf16>(ka, WS_XB), wsp<bf16>(ka, WS_WQT) + (size_t)l * 2048 * DM, NTOK, 2048, DM}; pg8::StaticOrder S; S.init(NTOK, 2048, F.G, (int)blockIdx.x);
            pg8::EpiBf16<0> E{wsp<bf16>(ka, WS_HB), 2048, nullptr, 0, 0, 1.f};
            pg8::gemm_phase<pg8::EpiBf16<0>, pg8::StaticOrder, PG8_ALIGN, PG8_SP2>(F.lds + RING_OFF, g, S, E);
            SEAM(pb + 5);
        }
        if (EN(7) && IN(pb + 6)) PHASE_REP(7) { const kap_t ka = ka_fresh(); PHASE_IDS();
            for (int u = gw; u < (NTOK / 32) * 8; u += NGW) p7_unit(F, ka, l, u >> 3, u & 7);
            SEAM(pb + 6);
        }
        if (EN(8) && IN(pb + 7)) PHASE_REP(8) { const kap_t ka = ka_fresh(); PHASE_IDS();
            const bool split = (F.G % 8 == 0); const int npp = split ? F.G / 8 : F.G;
            for (unsigned part = split ? (unsigned)(F.vcu / npp) : 0u, pend = split ? part + 1u : 8u; part < pend; ++part) {
                const int pw = (F.vcu % npp) * NWAVES + F.wave, npw = npp * NWAVES;
                const unsigned* EL = wsp<unsigned>(ka, WS_EL) + F.lane; const float* GL = wsp<float>(ka, WS_GL) + F.lane;
                unsigned e0 = 0u, e1 = 0u; float g0 = 0.f, g1 = 0.f;
                if (pw < NTOK) { e0 = EL[(size_t)pw * 128]; e1 = EL[(size_t)pw * 128 + 64]; g0 = GL[(size_t)pw * 128]; g1 = GL[(size_t)pw * 128 + 64]; }
                for (int t = pw; t < NTOK; t += npw) {
                    unsigned ne0 = 0u, ne1 = 0u; float ng0 = 0.f, ng1 = 0.f;
                    if (t + npw < NTOK) { const size_t o = (size_t)(t + npw) * 128; ne0 = EL[o]; ne1 = EL[o + 64]; ng0 = GL[o]; ng1 = GL[o + 64]; }
                    p8a_token(F, ka, l, t, part, e0, e1, g0, g1);
                    e0 = ne0; e1 = ne1; g0 = ng0; g1 = ng1;
                }
            }
            SEAM(pb + 7);
        }
        if (EN(9) && IN(pb + 8)) PHASE_REP(9) { const kap_t ka = ka_fresh(); PHASE_IDS();
            const bool split = (F.G % 8 == 0); const int npp = split ? F.G / 8 : F.G;
            for (unsigned part = split ? (unsigned)(F.vcu / npp) : 0u, pend = split ? part + 1u : 8u; part < pend; ++part) {
                const int pw = (F.vcu % npp) * NWAVES + F.wave, npw = npp * NWAVES;
                LAS unsigned* le = (LAS unsigned*)(F.lds + RING_OFF + F.wave * 1024); LAS float* la = (LAS float*)(F.lds + RING_OFF + F.wave * 1024 + 512);
                const unsigned* EL = wsp<unsigned>(ka, WS_EL) + F.lane; const float* AC = wsp<float>(ka, WS_AC) + F.lane;
                unsigned e0 = 0u, e1 = 0u; float a0 = 0.f, a1 = 0.f;
                if (pw < NTOK) { e0 = EL[(size_t)pw * 128]; e1 = EL[(size_t)pw * 128 + 64]; a0 = AC[(size_t)pw * 128]; a1 = AC[(size_t)pw * 128 + 64]; }
                for (int t = pw; t < NTOK; t += npw) {
                    unsigned ne0 = 0u, ne1 = 0u; float na0 = 0.f, na1 = 0.f;
                    if (t + npw < NTOK) { const size_t o = (size_t)(t + npw) * 128; ne0 = EL[o]; ne1 = EL[o + 64]; na0 = AC[o]; na1 = AC[o + 64]; }
                    p8b_token(F, ka, l, t, part, e0, e1, a0, a1, le, la);
                    e0 = ne0; e1 = ne1; a0 = na0; a1 = na1;
                }
            }
            SEAM(pb + 8);
        }
        if (EN(10) && IN(pb + 9)) PHASE_REP(10) { const kap_t ka = ka_fresh(); PHASE_IDS();
            for (int r = gw; r < NTOK; r += NGW) ln_row<false>(F, ka, r, ka->in[I_LN2G] + l * DM, ka->in[I_LN2B] + l * DM);
            if (l + 1 < DEPTH) SEAM(pb + 9);
        }
    }
#undef IN
#undef SEAM
}

#ifndef MK_PER_PHASE
#define MK_PER_PHASE 0
#endif
extern "C" void kernel_launch(void* const* d_in, const int* in_sizes, int n_in, void* d_out, int out_size, void* d_ws, size_t ws_size, hipStream_t stream) {
    static int grid = 0;
    if (grid == 0) {
        if (n_in != 15 || out_size != NTOK * DM || ws_size < WS_END) { fprintf(stderr, "kernel_launch: unexpected shapes (n_in %d, out %d, ws %zu); nothing launched\n", n_in, out_size, ws_size); grid = -1; return; }
        int dev = 0, cus = 0, per_cu = 0;
        if (hipGetDevice(&dev) != hipSuccess || hipDeviceGetAttribute(&cus, hipDeviceAttributeMultiprocessorCount, dev) != hipSuccess) { fprintf(stderr, "kernel_launch: device query failed\n"); grid = -1; return; }
        if (hipFuncSetAttribute((const void*)mk_fwd, hipFuncAttributeMaxDynamicSharedMemorySize, LDS_BYTES) != hipSuccess) { fprintf(stderr, "kernel_launch: hipFuncSetAttribute failed\n"); grid = -1; return; }
        if (hipOccupancyMaxActiveBlocksPerMultiprocessor(&per_cu, (const void*)mk_fwd, NTHREADS, LDS_BYTES) != hipSuccess || per_cu < 1) { fprintf(stderr, "kernel_launch: occupancy query says %d blocks per CU\n", per_cu); per_cu = 1; }
        (void)hipGetLastError();
        grid = cus;
        fprintf(stderr, "kernel_launch: grid %d (occupancy query %d per CU)\n", grid, per_cu);
    }
    if (grid < 0) return;
    (void)hipMemsetAsync((char*)d_ws + WS_CTL, 0, CTL_ZERO_BYTES, stream);
    Args a{};
    for (int i = 0; i < 15; ++i) a.in[i] = (const float*)d_in[i];
    a.out = (float*)d_out; a.ws = (unsigned char*)d_ws;
#if MK_PER_PHASE
    for (int p = 0; p < NPHASE; ++p) { a.ph_lo = p; a.ph_hi = p + 1; hipLaunchKernelGGL(mk_fwd, dim3(grid), dim3(NTHREADS), LDS_BYTES, stream, a); }
#else
    a.ph_lo = 0; a.ph_hi = NPHASE;
    void* kargs[] = {&a};
    const hipError_t e = hipLaunchCooperativeKernel((const void*)mk_fwd, dim3(grid), dim3(NTHREADS), kargs, LDS_BYTES, stream);
    if (e != hipSuccess) fprintf(stderr, "kernel_launch: cooperative launch failed: %s (grid %d)\n", hipGetErrorString(e), grid);
#endif
}
```

```cpp
#include <hip/hip_runtime.h>
#include <cstdio>
#include <cstdint>
#include <math.h>
namespace pg8 {
#define PG8_LAS __attribute__((address_space(3)))
typedef unsigned short bf16_t;
typedef short bf16x8 __attribute__((ext_vector_type(8)));
typedef float f32x4 __attribute__((ext_vector_type(4)));
typedef unsigned u32x4 __attribute__((ext_vector_type(4)));
constexpr int BM = 256, BK = 64, HALF = 128, HTB = HALF * BK * 2  , STAGE_BYTES = 8 * HTB, NXCD = 8, WGM = 8;

__host__ __device__ __forceinline__ int lds_byte(int r, int c) { const int st = (r >> 4) * 2 + (c >> 5), rr = r & 15, cc = c & 31, ob = rr * 64 + cc * 2; return st * 1024 + (ob ^ (((ob >> 9) & 1) << 5)); }
__host__ __device__ __forceinline__ void stage_rc(int b, int& R, int& C) { const int st = b / 1024, sb = b % 1024, swz = sb ^ (((sb >> 9) & 1) << 5); R = (st >> 1) * 16 + swz / 64; C = (st & 1) * 32 + (swz % 64) / 2; }
__host__ __device__ __forceinline__ int perm32(int rho) { const int n = rho >> 4, i = rho & 15; return 8 * (i >> 2) + 4 * n + (i & 3); }

struct Unit { int pm, pn; };
struct Gemm { const bf16_t* A; const bf16_t* Bt; int M, N, K; };

struct StaticOrder {
    int nM, nN, nwg, G, c;
    __host__ __device__ void init(int M, int N, int G_, int c_) { nM = M / BM; nN = N / BM; nwg = nM * nN; G = G_; c = c_; }
    __host__ __device__ bool next(int i, Unit& u) const {
        const long L = (long)i * G + c; if (L >= nwg) return false;
        int wgid = (int)L; { const int q = nwg / NXCD, r = nwg % NXCD, xcd = wgid % NXCD, off = wgid / NXCD; wgid = (xcd < r ? xcd * (q + 1) : r * (q + 1) + (xcd - r) * q) + off; }
        const int nig = WGM * nN, gid = wgid / nig, fm = gid * WGM, gsz = (nM - fm) < WGM ? (nM - fm) : WGM;
        u.pm = fm + ((wgid % nig) % gsz); u.pn = (wgid % nig) / gsz; return true;
    }
    __device__ __forceinline__ void a_ready(const Unit&) const {}
    __device__ __forceinline__ void done(const Unit&) const {}
};

__device__ __forceinline__ unsigned cvt_pk_bf16(float lo, float hi) { unsigned r; asm volatile("v_cvt_pk_bf16_f32 %0, %1, %2" : "=v"(r) : "v"(lo), "v"(hi)); return r; }
typedef float f32x2 __attribute__((ext_vector_type(2)));
__device__ __forceinline__ f32x2 gelu_pk(f32x2 v) {
    const f32x2 av = __builtin_elementwise_abs(v), d = av * 0.2316418882f + 1.0f;
    f32x2 t; t.x = __builtin_amdgcn_rcpf(d.x); t.y = __builtin_amdgcn_rcpf(d.y);
    f32x2 q = t * 0.5307027145f + (-0.7265760135f); q = q * t + 0.7107068705f; q = q * t + (-0.142248368f); q = q * t + 0.127414796f; q = q * t;
    const f32x2 s = (v * v) * (-0.72134752044f);
    f32x2 e; e.x = __builtin_amdgcn_exp2f(s.x); e.y = __builtin_amdgcn_exp2f(s.y);
    const f32x2 m = v * (q * e), r = v - m;
    f32x2 o; o.x = v.x < 0.f ? m.x : r.x; o.y = v.y < 0.f ? m.y : r.y; return o;
}

template <int ACT  > struct EpiBf16 {
    static constexpr bool PERM = true, AFTER_DRAIN = false; static_assert(ACT == 0 || ACT == 1, "EpiBf16: ACT is 0 (none) or 1 (gelu_pk)");
    bf16_t* O; int ldc; const float* bias; int split_cols; size_t split_stride; float scale0;
    __device__ __forceinline__ void operator()(const f32x4 (&acc)[2][2][4][2], const Unit& u, int wr, int wc, int fr, int fq) const {
        const int row0 = u.pm * BM + wr * 64 + fr; int colt = u.pn * BM; bf16_t* base = O;
        float sc = 1.f; if (split_cols) { const int t = colt / split_cols; base += (size_t)t * split_stride; colt -= t * split_cols; if (t == 0) sc = scale0; }
        const int col0 = colt + wc * 32 + 8 * fq, bcol0 = u.pn * BM + wc * 32 + 8 * fq;
        f32x4 bv[2][2];
#pragma unroll
        for (int bj = 0; bj < 2; ++bj)
#pragma unroll
            for (int n = 0; n < 2; ++n) bv[bj][n] = bias ? *(const f32x4*)(bias + bcol0 + bj * HALF + 4 * n) : (f32x4){0.f, 0.f, 0.f, 0.f};
#pragma unroll
        for (int ai = 0; ai < 2; ++ai)
#pragma unroll
            for (int m = 0; m < 4; ++m) { bf16_t* rowp = base + (size_t)(row0 + ai * HALF + m * 16) * ldc + col0;
#pragma unroll
                for (int bj = 0; bj < 2; ++bj) { f32x4 v0 = acc[ai][bj][m][0] + bv[bj][0], v1 = acc[ai][bj][m][1] + bv[bj][1];
                    if (ACT == 1) { f32x2 a = gelu_pk((f32x2){v0[0], v0[1]}), b = gelu_pk((f32x2){v0[2], v0[3]}), c = gelu_pk((f32x2){v1[0], v1[1]}), d = gelu_pk((f32x2){v1[2], v1[3]});
                        v0 = (f32x4){a.x, a.y, b.x, b.y}; v1 = (f32x4){c.x, c.y, d.x, d.y}; }
                    v0 = v0 * sc; v1 = v1 * sc; u32x4 w; w.x = cvt_pk_bf16(v0[0], v0[1]); w.y = cvt_pk_bf16(v0[2], v0[3]); w.z = cvt_pk_bf16(v1[0], v1[1]); w.w = cvt_pk_bf16(v1[2], v1[3]);
                    *(u32x4*)(rowp + bj * HALF) = w; } }
    }
};
struct EpiResF32 {
    static constexpr bool PERM = false, AFTER_DRAIN = false;
    const float* res; float* out; int ldc; float alpha;
    __device__ __forceinline__ void operator()(const f32x4 (&acc)[2][2][4][2], const Unit& u, int wr, int wc, int fr, int fq) const {
        const int row0 = u.pm * BM + wr * 64 + fr, col0 = u.pn * BM + wc * 32 + 4 * fq;
#pragma unroll
        for (int ai = 0; ai < 2; ++ai)
#pragma unroll
            for (int m = 0; m < 4; ++m) { const size_t off = (size_t)(row0 + ai * HALF + m * 16) * ldc + col0;
#pragma unroll
                for (int bj = 0; bj < 2; ++bj)
#pragma unroll
                    for (int n = 0; n < 2; ++n) { const f32x4 rs = *(const f32x4*)(res + off + bj * HALF + n * 16); *(f32x4*)(out + off + bj * HALF + n * 16) = rs * alpha + acc[ai][bj][m][n]; }
                if (m & 1) asm volatile("" ::: "memory"); }
    }
};
template <class Epi, class Sched, bool ALIGN_EPI = false, bool SP2 = false>
__device__ __forceinline__ void gemm_phase(PG8_LAS unsigned char* lds, const Gemm g, const Sched& S, const Epi& E) {
    int tid_ = threadIdx.x; asm volatile("" : "+v"(tid_));
    const int tid = tid_, wid = __builtin_amdgcn_readfirstlane(tid >> 6), lane = tid & 63, wr = wid >> 2, wc = wid & 3, fr = lane & 15, fq = lane >> 4;
    const int K = g.K, nt = K / BK;
    unsigned voffA[2], voffB[2];
#pragma unroll
    for (int i = 0; i < 2; ++i) { int R, C; stage_rc(tid * 16 + i * 8192, R, C); const int Rb = Epi::PERM ? ((R & ~31) + perm32(R & 31)) : R;
        voffA[i] = (unsigned)(R * K + C) * 2u; voffB[i] = (unsigned)(Rb * K + C) * 2u; }
    const size_t kstep = (size_t)(BK * 2);
    const size_t hstep = (size_t)HALF * K * 2;
    const size_t tstep = 2 * hstep;
    const unsigned ldsw = (unsigned)wid * 1024u;
    const int aoff = lds_byte(wr * 64 + fr, fq * 8), boff = lds_byte(wc * 32 + fr, fq * 8);
#define PG8_SA(b, h) (((b) * 2 + (h)) * HTB)
#define PG8_SB(b, h) ((4 + (b) * 2 + (h)) * HTB)
#define PG8_STAGE(bufoff, gbase, voff) do { _Pragma("unroll") for (int _i = 0; _i < 2; ++_i) \
        __builtin_amdgcn_global_load_lds((const unsigned*)((const char*)(gbase) + (voff)[_i]), (PG8_LAS unsigned*)(lds + (bufoff) + ldsw + _i * 8192), 16, 0, 0); } while (0)
#define PG8_LDA(dst, b, h) do { _Pragma("unroll") for (int m = 0; m < 4; ++m) _Pragma("unroll") for (int k = 0; k < 2; ++k) dst[m][k] = *(const PG8_LAS bf16x8*)(lds + PG8_SA(b, h) + aoff + m * 2048 + k * 1024); } while (0)
#define PG8_LDB(dst, b, h) do { _Pragma("unroll") for (int n = 0; n < 2; ++n) _Pragma("unroll") for (int k = 0; k < 2; ++k) dst[n][k] = *(const PG8_LAS bf16x8*)(lds + PG8_SB(b, h) + boff + n * 2048 + k * 1024); } while (0)
#define PG8_MMA(ai, bj, At, Bt) do { __builtin_amdgcn_s_setprio(1); _Pragma("unroll") for (int m = 0; m < 4; ++m) _Pragma("unroll") for (int n = 0; n < 2; ++n) _Pragma("unroll") for (int k = 0; k < 2; ++k) \
        acc[ai][bj][m][n] = __builtin_amdgcn_mfma_f32_16x16x32_bf16(Bt[n][k], At[m][k], acc[ai][bj][m][n], 0, 0, 0); __builtin_amdgcn_s_setprio(0); } while (0)
#define PG8_WAIT_V(n) asm volatile("s_waitcnt vmcnt(" #n ")" ::: "memory")
#define PG8_WAIT_L(n) asm volatile("s_waitcnt lgkmcnt(" #n ")" ::: "memory")
#define PG8_BAR __builtin_amdgcn_s_barrier()
#define PG8_SCHED __builtin_amdgcn_sched_barrier(0)
    Unit cur, nxt; int ui = 0;
    if (!S.next(0, cur)) return;
    f32x4 acc[2][2][4][2];
#pragma unroll
    for (int a = 0; a < 2; ++a)
#pragma unroll
        for (int b = 0; b < 2; ++b)
#pragma unroll
            for (int m = 0; m < 4; ++m)
#pragma unroll
                for (int n = 0; n < 2; ++n) acc[a][b][m][n] = (f32x4){0.f, 0.f, 0.f, 0.f};
    bf16x8 At[4][2], B0[2][2], B1[2][2];
    const char* cA = (const char*)g.A + (size_t)cur.pm * tstep; const char* cB = (const char*)g.Bt + (size_t)cur.pn * tstep;
    S.a_ready(cur);
    if constexpr (SP2) {
        PG8_STAGE(PG8_SB(0, 0), cB, voffB); PG8_STAGE(PG8_SB(0, 1), cB + hstep, voffB); PG8_STAGE(PG8_SA(0, 0), cA, voffA); PG8_STAGE(PG8_SA(0, 1), cA + hstep, voffA);
        if (wr == 1) PG8_BAR;
        PG8_WAIT_V(2); PG8_BAR;
        PG8_STAGE(PG8_SB(1, 0), cB + kstep, voffB); PG8_STAGE(PG8_SA(1, 0), cA + kstep, voffA); PG8_STAGE(PG8_SB(1, 1), cB + hstep + kstep, voffB);
        PG8_WAIT_V(6); PG8_BAR;
    } else {
        PG8_STAGE(PG8_SB(0, 0), cB, voffB); PG8_STAGE(PG8_SA(0, 0), cA, voffA); PG8_STAGE(PG8_SB(0, 1), cB + hstep, voffB); PG8_STAGE(PG8_SA(0, 1), cA + hstep, voffA);
        if (wr == 1) PG8_BAR;
        PG8_WAIT_V(4); PG8_BAR;
        PG8_STAGE(PG8_SB(1, 0), cB + kstep, voffB); PG8_STAGE(PG8_SA(1, 0), cA + kstep, voffA); PG8_STAGE(PG8_SB(1, 1), cB + hstep + kstep, voffB);
        PG8_WAIT_V(6); PG8_BAR;
    }
    for (;;) {
        const bool has_next = S.next(ui + 1, nxt);
        const char* nA = has_next ? (const char*)g.A + (size_t)nxt.pm * tstep : cA; const char* nB = has_next ? (const char*)g.Bt + (size_t)nxt.pn * tstep : cB;
        for (int t = 0; t < nt; t += 2) {
            const bool last = (t == nt - 2);
            const char* a1 = cA + (size_t)(t + 1) * kstep;
            const char* a2 = last ? nA : cA + (size_t)(t + 2) * kstep; const char* b2 = last ? nB : cB + (size_t)(t + 2) * kstep;
            const char* a3 = a2 + kstep; const char* b3 = b2 + kstep;
            if (last && has_next) S.a_ready(nxt);
            if constexpr (SP2) {
            PG8_LDB(B0, 0, 0); PG8_LDB(B1, 0, 1); PG8_SCHED; PG8_LDA(At, 0, 0); PG8_STAGE(PG8_SA(1, 1), a1 + hstep, voffA);
            PG8_WAIT_V(8); PG8_WAIT_L(0); PG8_BAR; PG8_MMA(0, 0, At, B0); PG8_MMA(0, 1, At, B1); PG8_BAR; PG8_SCHED;
            PG8_LDA(At, 0, 1); PG8_STAGE(PG8_SB(0, 0), b2, voffB); PG8_STAGE(PG8_SB(0, 1), b2 + hstep, voffB); PG8_STAGE(PG8_SA(0, 0), a2, voffA);
            PG8_WAIT_V(8); PG8_WAIT_L(0); PG8_BAR; PG8_MMA(1, 0, At, B0); PG8_MMA(1, 1, At, B1); PG8_BAR; PG8_SCHED;
            PG8_LDB(B0, 1, 0); PG8_LDB(B1, 1, 1); PG8_SCHED; PG8_LDA(At, 1, 0); PG8_STAGE(PG8_SA(0, 1), a2 + hstep, voffA);
            PG8_WAIT_V(8); PG8_WAIT_L(0); PG8_BAR; PG8_MMA(0, 0, At, B0); PG8_MMA(0, 1, At, B1); PG8_BAR; PG8_SCHED;
            PG8_LDA(At, 1, 1); PG8_STAGE(PG8_SB(1, 0), b3, voffB); PG8_STAGE(PG8_SB(1, 1), b3 + hstep, voffB); PG8_STAGE(PG8_SA(1, 0), a3, voffA);
            PG8_WAIT_V(8); PG8_WAIT_L(0); PG8_BAR; PG8_MMA(1, 0, At, B0); PG8_MMA(1, 1, At, B1); PG8_BAR; PG8_SCHED;
            } else {
            PG8_LDB(B0, 0, 0); PG8_SCHED; PG8_LDA(At, 0, 0); PG8_STAGE(PG8_SA(1, 1), a1 + hstep, voffA);
            PG8_WAIT_L(8); PG8_BAR; PG8_WAIT_L(0); PG8_MMA(0, 0, At, B0); PG8_BAR; PG8_SCHED;
            PG8_LDB(B1, 0, 1); PG8_STAGE(PG8_SB(0, 0), b2, voffB);
            PG8_BAR; PG8_WAIT_L(0); PG8_MMA(0, 1, At, B1); PG8_BAR;
            PG8_LDA(At, 0, 1); PG8_STAGE(PG8_SA(0, 0), a2, voffA);
            PG8_BAR; PG8_WAIT_L(0); PG8_MMA(1, 0, At, B0); PG8_BAR; PG8_SCHED;
            PG8_STAGE(PG8_SB(0, 1), b2 + hstep, voffB);
            PG8_WAIT_V(6); PG8_BAR; PG8_MMA(1, 1, At, B1); PG8_BAR;
            PG8_LDB(B0, 1, 0); PG8_SCHED; PG8_LDA(At, 1, 0); PG8_STAGE(PG8_SA(0, 1), a2 + hstep, voffA);
            PG8_WAIT_L(8); PG8_BAR; PG8_WAIT_L(0); PG8_MMA(0, 0, At, B0); PG8_BAR; PG8_SCHED;
            PG8_LDB(B1, 1, 1); PG8_STAGE(PG8_SB(1, 0), b3, voffB);
            PG8_BAR; PG8_WAIT_L(0); PG8_MMA(0, 1, At, B1); PG8_BAR;
            PG8_LDA(At, 1, 1); PG8_STAGE(PG8_SA(1, 0), a3, voffA);
            PG8_BAR; PG8_WAIT_L(0); PG8_MMA(1, 0, At, B0); PG8_BAR; PG8_SCHED;
            PG8_STAGE(PG8_SB(1, 1), b3 + hstep, voffB);
            PG8_WAIT_V(6); PG8_BAR; PG8_MMA(1, 1, At, B1); PG8_BAR;
            }
        }
        if constexpr (ALIGN_EPI) { if (wr == 0) PG8_BAR; }
        if constexpr (!Epi::AFTER_DRAIN) { E(acc, cur, wr, wc, fr, fq); S.done(cur); }
        if (!has_next) break;
#pragma unroll
        for (int a = 0; a < 2; ++a)
#pragma unroll
            for (int b = 0; b < 2; ++b)
#pragma unroll
                for (int m = 0; m < 4; ++m)
#pragma unroll
                    for (int n = 0; n < 2; ++n) acc[a][b][m][n] = (f32x4){0.f, 0.f, 0.f, 0.f};
        cur = nxt; cA = nA; cB = nB; ++ui;
        if constexpr (ALIGN_EPI) { if (wr == 1) PG8_BAR; }
    }
    PG8_WAIT_V(0);
    if constexpr (!ALIGN_EPI) { if (wr == 0) PG8_BAR; }
    PG8_BAR;
    if constexpr (Epi::AFTER_DRAIN) { E.fused(acc, cur, wr, wc, fr, fq, lds, wid, lane); S.done(cur); }
#undef PG8_SA
#undef PG8_SB
#undef PG8_STAGE
#undef PG8_LDA
#undef PG8_LDB
#undef PG8_MMA
#undef PG8_WAIT_V
#undef PG8_WAIT_L
#undef PG8_BAR
#undef PG8_SCHED
}
}

#ifndef PG8_SP2
#define PG8_SP2 true
#endif
#ifndef PG8_ALIGN
#define PG8_ALIGN true
#endif
#define GAS __attribute__((address_space(1)))
#define LAS __attribute__((address_space(3)))
typedef unsigned short bf16;
typedef unsigned v4u __attribute__((ext_vector_type(4)));
typedef float f32x4 __attribute__((ext_vector_type(4)));
typedef short bf16x8 __attribute__((ext_vector_type(8)));
typedef GAS unsigned gu32;
typedef GAS unsigned long long gu64;
#define RLX_AGENT __ATOMIC_RELAXED, __HIP_MEMORY_SCOPE_AGENT
#define LDS_WAIT() asm volatile("s_waitcnt lgkmcnt(0)" ::: "memory")
#define VM_WAIT() asm volatile("s_waitcnt vmcnt(0)" ::: "memory")
__device__ __forceinline__ unsigned long long rt() { return __builtin_amdgcn_s_memrealtime(); }
__device__ __forceinline__ unsigned f2bf(float f) { unsigned u = __builtin_bit_cast(unsigned, f); return (u + 0x7fffu + ((u >> 16) & 1u)) >> 16; }
typedef float pk2_f32x2_t __attribute__((ext_vector_type(2))); typedef __bf16 pk2_bf16x2_t __attribute__((ext_vector_type(2)));
__device__ __forceinline__ unsigned pk2(float lo, float hi) { const pk2_f32x2_t v = {lo, hi}; return __builtin_bit_cast(unsigned, __builtin_convertvector(v, pk2_bf16x2_t)); }

#define XB_TMO      128
#define XB_XCNT(j)  (256  + 64 * (j))
#define XB_XSUB(j)  (1280 + 64 * (j))
#define XB_XGEN(j)  (2304 + 64 * (j))
#define XB_TOP      3328
#define XB_TOPGEN   3392
#define XCD_BAR_WORDS 3456
#define XB_SPIN_CAP (1u << 18)

__device__ __forceinline__ unsigned xb_ld(unsigned* p)              { return __hip_atomic_load(p, __ATOMIC_RELAXED, __HIP_MEMORY_SCOPE_AGENT); }
__device__ __forceinline__ unsigned xb_add(unsigned* p, unsigned v) { return __hip_atomic_fetch_add(p, v, __ATOMIC_RELAXED, __HIP_MEMORY_SCOPE_AGENT); }
__device__ __forceinline__ unsigned xb_xcc_id() { return (unsigned)__builtin_amdgcn_s_getreg((3 << 11) | 20) & 0xFu; }
#define XB_SPIN(cond, bar) do { unsigned _sp = 0; while (cond) { __builtin_amdgcn_s_sleep(1); \
    if ((++_sp & 255u) == 0u) { if (xb_ld(&(bar)[XB_TMO])) break; if (_sp > XB_SPIN_CAP) { atomicAdd(&(bar)[XB_TMO], 1u); break; } } } } while (0)

struct XcdBarrier {
    unsigned* bar; unsigned x;
    volatile LAS unsigned* st;
};

__device__ __forceinline__ XcdBarrier xcd_barrier_post(unsigned* bar, volatile LAS unsigned* st) {
    XcdBarrier b; b.bar = bar; b.x = xb_xcc_id(); b.st = st;
    if (threadIdx.x == 0) (void)xb_add(&bar[XB_XCNT(b.x)], 1u);
    return b;
}
__device__ __forceinline__ void xcd_barrier_complete(unsigned* bar, unsigned x, unsigned& nloc, unsigned& nx) {
    const unsigned G = gridDim.x * gridDim.y * gridDim.z;
    unsigned sum, cnt, mine, sp = 0u;
    for (;;) {
        sum = 0u; cnt = 0u; mine = 0u;
#pragma unroll
        for (unsigned j = 0; j < 16; ++j) { const unsigned c = xb_ld(&bar[XB_XCNT(j)]); sum += c; cnt += (c > 0u) ? 1u : 0u; mine = (j == x) ? c : mine; }
        if (sum == G) break;
        __builtin_amdgcn_s_sleep(1);
        if ((++sp & 255u) == 0u) { if (xb_ld(&bar[XB_TMO])) break; if (sp > XB_SPIN_CAP) { atomicAdd(&bar[XB_TMO], 1u); break; } }
    }
    nloc = mine > 0u ? mine : 1u; nx = cnt > 0u ? cnt : 1u;
}

__device__ __forceinline__ void xcd_barrier(const XcdBarrier& b) {
    asm volatile("s_waitcnt vmcnt(0)" ::: "memory");
    __syncthreads();
    if (threadIdx.x == 0) {
        unsigned* bar = b.bar;
        __builtin_amdgcn_s_waitcnt(0);
        unsigned nloc = b.st[0], nx = b.st[1];
        if (nloc == 0u) { xcd_barrier_complete(bar, b.x, nloc, nx); b.st[0] = nloc; b.st[1] = nx; }
        const unsigned old = xb_add(&bar[XB_XSUB(b.x)], 1u);
        const unsigned gen = old / nloc;
        if (old + 1u == (gen + 1u) * nloc) {
            __builtin_amdgcn_fence(__ATOMIC_RELEASE, "agent");
            asm volatile("s_waitcnt vmcnt(0)" ::: "memory");
            const unsigned og = xb_add(&bar[XB_TOP], 1u);
            const unsigned tg = og / nx;
            if (og + 1u == (tg + 1u) * nx) xb_add(&bar[XB_TOPGEN], 1u);
            else XB_SPIN(xb_ld(&bar[XB_TOPGEN]) == tg, bar);
            __builtin_amdgcn_fence(__ATOMIC_ACQUIRE, "agent");
            xb_add(&bar[XB_XGEN(b.x)], 1u);
            asm volatile("s_waitcnt vmcnt(0)" ::: "memory");
        } else {
            XB_SPIN(xb_ld(&bar[XB_XGEN(b.x)]) == gen, bar);
            __builtin_amdgcn_fence(__ATOMIC_ACQUIRE, "agent");
            asm volatile("s_waitcnt vmcnt(0)" ::: "memory");
        }
    }
    __syncthreads();
}

constexpr int NWAVES = 8, NTHREADS = 512;
constexpr int DM = 1024, NB = 4, SEQ = 4096, DEPTH = 2, NTOK = NB * SEQ, NEXP = 16384;
constexpr int DIN = 1952, DINP = 2048;
constexpr float ALPHA = 1.4142135623730951f;
constexpr float LN_EPS = 1e-5f, RMS_EPS = 1e-6f;
constexpr float QSCALE = 0.10206207261596575f * 1.4426950408889634f;
constexpr int NPL = 10;
constexpr int NPHASE = 1 + NPL * DEPTH;
constexpr size_t MiB = 1u << 20;
constexpr size_t WS_CTL = 0, CTL_ZERO_BYTES = 64 * 1024;
constexpr size_t WS_WIT = 2 * MiB;
constexpr size_t WS_WQT = 10 * MiB;
constexpr size_t WS_WOT = 18 * MiB;
constexpr size_t WS_WUQT = 22 * MiB;
constexpr size_t WS_WUKVT = 23 * MiB;
constexpr size_t WS_KEYS = 24 * MiB;
constexpr size_t WS_ROPE = 25 * MiB;
constexpr size_t WS_SUV = 26 * MiB;
constexpr size_t WS_UT = 32 * MiB;
constexpr size_t WS_VT = 96 * MiB;
constexpr size_t WS_XB = 160 * MiB;
constexpr size_t WS_HB = 192 * MiB;
constexpr size_t WS_QM = 256 * MiB;
constexpr size_t WS_KM = 280 * MiB;
constexpr size_t WS_VMT = 304 * MiB;
constexpr size_t WS_VST = 320 * MiB;
constexpr size_t WS_OB = 336 * MiB;
constexpr size_t WS_EL = 368 * MiB;
constexpr size_t WS_GL = 376 * MiB;
constexpr size_t WS_XQ = WS_KM;
constexpr size_t WS_SX = WS_VST;
constexpr size_t WS_AC = WS_QM;
constexpr size_t WS_END = 384 * MiB;
constexpr int CW_BAR = 1024;
static_assert((CW_BAR + XCD_BAR_WORDS) * 4 <= (int)CTL_ZERO_BYTES, "barrier words inside the memset region");
constexpr int RING_OFF = 0, RING_BYTES = 131072;
constexpr int LDSCTL_OFF = RING_BYTES, MISC_OFF = LDSCTL_OFF + 320;
constexpr int LDS_BYTES = 147456;
static_assert(MISC_OFF + 128 <= LDS_BYTES, "LDS map");

typedef float f32x16 __attribute__((ext_vector_type(16)));
typedef float f32x2 __attribute__((ext_vector_type(2)));
typedef unsigned v2u __attribute__((ext_vector_type(2)));
typedef __bf16 bf2_t __attribute__((ext_vector_type(2)));

struct Args { const float* in[15]; float* out; unsigned char* ws; int ph_lo, ph_hi; };
typedef const __attribute__((address_space(4))) Args* kap_t;
__device__ __forceinline__ kap_t ka_fresh() { kap_t p = (kap_t)__builtin_amdgcn_kernarg_segment_ptr(); asm volatile("" : "+s"(p)); return p; }
enum { I_X = 0, I_WIN, I_GCQ, I_WUQ, I_GCKV, I_WUKV, I_WO, I_LN1G, I_LN1B, I_WQ, I_KEYS, I_U, I_V, I_LN2G, I_LN2B };
struct Frame {
    LAS unsigned char* lds;
    volatile LAS unsigned* MISC;
    int tid, lane, wave, vcu, G;
};
template <class T> __device__ __forceinline__ T* wsp(kap_t ka, size_t off) { return (T*)(ka->ws + off); }

__device__ __forceinline__ float bflo(unsigned w) { return __uint_as_float(w << 16); }
__device__ __forceinline__ float bfhi(unsigned w) { return __uint_as_float(w & 0xffff0000u); }
__device__ __forceinline__ float bf1(short s) { return __uint_as_float(((unsigned)(unsigned short)s) << 16); }
__device__ __forceinline__ int crow(int r, int hi) { return (r & 3) + 8 * (r >> 2) + 4 * hi; }
__device__ __forceinline__ int kperm(int s) { return (s & ~15) | (((s >> 2) & 1) << 3) | (((s >> 3) & 1) << 2) | (s & 3); }
template <int CTRL> __device__ __forceinline__ float dpp_f(float v) { return __builtin_bit_cast(float, __builtin_amdgcn_update_dpp(0, __builtin_bit_cast(int, v), CTRL, 0xF, 0xF, true)); }
__device__ __forceinline__ int shx_i(int v, int mask, int lane) { return __builtin_amdgcn_ds_bpermute((lane ^ mask) << 2, v); }
__device__ __forceinline__ float shx_f(float v, int mask, int lane) { return __builtin_bit_cast(float, __builtin_amdgcn_ds_bpermute((lane ^ mask) << 2, __builtin_bit_cast(int, v))); }
__device__ __forceinline__ float wave_sum_all(float v, int lane) {
    v += dpp_f<0xB1>(v);
    v += dpp_f<0x4E>(v);
    v += dpp_f<0x141>(v);
    v += dpp_f<0x140>(v);
    v += shx_f(v, 16, lane);
    v += shx_f(v, 32, lane);
    return v;
}
__device__ __forceinline__ int wave_sum_all_i(int v, int lane) {
    v += __builtin_amdgcn_update_dpp(0, v, 0xB1, 0xF, 0xF, true); v += __builtin_amdgcn_update_dpp(0, v, 0x4E, 0xF, 0xF, true);
    v += __builtin_amdgcn_update_dpp(0, v, 0x141, 0xF, 0xF, true); v += __builtin_amdgcn_update_dpp(0, v, 0x140, 0xF, 0xF, true);
    v += shx_i(v, 16, lane); v += shx_i(v, 32, lane);
    return v;
}
__device__ __forceinline__ float wave_max_all(float v, int lane) {
    v = fmaxf(v, dpp_f<0xB1>(v)); v = fmaxf(v, dpp_f<0x4E>(v)); v = fmaxf(v, dpp_f<0x141>(v)); v = fmaxf(v, dpp_f<0x140>(v));
    v = fmaxf(v, shx_f(v, 16, lane)); v = fmaxf(v, shx_f(v, 32, lane));
    return v;
}
__device__ __forceinline__ bf16x8 pack8(float a0, float a1, float a2, float a3, float a4, float a5, float a6, float a7) {
    v4u w; w.x = pk2(a0, a1); w.y = pk2(a2, a3); w.z = pk2(a4, a5); w.w = pk2(a6, a7); return __builtin_bit_cast(bf16x8, w);
}

__device__ __forceinline__ void p0_transpose_item(const float* W, int K, int N, bf16* WT, const float* gs, LAS float* scr, int item, int lane) {
    const int nblk = N / 32, kb = item / nblk, nb = item % nblk, k0 = 64 * kb, n0 = 32 * nb;
#pragma unroll 8
    for (int i = 0; i < 32; ++i) { const int kk = 2 * i + (lane >> 5); float w = W[(size_t)(k0 + kk) * N + n0 + (lane & 31)]; if (gs) w *= gs[k0 + kk]; scr[kk * 33 + (lane & 31)] = w; }
    LDS_WAIT(); asm volatile("" ::: "memory");
    const int c = lane & 7;
#pragma unroll
    for (int j = 0; j < 4; ++j) { const int n = (lane >> 3) + 8 * j; const LAS float* s = scr + (8 * c) * 33 + n;
        v4u o; o.x = pk2(s[0 * 33], s[1 * 33]); o.y = pk2(s[2 * 33], s[3 * 33]); o.z = pk2(s[4 * 33], s[5 * 33]); o.w = pk2(s[6 * 33], s[7 * 33]);
        *(GAS v4u*)(WT + (size_t)(n0 + n) * K + k0 + 8 * c) = o; }
    LDS_WAIT(); asm volatile("" ::: "memory");
}
__device__ __forceinline__ void cvt8_range(Frame& F, const float* src, bf16* dst, size_t n8) {
    const size_t gt = (size_t)blockIdx.x * NTHREADS + F.tid, nt = (size_t)F.G * NTHREADS;
    for (size_t i = gt; i < n8; i += nt) { const f32x4 a = *(const f32x4*)(src + i * 8), b = *(const f32x4*)(src + i * 8 + 4);
        v4u o; o.x = pk2(a.x, a.y); o.y = pk2(a.z, a.w); o.z = pk2(b.x, b.y); o.w = pk2(b.z, b.w); *(v4u*)(dst + i * 8) = o; }
}
__device__ __forceinline__ void p0_prologue(Frame& F, kap_t ka) {
    LAS float* scr = (LAS float*)(F.lds + RING_OFF + F.wave * 16384);
    const int gw = F.vcu * NWAVES + F.wave, NGW = F.G * NWAVES;
    constexpr int I_IN = 16 * 61, I_Q = 16 * 64, I_O = 16 * 32, I_UQ = 4 * 24, I_UKV = 2 * 32, I_L = I_IN + I_Q + I_O + I_UQ + I_UKV;
    for (int it = gw; it < DEPTH * I_L; it += NGW) {
        const int l = it / I_L; int r = it % I_L;
        if (r < I_IN) { p0_transpose_item(ka->in[I_WIN] + (size_t)l * DM * DIN, DM, DIN, wsp<bf16>(ka, WS_WIT) + (size_t)l * DINP * DM, nullptr, scr, r, F.lane); continue; } r -= I_IN;
        if (r < I_Q) { p0_transpose_item(ka->in[I_WQ] + (size_t)l * DM * 2048, DM, 2048, wsp<bf16>(ka, WS_WQT) + (size_t)l * 2048 * DM, nullptr, scr, r, F.lane); continue; } r -= I_Q;
        if (r < I_O) { p0_transpose_item(ka->in[I_WO] + (size_t)l * DM * DM, DM, DM, wsp<bf16>(ka, WS_WOT) + (size_t)l * DM * DM, nullptr, scr, r, F.lane); continue; } r -= I_O;
        if (r < I_UQ) { p0_transpose_item(ka->in[I_WUQ] + (size_t)l * 256 * 768, 256, 768, wsp<bf16>(ka, WS_WUQT) + (size_t)l * 768 * 256, ka->in[I_GCQ] + l * 256, scr, r, F.lane); continue; } r -= I_UQ;
        p0_transpose_item(ka->in[I_WUKV] + (size_t)l * 128 * 1024, 128, 1024, wsp<bf16>(ka, WS_WUKVT) + (size_t)l * 1024 * 128, ka->in[I_GCKV] + l * 128, scr, r, F.lane);
    }
    const size_t gt = (size_t)blockIdx.x * NTHREADS + F.tid, nt = (size_t)F.G * NTHREADS;
    for (size_t i = gt; i < 2 * 12288; i += nt) { const size_t l = i / 12288, j = i % 12288; *(v4u*)(wsp<bf16>(ka, WS_WIT) + l * DINP * DM + (size_t)DIN * DM + j * 8) = (v4u){0u, 0u, 0u, 0u}; }
    for (size_t i = gt; i < (size_t)SEQ * 16; i += nt) { const int pos = (int)(i >> 4), k = (int)(i & 15);
        const float inv_freq = (float)pow(10000.0, -(double)k / 16.0); const float ang = (float)pos * inv_freq;
        wsp<f32x2>(ka, WS_ROPE)[i] = (f32x2){(float)cos((double)ang), (float)sin((double)ang)}; }
    for (size_t i = gt; i < (size_t)DEPTH * 8 * 2 * 128 * 16; i += nt) {
        const size_t lhc = i >> 11; const int n = (int)(i >> 4) & 127, dg = (int)i & 15;
        const float* src = ka->in[I_KEYS] + i * 8; const f32x4 a = *(const f32x4*)src, b = *(const f32x4*)(src + 4);
        v4u o; o.x = pk2(a.x, a.y); o.y = pk2(a.z, a.w); o.z = pk2(b.x, b.y); o.w = pk2(b.z, b.w);
        *(v4u*)(wsp<bf16>(ka, WS_KEYS) + (lhc * 2048 + (size_t)(((n >> 5) * 8 + (dg >> 1)) * 64 + (dg & 1) * 32 + (n & 31))) * 8) = o;
    }
    cvt8_range(F, ka->in[I_X], wsp<bf16>(ka, WS_XB), (size_t)NTOK * DM / 8);
    {
#ifdef MK_DBG_L0
        constexpr int NL = 1;
#else
        constexpr int NL = DEPTH;
#endif
        unsigned char* UQ = wsp<unsigned char>(ka, WS_UT); unsigned char* VQ = wsp<unsigned char>(ka, WS_VT); float* SUV = wsp<float>(ka, WS_SUV);
        for (int row = gw; row < 2 * NL * NEXP; row += NGW) {
            const int tbl = row / (NL * NEXP), r = row % (NL * NEXP);
            const float* src = (tbl ? ka->in[I_V] : ka->in[I_U]) + (size_t)r * DM + 16 * F.lane;
            f32x4 v[4]; float m = 0.f;
#pragma unroll
            for (int j = 0; j < 4; ++j) { v[j] = *(const f32x4*)(src + 4 * j); m = fmaxf(m, fmaxf(fmaxf(fabsf(v[j].x), fabsf(v[j].y)), fmaxf(fabsf(v[j].z), fabsf(v[j].w)))); }
            m = wave_max_all(m, F.lane);
            const float inv = m > 0.f ? 127.f / m : 0.f;
            const int off = 0;
            v4u o;
#pragma unroll
            for (int j = 0; j < 4; ++j) {
                const unsigned b0 = (unsigned)((int)rintf(v[j].x * inv) + off) & 0xffu, b1 = (unsigned)((int)rintf(v[j].y * inv) + off) & 0xffu, b2 = (unsigned)((int)rintf(v[j].z * inv) + off) & 0xffu, b3 = (unsigned)((int)rintf(v[j].w * inv) + off) & 0xffu;
                o[j] = b0 | (b1 << 8) | (b2 << 16) | (b3 << 24);
            }
            if (tbl) *(v4u*)(VQ + (size_t)(r / NEXP) * NEXP * DM + ((size_t)(F.lane >> 3) * NEXP + (size_t)(r % NEXP)) * 128 + 16 * (F.lane & 7)) = o;
            else *(v4u*)(UQ + (size_t)r * DM + 16 * F.lane) = o;
            if (F.lane == 0) SUV[2 * (size_t)r + tbl] = m * (1.f / 127.f);
        }
    }
}

__device__ __forceinline__ void p2_unit(Frame& F, kap_t ka, int l, int tb, int part) {
    const int lane = F.lane, r32 = lane & 31, hi = lane >> 5;
    const int tok = tb * 32 + r32, b = tok / SEQ, s = tok % SEQ;
    const bf16* hrow = wsp<bf16>(ka, WS_HB) + (size_t)tok * DINP;
    if (part < 2) {
        bf16x8 xf[16]; float ssq = 0.f;
#pragma unroll
        for (int ks = 0; ks < 16; ++ks) { xf[ks] = *(const bf16x8*)(hrow + 1536 + ks * 16 + 8 * hi);
#pragma unroll
            for (int e = 0; e < 8; ++e) { const float v = bf1(xf[ks][e]); ssq += v * v; } }
        ssq += shx_f(ssq, 32, lane);
        const float rstd = rsqrtf(ssq * (1.f / 256.f) + RMS_EPS) * QSCALE;
        const bf16* W = wsp<bf16>(ka, WS_WUQT) + (size_t)l * 768 * 256;
        for (int j = part * 12; j < part * 12 + 12; ++j) {
            const int head = j / 3, sub = j % 3;
            const bf16* wrow = W + (size_t)(j * 32 + r32) * 256 + 8 * hi;
            f32x16 acc = {};
#pragma unroll
            for (int ks = 0; ks < 16; ++ks) acc = __builtin_amdgcn_mfma_f32_32x32x16_bf16(*(const bf16x8*)(wrow + ks * 16), xf[ks], acc, 0, 0, 0);
            float v[16];
#pragma unroll
            for (int r = 0; r < 16; ++r) v[r] = acc[r] * rstd;
            if (sub == 2) {
#pragma unroll
                for (int r = 0; r < 8; ++r) { const f32x2 cs = wsp<f32x2>(ka, WS_ROPE)[s * 16 + crow(r, hi)]; const float x1 = v[r], x2 = v[r + 8]; v[r] = x1 * cs.x - x2 * cs.y; v[r + 8] = x2 * cs.x + x1 * cs.y; }
            }
            bf16* dst = wsp<bf16>(ka, WS_QM) + ((size_t)(b * 8 + head) * SEQ + s) * 96 + sub * 32 + 4 * hi;
#pragma unroll
            for (int g = 0; g < 4; ++g) { v2u w; w.x = pk2(v[4 * g], v[4 * g + 1]); w.y = pk2(v[4 * g + 2], v[4 * g + 3]); *(v2u*)(dst + 8 * g) = w; }
        }
    } else {
        const int h0 = (part - 2) * 4;
        bf16x8 xf[8]; float ssq = 0.f;
#pragma unroll
        for (int ks = 0; ks < 8; ++ks) { xf[ks] = *(const bf16x8*)(hrow + 1792 + ks * 16 + 8 * hi);
#pragma unroll
            for (int e = 0; e < 8; ++e) { const float v = bf1(xf[ks][e]); ssq += v * v; } }
        ssq += shx_f(ssq, 32, lane);
        const float rstd = rsqrtf(ssq * (1.f / 128.f) + RMS_EPS);
        const bf16* W = wsp<bf16>(ka, WS_WUKVT) + (size_t)l * 1024 * 128;
        const int sp = kperm(s);
        for (int j = h0 * 4; j < h0 * 4 + 16; ++j) {
            const int head = j >> 2, sub = j & 3;
            const bf16* wrow = W + (size_t)(j * 32 + r32) * 128 + 8 * hi;
            f32x16 acc = {};
#pragma unroll
            for (int ks = 0; ks < 8; ++ks) acc = __builtin_amdgcn_mfma_f32_32x32x16_bf16(*(const bf16x8*)(wrow + ks * 16), xf[ks], acc, 0, 0, 0);
            if (sub < 2) {
                bf16* dst = wsp<bf16>(ka, WS_KM) + (size_t)(b * 8 + head) * SEQ * 96 + (size_t)(s >> 5) * (6 * 512) + (size_t)r32 * 8 + 4 * hi;
#pragma unroll
                for (int g = 0; g < 4; ++g) { v2u w; w.x = pk2(acc[4 * g] * rstd, acc[4 * g + 1] * rstd); w.y = pk2(acc[4 * g + 2] * rstd, acc[4 * g + 3] * rstd); *(v2u*)(dst + (2 * sub + (g >> 1)) * 512 + (g & 1) * 256) = w; }
            } else {
                bf16* dst = wsp<bf16>(ka, WS_VMT) + (size_t)(b * 8 + head) * 64 * SEQ + (size_t)(s >> 5) * (4 * 512) + ((sub - 2) * 2 + ((s >> 4) & 1)) * 512 + ((sp >> 3) & 1) * 256 + (sp & 7);
#pragma unroll
                for (int r = 0; r < 16; ++r) dst[crow(r, hi) * 8] = (bf16)f2bf(acc[r] * rstd);
            }
        }
        { const bf16x8 a1 = *(const bf16x8*)(hrow + 1920 + 8 * hi), a2 = *(const bf16x8*)(hrow + 1936 + 8 * hi);
          float o1[8], o2[8];
#pragma unroll
          for (int e = 0; e < 8; ++e) { const f32x2 cs = wsp<f32x2>(ka, WS_ROPE)[s * 16 + 8 * hi + e]; const float x1 = bf1(a1[e]), x2 = bf1(a2[e]); o1[e] = x1 * cs.x - x2 * cs.y; o2[e] = x2 * cs.x + x1 * cs.y; }
          const bf16x8 p1 = pack8(o1[0], o1[1], o1[2], o1[3], o1[4], o1[5], o1[6], o1[7]), p2 = pack8(o2[0], o2[1], o2[2], o2[3], o2[4], o2[5], o2[6], o2[7]);
#pragma unroll
          for (int hh = 0; hh < 4; ++hh) { bf16* dst = wsp<bf16>(ka, WS_KM) + (size_t)(b * 8 + h0 + hh) * SEQ * 96 + (size_t)(s >> 5) * (6 * 512) + 4 * 512 + hi * 256 + (size_t)r32 * 8; *(bf16x8*)dst = p1; *(bf16x8*)(dst + 512) = p2; } }
#pragma unroll
        for (int hh = 0; hh < 4; ++hh) {
            const int head = h0 + hh;
#pragma unroll
            for (int c4 = 0; c4 < 4; ++c4) { const bf16x8 a = *(const bf16x8*)(hrow + 1024 + head * 64 + 32 * hi + c4 * 8);
                bf16* dst = wsp<bf16>(ka, WS_VST) + ((size_t)(b * 8 + head) * 64 + 32 * hi + c4 * 8) * SEQ + sp;
#pragma unroll
                for (int e = 0; e < 8; ++e) dst[(size_t)e * SEQ] = (bf16)a[e]; }
        }
    }
}

__device__ __forceinline__ float xhalf_max(float v) { auto rr = __builtin_amdgcn_permlane32_swap(__float_as_uint(v), __float_as_uint(v), false, false); return fmaxf(__uint_as_float(rr[0]), __uint_as_float(rr[1])); }
__device__ __forceinline__ float xhalf_sum(float v) { auto rr = __builtin_amdgcn_permlane32_swap(__float_as_uint(v), __float_as_uint(v), false, false); return __uint_as_float(rr[0]) + __uint_as_float(rr[1]); }
constexpr float MLA_THR = 8.f;
__device__ __forceinline__ void mla_unit(Frame& F, kap_t ka, int bh, int qb) {
    const int lane = F.lane, r32 = lane & 31, hi = lane >> 5, q0 = qb * 32;
    const bf16* Qp = wsp<bf16>(ka, WS_QM) + ((size_t)bh * SEQ + q0 + r32) * 96 + 8 * hi;
    bf16x8 qf[6];
#pragma unroll
    for (int ks = 0; ks < 6; ++ks) qf[ks] = *(const bf16x8*)(Qp + ks * 16);
    f32x16 o0 = {}, o1 = {};
    float m = -1e30f, l = 0.f;
    const bf16* Kp = wsp<bf16>(ka, WS_KM) + (size_t)bh * SEQ * 96 + 8 * lane;
    const bf16* Vp = wsp<bf16>(ka, WS_VMT) + (size_t)bh * 64 * SEQ + 8 * lane;
#define MLA_LOADK(KF, kt) do { _Pragma("unroll") for (int ks = 0; ks < 6; ++ks) KF[ks] = *(const bf16x8*)(Kp + (size_t)((kt) * 6 + ks) * 512); } while (0)
#define MLA_LOADV(VF, kt) do { _Pragma("unroll") for (int i = 0; i < 4; ++i) VF[i] = *(const bf16x8*)(Vp + (size_t)((kt) * 4 + i) * 512); } while (0)
#define MLA_QK(S, KF) do { S = (f32x16){}; _Pragma("unroll") for (int ks = 0; ks < 6; ++ks) S = __builtin_amdgcn_mfma_f32_32x32x16_bf16(KF[ks], qf[ks], S, 0, 0, 0); } while (0)
#define MLA_SMPV(S, VF, kt) do { \
        if ((kt) == qb) { _Pragma("unroll") for (int r = 0; r < 16; ++r) if (crow(r, hi) > r32) S[r] = -1e30f; } \
        float mx = fmaxf(fmaxf(S[0], S[1]), fmaxf(S[2], S[3])); \
        _Pragma("unroll") for (int r = 4; r < 16; r += 4) mx = fmaxf(mx, fmaxf(fmaxf(S[r], S[r + 1]), fmaxf(S[r + 2], S[r + 3]))); \
        mx = xhalf_max(mx); \
        if (__any(mx - m > MLA_THR)) { const float mn = fmaxf(m, mx), alpha = __builtin_amdgcn_exp2f(m - mn); l *= alpha; m = mn; \
            _Pragma("unroll") for (int r = 0; r < 16; ++r) { o0[r] *= alpha; o1[r] *= alpha; } } \
        float p[16], rs0 = 0.f, rs1 = 0.f; \
        _Pragma("unroll") for (int r = 0; r < 16; r += 2) { p[r] = __builtin_amdgcn_exp2f(S[r] - m); p[r + 1] = __builtin_amdgcn_exp2f(S[r + 1] - m); rs0 += p[r]; rs1 += p[r + 1]; } \
        l += rs0 + rs1; \
        const bf16x8 pf0 = pack8(p[0], p[1], p[2], p[3], p[4], p[5], p[6], p[7]), pf1 = pack8(p[8], p[9], p[10], p[11], p[12], p[13], p[14], p[15]); \
        o0 = __builtin_amdgcn_mfma_f32_32x32x16_bf16(VF[0], pf0, o0, 0, 0, 0); \
        o1 = __builtin_amdgcn_mfma_f32_32x32x16_bf16(VF[2], pf0, o1, 0, 0, 0); \
        o0 = __builtin_amdgcn_mfma_f32_32x32x16_bf16(VF[1], pf1, o0, 0, 0, 0); \
        o1 = __builtin_amdgcn_mfma_f32_32x32x16_bf16(VF[3], pf1, o1, 0, 0, 0); } while (0)
    bf16x8 kA[6], kB[6], vA[4];
    f32x16 sA, sB;
    MLA_LOADK(kA, 0); MLA_LOADK(kB, 1);
    MLA_QK(sA, kA);
    for (int kt = 0; kt <= qb; kt += 2) {
        MLA_LOADK(kA, kt + 2); MLA_LOADV(vA, kt);
        MLA_QK(sB, kB);
        MLA_SMPV(sA, vA, kt);
        if (kt + 1 > qb) break;
        MLA_LOADK(kB, kt + 3); MLA_LOADV(vA, kt + 1);
        MLA_QK(sA, kA);
        MLA_SMPV(sB, vA, kt + 1);
    }
#undef MLA_LOADK
#undef MLA_LOADV
#undef MLA_QK
#undef MLA_SMPV
    l = xhalf_sum(l);
    const float rl = 1.f / l;
    const int b = bh >> 3, h = bh & 7;
    bf16* dst = wsp<bf16>(ka, WS_OB) + ((size_t)b * SEQ + q0 + r32) * DM + 512 + h * 64 + 4 * hi;
#pragma unroll
    for (int g = 0; g < 4; ++g) {
        v2u w; w.x = pk2(o0[4 * g] * rl, o0[4 * g + 1] * rl); w.y = pk2(o0[4 * g + 2] * rl, o0[4 * g + 3] * rl); *(v2u*)(dst + 8 * g) = w;
        v2u u; u.x = pk2(o1[4 * g] * rl, o1[4 * g + 1] * rl); u.y = pk2(o1[4 * g + 2] * rl, o1[4 * g + 3] * rl); *(v2u*)(dst + 32 + 8 * g) = u;
    }
}

__device__ __forceinline__ void mla_block(Frame& F, kap_t ka, int bh, int J) {
    const int tid = F.tid, lane = F.lane, r32 = lane & 31, hi = lane >> 5, wave = F.wave;
    const int qb = 8 * J + wave, q0 = qb * 32, T = 8 * J + 8;
    const bf16* Qp = wsp<bf16>(ka, WS_QM) + ((size_t)bh * SEQ + q0 + r32) * 96 + 8 * hi;
    bf16x8 qf[6];
#pragma unroll
    for (int ks = 0; ks < 6; ++ks) qf[ks] = *(const bf16x8*)(Qp + ks * 16);
    f32x16 o0 = {}, o1 = {};
    float m = -1e30f, l = 0.f;
    const unsigned char* Kt = (const unsigned char*)(wsp<bf16>(ka, WS_KM) + (size_t)bh * SEQ * 96);
    const unsigned char* Vt = (const unsigned char*)(wsp<bf16>(ka, WS_VMT) + (size_t)bh * 64 * SEQ);
    LAS unsigned char* ring = F.lds + RING_OFF;
    const bool c0k = tid < 384;
    const size_t off0 = c0k ? (size_t)tid * 16 : (size_t)(tid - 384) * 16, off1 = (size_t)(128 + tid) * 16;
#define MB_GLOAD(t) do { r0 = *(const v4u*)((c0k ? Kt + (size_t)(t) * 6144 : Vt + (size_t)(t) * 4096) + off0); if (tid < 128) r1 = *(const v4u*)(Vt + (size_t)(t) * 4096 + off1); } while (0)
#define MB_LWRITE(s) do { *(LAS v4u*)(ring + (s) * 10240 + tid * 16) = r0; if (tid < 128) *(LAS v4u*)(ring + (s) * 10240 + 8192 + tid * 16) = r1; } while (0)
    v4u r0 = {}, r1 = {};
    MB_GLOAD(0); MB_LWRITE(0);
    if (T > 1) MB_GLOAD(1);
    for (int t = 0; t < T; ++t) {
        __syncthreads();
        const bool active = t <= qb;
        bf16x8 kf[6], vf[4];
        if (active) { const LAS unsigned char* sl = ring + (t & 1) * 10240 + lane * 16;
#pragma unroll
            for (int ks = 0; ks < 6; ++ks) kf[ks] = *(const LAS bf16x8*)(sl + ks * 1024);
#pragma unroll
            for (int i = 0; i < 4; ++i) vf[i] = *(const LAS bf16x8*)(sl + 6144 + i * 1024); }
        if (t + 1 < T) MB_LWRITE((t + 1) & 1);
        if (t + 2 < T) MB_GLOAD(t + 2);
        if (active) {
            f32x16 sa = {};
#pragma unroll
            for (int ks = 0; ks < 6; ++ks) sa = __builtin_amdgcn_mfma_f32_32x32x16_bf16(kf[ks], qf[ks], sa, 0, 0, 0);
            if (t == qb) {
#pragma unroll
                for (int r = 0; r < 16; ++r) if (crow(r, hi) > r32) sa[r] = -1e30f;
            }
            float mx = fmaxf(fmaxf(sa[0], sa[1]), fmaxf(sa[2], sa[3]));
#pragma unroll
            for (int r = 4; r < 16; r += 4) mx = fmaxf(mx, fmaxf(fmaxf(sa[r], sa[r + 1]), fmaxf(sa[r + 2], sa[r + 3])));
            mx = xhalf_max(mx);
            if (__any(mx - m > MLA_THR)) { const float mn = fmaxf(m, mx), alpha = __builtin_amdgcn_exp2f(m - mn); l *= alpha; m = mn;
#pragma unroll
                for (int r = 0; r < 16; ++r) { o0[r] *= alpha; o1[r] *= alpha; } }
            float p[16], rs = 0.f;
#pragma unroll
            for (int r = 0; r < 16; ++r) { p[r] = __builtin_amdgcn_exp2f(sa[r] - m); rs += p[r]; }
            l += rs;
            const bf16x8 pf0 = pack8(p[0], p[1], p[2], p[3], p[4], p[5], p[6], p[7]), pf1 = pack8(p[8], p[9], p[10], p[11], p[12], p[13], p[14], p[15]);
            o0 = __builtin_amdgcn_mfma_f32_32x32x16_bf16(vf[0], pf0, o0, 0, 0, 0);
            o0 = __builtin_amdgcn_mfma_f32_32x32x16_bf16(vf[1], pf1, o0, 0, 0, 0);
            o1 = __builtin_amdgcn_mfma_f32_32x32x16_bf16(vf[2], pf0, o1, 0, 0, 0);
            o1 = __builtin_amdgcn_mfma_f32_32x32x16_bf16(vf[3], pf1, o1, 0, 0, 0);
        }
    }
#undef MB_GLOAD
#undef MB_LWRITE
    __syncthreads();
    l = xhalf_sum(l);
    const float rl = 1.f / l;
    const int b = bh >> 3, h = bh & 7;
    bf16* dst = wsp<bf16>(ka, WS_OB) + ((size_t)b * SEQ + q0 + r32) * DM + 512 + h * 64 + 4 * hi;
#pragma unroll
    for (int g = 0; g < 4; ++g) {
        v2u w; w.x = pk2(o0[4 * g] * rl, o0[4 * g + 1] * rl); w.y = pk2(o0[4 * g + 2] * rl, o0[4 * g + 3] * rl); *(v2u*)(dst + 8 * g) = w;
        v2u u; u.x = pk2(o1[4 * g] * rl, o1[4 * g + 1] * rl); u.y = pk2(o1[4 * g + 2] * rl, o1[4 * g + 3] * rl); *(v2u*)(dst + 32 + 8 * g) = u;
    }
}

__device__ __forceinline__ void sb_unit(Frame& F, kap_t ka, int bh, int qb) {
    const int lane = F.lane, r32 = lane & 31, hi = lane >> 5, q0 = qb * 32;
    const int b = bh >> 3, h = bh & 7;
    const bf16* Hb = wsp<bf16>(ka, WS_HB) + (size_t)b * SEQ * DINP + h * 64 + 8 * hi;
    bf16x8 qf[4];
#pragma unroll
    for (int ks = 0; ks < 4; ++ks) qf[ks] = *(const bf16x8*)(Hb + (size_t)(q0 + r32) * DINP + ks * 16);
    f32x16 o0 = {}, o1 = {};
    float R = 0.f;
    const bf16* Vp = wsp<bf16>(ka, WS_VST) + ((size_t)bh * 64 + r32) * SEQ + 8 * hi;
    for (int k0 = q0; k0 >= 0; k0 -= 32) {
        bf16x8 kf[4], vf[4];
#pragma unroll
        for (int ks = 0; ks < 4; ++ks) kf[ks] = *(const bf16x8*)(Hb + (size_t)(k0 + r32) * DINP + 512 + ks * 16);
#pragma unroll
        for (int i = 0; i < 4; ++i) vf[i] = *(const bf16x8*)(Vp + (size_t)(i >> 1) * 32 * SEQ + k0 + 16 * (i & 1));
        f32x16 za = {};
#pragma unroll
        for (int ks = 0; ks < 4; ++ks) za = __builtin_amdgcn_mfma_f32_32x32x16_bf16(kf[ks], qf[ks], za, 0, 0, 0);
        const bool diag = (k0 == q0);
        float L[16], lw[16];
#pragma unroll
        for (int r = 0; r < 16; ++r) {
            const float z = za[r] * 0.125f;
            const float sp = fmaxf(z, 0.f) + __logf(1.f + __expf(-fabsf(z)));
            const bool valid = !diag || (crow(r, hi) < r32);
            L[r] = valid ? -sp : 0.f;
            lw[r] = valid ? (z - sp) : -1e30f;
        }
        float e[16], T[4], U[4];
#pragma unroll
        for (int g = 0; g < 4; ++g) { e[4 * g + 3] = 0.f; e[4 * g + 2] = L[4 * g + 3]; e[4 * g + 1] = e[4 * g + 2] + L[4 * g + 2]; e[4 * g] = e[4 * g + 1] + L[4 * g + 1]; T[g] = e[4 * g] + L[4 * g]; }
#pragma unroll
        for (int g = 0; g < 4; ++g) U[g] = shx_f(T[g], 32, lane);
        float sT[4], sUge[4];
        sT[3] = 0.f; sT[2] = T[3]; sT[1] = T[3] + T[2]; sT[0] = sT[1] + T[1];
        sUge[3] = U[3]; sUge[2] = U[3] + U[2]; sUge[1] = sUge[2] + U[1]; sUge[0] = sUge[1] + U[0];
        float w[16];
#pragma unroll
        for (int g = 0; g < 4; ++g) {
            const float sfx = R + sT[g] + (hi ? (sUge[g] - U[g]) : sUge[g]);
#pragma unroll
            for (int i = 0; i < 4; ++i) w[4 * g + i] = __expf(lw[4 * g + i] + sfx + e[4 * g + i]);
        }
        R += (sT[0] + T[0]) + sUge[0];
        const bf16x8 pf0 = pack8(w[0], w[1], w[2], w[3], w[4], w[5], w[6], w[7]), pf1 = pack8(w[8], w[9], w[10], w[11], w[12], w[13], w[14], w[15]);
        o0 = __builtin_amdgcn_mfma_f32_32x32x16_bf16(vf[0], pf0, o0, 0, 0, 0);
        o0 = __builtin_amdgcn_mfma_f32_32x32x16_bf16(vf[1], pf1, o0, 0, 0, 0);
        o1 = __builtin_amdgcn_mfma_f32_32x32x16_bf16(vf[2], pf0, o1, 0, 0, 0);
        o1 = __builtin_amdgcn_mfma_f32_32x32x16_bf16(vf[3], pf1, o1, 0, 0, 0);
        if (__all(R < -88.f)) break;
    }
    bf16* dst = wsp<bf16>(ka, WS_OB) + ((size_t)b * SEQ + q0 + r32) * DM + h * 64 + 4 * hi;
#pragma unroll
    for (int g = 0; g < 4; ++g) {
        v2u wv; wv.x = pk2(o0[4 * g], o0[4 * g + 1]); wv.y = pk2(o0[4 * g + 2], o0[4 * g + 3]); *(v2u*)(dst + 8 * g) = wv;
        v2u u; u.x = pk2(o1[4 * g], o1[4 * g + 1]); u.y = pk2(o1[4 * g + 2], o1[4 * g + 3]); *(v2u*)(dst + 32 + 8 * g) = u;
    }
}

template <bool QUANT> __device__ __forceinline__ void ln_row(Frame& F, kap_t ka, int row, const float* g, const float* bb) {
    float* yr = ka->out + (size_t)row * DM;
    f32x4 v[4]; float s = 0.f;
#pragma unroll
    for (int j = 0; j < 4; ++j) { v[j] = *(const f32x4*)(yr + 4 * F.lane + 256 * j); s += (v[j].x + v[j].y) + (v[j].z + v[j].w); }
    const float mean = wave_sum_all(s, F.lane) * (1.f / DM); float s2 = 0.f;
#pragma unroll
    for (int j = 0; j < 4; ++j) { v[j] = v[j] - mean; s2 += (v[j].x * v[j].x + v[j].y * v[j].y) + (v[j].z * v[j].z + v[j].w * v[j].w); }
    const float rstd = rsqrtf(wave_sum_all(s2, F.lane) * (1.f / DM) + LN_EPS);
#pragma unroll
    for (int j = 0; j < 4; ++j) { const int c = 4 * F.lane + 256 * j; const f32x4 gg = *(const f32x4*)(g + c), bv = *(const f32x4*)(bb + c);
        const f32x4 o = v[j] * rstd * gg + bv; *(f32x4*)(yr + c) = o; v[j] = o;
        v2u w; w.x = pk2(o.x, o.y); w.y = pk2(o.z, o.w); *(v2u*)(wsp<bf16>(ka, WS_XB) + (size_t)row * DM + c) = w; }
    if (QUANT) {
        float xm = 0.f;
#pragma unroll
        for (int j = 0; j < 4; ++j) xm = fmaxf(xm, fmaxf(fmaxf(fabsf(v[j].x), fabsf(v[j].y)), fmaxf(fabsf(v[j].z), fabsf(v[j].w))));
        xm = wave_max_all(xm, F.lane);
        const float inv = xm > 0.f ? 127.f / xm : 0.f;
        unsigned char* xq = wsp<unsigned char>(ka, WS_XQ) + (size_t)row * DM;
#pragma unroll
        for (int j = 0; j < 4; ++j) *(unsigned*)(xq + 4 * F.lane + 256 * j) = ((unsigned)(int)rintf(v[j].x * inv) & 0xffu) | (((unsigned)(int)rintf(v[j].y * inv) & 0xffu) << 8) | (((unsigned)(int)rintf(v[j].z * inv) & 0xffu) << 16) | (((unsigned)(int)rintf(v[j].w * inv) & 0xffu) << 24);
        if (F.lane == 0) wsp<float>(ka, WS_SX)[row] = xm * (1.f / 127.f);
    }
}

template <int N, int K, int J, bool FLIP> __device__ __forceinline__ void bitonic_stage(unsigned (&v)[N]) {
#pragma unroll
    for (int i = 0; i < N; ++i) { const int p = i ^ J; if (p > i) { const bool desc = (((i & K) == 0) != FLIP); const unsigned a = v[i], c = v[p]; const unsigned mx = a > c ? a : c, mn = a > c ? c : a; v[i] = desc ? mx : mn; v[p] = desc ? mn : mx; } }
}
template <bool FLIP> __device__ __forceinline__ void bitonic_merge16(unsigned (&v)[16]) {
    bitonic_stage<16, 16, 8, FLIP>(v); bitonic_stage<16, 16, 4, FLIP>(v); bitonic_stage<16, 16, 2, FLIP>(v); bitonic_stage<16, 16, 1, FLIP>(v);
}
__device__ __forceinline__ unsigned ord_key(float f, unsigned idx) { const unsigned u = __float_as_uint(f); const unsigned o = u ^ ((unsigned)((int)u >> 31) | 0x80000000u); return (o & 0xFFFFFF80u) | idx; }
__device__ __forceinline__ float key_val(unsigned k) { const unsigned o = (k & 0xFFFFFF80u) | 0x40u; const unsigned u = (o & 0x80000000u) ? (o ^ 0x80000000u) : ~o; return __uint_as_float(u); }
template <int N, int K, int J, bool FLIP> __device__ __forceinline__ void bitonic_stage_kv(unsigned (&k)[N], unsigned (&p)[N]) {
#pragma unroll
    for (int i = 0; i < N; ++i) { const int q = i ^ J; if (q > i) { const bool desc = (((i & K) == 0) != FLIP); const bool sw = desc ? (k[i] < k[q]) : (k[i] > k[q]);
        const unsigned ki = sw ? k[q] : k[i], kq = sw ? k[i] : k[q], pi = sw ? p[q] : p[i], pq = sw ? p[i] : p[q]; k[i] = ki; k[q] = kq; p[i] = pi; p[q] = pq; } }
}
template <bool FLIP> __device__ __forceinline__ void bitonic_merge16_kv(unsigned (&k)[16], unsigned (&p)[16]) {
    bitonic_stage_kv<16, 16, 8, FLIP>(k, p); bitonic_stage_kv<16, 16, 4, FLIP>(k, p); bitonic_stage_kv<16, 16, 2, FLIP>(k, p); bitonic_stage_kv<16, 16, 1, FLIP>(k, p);
}
__device__ __forceinline__ void p7_half(Frame& F, kap_t ka, int l, int tok, int h, int c, unsigned (&Cc)[16]) {
    const int lane = F.lane, hi = lane >> 5;
    const bf16* qrow = wsp<bf16>(ka, WS_HB) + (size_t)tok * 2048 + h * 256 + c * 128 + 8 * hi;
    bf16x8 qf[8];
#pragma unroll
    for (int ks = 0; ks < 8; ++ks) qf[ks] = *(const bf16x8*)(qrow + ks * 16);
    const bf16* kb = wsp<bf16>(ka, WS_KEYS) + (size_t)((l * 8 + h) * 2 + c) * 16384 + 8 * lane;
    unsigned key[64];
#pragma unroll
    for (int ch = 0; ch < 4; ++ch) {
        f32x16 acc = {};
#pragma unroll
        for (int ks = 0; ks < 8; ++ks) acc = __builtin_amdgcn_mfma_f32_32x32x16_bf16(*(const bf16x8*)(kb + (ch * 8 + ks) * 512), qf[ks], acc, 0, 0, 0);
#pragma unroll
        for (int r = 0; r < 16; ++r) key[ch * 16 + r] = ord_key(acc[r], (unsigned)(ch * 32 + crow(r, hi)));
    }
    bitonic_stage<64, 2, 1, false>(key);
    bitonic_stage<64, 4, 2, false>(key); bitonic_stage<64, 4, 1, false>(key);
    bitonic_stage<64, 8, 4, false>(key); bitonic_stage<64, 8, 2, false>(key); bitonic_stage<64, 8, 1, false>(key);
    bitonic_stage<64, 16, 8, false>(key); bitonic_stage<64, 16, 4, false>(key); bitonic_stage<64, 16, 2, false>(key); bitonic_stage<64, 16, 1, false>(key);
    unsigned A[16], B[16];
#pragma unroll
    for (int i = 0; i < 16; ++i) { A[i] = key[i] > key[16 + i] ? key[i] : key[16 + i]; B[i] = key[32 + i] > key[48 + i] ? key[32 + i] : key[48 + i]; }
    bitonic_merge16<false>(A);
    bitonic_merge16<true>(B);
#pragma unroll
    for (int i = 0; i < 16; ++i) A[i] = A[i] > B[i] ? A[i] : B[i];
    bitonic_merge16<false>(A);
#pragma unroll
    for (int i = 0; i < 16; ++i) B[i] = (unsigned)shx_i((int)A[i], 32, lane);
#pragma unroll
    for (int i = 0; i < 16; ++i) Cc[i] = A[i] > B[15 - i] ? A[i] : B[15 - i];
    bitonic_merge16<false>(Cc);
}
__device__ __forceinline__ void p7_unit(Frame& F, kap_t ka, int l, int tb, int h) {
    const int lane = F.lane, r32 = lane & 31, hi = lane >> 5;
    const int tok = tb * 32 + r32;
    unsigned L0[16], L1[16];
#pragma unroll
    for (int i = 0; i < 16; ++i) { L0[i] = 0u; L1[i] = 0u; }
#pragma unroll 1
    for (int c = 0; c < 2; ++c) {
        unsigned Cc[16];
        p7_half(F, ka, l, tok, h, c, Cc);
#pragma unroll
        for (int i = 0; i < 16; ++i) { L0[i] = c == 0 ? Cc[i] : L0[i]; L1[i] = c == 0 ? L1[i] : Cc[i]; }
    }
    __builtin_amdgcn_sched_barrier(0);
    unsigned key[64];
    {
        float v0[16], v1[16];
#pragma unroll
        for (int i = 0; i < 16; ++i) { v0[i] = key_val(L0[i]); v1[i] = key_val(L1[i]); }
#define P7_ROW(a, off, nb) { _Pragma("unroll") for (int b2 = 0; b2 < (nb); ++b2) { \
            const float sum = v0[a] + v1[b2]; const unsigned u = __float_as_uint(sum); const unsigned o = u ^ ((unsigned)((int)u >> 31) | 0x80000000u); \
            key[(off) + b2] = (o & 0xFFFFFF00u) | (unsigned)(255 - (16 * (a) + b2)); } }
        P7_ROW(0, 0, 16) P7_ROW(1, 16, 8) P7_ROW(2, 24, 5) P7_ROW(3, 29, 4) P7_ROW(4, 33, 3) P7_ROW(5, 36, 2) P7_ROW(6, 38, 2) P7_ROW(7, 40, 2)
        P7_ROW(8, 42, 1) P7_ROW(9, 43, 1) P7_ROW(10, 44, 1) P7_ROW(11, 45, 1) P7_ROW(12, 46, 1) P7_ROW(13, 47, 1) P7_ROW(14, 48, 1) P7_ROW(15, 49, 1)
#undef P7_ROW
#pragma unroll
        for (int i = 50; i < 64; ++i) key[i] = 0u;
    }
    LAS unsigned char* slot = F.lds + RING_OFF + F.wave * 2304 + lane * 36;
#pragma unroll
    for (int q = 0; q < 4; ++q) {
        ((LAS unsigned*)slot)[q] = (L0[4 * q] & 127u) | ((L0[4 * q + 1] & 127u) << 8) | ((L0[4 * q + 2] & 127u) << 16) | ((L0[4 * q + 3] & 127u) << 24);
        ((LAS unsigned*)slot)[4 + q] = (L1[4 * q] & 127u) | ((L1[4 * q + 1] & 127u) << 8) | ((L1[4 * q + 2] & 127u) << 16) | ((L1[4 * q + 3] & 127u) << 24);
    }
    bitonic_stage<64, 2, 1, false>(key);
    bitonic_stage<64, 4, 2, false>(key); bitonic_stage<64, 4, 1, false>(key);
    bitonic_stage<64, 8, 4, false>(key); bitonic_stage<64, 8, 2, false>(key); bitonic_stage<64, 8, 1, false>(key);
    bitonic_stage<64, 16, 8, false>(key); bitonic_stage<64, 16, 4, false>(key); bitonic_stage<64, 16, 2, false>(key); bitonic_stage<64, 16, 1, false>(key);
    unsigned A[16], B[16];
#pragma unroll
    for (int i = 0; i < 16; ++i) { A[i] = key[i] > key[16 + i] ? key[i] : key[16 + i]; B[i] = key[32 + i] > key[48 + i] ? key[32 + i] : key[48 + i]; }
    bitonic_merge16<false>(A);
    bitonic_merge16<true>(B);
#pragma unroll
    for (int i = 0; i < 16; ++i) A[i] = A[i] > B[i] ? A[i] : B[i];
    bitonic_merge16<false>(A);
    LDS_WAIT(); asm volatile("" ::: "memory");
    unsigned PA[16]; float g[16], den = 0.f;
    { const unsigned o0 = (A[0] & 0xFFFFFF00u) | 128u; const float m = __uint_as_float((o0 & 0x80000000u) ? (o0 ^ 0x80000000u) : ~o0);
#pragma unroll
      for (int i = 0; i < 16; ++i) { const unsigned o = (A[i] & 0xFFFFFF00u) | 128u; const float sv = __uint_as_float((o & 0x80000000u) ? (o ^ 0x80000000u) : ~o); g[i] = __expf(sv - m); den += g[i];
          const unsigned flat = 255u - (A[i] & 255u); PA[i] = (unsigned)slot[flat >> 4] * 128u + (unsigned)slot[16 + (flat & 15u)]; } }
    LDS_WAIT(); asm volatile("" ::: "memory");
    const float rden = 1.f / den;
    if (hi == 0) {
        unsigned* de = wsp<unsigned>(ka, WS_EL) + (size_t)tok * 128 + h * 16; float* dg = wsp<float>(ka, WS_GL) + (size_t)tok * 128 + h * 16;
#pragma unroll
        for (int q = 0; q < 4; ++q) { *(v4u*)(de + 4 * q) = (v4u){PA[4 * q], PA[4 * q + 1], PA[4 * q + 2], PA[4 * q + 3]};
            *(f32x4*)(dg + 4 * q) = (f32x4){g[4 * q] * rden, g[4 * q + 1] * rden, g[4 * q + 2] * rden, g[4 * q + 3] * rden}; }
    }
}

__device__ __forceinline__ float dot2_bf16(unsigned w, unsigned x, float acc) { return __builtin_amdgcn_fdot2_f32_bf16(__builtin_bit_cast(bf2_t, w), __builtin_bit_cast(bf2_t, x), acc, false); }
__device__ __forceinline__ float gelu_erf(float v) {
    const float av = fabsf(v), t = __builtin_amdgcn_rcpf(av * 0.2316418882f + 1.0f);
    float q = t * 0.5307027145f + (-0.7265760135f); q = q * t + 0.7107068705f; q = q * t + (-0.142248368f); q = q * t + 0.127414796f; q = q * t;
    const float e = __builtin_amdgcn_exp2f((v * v) * (-0.72134752044f));
    const float m = v * (q * e);
    return v < 0.f ? m : v - m;
}
__device__ __forceinline__ void p8a_token(Frame& F, kap_t ka, int l, int tok, unsigned part, const unsigned ev0, const unsigned ev1, const float gv0, const float gv1, const v4u (&x4)[4], const float sx, LAS unsigned* qu, LAS int* res) {
    const int lane = F.lane, qd = lane >> 4, i16 = lane & 15;
    const bool in0 = (ev0 >> 11) == part, in1 = (ev1 >> 11) == part;
    const f32x2* SUV = wsp<f32x2>(ka, WS_SUV) + (size_t)l * NEXP;
    f32x2 sc0 = {0.f, 0.f}, sc1 = {0.f, 0.f};
    if (in0) sc0 = SUV[ev0];
    if (in1) sc1 = SUV[ev1];
    const unsigned long long m0 = __ballot(in0), m1 = __ballot(in1);
    const int n0 = __builtin_popcountll(m0), N = n0 + __builtin_popcountll(m1);
    if (in0) qu[__builtin_amdgcn_mbcnt_hi((unsigned)(m0 >> 32), __builtin_amdgcn_mbcnt_lo((unsigned)m0, 0u))] = ev0 | ((unsigned)lane << 16);
    if (in1) qu[n0 + __builtin_amdgcn_mbcnt_hi((unsigned)(m1 >> 32), __builtin_amdgcn_mbcnt_lo((unsigned)m1, 0u))] = ev1 | ((unsigned)(64 + lane) << 16);
    if (lane < 4) qu[N + lane] = (part << 11) | (128u << 16);
    LDS_WAIT(); asm volatile("" ::: "memory");
    const unsigned char* UQ = wsp<unsigned char>(ka, WS_UT) + (size_t)l * NEXP * DM;
    const unsigned loff = 16u * (unsigned)i16;
    for (int g0 = 0; g0 < N; g0 += 24) {
        v4u buf[6][4]; unsigned ent[6];
#pragma unroll
        for (int gi = 0; gi < 6; ++gi) if (g0 + 4 * gi < N) { ent[gi] = qu[g0 + 4 * gi + qd]; const unsigned ro = ((ent[gi] & 0xffffu) << 10) + loff;
#pragma unroll
            for (int c = 0; c < 4; ++c) buf[gi][c] = *(const v4u*)(UQ + (ro + 256u * c)); }
#pragma unroll
        for (int gi = 0; gi < 6; ++gi) if (g0 + 4 * gi < N) { int p = 0;
#pragma unroll
            for (int c = 0; c < 4; ++c) { p = __builtin_amdgcn_sdot4((int)buf[gi][c].x, (int)x4[c].x, p, false); p = __builtin_amdgcn_sdot4((int)buf[gi][c].y, (int)x4[c].y, p, false);
                p = __builtin_amdgcn_sdot4((int)buf[gi][c].z, (int)x4[c].z, p, false); p = __builtin_amdgcn_sdot4((int)buf[gi][c].w, (int)x4[c].w, p, false); }
            p += __builtin_amdgcn_update_dpp(0, p, 0xB1, 0xF, 0xF, true); p += __builtin_amdgcn_update_dpp(0, p, 0x4E, 0xF, 0xF, true);
            p += __builtin_amdgcn_update_dpp(0, p, 0x141, 0xF, 0xF, true); p += __builtin_amdgcn_update_dpp(0, p, 0x140, 0xF, 0xF, true);
            asm volatile("" : "+v"(p));
            if (i16 == 0) res[ent[gi] >> 16] = p; }
    }
    LDS_WAIT(); asm volatile("" ::: "memory");
    float* AC = wsp<float>(ka, WS_AC) + (size_t)tok * 128;
    if (in0) AC[lane] = gv0 * gelu_erf((float)res[lane] * (sc0.x * sx)) * sc0.y;
    if (in1) AC[64 + lane] = gv1 * gelu_erf((float)res[64 + lane] * (sc1.x * sx)) * sc1.y;
    LDS_WAIT(); asm volatile("" ::: "memory");
}
struct P8bS { float sa; v4u R[16]; };
__device__ __forceinline__ void p8b_stage0(Frame& F, kap_t ka, int l, int tok, unsigned part, const unsigned ev0, const unsigned ev1, const float av0, const float av1, LAS unsigned* le, LAS unsigned* la8, P8bS& S, int var = 0) {
    const int lane = F.lane, g = lane >> 3, c = lane & 7;
    const float am = wave_max_all(fmaxf(fabsf(av0), fabsf(av1)), lane);
    const float inv = am > 0.f ? 127.f / am : 0.f; S.sa = am * (1.f / 127.f);
    le[lane] = ev0; le[64 + lane] = ev1;
    ((LAS unsigned char*)la8)[lane] = (unsigned char)(int)rintf(av0 * inv); ((LAS unsigned char*)la8)[64 + lane] = (unsigned char)(int)rintf(av1 * inv);
    LDS_WAIT(); asm volatile("" ::: "memory");
    const unsigned char* VQ = wsp<unsigned char>(ka, WS_VT) + (size_t)l * NEXP * DM + (size_t)part * NEXP * 128;
    const unsigned loff = 16u * (unsigned)c;
#pragma unroll
    for (int i = 0; i < 16; ++i) S.R[i] = *(const v4u*)(VQ + (((var == 1 ? 0u : le[32 * (i >> 2) + 4 * g + (i & 3)]) << 7) + loff));
}
__device__ __forceinline__ void p8b_stage1(Frame& F, kap_t ka, int tok, unsigned part, LAS unsigned* la8, P8bS& S, float* ybase, int var = 0) {
    const int lane = F.lane, g = lane >> 3, c = lane & 7;
    float* yrow = ka->out + (size_t)tok * DM + 128 * part + 16 * c;
    f32x4 xv[4] = {};
    if (g == 0) {
#pragma unroll
        for (int q = 0; q < 4; ++q) xv[q] = *(const f32x4*)(yrow + 4 * q);
    }
    int acc[16];
#pragma unroll
    for (int i = 0; i < 16; ++i) acc[i] = 0;
    if (var == 2) {
#pragma unroll
        for (int i = 0; i < 16; ++i) acc[i] = (int)(S.R[i].x + S.R[i].y + S.R[i].z + S.R[i].w);
    } else
#pragma unroll
    for (int m = 0; m < 4; ++m) {
        const int ap = (int)la8[8 * m + g];
#pragma unroll
        for (int d = 0; d < 4; ++d) {
            const unsigned r0 = S.R[4 * m][d], r1 = S.R[4 * m + 1][d], r2 = S.R[4 * m + 2][d], r3 = S.R[4 * m + 3][d];
            const unsigned t01l = __builtin_amdgcn_perm(r1, r0, 0x05010400u), t01h = __builtin_amdgcn_perm(r1, r0, 0x07030602u);
            const unsigned t23l = __builtin_amdgcn_perm(r3, r2, 0x05010400u), t23h = __builtin_amdgcn_perm(r3, r2, 0x07030602u);
            acc[4 * d] = __builtin_amdgcn_sdot4((int)__builtin_amdgcn_perm(t23l, t01l, 0x05040100u), ap, acc[4 * d], false);
            acc[4 * d + 1] = __builtin_amdgcn_sdot4((int)__builtin_amdgcn_perm(t23l, t01l, 0x07060302u), ap, acc[4 * d + 1], false);
            acc[4 * d + 2] = __builtin_amdgcn_sdot4((int)__builtin_amdgcn_perm(t23h, t01h, 0x05040100u), ap, acc[4 * d + 2], false);
            acc[4 * d + 3] = __builtin_amdgcn_sdot4((int)__builtin_amdgcn_perm(t23h, t01h, 0x07060302u), ap, acc[4 * d + 3], false);
        }
    }
#pragma unroll
    for (int i = 0; i < 16; ++i) { acc[i] += shx_i(acc[i], 8, lane); acc[i] += shx_i(acc[i], 16, lane); acc[i] += shx_i(acc[i], 32, lane); }
    if (g == 0) {
        const float sa = S.sa;
#pragma unroll
        for (int q = 0; q < 4; ++q) { const f32x4 x = xv[q];
            *(f32x4*)(ybase + (size_t)tok * DM + 128 * part + 16 * c + 4 * q) = (f32x4){ALPHA * x.x + (float)acc[4 * q] * sa, ALPHA * x.y + (float)acc[4 * q + 1] * sa, ALPHA * x.z + (float)acc[4 * q + 2] * sa, ALPHA * x.w + (float)acc[4 * q + 3] * sa}; }
    }
}

__global__ void __launch_bounds__(NTHREADS, 2) mk_fwd(Args args) {
    extern __shared__ __attribute__((aligned(16))) unsigned char lds[];
    Frame F;
    F.lds = (LAS unsigned char*)lds;
    F.MISC = (volatile LAS unsigned*)(F.lds + MISC_OFF);
    F.tid = threadIdx.x; F.lane = F.tid & 63; F.wave = __builtin_amdgcn_readfirstlane(F.tid >> 6);
    F.G = gridDim.x; { const int bx = blockIdx.x; F.vcu = (F.G % 8 == 0) ? (bx % 8) * (F.G / 8) + bx / 8 : bx; }
    for (int u = F.tid; u < (LDS_BYTES - LDSCTL_OFF) / 4; u += NTHREADS) ((LAS unsigned*)(F.lds + LDSCTL_OFF))[u] = 0u;
    __syncthreads();
    const int lo = args.ph_lo, hi = args.ph_hi;
    unsigned* const barw = (unsigned*)(args.ws + WS_CTL) + CW_BAR;
    const bool one_phase = (hi - lo) == 1;
    XcdBarrier bar; bar.bar = barw; bar.x = 0; bar.st = nullptr;
    if (!one_phase) bar = xcd_barrier_post(barw, F.MISC + 8);
#ifndef MK_EN
#define MK_EN 0x7ff
#endif
#ifndef MK_MLA_LDS
#define MK_MLA_LDS 0
#endif
#ifndef MK_MLA_REP
#define MK_MLA_REP 1
#endif
#ifndef MK_SB_REP
#define MK_SB_REP 1
#endif
#ifndef MK_P8B_VAR
#define MK_P8B_VAR 0
#endif
#define EN(n) (((MK_EN) >> (n)) & 1)
#ifndef MK_REP
#define MK_REP 0
#endif
#define PHASE_REP(n) for (int rep_ = 0; rep_ < ((((MK_REP) >> (n)) & 1) + 1); ++rep_)
#define IN(k) (lo <= (k) && (k) < hi)
#define PHASE_IDS() do { int t_ = threadIdx.x; asm volatile("" : "+v"(t_)); F.tid = t_; F.lane = t_ & 63; } while (0)
#define SEAM(k) do { if (IN((k) + 1)) xcd_barrier(bar); } while (0)
    const int gw = F.vcu * NWAVES + F.wave, NGW = F.G * NWAVES;

    if (EN(0) && IN(0)) PHASE_REP(0) { PHASE_IDS(); p0_prologue(F, ka_fresh()); SEAM(0); }
    for (int l = 0; l < DEPTH; ++l) {
        const int pb = 1 + NPL * l;
        if (EN(1) && IN(pb + 0)) PHASE_REP(1) { const kap_t ka = ka_fresh(); PHASE_IDS();
            pg8::Gemm g{wsp<bf16>(ka, WS_XB), wsp<bf16>(ka, WS_WIT) + (size_t)l * DINP * DM, NTOK, DINP, DM}; pg8::StaticOrder S; S.init(NTOK, DINP, F.G, (int)blockIdx.x);
            pg8::EpiBf16<0> E{wsp<bf16>(ka, WS_HB), DINP, nullptr, 0, 0, 1.f};
            pg8::gemm_phase<pg8::EpiBf16<0>, pg8::StaticOrder, PG8_ALIGN, PG8_SP2>(F.lds + RING_OFF, g, S, E);
            SEAM(pb + 0);
        }
        if (EN(2) && IN(pb + 1)) PHASE_REP(2) { const kap_t ka = ka_fresh(); PHASE_IDS();
            for (int u = gw; u < (NTOK / 32) * 4; u += NGW) p2_unit(F, ka, l, u >> 2, u & 3);
            SEAM(pb + 1);
        }
        if (EN(3) && IN(pb + 2)) PHASE_REP(3) { const kap_t ka = ka_fresh(); PHASE_IDS();
#if MK_MLA_LDS
            for (int u = F.vcu; u < 32 * 8; u += F.G) {
                const int bh = u >> 3, j = u & 7;
                mla_block(F, ka, bh, 15 - j); sb_unit(F, ka, bh, 8 * (15 - j) + F.wave);
                mla_block(F, ka, bh, j); sb_unit(F, ka, bh, 8 * j + F.wave);
            }
#else
            for (int u = gw; u < 32 * 64; u += NGW) {
                const int bh = u >> 6, pi = u & 63;
                for (int r_ = 0; r_ < MK_MLA_REP; ++r_) mla_unit(F, ka, bh, 127 - pi);
                for (int r_ = 0; r_ < MK_SB_REP; ++r_) sb_unit(F, ka, bh, 127 - pi);
                for (int r_ = 0; r_ < MK_MLA_REP; ++r_) mla_unit(F, ka, bh, pi);
                for (int r_ = 0; r_ < MK_SB_REP; ++r_) sb_unit(F, ka, bh, pi);
            }
#endif
            SEAM(pb + 2);
        }
        if (EN(4) && IN(pb + 3)) PHASE_REP(4) { const kap_t ka = ka_fresh(); PHASE_IDS();
            pg8::Gemm g{wsp<bf16>(ka, WS_OB), wsp<bf16>(ka, WS_WOT) + (size_t)l * DM * DM, NTOK, DM, DM}; pg8::StaticOrder S; S.init(NTOK, DM, F.G, (int)blockIdx.x);
            pg8::EpiResF32 E{l == 0 ? ka->in[I_X] : ka->out, ka->out, DM, ALPHA};
            pg8::gemm_phase<pg8::EpiResF32, pg8::StaticOrder, PG8_ALIGN, PG8_SP2>(F.lds + RING_OFF, g, S, E);
            SEAM(pb + 3);
        }
        if (EN(5) && IN(pb + 4)) PHASE_REP(5) { const kap_t ka = ka_fresh(); PHASE_IDS();
            for (int r = gw; r < NTOK; r += NGW) ln_row<true>(F, ka, r, ka->in[I_LN1G] + l * DM, ka->in[I_LN1B] + l * DM);
            SEAM(pb + 4);
        }
        if (EN(6) && IN(pb + 5)) PHASE_REP(6) { const kap_t ka = ka_fresh(); PHASE_IDS();
            pg8::Gemm g{wsp<bf16>(ka, WS_XB), wsp<bf16>(ka, WS_WQT) + (size_t)l * 2048 * DM, NTOK, 2048, DM}; pg8::StaticOrder S; S.init(NTOK, 2048, F.G, (int)blockIdx.x);
            pg8::EpiBf16<0> E{wsp<bf16>(ka, WS_HB), 2048, nullptr, 0, 0, 1.f};
            pg8::gemm_phase<pg8::EpiBf16<0>, pg8::StaticOrder, PG8_ALIGN, PG8_SP2>(F.lds + RING_OFF, g, S, E);
            SEAM(pb + 5);
        }
        if (EN(7) && IN(pb + 6)) PHASE_REP(7) { const kap_t ka = ka_fresh(); PHASE_IDS();
            for (int u = gw; u < (NTOK / 32) * 8; u += NGW) p7_unit(F, ka, l, u >> 3, u & 7);
            SEAM(pb + 6);
        }
        if (EN(8) && IN(pb + 7)) PHASE_REP(8) { const kap_t ka = ka_fresh(); PHASE_IDS();
            const bool split = (F.G % 8 == 0); const int npp = split ? F.G / 8 : F.G;
            for (unsigned part = split ? (unsigned)(F.vcu / npp) : 0u, pend = split ? part + 1u : 8u; part < pend; ++part) {
                const int pw = (F.vcu % npp) * NWAVES + F.wave, npw = npp * NWAVES;
                const unsigned* EL = wsp<unsigned>(ka, WS_EL) + F.lane; const float* GL = wsp<float>(ka, WS_GL) + F.lane;
                const unsigned char* XQ = wsp<unsigned char>(ka, WS_XQ) + 16 * (F.lane & 15); const float* SX = wsp<float>(ka, WS_SX);
                unsigned e0 = 0u, e1 = 0u; float g0 = 0.f, g1 = 0.f, sx = 0.f; v4u x4[4] = {};
                if (pw < NTOK) { e0 = EL[(size_t)pw * 128]; e1 = EL[(size_t)pw * 128 + 64]; g0 = GL[(size_t)pw * 128]; g1 = GL[(size_t)pw * 128 + 64]; sx = SX[pw];
#pragma unroll
                    for (int c = 0; c < 4; ++c) x4[c] = *(const v4u*)(XQ + (size_t)pw * DM + 256 * c); }
                for (int t = pw; t < NTOK; t += npw) {
                    unsigned ne0 = 0u, ne1 = 0u; float ng0 = 0.f, ng1 = 0.f, nsx = 0.f; v4u nx4[4] = {};
                    if (t + npw < NTOK) { const size_t o = (size_t)(t + npw) * 128; ne0 = EL[o]; ne1 = EL[o + 64]; ng0 = GL[o]; ng1 = GL[o + 64]; nsx = SX[t + npw];
#pragma unroll
                        for (int c = 0; c < 4; ++c) nx4[c] = *(const v4u*)(XQ + (size_t)(t + npw) * DM + 256 * c); }
                    p8a_token(F, ka, l, t, part, e0, e1, g0, g1, x4, sx, (LAS unsigned*)(F.lds + RING_OFF + F.wave * 2048), (LAS int*)(F.lds + RING_OFF + F.wave * 2048 + 1024));
                    e0 = ne0; e1 = ne1; g0 = ng0; g1 = ng1; sx = nsx;
#pragma unroll
                    for (int c = 0; c < 4; ++c) x4[c] = nx4[c];
                }
            }
            SEAM(pb + 7);
        }
        if (EN(9) && IN(pb + 8)) PHASE_REP(9) { const kap_t ka = ka_fresh(); PHASE_IDS();
            const bool split = (F.G % 8 == 0); const int npp = split ? F.G / 8 : F.G;
            for (unsigned part = split ? (unsigned)(F.vcu / npp) : 0u, pend = split ? part + 1u : 8u; part < pend; ++part) {
                const int pw = (F.vcu % npp) * NWAVES + F.wave, npw = npp * NWAVES;
                LAS unsigned* leA = (LAS unsigned*)(F.lds + RING_OFF + F.wave * 2048); LAS unsigned* laA = (LAS unsigned*)(F.lds + RING_OFF + F.wave * 2048 + 512);
                LAS unsigned* leB = (LAS unsigned*)(F.lds + RING_OFF + F.wave * 2048 + 1024); LAS unsigned* laB = (LAS unsigned*)(F.lds + RING_OFF + F.wave * 2048 + 1536);
                const unsigned* EL = wsp<unsigned>(ka, WS_EL) + F.lane; const float* AC = wsp<float>(ka, WS_AC) + F.lane;
                const int pvar = (rep_ == 0) ? 0 : MK_P8B_VAR;
                float* ybase = (rep_ == 0) ? ka->out : (float*)wsp<bf16>(ka, WS_HB);
                unsigned eA0 = 0u, eA1 = 0u, eB0 = 0u, eB1 = 0u; float aA0 = 0.f, aA1 = 0.f, aB0 = 0.f, aB1 = 0.f;
                if (pw < NTOK) { const size_t o = (size_t)pw * 128; eA0 = EL[o]; eA1 = EL[o + 64]; aA0 = AC[o]; aA1 = AC[o + 64]; }
                if (pw + npw < NTOK) { const size_t o = (size_t)(pw + npw) * 128; eB0 = EL[o]; eB1 = EL[o + 64]; aB0 = AC[o]; aB1 = AC[o + 64]; }
                int t = pw;
                for (; t + npw < NTOK; t += 2 * npw) {
                    const int tB = t + npw;
                    unsigned nA0 = 0u, nA1 = 0u, nB0 = 0u, nB1 = 0u; float mA0 = 0.f, mA1 = 0.f, mB0 = 0.f, mB1 = 0.f;
                    if (t + 2 * npw < NTOK) { const size_t o = (size_t)(t + 2 * npw) * 128; nA0 = EL[o]; nA1 = EL[o + 64]; mA0 = AC[o]; mA1 = AC[o + 64]; }
                    if (t + 3 * npw < NTOK) { const size_t o = (size_t)(t + 3 * npw) * 128; nB0 = EL[o]; nB1 = EL[o + 64]; mB0 = AC[o]; mB1 = AC[o + 64]; }
                    P8bS SA, SB;
                    p8b_stage0(F, ka, l, t, part, eA0, eA1, aA0, aA1, leA, laA, SA, pvar);
                    p8b_stage0(F, ka, l, tB, part, eB0, eB1, aB0, aB1, leB, laB, SB, pvar);
                    p8b_stage1(F, ka, t, part, laA, SA, ybase, pvar);
                    p8b_stage1(F, ka, tB, part, laB, SB, ybase, pvar);
                    LDS_WAIT(); asm volatile("" ::: "memory");
                    eA0 = nA0; eA1 = nA1; aA0 = mA0; aA1 = mA1; eB0 = nB0; eB1 = nB1; aB0 = mB0; aB1 = mB1;
                }
                if (t < NTOK) {
                    P8bS SA;
                    p8b_stage0(F, ka, l, t, part, eA0, eA1, aA0, aA1, leA, laA, SA);
                    p8b_stage1(F, ka, t, part, laA, SA, ybase);
                    LDS_WAIT(); asm volatile("" ::: "memory");
                }
            }
            SEAM(pb + 8);
        }
        if (EN(10) && IN(pb + 9)) PHASE_REP(10) { const kap_t ka = ka_fresh(); PHASE_IDS();
            for (int r = gw; r < NTOK; r += NGW) ln_row<false>(F, ka, r, ka->in[I_LN2G] + l * DM, ka->in[I_LN2B] + l * DM);
            if (l + 1 < DEPTH) SEAM(pb + 9);
        }
    }
#undef IN
#undef SEAM
}

#ifndef MK_PER_PHASE
#define MK_PER_PHASE 0
#endif
extern "C" void kernel_launch(void* const* d_in, const int* in_sizes, int n_in, void* d_out, int out_size, void* d_ws, size_t ws_size, hipStream_t stream) {
    static int grid = 0;
    if (grid == 0) {
        if (n_in != 15 || out_size != NTOK * DM || ws_size < WS_END) { fprintf(stderr, "kernel_launch: unexpected shapes (n_in %d, out %d, ws %zu); nothing launched\n", n_in, out_size, ws_size); grid = -1; return; }
        int dev = 0, cus = 0, per_cu = 0;
        if (hipGetDevice(&dev) != hipSuccess || hipDeviceGetAttribute(&cus, hipDeviceAttributeMultiprocessorCount, dev) != hipSuccess) { fprintf(stderr, "kernel_launch: device query failed\n"); grid = -1; return; }
        if (hipFuncSetAttribute((const void*)mk_fwd, hipFuncAttributeMaxDynamicSharedMemorySize, LDS_BYTES) != hipSuccess) { fprintf(stderr, "kernel_launch: hipFuncSetAttribute failed\n"); grid = -1; return; }
        if (hipOccupancyMaxActiveBlocksPerMultiprocessor(&per_cu, (const void*)mk_fwd, NTHREADS, LDS_BYTES) != hipSuccess || per_cu < 1) { fprintf(stderr, "kernel_launch: occupancy query says %d blocks per CU\n", per_cu); per_cu = 1; }
        (void)hipGetLastError();
        grid = cus;
        fprintf(stderr, "kernel_launch: grid %d (occupancy query %d per CU)\n", grid, per_cu);
    }
    if (grid < 0) return;
    (void)hipMemsetAsync((char*)d_ws + WS_CTL, 0, CTL_ZERO_BYTES, stream);
    Args a{};
    for (int i = 0; i < 15; ++i) a.in[i] = (const float*)d_in[i];
    a.out = (float*)d_out; a.ws = (unsigned char*)d_ws;
#if MK_PER_PHASE
    for (int p = 0; p < NPHASE; ++p) { a.ph_lo = p; a.ph_hi = p + 1; hipLaunchKernelGGL(mk_fwd, dim3(grid), dim3(NTHREADS), LDS_BYTES, stream, a); }
#else
    a.ph_lo = 0; a.ph_hi = NPHASE;
    void* kargs[] = {&a};
    const hipError_t e = hipLaunchCooperativeKernel((const void*)mk_fwd, dim3(grid), dim3(NTHREADS), kargs, LDS_BYTES, stream);
    if (e != hipSuccess) fprintf(stderr, "kernel_launch: cooperative launch failed: %s (grid %d)\n", hipGetErrorString(e), grid);
#endif
}
```

```cpp
#include <hip/hip_runtime.h>
#include <cstdio>
#include <cstdint>
#include <math.h>
namespace pg8 {
#define PG8_LAS __attribute__((address_space(3)))
typedef unsigned short bf16_t;
typedef short bf16x8 __attribute__((ext_vector_type(8)));
typedef float f32x4 __attribute__((ext_vector_type(4)));
typedef unsigned u32x4 __attribute__((ext_vector_type(4)));
constexpr int BM = 256, BK = 64, HALF = 128, HTB = HALF * BK * 2  , STAGE_BYTES = 8 * HTB, NXCD = 8, WGM = 8;

__host__ __device__ __forceinline__ int lds_byte(int r, int c) { const int st = (r >> 4) * 2 + (c >> 5), rr = r & 15, cc = c & 31, ob = rr * 64 + cc * 2; return st * 1024 + (ob ^ (((ob >> 9) & 1) << 5)); }
__host__ __device__ __forceinline__ void stage_rc(int b, int& R, int& C) { const int st = b / 1024, sb = b % 1024, swz = sb ^ (((sb >> 9) & 1) << 5); R = (st >> 1) * 16 + swz / 64; C = (st & 1) * 32 + (swz % 64) / 2; }
__host__ __device__ __forceinline__ int perm32(int rho) { const int n = rho >> 4, i = rho & 15; return 8 * (i >> 2) + 4 * n + (i & 3); }

struct Unit { int pm, pn; };
struct Gemm { const bf16_t* A; const bf16_t* Bt; int M, N, K; };

struct StaticOrder {
    int nM, nN, nwg, G, c;
    __host__ __device__ void init(int M, int N, int G_, int c_) { nM = M / BM; nN = N / BM; nwg = nM * nN; G = G_; c = c_; }
    __host__ __device__ bool next(int i, Unit& u) const {
        const long L = (long)i * G + c; if (L >= nwg) return false;
        int wgid = (int)L; { const int q = nwg / NXCD, r = nwg % NXCD, xcd = wgid % NXCD, off = wgid / NXCD; wgid = (xcd < r ? xcd * (q + 1) : r * (q + 1) + (xcd - r) * q) + off; }
        const int nig = WGM * nN, gid = wgid / nig, fm = gid * WGM, gsz = (nM - fm) < WGM ? (nM - fm) : WGM;
        u.pm = fm + ((wgid % nig) % gsz); u.pn = (wgid % nig) / gsz; return true;
    }
    __device__ __forceinline__ void a_ready(const Unit&) const {}
    __device__ __forceinline__ void done(const Unit&) const {}
};

__device__ __forceinline__ unsigned cvt_pk_bf16(float lo, float hi) { unsigned r; asm volatile("v_cvt_pk_bf16_f32 %0, %1, %2" : "=v"(r) : "v"(lo), "v"(hi)); return r; }
typedef float f32x2 __attribute__((ext_vector_type(2)));
__device__ __forceinline__ f32x2 gelu_pk(f32x2 v) {
    const f32x2 av = __builtin_elementwise_abs(v), d = av * 0.2316418882f + 1.0f;
    f32x2 t; t.x = __builtin_amdgcn_rcpf(d.x); t.y = __builtin_amdgcn_rcpf(d.y);
    f32x2 q = t * 0.5307027145f + (-0.7265760135f); q = q * t + 0.7107068705f; q = q * t + (-0.142248368f); q = q * t + 0.127414796f; q = q * t;
    const f32x2 s = (v * v) * (-0.72134752044f);
    f32x2 e; e.x = __builtin_amdgcn_exp2f(s.x); e.y = __builtin_amdgcn_exp2f(s.y);
    const f32x2 m = v * (q * e), r = v - m;
    f32x2 o; o.x = v.x < 0.f ? m.x : r.x; o.y = v.y < 0.f ? m.y : r.y; return o;
}

template <int ACT  > struct EpiBf16 {
    static constexpr bool PERM = true, AFTER_DRAIN = false; static_assert(ACT == 0 || ACT == 1, "EpiBf16: ACT is 0 (none) or 1 (gelu_pk)");
    bf16_t* O; int ldc; const float* bias; int split_cols; size_t split_stride; float scale0;
    __device__ __forceinline__ void operator()(const f32x4 (&acc)[2][2][4][2], const Unit& u, int wr, int wc, int fr, int fq) const {
        const int row0 = u.pm * BM + wr * 64 + fr; int colt = u.pn * BM; bf16_t* base = O;
        float sc = 1.f; if (split_cols) { const int t = colt / split_cols; base += (size_t)t * split_stride; colt -= t * split_cols; if (t == 0) sc = scale0; }
        const int col0 = colt + wc * 32 + 8 * fq, bcol0 = u.pn * BM + wc * 32 + 8 * fq;
        f32x4 bv[2][2];
#pragma unroll
        for (int bj = 0; bj < 2; ++bj)
#pragma unroll
            for (int n = 0; n < 2; ++n) bv[bj][n] = bias ? *(const f32x4*)(bias + bcol0 + bj * HALF + 4 * n) : (f32x4){0.f, 0.f, 0.f, 0.f};
#pragma unroll
        for (int ai = 0; ai < 2; ++ai)
#pragma unroll
            for (int m = 0; m < 4; ++m) { bf16_t* rowp = base + (size_t)(row0 + ai * HALF + m * 16) * ldc + col0;
#pragma unroll
                for (int bj = 0; bj < 2; ++bj) { f32x4 v0 = acc[ai][bj][m][0] + bv[bj][0], v1 = acc[ai][bj][m][1] + bv[bj][1];
                    if (ACT == 1) { f32x2 a = gelu_pk((f32x2){v0[0], v0[1]}), b = gelu_pk((f32x2){v0[2], v0[3]}), c = gelu_pk((f32x2){v1[0], v1[1]}), d = gelu_pk((f32x2){v1[2], v1[3]});
                        v0 = (f32x4){a.x, a.y, b.x, b.y}; v1 = (f32x4){c.x, c.y, d.x, d.y}; }
                    v0 = v0 * sc; v1 = v1 * sc; u32x4 w; w.x = cvt_pk_bf16(v0[0], v0[1]); w.y = cvt_pk_bf16(v0[2], v0[3]); w.z = cvt_pk_bf16(v1[0], v1[1]); w.w = cvt_pk_bf16(v1[2], v1[3]);
                    *(u32x4*)(rowp + bj * HALF) = w; } }
    }
};
struct EpiResF32 {
    static constexpr bool PERM = false, AFTER_DRAIN = false;
    const float* res; float* out; int ldc; float alpha;
    __device__ __forceinline__ void operator()(const f32x4 (&acc)[2][2][4][2], const Unit& u, int wr, int wc, int fr, int fq) const {
        const int row0 = u.pm * BM + wr * 64 + fr, col0 = u.pn * BM + wc * 32 + 4 * fq;
#pragma unroll
        for (int ai = 0; ai < 2; ++ai)
#pragma unroll
            for (int m = 0; m < 4; ++m) { const size_t off = (size_t)(row0 + ai * HALF + m * 16) * ldc + col0;
#pragma unroll
                for (int bj = 0; bj < 2; ++bj)
#pragma unroll
                    for (int n = 0; n < 2; ++n) { const f32x4 rs = *(const f32x4*)(res + off + bj * HALF + n * 16); *(f32x4*)(out + off + bj * HALF + n * 16) = rs * alpha + acc[ai][bj][m][n]; }
                if (m & 1) asm volatile("" ::: "memory"); }
    }
};
template <class Epi, class Sched, bool ALIGN_EPI = false, bool SP2 = false>
__device__ __forceinline__ void gemm_phase(PG8_LAS unsigned char* lds, const Gemm g, const Sched& S, const Epi& E, int tid_in) {
    int tid_ = tid_in; asm volatile("" : "+v"(tid_));
    const int tid = tid_, wid = __builtin_amdgcn_readfirstlane(tid >> 6), lane = tid & 63, wr = wid >> 2, wc = wid & 3, fr = lane & 15, fq = lane >> 4;
    const int K = g.K, nt = K / BK;
    unsigned voffA[2], voffB[2];
#pragma unroll
    for (int i = 0; i < 2; ++i) { int R, C; stage_rc(tid * 16 + i * 8192, R, C); const int Rb = Epi::PERM ? ((R & ~31) + perm32(R & 31)) : R;
        voffA[i] = (unsigned)(R * K + C) * 2u; voffB[i] = (unsigned)(Rb * K + C) * 2u; }
    const size_t kstep = (size_t)(BK * 2);
    const size_t hstep = (size_t)HALF * K * 2;
    const size_t tstep = 2 * hstep;
    const unsigned ldsw = (unsigned)wid * 1024u;
    const int aoff = lds_byte(wr * 64 + fr, fq * 8), boff = lds_byte(wc * 32 + fr, fq * 8);
#define PG8_SA(b, h) (((b) * 2 + (h)) * HTB)
#define PG8_SB(b, h) ((4 + (b) * 2 + (h)) * HTB)
#define PG8_STAGE(bufoff, gbase, voff) do { _Pragma("unroll") for (int _i = 0; _i < 2; ++_i) \
        __builtin_amdgcn_global_load_lds((const unsigned*)((const char*)(gbase) + (voff)[_i]), (PG8_LAS unsigned*)(lds + (bufoff) + ldsw + _i * 8192), 16, 0, 0); } while (0)
#define PG8_LDA(dst, b, h) do { _Pragma("unroll") for (int m = 0; m < 4; ++m) _Pragma("unroll") for (int k = 0; k < 2; ++k) dst[m][k] = *(const PG8_LAS bf16x8*)(lds + PG8_SA(b, h) + aoff + m * 2048 + k * 1024); } while (0)
#define PG8_LDB(dst, b, h) do { _Pragma("unroll") for (int n = 0; n < 2; ++n) _Pragma("unroll") for (int k = 0; k < 2; ++k) dst[n][k] = *(const PG8_LAS bf16x8*)(lds + PG8_SB(b, h) + boff + n * 2048 + k * 1024); } while (0)
#define PG8_MMA(ai, bj, At, Bt) do { __builtin_amdgcn_s_setprio(1); _Pragma("unroll") for (int m = 0; m < 4; ++m) _Pragma("unroll") for (int n = 0; n < 2; ++n) _Pragma("unroll") for (int k = 0; k < 2; ++k) \
        acc[ai][bj][m][n] = __builtin_amdgcn_mfma_f32_16x16x32_bf16(Bt[n][k], At[m][k], acc[ai][bj][m][n], 0, 0, 0); __builtin_amdgcn_s_setprio(0); } while (0)
#define PG8_WAIT_V(n) asm volatile("s_waitcnt vmcnt(" #n ")" ::: "memory")
#define PG8_WAIT_L(n) asm volatile("s_waitcnt lgkmcnt(" #n ")" ::: "memory")
#define PG8_BAR __builtin_amdgcn_s_barrier()
#define PG8_SCHED __builtin_amdgcn_sched_barrier(0)
    Unit cur, nxt; int ui = 0;
    if (!S.next(0, cur)) return;
    f32x4 acc[2][2][4][2];
#pragma unroll
    for (int a = 0; a < 2; ++a)
#pragma unroll
        for (int b = 0; b < 2; ++b)
#pragma unroll
            for (int m = 0; m < 4; ++m)
#pragma unroll
                for (int n = 0; n < 2; ++n) acc[a][b][m][n] = (f32x4){0.f, 0.f, 0.f, 0.f};
    bf16x8 At[4][2], B0[2][2], B1[2][2];
    const char* cA = (const char*)g.A + (size_t)cur.pm * tstep; const char* cB = (const char*)g.Bt + (size_t)cur.pn * tstep;
    S.a_ready(cur);
    if constexpr (SP2) {
        PG8_STAGE(PG8_SB(0, 0), cB, voffB); PG8_STAGE(PG8_SB(0, 1), cB + hstep, voffB); PG8_STAGE(PG8_SA(0, 0), cA, voffA); PG8_STAGE(PG8_SA(0, 1), cA + hstep, voffA);
        if (wr == 1) PG8_BAR;
        PG8_WAIT_V(2); PG8_BAR;
        PG8_STAGE(PG8_SB(1, 0), cB + kstep, voffB); PG8_STAGE(PG8_SA(1, 0), cA + kstep, voffA); PG8_STAGE(PG8_SB(1, 1), cB + hstep + kstep, voffB);
        PG8_WAIT_V(6); PG8_BAR;
    } else {
        PG8_STAGE(PG8_SB(0, 0), cB, voffB); PG8_STAGE(PG8_SA(0, 0), cA, voffA); PG8_STAGE(PG8_SB(0, 1), cB + hstep, voffB); PG8_STAGE(PG8_SA(0, 1), cA + hstep, voffA);
        if (wr == 1) PG8_BAR;
        PG8_WAIT_V(4); PG8_BAR;
        PG8_STAGE(PG8_SB(1, 0), cB + kstep, voffB); PG8_STAGE(PG8_SA(1, 0), cA + kstep, voffA); PG8_STAGE(PG8_SB(1, 1), cB + hstep + kstep, voffB);
        PG8_WAIT_V(6); PG8_BAR;
    }
    for (;;) {
        const bool has_next = S.next(ui + 1, nxt);
        const char* nA = has_next ? (const char*)g.A + (size_t)nxt.pm * tstep : cA; const char* nB = has_next ? (const char*)g.Bt + (size_t)nxt.pn * tstep : cB;
        for (int t = 0; t < nt; t += 2) {
            const bool last = (t == nt - 2);
            const char* a1 = cA + (size_t)(t + 1) * kstep;
            const char* a2 = last ? nA : cA + (size_t)(t + 2) * kstep; const char* b2 = last ? nB : cB + (size_t)(t + 2) * kstep;
            const char* a3 = a2 + kstep; const char* b3 = b2 + kstep;
            if (last && has_next) S.a_ready(nxt);
            if constexpr (SP2) {
            PG8_LDB(B0, 0, 0); PG8_LDB(B1, 0, 1); PG8_SCHED; PG8_LDA(At, 0, 0); PG8_STAGE(PG8_SA(1, 1), a1 + hstep, voffA);
            PG8_WAIT_V(8); PG8_WAIT_L(0); PG8_BAR; PG8_MMA(0, 0, At, B0); PG8_MMA(0, 1, At, B1); PG8_BAR; PG8_SCHED;
            PG8_LDA(At, 0, 1); PG8_STAGE(PG8_SB(0, 0), b2, voffB); PG8_STAGE(PG8_SB(0, 1), b2 + hstep, voffB); PG8_STAGE(PG8_SA(0, 0), a2, voffA);
            PG8_WAIT_V(8); PG8_WAIT_L(0); PG8_BAR; PG8_MMA(1, 0, At, B0); PG8_MMA(1, 1, At, B1); PG8_BAR; PG8_SCHED;
            PG8_LDB(B0, 1, 0); PG8_LDB(B1, 1, 1); PG8_SCHED; PG8_LDA(At, 1, 0); PG8_STAGE(PG8_SA(0, 1), a2 + hstep, voffA);
            PG8_WAIT_V(8); PG8_WAIT_L(0); PG8_BAR; PG8_MMA(0, 0, At, B0); PG8_MMA(0, 1, At, B1); PG8_BAR; PG8_SCHED;
            PG8_LDA(At, 1, 1); PG8_STAGE(PG8_SB(1, 0), b3, voffB); PG8_STAGE(PG8_SB(1, 1), b3 + hstep, voffB); PG8_STAGE(PG8_SA(1, 0), a3, voffA);
            PG8_WAIT_V(8); PG8_WAIT_L(0); PG8_BAR; PG8_MMA(1, 0, At, B0); PG8_MMA(1, 1, At, B1); PG8_BAR; PG8_SCHED;
            } else {
            PG8_LDB(B0, 0, 0); PG8_SCHED; PG8_LDA(At, 0, 0); PG8_STAGE(PG8_SA(1, 1), a1 + hstep, voffA);
            PG8_WAIT_L(8); PG8_BAR; PG8_WAIT_L(0); PG8_MMA(0, 0, At, B0); PG8_BAR; PG8_SCHED;
            PG8_LDB(B1, 0, 1); PG8_STAGE(PG8_SB(0, 0), b2, voffB);
            PG8_BAR; PG8_WAIT_L(0); PG8_MMA(0, 1, At, B1); PG8_BAR;
            PG8_LDA(At, 0, 1); PG8_STAGE(PG8_SA(0, 0), a2, voffA);
            PG8_BAR; PG8_WAIT_L(0); PG8_MMA(1, 0, At, B0); PG8_BAR; PG8_SCHED;
            PG8_STAGE(PG8_SB(0, 1), b2 + hstep, voffB);
            PG8_WAIT_V(6); PG8_BAR; PG8_MMA(1, 1, At, B1); PG8_BAR;
            PG8_LDB(B0, 1, 0); PG8_SCHED; PG8_LDA(At, 1, 0); PG8_STAGE(PG8_SA(0, 1), a2 + hstep, voffA);
            PG8_WAIT_L(8); PG8_BAR; PG8_WAIT_L(0); PG8_MMA(0, 0, At, B0); PG8_BAR; PG8_SCHED;
            PG8_LDB(B1, 1, 1); PG8_STAGE(PG8_SB(1, 0), b3, voffB);
            PG8_BAR; PG8_WAIT_L(0); PG8_MMA(0, 1, At, B1); PG8_BAR;
            PG8_LDA(At, 1, 1); PG8_STAGE(PG8_SA(1, 0), a3, voffA);
            PG8_BAR; PG8_WAIT_L(0); PG8_MMA(1, 0, At, B0); PG8_BAR; PG8_SCHED;
            PG8_STAGE(PG8_SB(1, 1), b3 + hstep, voffB);
            PG8_WAIT_V(6); PG8_BAR; PG8_MMA(1, 1, At, B1); PG8_BAR;
            }
        }
        if constexpr (ALIGN_EPI) { if (wr == 0) PG8_BAR; }
        if constexpr (!Epi::AFTER_DRAIN) { E(acc, cur, wr, wc, fr, fq); S.done(cur); }
        if (!has_next) break;
#pragma unroll
        for (int a = 0; a < 2; ++a)
#pragma unroll
            for (int b = 0; b < 2; ++b)
#pragma unroll
                for (int m = 0; m < 4; ++m)
#pragma unroll
                    for (int n = 0; n < 2; ++n) acc[a][b][m][n] = (f32x4){0.f, 0.f, 0.f, 0.f};
        cur = nxt; cA = nA; cB = nB; ++ui;
        if constexpr (ALIGN_EPI) { if (wr == 1) PG8_BAR; }
    }
    PG8_WAIT_V(0);
    if constexpr (!ALIGN_EPI) { if (wr == 0) PG8_BAR; }
    PG8_BAR;
    if constexpr (Epi::AFTER_DRAIN) { E.fused(acc, cur, wr, wc, fr, fq, lds, wid, lane); S.done(cur); }
#undef PG8_SA
#undef PG8_SB
#undef PG8_STAGE
#undef PG8_LDA
#undef PG8_LDB
#undef PG8_MMA
#undef PG8_WAIT_V
#undef PG8_WAIT_L
#undef PG8_BAR
#undef PG8_SCHED
}
}

#ifndef PG8_SP2
#define PG8_SP2 true
#endif
#ifndef PG8_ALIGN
#define PG8_ALIGN true
#endif
#define GAS __attribute__((address_space(1)))
#define LAS __attribute__((address_space(3)))
typedef unsigned short bf16;
typedef unsigned v4u __attribute__((ext_vector_type(4)));
typedef float f32x4 __attribute__((ext_vector_type(4)));
typedef short bf16x8 __attribute__((ext_vector_type(8)));
typedef GAS unsigned gu32;
typedef GAS unsigned long long gu64;
#define RLX_AGENT __ATOMIC_RELAXED, __HIP_MEMORY_SCOPE_AGENT
#define LDS_WAIT() asm volatile("s_waitcnt lgkmcnt(0)" ::: "memory")
#define VM_WAIT() asm volatile("s_waitcnt vmcnt(0)" ::: "memory")
__device__ __forceinline__ unsigned long long rt() { return __builtin_amdgcn_s_memrealtime(); }
__device__ __forceinline__ unsigned f2bf(float f) { unsigned u = __builtin_bit_cast(unsigned, f); return (u + 0x7fffu + ((u >> 16) & 1u)) >> 16; }
typedef float pk2_f32x2_t __attribute__((ext_vector_type(2))); typedef __bf16 pk2_bf16x2_t __attribute__((ext_vector_type(2)));
__device__ __forceinline__ unsigned pk2(float lo, float hi) { const pk2_f32x2_t v = {lo, hi}; return __builtin_bit_cast(unsigned, __builtin_convertvector(v, pk2_bf16x2_t)); }

#define XB_TMO      128
#define XB_XCNT(j)  (256  + 64 * (j))
#define XB_XSUB(j)  (1280 + 64 * (j))
#define XB_XGEN(j)  (2304 + 64 * (j))
#define XB_TOP      3328
#define XB_TOPGEN   3392
#define XCD_BAR_WORDS 3456
#define XB_SPIN_CAP (1u << 18)

__device__ __forceinline__ unsigned xb_ld(unsigned* p)              { return __hip_atomic_load(p, __ATOMIC_RELAXED, __HIP_MEMORY_SCOPE_AGENT); }
__device__ __forceinline__ unsigned xb_add(unsigned* p, unsigned v) { return __hip_atomic_fetch_add(p, v, __ATOMIC_RELAXED, __HIP_MEMORY_SCOPE_AGENT); }
__device__ __forceinline__ unsigned xb_xcc_id() { return (unsigned)__builtin_amdgcn_s_getreg((3 << 11) | 20) & 0xFu; }
#define XB_SPIN(cond, bar) do { unsigned _sp = 0; while (cond) { __builtin_amdgcn_s_sleep(1); \
    if ((++_sp & 255u) == 0u) { if (xb_ld(&(bar)[XB_TMO])) break; if (_sp > XB_SPIN_CAP) { atomicAdd(&(bar)[XB_TMO], 1u); break; } } } } while (0)

struct XcdBarrier {
    unsigned* bar; unsigned x;
    volatile LAS unsigned* st;
};

__device__ __forceinline__ XcdBarrier xcd_barrier_post(unsigned* bar, volatile LAS unsigned* st) {
    XcdBarrier b; b.bar = bar; b.x = xb_xcc_id(); b.st = st;
    if (threadIdx.x == 0) (void)xb_add(&bar[XB_XCNT(b.x)], 1u);
    return b;
}
__device__ __forceinline__ void xcd_barrier_complete(unsigned* bar, unsigned x, unsigned& nloc, unsigned& nx) {
    const unsigned G = gridDim.x * gridDim.y * gridDim.z;
    unsigned sum, cnt, mine, sp = 0u;
    for (;;) {
        sum = 0u; cnt = 0u; mine = 0u;
#pragma unroll
        for (unsigned j = 0; j < 16; ++j) { const unsigned c = xb_ld(&bar[XB_XCNT(j)]); sum += c; cnt += (c > 0u) ? 1u : 0u; mine = (j == x) ? c : mine; }
        if (sum == G) break;
        __builtin_amdgcn_s_sleep(1);
        if ((++sp & 255u) == 0u) { if (xb_ld(&bar[XB_TMO])) break; if (sp > XB_SPIN_CAP) { atomicAdd(&bar[XB_TMO], 1u); break; } }
    }
    nloc = mine > 0u ? mine : 1u; nx = cnt > 0u ? cnt : 1u;
}

__device__ __forceinline__ void xcd_barrier(const XcdBarrier& b) {
    asm volatile("s_waitcnt vmcnt(0)" ::: "memory");
    __syncthreads();
    if (threadIdx.x == 0) {
        unsigned* bar = b.bar;
        __builtin_amdgcn_s_waitcnt(0);
        unsigned nloc = b.st[0], nx = b.st[1];
        if (nloc == 0u) { xcd_barrier_complete(bar, b.x, nloc, nx); b.st[0] = nloc; b.st[1] = nx; }
        const unsigned old = xb_add(&bar[XB_XSUB(b.x)], 1u);
        const unsigned gen = old / nloc;
        if (old + 1u == (gen + 1u) * nloc) {
            __builtin_amdgcn_fence(__ATOMIC_RELEASE, "agent");
            asm volatile("s_waitcnt vmcnt(0)" ::: "memory");
            const unsigned og = xb_add(&bar[XB_TOP], 1u);
            const unsigned tg = og / nx;
            if (og + 1u == (tg + 1u) * nx) xb_add(&bar[XB_TOPGEN], 1u);
            else XB_SPIN(xb_ld(&bar[XB_TOPGEN]) == tg, bar);
            __builtin_amdgcn_fence(__ATOMIC_ACQUIRE, "agent");
            xb_add(&bar[XB_XGEN(b.x)], 1u);
            asm volatile("s_waitcnt vmcnt(0)" ::: "memory");
        } else {
            XB_SPIN(xb_ld(&bar[XB_XGEN(b.x)]) == gen, bar);
            __builtin_amdgcn_fence(__ATOMIC_ACQUIRE, "agent");
            asm volatile("s_waitcnt vmcnt(0)" ::: "memory");
        }
    }
    __syncthreads();
}

constexpr int NWAVES = 8, NTHREADS = 512;
constexpr int DM = 1024, NB = 4, SEQ = 4096, DEPTH = 2, NTOK = NB * SEQ, NEXP = 16384;
constexpr int DIN = 1952, DINP = 2048;
constexpr float ALPHA = 1.4142135623730951f;
constexpr float LN_EPS = 1e-5f, RMS_EPS = 1e-6f;
constexpr float QSCALE = 0.10206207261596575f * 1.4426950408889634f;
constexpr int NPL = 10;
constexpr int NPHASE = 1 + NPL * DEPTH;
constexpr size_t MiB = 1u << 20;
constexpr size_t WS_CTL = 0, CTL_ZERO_BYTES = 64 * 1024;
constexpr size_t WS_WIT = 2 * MiB;
constexpr size_t WS_WQT = 10 * MiB;
constexpr size_t WS_WOT = 18 * MiB;
constexpr size_t WS_WUQT = 22 * MiB;
constexpr size_t WS_WUKVT = 23 * MiB;
constexpr size_t WS_KEYS = 24 * MiB;
constexpr size_t WS_ROPE = 25 * MiB;
constexpr size_t WS_SUV = 26 * MiB;
constexpr size_t WS_UT = 32 * MiB;
constexpr size_t WS_VT = 96 * MiB;
constexpr size_t WS_XB = 160 * MiB;
constexpr size_t WS_HB = 192 * MiB;
constexpr size_t WS_QM = 256 * MiB;
constexpr size_t WS_KM = 280 * MiB;
constexpr size_t WS_VMT = 304 * MiB;
constexpr size_t WS_VST = 320 * MiB;
constexpr size_t WS_OB = 336 * MiB;
constexpr size_t WS_EL = 368 * MiB;
constexpr size_t WS_GL = 376 * MiB;
constexpr size_t WS_XQ = WS_KM;
constexpr size_t WS_SX = WS_VST;
constexpr size_t WS_AC = WS_QM;
constexpr size_t WS_KSF = 384 * MiB;
constexpr size_t WS_END = 400 * MiB;
constexpr int CW_BAR = 1024;
static_assert((CW_BAR + XCD_BAR_WORDS) * 4 <= (int)CTL_ZERO_BYTES, "barrier words inside the memset region");
constexpr int RING_OFF = 0, RING_BYTES = 131072;
constexpr int LDSCTL_OFF = RING_BYTES, MISC_OFF = LDSCTL_OFF + 320;
constexpr int LDS_BYTES = 147456;
static_assert(MISC_OFF + 128 <= LDS_BYTES, "LDS map");

typedef float f32x16 __attribute__((ext_vector_type(16)));
typedef float f32x2 __attribute__((ext_vector_type(2)));
typedef unsigned v2u __attribute__((ext_vector_type(2)));
typedef __bf16 bf2_t __attribute__((ext_vector_type(2)));

struct Args { const float* in[15]; float* out; unsigned char* ws; int ph_lo, ph_hi; };
typedef const __attribute__((address_space(4))) Args* kap_t;
__device__ __forceinline__ kap_t ka_fresh() { kap_t p = (kap_t)__builtin_amdgcn_kernarg_segment_ptr(); asm volatile("" : "+s"(p)); return p; }
enum { I_X = 0, I_WIN, I_GCQ, I_WUQ, I_GCKV, I_WUKV, I_WO, I_LN1G, I_LN1B, I_WQ, I_KEYS, I_U, I_V, I_LN2G, I_LN2B };
struct Frame {
    LAS unsigned char* lds;
    volatile LAS unsigned* MISC;
    int tid, lane, wave, vcu, G;
};
template <class T> __device__ __forceinline__ T* wsp(kap_t ka, size_t off) { return (T*)(ka->ws + off); }

__device__ __forceinline__ float bflo(unsigned w) { return __uint_as_float(w << 16); }
__device__ __forceinline__ float bfhi(unsigned w) { return __uint_as_float(w & 0xffff0000u); }
__device__ __forceinline__ float bf1(short s) { return __uint_as_float(((unsigned)(unsigned short)s) << 16); }
__device__ __forceinline__ int crow(int r, int hi) { return (r & 3) + 8 * (r >> 2) + 4 * hi; }
__device__ __forceinline__ int kperm(int s) { return (s & ~15) | (((s >> 2) & 1) << 3) | (((s >> 3) & 1) << 2) | (s & 3); }
template <int CTRL> __device__ __forceinline__ float dpp_f(float v) { return __builtin_bit_cast(float, __builtin_amdgcn_update_dpp(0, __builtin_bit_cast(int, v), CTRL, 0xF, 0xF, true)); }
__device__ __forceinline__ int shx_i(int v, int mask, int lane) { return __builtin_amdgcn_ds_bpermute((lane ^ mask) << 2, v); }
__device__ __forceinline__ float shx_f(float v, int mask, int lane) { return __builtin_bit_cast(float, __builtin_amdgcn_ds_bpermute((lane ^ mask) << 2, __builtin_bit_cast(int, v))); }
__device__ __forceinline__ float wave_sum_all(float v, int lane) {
    v += dpp_f<0xB1>(v);
    v += dpp_f<0x4E>(v);
    v += dpp_f<0x141>(v);
    v += dpp_f<0x140>(v);
    v += shx_f(v, 16, lane);
    v += shx_f(v, 32, lane);
    return v;
}
__device__ __forceinline__ int wave_sum_all_i(int v, int lane) {
    v += __builtin_amdgcn_update_dpp(0, v, 0xB1, 0xF, 0xF, true); v += __builtin_amdgcn_update_dpp(0, v, 0x4E, 0xF, 0xF, true);
    v += __builtin_amdgcn_update_dpp(0, v, 0x141, 0xF, 0xF, true); v += __builtin_amdgcn_update_dpp(0, v, 0x140, 0xF, 0xF, true);
    v += shx_i(v, 16, lane); v += shx_i(v, 32, lane);
    return v;
}
__device__ __forceinline__ float wave_max_all(float v, int lane) {
    v = fmaxf(v, dpp_f<0xB1>(v)); v = fmaxf(v, dpp_f<0x4E>(v)); v = fmaxf(v, dpp_f<0x141>(v)); v = fmaxf(v, dpp_f<0x140>(v));
    v = fmaxf(v, shx_f(v, 16, lane)); v = fmaxf(v, shx_f(v, 32, lane));
    return v;
}
__device__ __forceinline__ bf16x8 pack8(float a0, float a1, float a2, float a3, float a4, float a5, float a6, float a7) {
    v4u w; w.x = pk2(a0, a1); w.y = pk2(a2, a3); w.z = pk2(a4, a5); w.w = pk2(a6, a7); return __builtin_bit_cast(bf16x8, w);
}

template <bool FRAG> __device__ __forceinline__ void p0_transpose_item(const float* W, int K, int N, bf16* WT, const float* gs, LAS float* scr, int item, int lane) {
    const int nblk = N / 32, kb = item / nblk, nb = item % nblk, k0 = 64 * kb, n0 = 32 * nb;
#pragma unroll 8
    for (int i = 0; i < 32; ++i) { const int kk = 2 * i + (lane >> 5); float w = W[(size_t)(k0 + kk) * N + n0 + (lane & 31)]; if (gs) w *= gs[k0 + kk]; scr[kk * 33 + (lane & 31)] = w; }
    LDS_WAIT(); asm volatile("" ::: "memory");
    const int c = lane & 7;
#pragma unroll
    for (int j = 0; j < 4; ++j) { const int n = (lane >> 3) + 8 * j; const LAS float* s = scr + (8 * c) * 33 + n;
        v4u o; o.x = pk2(s[0 * 33], s[1 * 33]); o.y = pk2(s[2 * 33], s[3 * 33]); o.z = pk2(s[4 * 33], s[5 * 33]); o.w = pk2(s[6 * 33], s[7 * 33]);
        if (FRAG) { const int nn = n0 + n, kk = k0 + 8 * c; *(GAS v4u*)(WT + ((size_t)((nn >> 5) * (K >> 4) + (kk >> 4)) * 64 + ((kk >> 3) & 1) * 32 + (nn & 31)) * 8) = o; }
        else *(GAS v4u*)(WT + (size_t)(n0 + n) * K + k0 + 8 * c) = o; }
    LDS_WAIT(); asm volatile("" ::: "memory");
}
__device__ __forceinline__ void cvt8_range(Frame& F, const float* src, bf16* dst, size_t n8) {
    const size_t gt = (size_t)blockIdx.x * NTHREADS + F.tid, nt = (size_t)F.G * NTHREADS;
    for (size_t i = gt; i < n8; i += nt) { const f32x4 a = *(const f32x4*)(src + i * 8), b = *(const f32x4*)(src + i * 8 + 4);
        v4u o; o.x = pk2(a.x, a.y); o.y = pk2(a.z, a.w); o.z = pk2(b.x, b.y); o.w = pk2(b.z, b.w); *(v4u*)(dst + i * 8) = o; }
}
__device__ __forceinline__ void p0_prologue(Frame& F, kap_t ka) {
    LAS float* scr = (LAS float*)(F.lds + RING_OFF + F.wave * 16384);
    const int gw = F.vcu * NWAVES + F.wave, NGW = F.G * NWAVES;
    constexpr int I_IN = 16 * 61, I_Q = 16 * 64, I_O = 16 * 32, I_UQ = 4 * 24, I_UKV = 2 * 32, I_L = I_IN + I_Q + I_O + I_UQ + I_UKV;
    for (int it = gw; it < DEPTH * I_L; it += NGW) {
        const int l = it / I_L; int r = it % I_L;
        if (r < I_IN) { p0_transpose_item<false>(ka->in[I_WIN] + (size_t)l * DM * DIN, DM, DIN, wsp<bf16>(ka, WS_WIT) + (size_t)l * DINP * DM, nullptr, scr, r, F.lane); continue; } r -= I_IN;
        if (r < I_Q) { p0_transpose_item<false>(ka->in[I_WQ] + (size_t)l * DM * 2048, DM, 2048, wsp<bf16>(ka, WS_WQT) + (size_t)l * 2048 * DM, nullptr, scr, r, F.lane); continue; } r -= I_Q;
        if (r < I_O) { p0_transpose_item<false>(ka->in[I_WO] + (size_t)l * DM * DM, DM, DM, wsp<bf16>(ka, WS_WOT) + (size_t)l * DM * DM, nullptr, scr, r, F.lane); continue; } r -= I_O;
        if (r < I_UQ) { p0_transpose_item<true>(ka->in[I_WUQ] + (size_t)l * 256 * 768, 256, 768, wsp<bf16>(ka, WS_WUQT) + (size_t)l * 768 * 256, ka->in[I_GCQ] + l * 256, scr, r, F.lane); continue; } r -= I_UQ;
        p0_transpose_item<true>(ka->in[I_WUKV] + (size_t)l * 128 * 1024, 128, 1024, wsp<bf16>(ka, WS_WUKVT) + (size_t)l * 1024 * 128, ka->in[I_GCKV] + l * 128, scr, r, F.lane);
    }
    const size_t gt = (size_t)blockIdx.x * NTHREADS + F.tid, nt = (size_t)F.G * NTHREADS;
    for (size_t i = gt; i < 2 * 12288; i += nt) { const size_t l = i / 12288, j = i % 12288; *(v4u*)(wsp<bf16>(ka, WS_WIT) + l * DINP * DM + (size_t)DIN * DM + j * 8) = (v4u){0u, 0u, 0u, 0u}; }
    for (size_t i = gt; i < (size_t)SEQ * 16; i += nt) { const int pos = (int)(i >> 4), k = (int)(i & 15);
        const float inv_freq = (float)pow(10000.0, -(double)k / 16.0); const float ang = (float)pos * inv_freq;
        wsp<f32x2>(ka, WS_ROPE)[i] = (f32x2){(float)cos((double)ang), (float)sin((double)ang)}; }
    for (size_t i = gt; i < (size_t)DEPTH * 8 * 2 * 128 * 16; i += nt) {
        const size_t lhc = i >> 11; const int n = (int)(i >> 4) & 127, dg = (int)i & 15;
        const float* src = ka->in[I_KEYS] + i * 8; const f32x4 a = *(const f32x4*)src, b = *(const f32x4*)(src + 4);
        v4u o; o.x = pk2(a.x, a.y); o.y = pk2(a.z, a.w); o.z = pk2(b.x, b.y); o.w = pk2(b.z, b.w);
        *(v4u*)(wsp<bf16>(ka, WS_KEYS) + (lhc * 2048 + (size_t)(((n >> 5) * 8 + (dg >> 1)) * 64 + (dg & 1) * 32 + (n & 31))) * 8) = o;
    }
    cvt8_range(F, ka->in[I_X], wsp<bf16>(ka, WS_XB), (size_t)NTOK * DM / 8);
    {
#ifdef MK_DBG_L0
        constexpr int NL = 1;
#else
        constexpr int NL = DEPTH;
#endif
        unsigned char* UQ = wsp<unsigned char>(ka, WS_UT); unsigned char* VQ = wsp<unsigned char>(ka, WS_VT); float* SUV = wsp<float>(ka, WS_SUV);
        for (int row = gw; row < 2 * NL * NEXP; row += NGW) {
            const int tbl = row / (NL * NEXP), r = row % (NL * NEXP);
            const float* src = (tbl ? ka->in[I_V] : ka->in[I_U]) + (size_t)r * DM + 16 * F.lane;
            f32x4 v[4]; float m = 0.f;
#pragma unroll
            for (int j = 0; j < 4; ++j) { v[j] = *(const f32x4*)(src + 4 * j); m = fmaxf(m, fmaxf(fmaxf(fabsf(v[j].x), fabsf(v[j].y)), fmaxf(fabsf(v[j].z), fabsf(v[j].w)))); }
            m = wave_max_all(m, F.lane);
            const float inv = m > 0.f ? 127.f / m : 0.f;
            const int off = 0;
            v4u o;
#pragma unroll
            for (int j = 0; j < 4; ++j) {
                const unsigned b0 = (unsigned)((int)rintf(v[j].x * inv) + off) & 0xffu, b1 = (unsigned)((int)rintf(v[j].y * inv) + off) & 0xffu, b2 = (unsigned)((int)rintf(v[j].z * inv) + off) & 0xffu, b3 = (unsigned)((int)rintf(v[j].w * inv) + off) & 0xffu;
                o[j] = b0 | (b1 << 8) | (b2 << 16) | (b3 << 24);
            }
            if (tbl) *(v4u*)(VQ + (size_t)(r / NEXP) * NEXP * DM + ((size_t)(F.lane >> 3) * NEXP + (size_t)(r % NEXP)) * 128 + 16 * (F.lane & 7)) = o;
            else *(v4u*)(UQ + (size_t)r * DM + 16 * F.lane) = o;
            if (F.lane == 0) SUV[2 * (size_t)r + tbl] = m * (1.f / 127.f);
        }
    }
}

__device__ __forceinline__ void p2_unit(Frame& F, kap_t ka, int l, int tb, int part) {
    const int lane = F.lane, r32 = lane & 31, hi = lane >> 5;
    const int tok = tb * 32 + r32, b = tok / SEQ, s = tok % SEQ;
    const bf16* hrow = wsp<bf16>(ka, WS_HB) + (size_t)tok * DINP;
    if (part < 2) {
        bf16x8 xf[16]; float ssq = 0.f;
#pragma unroll
        for (int ks = 0; ks < 16; ++ks) { xf[ks] = *(const bf16x8*)(hrow + 1536 + ks * 16 + 8 * hi);
#pragma unroll
            for (int e = 0; e < 8; ++e) { const float v = bf1(xf[ks][e]); ssq += v * v; } }
        ssq += shx_f(ssq, 32, lane);
        const float rstd = rsqrtf(ssq * (1.f / 256.f) + RMS_EPS) * QSCALE;
        const bf16* W = wsp<bf16>(ka, WS_WUQT) + (size_t)l * 768 * 256;
        const bf16* wbase = W + 8 * lane;
        bf16x8 wA[16];
#define P2Q_LOADW(WF, j) do { _Pragma("unroll") for (int ks = 0; ks < 16; ++ks) WF[ks] = *(const bf16x8*)(wbase + (size_t)((j) * 16 + ks) * 512); } while (0)
#define P2Q_MMA(WF, ACC) do { ACC = (f32x16){}; _Pragma("unroll") for (int ks = 0; ks < 16; ++ks) ACC = __builtin_amdgcn_mfma_f32_32x32x16_bf16(WF[ks], xf[ks], ACC, 0, 0, 0); } while (0)
#define P2Q_EPI(ACC, j) do { const int head_ = (j) / 3, sub_ = (j) % 3; float v[16]; \
            _Pragma("unroll") for (int r = 0; r < 16; ++r) v[r] = ACC[r] * rstd; \
            if (sub_ == 2) { _Pragma("unroll") for (int r = 0; r < 8; ++r) { const f32x2 cs = wsp<f32x2>(ka, WS_ROPE)[s * 16 + crow(r, hi)]; const float x1 = v[r], x2 = v[r + 8]; v[r] = x1 * cs.x - x2 * cs.y; v[r + 8] = x2 * cs.x + x1 * cs.y; } } \
            bf16* dst = wsp<bf16>(ka, WS_QM) + ((size_t)(b * 8 + head_) * SEQ + s) * 96 + sub_ * 32 + 4 * hi; \
            _Pragma("unroll") for (int g = 0; g < 4; ++g) { v2u w; w.x = pk2(v[4 * g], v[4 * g + 1]); w.y = pk2(v[4 * g + 2], v[4 * g + 3]); *(v2u*)(dst + 8 * g) = w; } } while (0)
        P2Q_LOADW(wA, part * 12);
        for (int jj = 0; jj < 12; ++jj) {
            const int j = part * 12 + jj; f32x16 acc;
            P2Q_MMA(wA, acc);
            __builtin_amdgcn_sched_barrier(0);
            P2Q_LOADW(wA, jj + 1 < 12 ? j + 1 : j);
            __builtin_amdgcn_sched_barrier(0);
            P2Q_EPI(acc, j);
        }
#undef P2Q_LOADW
#undef P2Q_MMA
#undef P2Q_EPI
    } else {
        const int h0 = (part - 2) * 4;
        bf16x8 xf[8]; float ssq = 0.f;
#pragma unroll
        for (int ks = 0; ks < 8; ++ks) { xf[ks] = *(const bf16x8*)(hrow + 1792 + ks * 16 + 8 * hi);
#pragma unroll
            for (int e = 0; e < 8; ++e) { const float v = bf1(xf[ks][e]); ssq += v * v; } }
        ssq += shx_f(ssq, 32, lane);
        const float rstd = rsqrtf(ssq * (1.f / 128.f) + RMS_EPS);
        const bf16* W = wsp<bf16>(ka, WS_WUKVT) + (size_t)l * 1024 * 128;
        const int sp = kperm(s);
        const bf16* wbase = W + 8 * lane;
        bf16x8 wA[8], wB[8];
#define P2K_LOADW(WF, j) do { _Pragma("unroll") for (int ks = 0; ks < 8; ++ks) WF[ks] = *(const bf16x8*)(wbase + (size_t)((j) * 8 + ks) * 512); } while (0)
#define P2K_MMA(WF, ACC) do { ACC = (f32x16){}; _Pragma("unroll") for (int ks = 0; ks < 8; ++ks) ACC = __builtin_amdgcn_mfma_f32_32x32x16_bf16(WF[ks], xf[ks], ACC, 0, 0, 0); } while (0)
        P2K_LOADW(wA, h0 * 4);
        for (int jj = 0; jj < 16; jj += 2) {
            f32x16 accA, accB;
            P2K_LOADW(wB, h0 * 4 + jj + 1);
            P2K_MMA(wA, accA);
            P2K_LOADW(wA, jj + 2 < 16 ? h0 * 4 + jj + 2 : h0 * 4 + jj + 1);
            P2K_MMA(wB, accB);
#pragma unroll
            for (int u2 = 0; u2 < 2; ++u2) {
                const int j = h0 * 4 + jj + u2; const int head = j >> 2, sub = j & 3; const f32x16 acc = u2 ? accB : accA;
            if (sub < 2) {
                bf16* dst = wsp<bf16>(ka, WS_KM) + (size_t)(b * 8 + head) * SEQ * 96 + (size_t)(s >> 5) * (6 * 512) + (size_t)r32 * 8 + 4 * hi;
#pragma unroll
                for (int g = 0; g < 4; ++g) { v2u w; w.x = pk2(acc[4 * g] * rstd, acc[4 * g + 1] * rstd); w.y = pk2(acc[4 * g + 2] * rstd, acc[4 * g + 3] * rstd); *(v2u*)(dst + (2 * sub + (g >> 1)) * 512 + (g & 1) * 256) = w; }
            } else {
                bf16* dst = wsp<bf16>(ka, WS_VMT) + (size_t)(b * 8 + head) * 64 * SEQ + (size_t)(s >> 5) * (4 * 512) + ((sub - 2) * 2 + ((s >> 4) & 1)) * 512 + ((sp >> 3) & 1) * 256 + (sp & 7);
#pragma unroll
                for (int r = 0; r < 16; ++r) dst[crow(r, hi) * 8] = (bf16)f2bf(acc[r] * rstd);
            }
            }
        }
#undef P2K_LOADW
#undef P2K_MMA
        { const bf16x8 a1 = *(const bf16x8*)(hrow + 1920 + 8 * hi), a2 = *(const bf16x8*)(hrow + 1936 + 8 * hi);
          float o1[8], o2[8];
#pragma unroll
          for (int e = 0; e < 8; ++e) { const f32x2 cs = wsp<f32x2>(ka, WS_ROPE)[s * 16 + 8 * hi + e]; const float x1 = bf1(a1[e]), x2 = bf1(a2[e]); o1[e] = x1 * cs.x - x2 * cs.y; o2[e] = x2 * cs.x + x1 * cs.y; }
          const bf16x8 p1 = pack8(o1[0], o1[1], o1[2], o1[3], o1[4], o1[5], o1[6], o1[7]), p2 = pack8(o2[0], o2[1], o2[2], o2[3], o2[4], o2[5], o2[6], o2[7]);
#pragma unroll
          for (int hh = 0; hh < 4; ++hh) { bf16* dst = wsp<bf16>(ka, WS_KM) + (size_t)(b * 8 + h0 + hh) * SEQ * 96 + (size_t)(s >> 5) * (6 * 512) + 4 * 512 + hi * 256 + (size_t)r32 * 8; *(bf16x8*)dst = p1; *(bf16x8*)(dst + 512) = p2; } }
#pragma unroll 1
        for (int hh = 0; hh < 4; ++hh) {
            const int head = h0 + hh;
#pragma unroll
            for (int c4 = 0; c4 < 4; ++c4) { const bf16x8 a = *(const bf16x8*)(hrow + 1024 + head * 64 + 32 * hi + c4 * 8);
                bf16* dst = wsp<bf16>(ka, WS_VST) + (size_t)(b * 8 + head) * 64 * SEQ + (size_t)(s >> 5) * (4 * 512) + (hi * 2 + ((s >> 4) & 1)) * 512 + ((sp >> 3) & 1) * 256 + c4 * 64 + (sp & 7);
#pragma unroll
                for (int e = 0; e < 8; ++e) dst[e * 8] = (bf16)a[e]; }
#pragma unroll
            for (int ks = 0; ks < 4; ++ks) *(bf16x8*)(wsp<bf16>(ka, WS_KSF) + (size_t)(b * 8 + head) * SEQ * 64 + (size_t)(s >> 5) * (4 * 512) + ks * 512 + (size_t)lane * 8) = *(const bf16x8*)(hrow + 512 + head * 64 + ks * 16 + 8 * hi);
        }
    }
}

__device__ __forceinline__ float xhalf_max(float v) { auto rr = __builtin_amdgcn_permlane32_swap(__float_as_uint(v), __float_as_uint(v), false, false); return fmaxf(__uint_as_float(rr[0]), __uint_as_float(rr[1])); }
__device__ __forceinline__ float xhalf_sum(float v) { auto rr = __builtin_amdgcn_permlane32_swap(__float_as_uint(v), __float_as_uint(v), false, false); return __uint_as_float(rr[0]) + __uint_as_float(rr[1]); }
constexpr float MLA_THR = 8.f;
__device__ __forceinline__ void mla_unit(Frame& F, kap_t ka, int bh, int qb) {
    const int lane = F.lane, r32 = lane & 31, hi = lane >> 5, q0 = qb * 32;
    const bf16* Qp = wsp<bf16>(ka, WS_QM) + ((size_t)bh * SEQ + q0 + r32) * 96 + 8 * hi;
    bf16x8 qf[6];
#pragma unroll
    for (int ks = 0; ks < 6; ++ks) qf[ks] = *(const bf16x8*)(Qp + ks * 16);
    f32x16 o0 = {}, o1 = {};
    float m = -1e30f, l = 0.f;
    const bf16* Kp = wsp<bf16>(ka, WS_KM) + (size_t)bh * SEQ * 96 + 8 * lane;
    const bf16* Vp = wsp<bf16>(ka, WS_VMT) + (size_t)bh * 64 * SEQ + 8 * lane;
#define MLA_LOADK(KF, kt) do { _Pragma("unroll") for (int ks = 0; ks < 6; ++ks) KF[ks] = *(const bf16x8*)(Kp + (size_t)((kt) * 6 + ks) * 512); } while (0)
#define MLA_LOADV(VF, kt) do { _Pragma("unroll") for (int i = 0; i < 4; ++i) VF[i] = *(const bf16x8*)(Vp + (size_t)((kt) * 4 + i) * 512); } while (0)
#define MLA_QK(S, KF) do { S = (f32x16){}; _Pragma("unroll") for (int ks = 0; ks < 6; ++ks) S = __builtin_amdgcn_mfma_f32_32x32x16_bf16(KF[ks], qf[ks], S, 0, 0, 0); } while (0)
#define MLA_SMPV(S, VF, kt) do { \
        if ((kt) == qb) { _Pragma("unroll") for (int r = 0; r < 16; ++r) if (crow(r, hi) > r32) S[r] = -1e30f; } \
        float mx = fmaxf(fmaxf(S[0], S[1]), fmaxf(S[2], S[3])); \
        _Pragma("unroll") for (int r = 4; r < 16; r += 4) mx = fmaxf(mx, fmaxf(fmaxf(S[r], S[r + 1]), fmaxf(S[r + 2], S[r + 3]))); \
        mx = xhalf_max(mx); \
        if (__any(mx - m > MLA_THR)) { const float mn = fmaxf(m, mx), alpha = __builtin_amdgcn_exp2f(m - mn); l *= alpha; m = mn; \
            _Pragma("unroll") for (int r = 0; r < 16; ++r) { o0[r] *= alpha; o1[r] *= alpha; } } \
        float p[16], rs0 = 0.f, rs1 = 0.f; \
        _Pragma("unroll") for (int r = 0; r < 16; r += 2) { p[r] = __builtin_amdgcn_exp2f(S[r] - m); p[r + 1] = __builtin_amdgcn_exp2f(S[r + 1] - m); rs0 += p[r]; rs1 += p[r + 1]; } \
        l += rs0 + rs1; \
        const bf16x8 pf0 = pack8(p[0], p[1], p[2], p[3], p[4], p[5], p[6], p[7]), pf1 = pack8(p[8], p[9], p[10], p[11], p[12], p[13], p[14], p[15]); \
        o0 = __builtin_amdgcn_mfma_f32_32x32x16_bf16(VF[0], pf0, o0, 0, 0, 0); \
        o1 = __builtin_amdgcn_mfma_f32_32x32x16_bf16(VF[2], pf0, o1, 0, 0, 0); \
        o0 = __builtin_amdgcn_mfma_f32_32x32x16_bf16(VF[1], pf1, o0, 0, 0, 0); \
        o1 = __builtin_amdgcn_mfma_f32_32x32x16_bf16(VF[3], pf1, o1, 0, 0, 0); } while (0)
    bf16x8 kA[6], kB[6], vA[4];
    f32x16 sA, sB;
    MLA_LOADK(kA, 0); MLA_LOADK(kB, 1);
    MLA_QK(sA, kA);
    for (int kt = 0; kt <= qb; kt += 2) {
        MLA_LOADK(kA, kt + 2); MLA_LOADV(vA, kt);
        MLA_QK(sB, kB);
        MLA_SMPV(sA, vA, kt);
        if (kt + 1 > qb) break;
        MLA_LOADK(kB, kt + 3); MLA_LOADV(vA, kt + 1);
        MLA_QK(sA, kA);
        MLA_SMPV(sB, vA, kt + 1);
    }
#undef MLA_LOADK
#undef MLA_LOADV
#undef MLA_QK
#undef MLA_SMPV
    l = xhalf_sum(l);
    const float rl = 1.f / l;
    const int b = bh >> 3, h = bh & 7;
    bf16* dst = wsp<bf16>(ka, WS_OB) + ((size_t)b * SEQ + q0 + r32) * DM + 512 + h * 64 + 4 * hi;
#pragma unroll
    for (int g = 0; g < 4; ++g) {
        v2u w; w.x = pk2(o0[4 * g] * rl, o0[4 * g + 1] * rl); w.y = pk2(o0[4 * g + 2] * rl, o0[4 * g + 3] * rl); *(v2u*)(dst + 8 * g) = w;
        v2u u; u.x = pk2(o1[4 * g] * rl, o1[4 * g + 1] * rl); u.y = pk2(o1[4 * g + 2] * rl, o1[4 * g + 3] * rl); *(v2u*)(dst + 32 + 8 * g) = u;
    }
}

__device__ __forceinline__ void mla_block(Frame& F, kap_t ka, int bh, int J) {
    const int tid = F.tid, lane = F.lane, r32 = lane & 31, hi = lane >> 5, wave = F.wave;
    const int qb = 8 * J + wave, q0 = qb * 32, T = 8 * J + 8;
    const bf16* Qp = wsp<bf16>(ka, WS_QM) + ((size_t)bh * SEQ + q0 + r32) * 96 + 8 * hi;
    bf16x8 qf[6];
#pragma unroll
    for (int ks = 0; ks < 6; ++ks) qf[ks] = *(const bf16x8*)(Qp + ks * 16);
    f32x16 o0 = {}, o1 = {};
    float m = -1e30f, l = 0.f;
    const unsigned char* Kt = (const unsigned char*)(wsp<bf16>(ka, WS_KM) + (size_t)bh * SEQ * 96);
    const unsigned char* Vt = (const unsigned char*)(wsp<bf16>(ka, WS_VMT) + (size_t)bh * 64 * SEQ);
    LAS unsigned char* ring = F.lds + RING_OFF;
    const bool c0k = tid < 384;
    const size_t off0 = c0k ? (size_t)tid * 16 : (size_t)(tid - 384) * 16, off1 = (size_t)(128 + tid) * 16;
#define MB_GLOAD(t) do { r0 = *(const v4u*)((c0k ? Kt + (size_t)(t) * 6144 : Vt + (size_t)(t) * 4096) + off0); if (tid < 128) r1 = *(const v4u*)(Vt + (size_t)(t) * 4096 + off1); } while (0)
#define MB_LWRITE(s) do { *(LAS v4u*)(ring + (s) * 10240 + tid * 16) = r0; if (tid < 128) *(LAS v4u*)(ring + (s) * 10240 + 8192 + tid * 16) = r1; } while (0)
    v4u r0 = {}, r1 = {};
    MB_GLOAD(0); MB_LWRITE(0);
    if (T > 1) MB_GLOAD(1);
    for (int t = 0; t < T; ++t) {
        __syncthreads();
        const bool active = t <= qb;
        bf16x8 kf[6], vf[4];
        if (active) { const LAS unsigned char* sl = ring + (t & 1) * 10240 + lane * 16;
#pragma unroll
            for (int ks = 0; ks < 6; ++ks) kf[ks] = *(const LAS bf16x8*)(sl + ks * 1024);
#pragma unroll
            for (int i = 0; i < 4; ++i) vf[i] = *(const LAS bf16x8*)(sl + 6144 + i * 1024); }
        if (t + 1 < T) MB_LWRITE((t + 1) & 1);
        if (t + 2 < T) MB_GLOAD(t + 2);
        if (active) {
            f32x16 sa = {};
#pragma unroll
            for (int ks = 0; ks < 6; ++ks) sa = __builtin_amdgcn_mfma_f32_32x32x16_bf16(kf[ks], qf[ks], sa, 0, 0, 0);
            if (t == qb) {
#pragma unroll
                for (int r = 0; r < 16; ++r) if (crow(r, hi) > r32) sa[r] = -1e30f;
            }
            float mx = fmaxf(fmaxf(sa[0], sa[1]), fmaxf(sa[2], sa[3]));
#pragma unroll
            for (int r = 4; r < 16; r += 4) mx = fmaxf(mx, fmaxf(fmaxf(sa[r], sa[r + 1]), fmaxf(sa[r + 2], sa[r + 3])));
            mx = xhalf_max(mx);
            if (__any(mx - m > MLA_THR)) { const float mn = fmaxf(m, mx), alpha = __builtin_amdgcn_exp2f(m - mn); l *= alpha; m = mn;
#pragma unroll
                for (int r = 0; r < 16; ++r) { o0[r] *= alpha; o1[r] *= alpha; } }
            float p[16], rs = 0.f;
#pragma unroll
            for (int r = 0; r < 16; ++r) { p[r] = __builtin_amdgcn_exp2f(sa[r] - m); rs += p[r]; }
            l += rs;
            const bf16x8 pf0 = pack8(p[0], p[1], p[2], p[3], p[4], p[5], p[6], p[7]), pf1 = pack8(p[8], p[9], p[10], p[11], p[12], p[13], p[14], p[15]);
            o0 = __builtin_amdgcn_mfma_f32_32x32x16_bf16(vf[0], pf0, o0, 0, 0, 0);
            o0 = __builtin_amdgcn_mfma_f32_32x32x16_bf16(vf[1], pf1, o0, 0, 0, 0);
            o1 = __builtin_amdgcn_mfma_f32_32x32x16_bf16(vf[2], pf0, o1, 0, 0, 0);
            o1 = __builtin_amdgcn_mfma_f32_32x32x16_bf16(vf[3], pf1, o1, 0, 0, 0);
        }
    }
#undef MB_GLOAD
#undef MB_LWRITE
    __syncthreads();
    l = xhalf_sum(l);
    const float rl = 1.f / l;
    const int b = bh >> 3, h = bh & 7;
    bf16* dst = wsp<bf16>(ka, WS_OB) + ((size_t)b * SEQ + q0 + r32) * DM + 512 + h * 64 + 4 * hi;
#pragma unroll
    for (int g = 0; g < 4; ++g) {
        v2u w; w.x = pk2(o0[4 * g] * rl, o0[4 * g + 1] * rl); w.y = pk2(o0[4 * g + 2] * rl, o0[4 * g + 3] * rl); *(v2u*)(dst + 8 * g) = w;
        v2u u; u.x = pk2(o1[4 * g] * rl, o1[4 * g + 1] * rl); u.y = pk2(o1[4 * g + 2] * rl, o1[4 * g + 3] * rl); *(v2u*)(dst + 32 + 8 * g) = u;
    }
}

__device__ __forceinline__ void sb_unit(Frame& F, kap_t ka, int bh, int qb) {
    const int lane = F.lane, r32 = lane & 31, hi = lane >> 5, q0 = qb * 32;
    const int b = bh >> 3, h = bh & 7;
    const bf16* Hb = wsp<bf16>(ka, WS_HB) + (size_t)b * SEQ * DINP + h * 64 + 8 * hi;
    bf16x8 qf[4];
#pragma unroll
    for (int ks = 0; ks < 4; ++ks) qf[ks] = *(const bf16x8*)(Hb + (size_t)(q0 + r32) * DINP + ks * 16);
    f32x16 o0 = {}, o1 = {};
    float R = 0.f;
    const bf16* Kp = wsp<bf16>(ka, WS_KSF) + (size_t)bh * SEQ * 64 + 8 * lane;
    const bf16* Vp = wsp<bf16>(ka, WS_VST) + (size_t)bh * 64 * SEQ + 8 * lane;
    for (int k0 = q0; k0 >= 0; k0 -= 32) {
        bf16x8 kf[4], vf[4];
#pragma unroll
        for (int ks = 0; ks < 4; ++ks) kf[ks] = *(const bf16x8*)(Kp + (size_t)((k0 >> 5) * 4 + ks) * 512);
#pragma unroll
        for (int i = 0; i < 4; ++i) vf[i] = *(const bf16x8*)(Vp + (size_t)((k0 >> 5) * 4 + i) * 512);
        f32x16 za = {};
#pragma unroll
        for (int ks = 0; ks < 4; ++ks) za = __builtin_amdgcn_mfma_f32_32x32x16_bf16(kf[ks], qf[ks], za, 0, 0, 0);
        const bool diag = (k0 == q0);
        float L[16], lw[16];
#pragma unroll
        for (int r = 0; r < 16; ++r) {
            const float z = za[r] * 0.125f;
            const float sp = fmaxf(z, 0.f) + __logf(1.f + __expf(-fabsf(z)));
            const bool valid = !diag || (crow(r, hi) < r32);
            L[r] = valid ? -sp : 0.f;
            lw[r] = valid ? (z - sp) : -1e30f;
        }
        float e[16], T[4], U[4];
#pragma unroll
        for (int g = 0; g < 4; ++g) { e[4 * g + 3] = 0.f; e[4 * g + 2] = L[4 * g + 3]; e[4 * g + 1] = e[4 * g + 2] + L[4 * g + 2]; e[4 * g] = e[4 * g + 1] + L[4 * g + 1]; T[g] = e[4 * g] + L[4 * g]; }
#pragma unroll
        for (int g = 0; g < 4; ++g) U[g] = shx_f(T[g], 32, lane);
        float sT[4], sUge[4];
        sT[3] = 0.f; sT[2] = T[3]; sT[1] = T[3] + T[2]; sT[0] = sT[1] + T[1];
        sUge[3] = U[3]; sUge[2] = U[3] + U[2]; sUge[1] = sUge[2] + U[1]; sUge[0] = sUge[1] + U[0];
        float w[16];
#pragma unroll
        for (int g = 0; g < 4; ++g) {
            const float sfx = R + sT[g] + (hi ? (sUge[g] - U[g]) : sUge[g]);
#pragma unroll
            for (int i = 0; i < 4; ++i) w[4 * g + i] = __expf(lw[4 * g + i] + sfx + e[4 * g + i]);
        }
        R += (sT[0] + T[0]) + sUge[0];
        const bf16x8 pf0 = pack8(w[0], w[1], w[2], w[3], w[4], w[5], w[6], w[7]), pf1 = pack8(w[8], w[9], w[10], w[11], w[12], w[13], w[14], w[15]);
        o0 = __builtin_amdgcn_mfma_f32_32x32x16_bf16(vf[0], pf0, o0, 0, 0, 0);
        o0 = __builtin_amdgcn_mfma_f32_32x32x16_bf16(vf[1], pf1, o0, 0, 0, 0);
        o1 = __builtin_amdgcn_mfma_f32_32x32x16_bf16(vf[2], pf0, o1, 0, 0, 0);
        o1 = __builtin_amdgcn_mfma_f32_32x32x16_bf16(vf[3], pf1, o1, 0, 0, 0);
        if (__all(R < -88.f)) break;
    }
    bf16* dst = wsp<bf16>(ka, WS_OB) + ((size_t)b * SEQ + q0 + r32) * DM + h * 64 + 4 * hi;
#pragma unroll
    for (int g = 0; g < 4; ++g) {
        v2u wv; wv.x = pk2(o0[4 * g], o0[4 * g + 1]); wv.y = pk2(o0[4 * g + 2], o0[4 * g + 3]); *(v2u*)(dst + 8 * g) = wv;
        v2u u; u.x = pk2(o1[4 * g], o1[4 * g + 1]); u.y = pk2(o1[4 * g + 2], o1[4 * g + 3]); *(v2u*)(dst + 32 + 8 * g) = u;
    }
}

template <bool QUANT> __device__ __forceinline__ void ln_row(Frame& F, kap_t ka, int row, const float* g, const float* bb) {
    float* yr = ka->out + (size_t)row * DM;
    f32x4 v[4]; float s = 0.f;
#pragma unroll
    for (int j = 0; j < 4; ++j) { v[j] = *(const f32x4*)(yr + 4 * F.lane + 256 * j); s += (v[j].x + v[j].y) + (v[j].z + v[j].w); }
    const float mean = wave_sum_all(s, F.lane) * (1.f / DM); float s2 = 0.f;
#pragma unroll
    for (int j = 0; j < 4; ++j) { v[j] = v[j] - mean; s2 += (v[j].x * v[j].x + v[j].y * v[j].y) + (v[j].z * v[j].z + v[j].w * v[j].w); }
    const float rstd = rsqrtf(wave_sum_all(s2, F.lane) * (1.f / DM) + LN_EPS);
#pragma unroll
    for (int j = 0; j < 4; ++j) { const int c = 4 * F.lane + 256 * j; const f32x4 gg = *(const f32x4*)(g + c), bv = *(const f32x4*)(bb + c);
        const f32x4 o = v[j] * rstd * gg + bv; *(f32x4*)(yr + c) = o; v[j] = o;
        v2u w; w.x = pk2(o.x, o.y); w.y = pk2(o.z, o.w); *(v2u*)(wsp<bf16>(ka, WS_XB) + (size_t)row * DM + c) = w; }
    if (QUANT) {
        float xm = 0.f;
#pragma unroll
        for (int j = 0; j < 4; ++j) xm = fmaxf(xm, fmaxf(fmaxf(fabsf(v[j].x), fabsf(v[j].y)), fmaxf(fabsf(v[j].z), fabsf(v[j].w))));
        xm = wave_max_all(xm, F.lane);
        const float inv = xm > 0.f ? 127.f / xm : 0.f;
        unsigned char* xq = wsp<unsigned char>(ka, WS_XQ) + (size_t)row * DM;
#pragma unroll
        for (int j = 0; j < 4; ++j) *(unsigned*)(xq + 4 * F.lane + 256 * j) = ((unsigned)(int)rintf(v[j].x * inv) & 0xffu) | (((unsigned)(int)rintf(v[j].y * inv) & 0xffu) << 8) | (((unsigned)(int)rintf(v[j].z * inv) & 0xffu) << 16) | (((unsigned)(int)rintf(v[j].w * inv) & 0xffu) << 24);
        if (F.lane == 0) wsp<float>(ka, WS_SX)[row] = xm * (1.f / 127.f);
    }
}

template <int N, int K, int J, bool FLIP> __device__ __forceinline__ void bitonic_stage(unsigned (&v)[N]) {
#pragma unroll
    for (int i = 0; i < N; ++i) { const int p = i ^ J; if (p > i) { const bool desc = (((i & K) == 0) != FLIP); const unsigned a = v[i], c = v[p]; const unsigned mx = a > c ? a : c, mn = a > c ? c : a; v[i] = desc ? mx : mn; v[p] = desc ? mn : mx; } }
}
template <bool FLIP> __device__ __forceinline__ void bitonic_merge16(unsigned (&v)[16]) {
    bitonic_stage<16, 16, 8, FLIP>(v); bitonic_stage<16, 16, 4, FLIP>(v); bitonic_stage<16, 16, 2, FLIP>(v); bitonic_stage<16, 16, 1, FLIP>(v);
}
__device__ __forceinline__ unsigned ord_key(float f, unsigned idx) { const unsigned u = __float_as_uint(f); const unsigned o = u ^ ((unsigned)((int)u >> 31) | 0x80000000u); return (o & 0xFFFFFF80u) | idx; }
__device__ __forceinline__ float key_val(unsigned k) { const unsigned o = (k & 0xFFFFFF80u) | 0x40u; const unsigned u = (o & 0x80000000u) ? (o ^ 0x80000000u) : ~o; return __uint_as_float(u); }
template <int N, int K, int J, bool FLIP> __device__ __forceinline__ void bitonic_stage_kv(unsigned (&k)[N], unsigned (&p)[N]) {
#pragma unroll
    for (int i = 0; i < N; ++i) { const int q = i ^ J; if (q > i) { const bool desc = (((i & K) == 0) != FLIP); const bool sw = desc ? (k[i] < k[q]) : (k[i] > k[q]);
        const unsigned ki = sw ? k[q] : k[i], kq = sw ? k[i] : k[q], pi = sw ? p[q] : p[i], pq = sw ? p[i] : p[q]; k[i] = ki; k[q] = kq; p[i] = pi; p[q] = pq; } }
}
template <bool FLIP> __device__ __forceinline__ void bitonic_merge16_kv(unsigned (&k)[16], unsigned (&p)[16]) {
    bitonic_stage_kv<16, 16, 8, FLIP>(k, p); bitonic_stage_kv<16, 16, 4, FLIP>(k, p); bitonic_stage_kv<16, 16, 2, FLIP>(k, p); bitonic_stage_kv<16, 16, 1, FLIP>(k, p);
}
__device__ __forceinline__ void p7_half(Frame& F, kap_t ka, int l, int tok, int h, int c, unsigned (&Cc)[16]) {
    const int lane = F.lane, hi = lane >> 5;
    const bf16* qrow = wsp<bf16>(ka, WS_HB) + (size_t)tok * 2048 + h * 256 + c * 128 + 8 * hi;
    bf16x8 qf[8];
#pragma unroll
    for (int ks = 0; ks < 8; ++ks) qf[ks] = *(const bf16x8*)(qrow + ks * 16);
    const bf16* kb = wsp<bf16>(ka, WS_KEYS) + (size_t)((l * 8 + h) * 2 + c) * 16384 + 8 * lane;
    unsigned key[64];
#pragma unroll
    for (int ch = 0; ch < 4; ++ch) {
        f32x16 acc = {};
#pragma unroll
        for (int ks = 0; ks < 8; ++ks) acc = __builtin_amdgcn_mfma_f32_32x32x16_bf16(*(const bf16x8*)(kb + (ch * 8 + ks) * 512), qf[ks], acc, 0, 0, 0);
#pragma unroll
        for (int r = 0; r < 16; ++r) key[ch * 16 + r] = ord_key(acc[r], (unsigned)(ch * 32 + crow(r, hi)));
    }
    bitonic_stage<64, 2, 1, false>(key);
    bitonic_stage<64, 4, 2, false>(key); bitonic_stage<64, 4, 1, false>(key);
    bitonic_stage<64, 8, 4, false>(key); bitonic_stage<64, 8, 2, false>(key); bitonic_stage<64, 8, 1, false>(key);
    bitonic_stage<64, 16, 8, false>(key); bitonic_stage<64, 16, 4, false>(key); bitonic_stage<64, 16, 2, false>(key); bitonic_stage<64, 16, 1, false>(key);
    unsigned A[16], B[16];
#pragma unroll
    for (int i = 0; i < 16; ++i) { A[i] = key[i] > key[16 + i] ? key[i] : key[16 + i]; B[i] = key[32 + i] > key[48 + i] ? key[32 + i] : key[48 + i]; }
    bitonic_merge16<false>(A);
    bitonic_merge16<true>(B);
#pragma unroll
    for (int i = 0; i < 16; ++i) A[i] = A[i] > B[i] ? A[i] : B[i];
    bitonic_merge16<false>(A);
#pragma unroll
    for (int i = 0; i < 16; ++i) B[i] = (unsigned)shx_i((int)A[i], 32, lane);
#pragma unroll
    for (int i = 0; i < 16; ++i) Cc[i] = A[i] > B[15 - i] ? A[i] : B[15 - i];
    bitonic_merge16<false>(Cc);
}
__device__ __forceinline__ void p7_unit(Frame& F, kap_t ka, int l, int tb, int h) {
    const int lane = F.lane, r32 = lane & 31, hi = lane >> 5;
    const int tok = tb * 32 + r32;
    unsigned L0[16], L1[16];
#pragma unroll
    for (int i = 0; i < 16; ++i) { L0[i] = 0u; L1[i] = 0u; }
#pragma unroll 1
    for (int c = 0; c < 2; ++c) {
        unsigned Cc[16];
        p7_half(F, ka, l, tok, h, c, Cc);
#pragma unroll
        for (int i = 0; i < 16; ++i) { L0[i] = c == 0 ? Cc[i] : L0[i]; L1[i] = c == 0 ? L1[i] : Cc[i]; }
    }
    __builtin_amdgcn_sched_barrier(0);
    unsigned key[64];
    {
        float v0[16], v1[16];
#pragma unroll
        for (int i = 0; i < 16; ++i) { v0[i] = key_val(L0[i]); v1[i] = key_val(L1[i]); }
#define P7_ROW(a, off, nb) { _Pragma("unroll") for (int b2 = 0; b2 < (nb); ++b2) { \
            const float sum = v0[a] + v1[b2]; const unsigned u = __float_as_uint(sum); const unsigned o = u ^ ((unsigned)((int)u >> 31) | 0x80000000u); \
            key[(off) + b2] = (o & 0xFFFFFF00u) | (unsigned)(255 - (16 * (a) + b2)); } }
        P7_ROW(0, 0, 16) P7_ROW(1, 16, 8) P7_ROW(2, 24, 5) P7_ROW(3, 29, 4) P7_ROW(4, 33, 3) P7_ROW(5, 36, 2) P7_ROW(6, 38, 2) P7_ROW(7, 40, 2)
        P7_ROW(8, 42, 1) P7_ROW(9, 43, 1) P7_ROW(10, 44, 1) P7_ROW(11, 45, 1) P7_ROW(12, 46, 1) P7_ROW(13, 47, 1) P7_ROW(14, 48, 1) P7_ROW(15, 49, 1)
#undef P7_ROW
#pragma unroll
        for (int i = 50; i < 64; ++i) key[i] = 0u;
    }
    LAS unsigned char* slot = F.lds + RING_OFF + F.wave * 2304 + lane * 36;
#pragma unroll
    for (int q = 0; q < 4; ++q) {
        ((LAS unsigned*)slot)[q] = (L0[4 * q] & 127u) | ((L0[4 * q + 1] & 127u) << 8) | ((L0[4 * q + 2] & 127u) << 16) | ((L0[4 * q + 3] & 127u) << 24);
        ((LAS unsigned*)slot)[4 + q] = (L1[4 * q] & 127u) | ((L1[4 * q + 1] & 127u) << 8) | ((L1[4 * q + 2] & 127u) << 16) | ((L1[4 * q + 3] & 127u) << 24);
    }
    bitonic_stage<64, 2, 1, false>(key);
    bitonic_stage<64, 4, 2, false>(key); bitonic_stage<64, 4, 1, false>(key);
    bitonic_stage<64, 8, 4, false>(key); bitonic_stage<64, 8, 2, false>(key); bitonic_stage<64, 8, 1, false>(key);
    bitonic_stage<64, 16, 8, false>(key); bitonic_stage<64, 16, 4, false>(key); bitonic_stage<64, 16, 2, false>(key); bitonic_stage<64, 16, 1, false>(key);
    unsigned A[16], B[16];
#pragma unroll
    for (int i = 0; i < 16; ++i) { A[i] = key[i] > key[16 + i] ? key[i] : key[16 + i]; B[i] = key[32 + i] > key[48 + i] ? key[32 + i] : key[48 + i]; }
    bitonic_merge16<false>(A);
    bitonic_merge16<true>(B);
#pragma unroll
    for (int i = 0; i < 16; ++i) A[i] = A[i] > B[i] ? A[i] : B[i];
    bitonic_merge16<false>(A);
    LDS_WAIT(); asm volatile("" ::: "memory");
    unsigned PA[16]; float g[16], den = 0.f;
    { const unsigned o0 = (A[0] & 0xFFFFFF00u) | 128u; const float m = __uint_as_float((o0 & 0x80000000u) ? (o0 ^ 0x80000000u) : ~o0);
#pragma unroll
      for (int i = 0; i < 16; ++i) { const unsigned o = (A[i] & 0xFFFFFF00u) | 128u; const float sv = __uint_as_float((o & 0x80000000u) ? (o ^ 0x80000000u) : ~o); g[i] = __expf(sv - m); den += g[i];
          const unsigned flat = 255u - (A[i] & 255u); PA[i] = (unsigned)slot[flat >> 4] * 128u + (unsigned)slot[16 + (flat & 15u)]; } }
    LDS_WAIT(); asm volatile("" ::: "memory");
    const float rden = 1.f / den;
    if (hi == 0) {
        unsigned* de = wsp<unsigned>(ka, WS_EL) + (size_t)tok * 128 + h * 16; float* dg = wsp<float>(ka, WS_GL) + (size_t)tok * 128 + h * 16;
#pragma unroll
        for (int q = 0; q < 4; ++q) { *(v4u*)(de + 4 * q) = (v4u){PA[4 * q], PA[4 * q + 1], PA[4 * q + 2], PA[4 * q + 3]};
            *(f32x4*)(dg + 4 * q) = (f32x4){g[4 * q] * rden, g[4 * q + 1] * rden, g[4 * q + 2] * rden, g[4 * q + 3] * rden}; }
    }
}

__device__ __forceinline__ float dot2_bf16(unsigned w, unsigned x, float acc) { return __builtin_amdgcn_fdot2_f32_bf16(__builtin_bit_cast(bf2_t, w), __builtin_bit_cast(bf2_t, x), acc, false); }
__device__ __forceinline__ float gelu_erf(float v) {
    const float av = fabsf(v), t = __builtin_amdgcn_rcpf(av * 0.2316418882f + 1.0f);
    float q = t * 0.5307027145f + (-0.7265760135f); q = q * t + 0.7107068705f; q = q * t + (-0.142248368f); q = q * t + 0.127414796f; q = q * t;
    const float e = __builtin_amdgcn_exp2f((v * v) * (-0.72134752044f));
    const float m = v * (q * e);
    return v < 0.f ? m : v - m;
}
__device__ __forceinline__ void p8a_token(Frame& F, kap_t ka, int l, int tok, unsigned part, const unsigned ev0, const unsigned ev1, const float gv0, const float gv1, const v4u (&x4)[4], const float sx, LAS unsigned* qu, LAS int* res) {
    const int lane = F.lane, qd = lane >> 4, i16 = lane & 15;
    const bool in0 = (ev0 >> 11) == part, in1 = (ev1 >> 11) == part;
    const f32x2* SUV = wsp<f32x2>(ka, WS_SUV) + (size_t)l * NEXP;
    f32x2 sc0 = {0.f, 0.f}, sc1 = {0.f, 0.f};
    if (in0) sc0 = SUV[ev0];
    if (in1) sc1 = SUV[ev1];
    const unsigned long long m0 = __ballot(in0), m1 = __ballot(in1);
    const int n0 = __builtin_popcountll(m0), N = n0 + __builtin_popcountll(m1);
    if (in0) qu[__builtin_amdgcn_mbcnt_hi((unsigned)(m0 >> 32), __builtin_amdgcn_mbcnt_lo((unsigned)m0, 0u))] = ev0 | ((unsigned)lane << 16);
    if (in1) qu[n0 + __builtin_amdgcn_mbcnt_hi((unsigned)(m1 >> 32), __builtin_amdgcn_mbcnt_lo((unsigned)m1, 0u))] = ev1 | ((unsigned)(64 + lane) << 16);
    if (lane < 4) qu[N + lane] = (part << 11) | (128u << 16);
    LDS_WAIT(); asm volatile("" ::: "memory");
    const unsigned char* UQ = wsp<unsigned char>(ka, WS_UT) + (size_t)l * NEXP * DM;
    const unsigned loff = 16u * (unsigned)i16;
    for (int g0 = 0; g0 < N; g0 += 24) {
        v4u buf[6][4]; unsigned ent[6];
#pragma unroll
        for (int gi = 0; gi < 6; ++gi) if (g0 + 4 * gi < N) { ent[gi] = qu[g0 + 4 * gi + qd]; const unsigned ro = ((ent[gi] & 0xffffu) << 10) + loff;
#pragma unroll
            for (int c = 0; c < 4; ++c) buf[gi][c] = *(const v4u*)(UQ + (ro + 256u * c)); }
#pragma unroll
        for (int gi = 0; gi < 6; ++gi) if (g0 + 4 * gi < N) { int p = 0;
#pragma unroll
            for (int c = 0; c < 4; ++c) { p = __builtin_amdgcn_sdot4((int)buf[gi][c].x, (int)x4[c].x, p, false); p = __builtin_amdgcn_sdot4((int)buf[gi][c].y, (int)x4[c].y, p, false);
                p = __builtin_amdgcn_sdot4((int)buf[gi][c].z, (int)x4[c].z, p, false); p = __builtin_amdgcn_sdot4((int)buf[gi][c].w, (int)x4[c].w, p, false); }
            p += __builtin_amdgcn_update_dpp(0, p, 0xB1, 0xF, 0xF, true); p += __builtin_amdgcn_update_dpp(0, p, 0x4E, 0xF, 0xF, true);
            p += __builtin_amdgcn_update_dpp(0, p, 0x141, 0xF, 0xF, true); p += __builtin_amdgcn_update_dpp(0, p, 0x140, 0xF, 0xF, true);
            asm volatile("" : "+v"(p));
            if (i16 == 0) res[ent[gi] >> 16] = p; }
    }
    LDS_WAIT(); asm volatile("" ::: "memory");
    float* AC = wsp<float>(ka, WS_AC) + (size_t)tok * 128;
    if (in0) AC[lane] = gv0 * gelu_erf((float)res[lane] * (sc0.x * sx)) * sc0.y;
    if (in1) AC[64 + lane] = gv1 * gelu_erf((float)res[64 + lane] * (sc1.x * sx)) * sc1.y;
    LDS_WAIT(); asm volatile("" ::: "memory");
}
__device__ __forceinline__ void p8b_pair(Frame& F, kap_t ka, int l, int tokA, int tokB, bool storeB, unsigned part, const v4u ev, const f32x4 av, float* ybase, LAS unsigned* le, LAS unsigned* la8) {
    const int lane = F.lane, tk = lane >> 5, g = (lane >> 3) & 3, c = lane & 7, l32 = lane & 31;
    const int tok = tk ? tokB : tokA;
    const float* yrow = ka->out + (size_t)tok * DM + 128 * part + 16 * c;
    f32x4 xv[4] = {};
    if (g == 0) {
#pragma unroll
        for (int q = 0; q < 4; ++q) xv[q] = *(const f32x4*)(yrow + 4 * q);
    }
    float am = fmaxf(fmaxf(fabsf(av.x), fabsf(av.y)), fmaxf(fabsf(av.z), fabsf(av.w)));
    am = fmaxf(am, dpp_f<0xB1>(am)); am = fmaxf(am, dpp_f<0x4E>(am)); am = fmaxf(am, dpp_f<0x141>(am)); am = fmaxf(am, dpp_f<0x140>(am)); am = fmaxf(am, shx_f(am, 16, lane));
    const float inv = am > 0.f ? 127.f / am : 0.f, sa = am * (1.f / 127.f);
    *(LAS v4u*)(le + tk * 128 + 4 * l32) = ev;
    la8[tk * 32 + l32] = ((unsigned)(int)rintf(av.x * inv) & 0xffu) | (((unsigned)(int)rintf(av.y * inv) & 0xffu) << 8) | (((unsigned)(int)rintf(av.z * inv) & 0xffu) << 16) | (((unsigned)(int)rintf(av.w * inv) & 0xffu) << 24);
    LDS_WAIT(); asm volatile("" ::: "memory");
    const unsigned char* VQ = wsp<unsigned char>(ka, WS_VT) + (size_t)l * NEXP * DM + (size_t)part * NEXP * 128;
    const unsigned loff = 16u * (unsigned)c;
    const LAS unsigned* lek = le + tk * 128 + 4 * g;
    v4u R[32];
#pragma unroll
    for (int i = 0; i < 32; ++i) R[i] = *(const v4u*)(VQ + ((lek[16 * (i >> 2) + (i & 3)] << 7) + loff));
    int acc[16];
#pragma unroll
    for (int i = 0; i < 16; ++i) acc[i] = 0;
#pragma unroll
    for (int m = 0; m < 8; ++m) {
        const int ap = (int)la8[tk * 32 + 4 * m + g];
#pragma unroll
        for (int d = 0; d < 4; ++d) {
            const unsigned r0 = R[4 * m][d], r1 = R[4 * m + 1][d], r2 = R[4 * m + 2][d], r3 = R[4 * m + 3][d];
            const unsigned t01l = __builtin_amdgcn_perm(r1, r0, 0x05010400u), t01h = __builtin_amdgcn_perm(r1, r0, 0x07030602u);
            const unsigned t23l = __builtin_amdgcn_perm(r3, r2, 0x05010400u), t23h = __builtin_amdgcn_perm(r3, r2, 0x07030602u);
            acc[4 * d] = __builtin_amdgcn_sdot4((int)__builtin_amdgcn_perm(t23l, t01l, 0x05040100u), ap, acc[4 * d], false);
            acc[4 * d + 1] = __builtin_amdgcn_sdot4((int)__builtin_amdgcn_perm(t23l, t01l, 0x07060302u), ap, acc[4 * d + 1], false);
            acc[4 * d + 2] = __builtin_amdgcn_sdot4((int)__builtin_amdgcn_perm(t23h, t01h, 0x05040100u), ap, acc[4 * d + 2], false);
            acc[4 * d + 3] = __builtin_amdgcn_sdot4((int)__builtin_amdgcn_perm(t23h, t01h, 0x07060302u), ap, acc[4 * d + 3], false);
        }
    }
#pragma unroll
    for (int i = 0; i < 16; ++i) { acc[i] += shx_i(acc[i], 8, lane); acc[i] += shx_i(acc[i], 16, lane); }
    if (g == 0 && (tk == 0 || storeB)) {
        float* yd = ybase + (size_t)tok * DM + 128 * part + 16 * c;
#pragma unroll
        for (int q = 0; q < 4; ++q) { const f32x4 x = xv[q];
            *(f32x4*)(yd + 4 * q) = (f32x4){ALPHA * x.x + (float)acc[4 * q] * sa, ALPHA * x.y + (float)acc[4 * q + 1] * sa, ALPHA * x.z + (float)acc[4 * q + 2] * sa, ALPHA * x.w + (float)acc[4 * q + 3] * sa}; }
    }
    LDS_WAIT(); asm volatile("" ::: "memory");
}

__global__ void __launch_bounds__(NTHREADS, 2) mk_fwd(Args args) {
    extern __shared__ __attribute__((aligned(16))) unsigned char lds[];
    Frame F;
    F.lds = (LAS unsigned char*)lds;
    F.MISC = (volatile LAS unsigned*)(F.lds + MISC_OFF);
    F.tid = threadIdx.x; F.lane = F.tid & 63; F.wave = __builtin_amdgcn_readfirstlane(F.tid >> 6);
    F.G = gridDim.x; { const int bx = blockIdx.x; F.vcu = (F.G % 8 == 0) ? (bx % 8) * (F.G / 8) + bx / 8 : bx; }
    for (int u = F.tid; u < (LDS_BYTES - LDSCTL_OFF) / 4; u += NTHREADS) ((LAS unsigned*)(F.lds + LDSCTL_OFF))[u] = 0u;
    __syncthreads();
    const int lo = args.ph_lo, hi = args.ph_hi;
    unsigned* const barw = (unsigned*)(args.ws + WS_CTL) + CW_BAR;
    const bool one_phase = (hi - lo) == 1;
    XcdBarrier bar; bar.bar = barw; bar.x = 0; bar.st = nullptr;
    if (!one_phase) bar = xcd_barrier_post(barw, F.MISC + 8);
#ifndef MK_EN
#define MK_EN 0x7ff
#endif
#ifndef MK_MLA_LDS
#define MK_MLA_LDS 0
#endif
#ifndef MK_MLA_REP
#define MK_MLA_REP 1
#endif
#ifndef MK_SB_REP
#define MK_SB_REP 1
#endif
#ifndef MK_P8B_VAR
#define MK_P8B_VAR 0
#endif
#define EN(n) (((MK_EN) >> (n)) & 1)
#ifndef MK_REP
#define MK_REP 0
#endif
#define PHASE_REP(n) for (int rep_ = 0; rep_ < ((((MK_REP) >> (n)) & 1) + 1); ++rep_)
#define IN(k) (lo <= (k) && (k) < hi)
#define PHASE_IDS() do { unsigned z_ = 0u; asm volatile("" : "+v"(z_)); const int ln_ = (int)__builtin_amdgcn_mbcnt_hi(~0u, __builtin_amdgcn_mbcnt_lo(~0u, z_)); F.lane = ln_; F.tid = F.wave * 64 + ln_; } while (0)
#define SEAM(k) do { if (IN((k) + 1)) { XcdBarrier b_ = bar; asm volatile("" : "+s"(b_.bar), "+s"(b_.x));     xcd_barrier(b_); } } while (0)
    const int gw = F.vcu * NWAVES + F.wave, NGW = F.G * NWAVES;

    if (EN(0) && IN(0)) PHASE_REP(0) { PHASE_IDS(); p0_prologue(F, ka_fresh()); SEAM(0); }
#pragma unroll
    for (int l = 0; l < DEPTH; ++l) {
        const int pb = 1 + NPL * l;
        if (EN(1) && IN(pb + 0)) PHASE_REP(1) { const kap_t ka = ka_fresh(); PHASE_IDS();
            pg8::Gemm g{wsp<bf16>(ka, WS_XB), wsp<bf16>(ka, WS_WIT) + (size_t)l * DINP * DM, NTOK, DINP, DM}; pg8::StaticOrder S; S.init(NTOK, DINP, F.G, (int)blockIdx.x);
            pg8::EpiBf16<0> E{wsp<bf16>(ka, WS_HB), DINP, nullptr, 0, 0, 1.f};
            pg8::gemm_phase<pg8::EpiBf16<0>, pg8::StaticOrder, PG8_ALIGN, PG8_SP2>(F.lds + RING_OFF, g, S, E, F.tid);
            SEAM(pb + 0);
        }
        if (EN(2) && IN(pb + 1)) PHASE_REP(2) { const kap_t ka = ka_fresh(); PHASE_IDS();
            for (int u = gw; u < (NTOK / 32) * 4; u += NGW) p2_unit(F, ka, l, u >> 2, u & 3);
            SEAM(pb + 1);
        }
        if (EN(3) && IN(pb + 2)) PHASE_REP(3) { const kap_t ka = ka_fresh(); PHASE_IDS();
#if MK_MLA_LDS
            for (int u = F.vcu; u < 32 * 8; u += F.G) {
                const int bh = u >> 3, j = u & 7;
                mla_block(F, ka, bh, 15 - j); sb_unit(F, ka, bh, 8 * (15 - j) + F.wave);
                mla_block(F, ka, bh, j); sb_unit(F, ka, bh, 8 * j + F.wave);
            }
#else
            for (int u = gw; u < 32 * 64; u += NGW) {
                const int bh = u >> 6, pi = u & 63;
                for (int r_ = 0; r_ < MK_MLA_REP; ++r_) { mla_unit(F, ka, bh, 127 - pi); mla_unit(F, ka, bh, pi); }
            }
            PHASE_IDS();
            for (int u = gw; u < 32 * 64; u += NGW) {
                const int bh = u >> 6, pi = u & 63;
                for (int r_ = 0; r_ < MK_SB_REP; ++r_) { sb_unit(F, ka, bh, 127 - pi); sb_unit(F, ka, bh, pi); }
            }
#endif
            SEAM(pb + 2);
        }
        if (EN(4) && IN(pb + 3)) PHASE_REP(4) { const kap_t ka = ka_fresh(); PHASE_IDS();
            pg8::Gemm g{wsp<bf16>(ka, WS_OB), wsp<bf16>(ka, WS_WOT) + (size_t)l * DM * DM, NTOK, DM, DM}; pg8::StaticOrder S; S.init(NTOK, DM, F.G, (int)blockIdx.x);
            pg8::EpiResF32 E{l == 0 ? ka->in[I_X] : ka->out, ka->out, DM, ALPHA};
            pg8::gemm_phase<pg8::EpiResF32, pg8::StaticOrder, PG8_ALIGN, PG8_SP2>(F.lds + RING_OFF, g, S, E, F.tid);
            SEAM(pb + 3);
        }
        if (EN(5) && IN(pb + 4)) PHASE_REP(5) { const kap_t ka = ka_fresh(); PHASE_IDS();
            for (int r = gw; r < NTOK; r += NGW) ln_row<true>(F, ka, r, ka->in[I_LN1G] + l * DM, ka->in[I_LN1B] + l * DM);
            SEAM(pb + 4);
        }
        if (EN(6) && IN(pb + 5)) PHASE_REP(6) { const kap_t ka = ka_fresh(); PHASE_IDS();
            pg8::Gemm g{wsp<bf16>(ka, WS_XB), wsp<bf16>(ka, WS_WQT) + (size_t)l * 2048 * DM, NTOK, 2048, DM}; pg8::StaticOrder S; S.init(NTOK, 2048, F.G, (int)blockIdx.x);
            pg8::EpiBf16<0> E{wsp<bf16>(ka, WS_HB), 2048, nullptr, 0, 0, 1.f};
            pg8::gemm_phase<pg8::EpiBf16<0>, pg8::StaticOrder, PG8_ALIGN, PG8_SP2>(F.lds + RING_OFF, g, S, E, F.tid);
            SEAM(pb + 5);
        }
        if (EN(7) && IN(pb + 6)) PHASE_REP(7) { const kap_t ka = ka_fresh(); PHASE_IDS();
            for (int u = gw; u < (NTOK / 32) * 8; u += NGW) p7_unit(F, ka, l, u >> 3, u & 7);
            SEAM(pb + 6);
        }
        if (EN(8) && IN(pb + 7)) PHASE_REP(8) { const kap_t ka = ka_fresh(); PHASE_IDS();
            const bool split = (F.G % 8 == 0); const int npp = split ? F.G / 8 : F.G;
            for (unsigned part = split ? (unsigned)(F.vcu / npp) : 0u, pend = split ? part + 1u : 8u; part < pend; ++part) {
                const int pw = (F.vcu % npp) * NWAVES + F.wave, npw = npp * NWAVES;
                const unsigned* EL = wsp<unsigned>(ka, WS_EL) + F.lane; const float* GL = wsp<float>(ka, WS_GL) + F.lane;
                const unsigned char* XQ = wsp<unsigned char>(ka, WS_XQ) + 16 * (F.lane & 15); const float* SX = wsp<float>(ka, WS_SX);
                unsigned e0 = 0u, e1 = 0u; float g0 = 0.f, g1 = 0.f, sx = 0.f; v4u x4[4] = {};
                if (pw < NTOK) { e0 = EL[(size_t)pw * 128]; e1 = EL[(size_t)pw * 128 + 64]; g0 = GL[(size_t)pw * 128]; g1 = GL[(size_t)pw * 128 + 64]; sx = SX[pw];
#pragma unroll
                    for (int c = 0; c < 4; ++c) x4[c] = *(const v4u*)(XQ + (size_t)pw * DM + 256 * c); }
                for (int t = pw; t < NTOK; t += npw) {
                    unsigned ne0 = 0u, ne1 = 0u; float ng0 = 0.f, ng1 = 0.f, nsx = 0.f; v4u nx4[4] = {};
                    if (t + npw < NTOK) { const size_t o = (size_t)(t + npw) * 128; ne0 = EL[o]; ne1 = EL[o + 64]; ng0 = GL[o]; ng1 = GL[o + 64]; nsx = SX[t + npw];
#pragma unroll
                        for (int c = 0; c < 4; ++c) nx4[c] = *(const v4u*)(XQ + (size_t)(t + npw) * DM + 256 * c); }
                    p8a_token(F, ka, l, t, part, e0, e1, g0, g1, x4, sx, (LAS unsigned*)(F.lds + RING_OFF + F.wave * 2048), (LAS int*)(F.lds + RING_OFF + F.wave * 2048 + 1024));
                    e0 = ne0; e1 = ne1; g0 = ng0; g1 = ng1; sx = nsx;
#pragma unroll
                    for (int c = 0; c < 4; ++c) x4[c] = nx4[c];
                }
            }
            SEAM(pb + 7);
        }
        if (EN(9) && IN(pb + 8)) PHASE_REP(9) { const kap_t ka = ka_fresh(); PHASE_IDS();
            const bool split = (F.G % 8 == 0); const int npp = split ? F.G / 8 : F.G;
            for (unsigned part = split ? (unsigned)(F.vcu / npp) : 0u, pend = split ? part + 1u : 8u; part < pend; ++part) {
                const int pw = (F.vcu % npp) * NWAVES + F.wave, npw = npp * NWAVES;
                LAS unsigned* le = (LAS unsigned*)(F.lds + RING_OFF + F.wave * 2048); LAS unsigned* la8 = (LAS unsigned*)(F.lds + RING_OFF + F.wave * 2048 + 1024);
                float* ybase = (rep_ == 0) ? ka->out : (float*)wsp<bf16>(ka, WS_HB);
                const int tk = F.lane >> 5, l32 = F.lane & 31;
                const unsigned* EL = wsp<unsigned>(ka, WS_EL) + 4 * l32; const float* AC = wsp<float>(ka, WS_AC) + 4 * l32;
                v4u ev = {}; f32x4 av = {};
                { const int t0 = pw + tk * npw; if (pw < NTOK) { const int tt = t0 < NTOK ? t0 : pw; ev = *(const v4u*)(EL + (size_t)tt * 128); av = *(const f32x4*)(AC + (size_t)tt * 128); } }
                for (int t = pw; t < NTOK; t += 2 * npw) {
                    const int tB = t + npw; const bool hasB = tB < NTOK;
                    v4u nev = {}; f32x4 nav = {};
                    if (t + 2 * npw < NTOK) { const int t0 = t + 2 * npw + tk * npw; const int tt = t0 < NTOK ? t0 : t + 2 * npw; nev = *(const v4u*)(EL + (size_t)tt * 128); nav = *(const f32x4*)(AC + (size_t)tt * 128); }
                    p8b_pair(F, ka, l, t, hasB ? tB : t, hasB, part, ev, av, ybase, le, la8);
                    ev = nev; av = nav;
                }
            }
            SEAM(pb + 8);
        }
        if (EN(10) && IN(pb + 9)) PHASE_REP(10) { const kap_t ka = ka_fresh(); PHASE_IDS();
            for (int r = gw; r < NTOK; r += NGW) ln_row<false>(F, ka, r, ka->in[I_LN2G] + l * DM, ka->in[I_LN2B] + l * DM);
            if (l + 1 < DEPTH) SEAM(pb + 9);
        }
    }
#undef IN
#undef SEAM
}

#ifndef MK_PER_PHASE
#define MK_PER_PHASE 0
#endif
extern "C" void kernel_launch(void* const* d_in, const int* in_sizes, int n_in, void* d_out, int out_size, void* d_ws, size_t ws_size, hipStream_t stream) {
    static int grid = 0;
    if (grid == 0) {
        if (n_in != 15 || out_size != NTOK * DM || ws_size < WS_END) { fprintf(stderr, "kernel_launch: unexpected shapes (n_in %d, out %d, ws %zu); nothing launched\n", n_in, out_size, ws_size); grid = -1; return; }
        int dev = 0, cus = 0, per_cu = 0;
        if (hipGetDevice(&dev) != hipSuccess || hipDeviceGetAttribute(&cus, hipDeviceAttributeMultiprocessorCount, dev) != hipSuccess) { fprintf(stderr, "kernel_launch: device query failed\n"); grid = -1; return; }
        if (hipFuncSetAttribute((const void*)mk_fwd, hipFuncAttributeMaxDynamicSharedMemorySize, LDS_BYTES) != hipSuccess) { fprintf(stderr, "kernel_launch: hipFuncSetAttribute failed\n"); grid = -1; return; }
        if (hipOccupancyMaxActiveBlocksPerMultiprocessor(&per_cu, (const void*)mk_fwd, NTHREADS, LDS_BYTES) != hipSuccess || per_cu < 1) { fprintf(stderr, "kernel_launch: occupancy query says %d blocks per CU\n", per_cu); per_cu = 1; }
        (void)hipGetLastError();
        grid = cus;
        fprintf(stderr, "kernel_launch: grid %d (occupancy query %d per CU)\n", grid, per_cu);
    }
    if (grid < 0) return;
    (void)hipMemsetAsync((char*)d_ws + WS_CTL, 0, CTL_ZERO_BYTES, stream);
    Args a{};
    for (int i = 0; i < 15; ++i) a.in[i] = (const float*)d_in[i];
    a.out = (float*)d_out; a.ws = (unsigned char*)d_ws;
#if MK_PER_PHASE
    for (int p = 0; p < NPHASE; ++p) { a.ph_lo = p; a.ph_hi = p + 1; hipLaunchKernelGGL(mk_fwd, dim3(grid), dim3(NTHREADS), LDS_BYTES, stream, a); }
#else
    a.ph_lo = 0; a.ph_hi = NPHASE;
    void* kargs[] = {&a};
    const hipError_t e = hipLaunchCooperativeKernel((const void*)mk_fwd, dim3(grid), dim3(NTHREADS), kargs, LDS_BYTES, stream);
    if (e != hipSuccess) fprintf(stderr, "kernel_launch: cooperative launch failed: %s (grid %d)\n", hipGetErrorString(e), grid);
#endif
}
```

```cpp
#include <hip/hip_runtime.h>
#include <cstdio>
#include <cstdint>
#include <math.h>
namespace pg8 {
#define PG8_LAS __attribute__((address_space(3)))
typedef unsigned short bf16_t;
typedef short bf16x8 __attribute__((ext_vector_type(8)));
typedef float f32x4 __attribute__((ext_vector_type(4)));
typedef unsigned u32x4 __attribute__((ext_vector_type(4)));
constexpr int BM = 256, BK = 64, HALF = 128, HTB = HALF * BK * 2  , STAGE_BYTES = 8 * HTB, NXCD = 8, WGM = 8;

__host__ __device__ __forceinline__ int lds_byte(int r, int c) { const int st = (r >> 4) * 2 + (c >> 5), rr = r & 15, cc = c & 31, ob = rr * 64 + cc * 2; return st * 1024 + (ob ^ (((ob >> 9) & 1) << 5)); }
__host__ __device__ __forceinline__ void stage_rc(int b, int& R, int& C) { const int st = b / 1024, sb = b % 1024, swz = sb ^ (((sb >> 9) & 1) << 5); R = (st >> 1) * 16 + swz / 64; C = (st & 1) * 32 + (swz % 64) / 2; }
__host__ __device__ __forceinline__ int perm32(int rho) { const int n = rho >> 4, i = rho & 15; return 8 * (i >> 2) + 4 * n + (i & 3); }

struct Unit { int pm, pn; };
struct Gemm { const bf16_t* A; const bf16_t* Bt; int M, N, K; };

struct StaticOrder {
    int nM, nN, nwg, G, c;
    __host__ __device__ void init(int M, int N, int G_, int c_) { nM = M / BM; nN = N / BM; nwg = nM * nN; G = G_; c = c_; }
    __host__ __device__ bool next(int i, Unit& u) const {
        const long L = (long)i * G + c; if (L >= nwg) return false;
        int wgid = (int)L; { const int q = nwg / NXCD, r = nwg % NXCD, xcd = wgid % NXCD, off = wgid / NXCD; wgid = (xcd < r ? xcd * (q + 1) : r * (q + 1) + (xcd - r) * q) + off; }
        const int nig = WGM * nN, gid = wgid / nig, fm = gid * WGM, gsz = (nM - fm) < WGM ? (nM - fm) : WGM;
        u.pm = fm + ((wgid % nig) % gsz); u.pn = (wgid % nig) / gsz; return true;
    }
    __device__ __forceinline__ void a_ready(const Unit&) const {}
    __device__ __forceinline__ void done(const Unit&) const {}
};

__device__ __forceinline__ unsigned cvt_pk_bf16(float lo, float hi) { unsigned r; asm volatile("v_cvt_pk_bf16_f32 %0, %1, %2" : "=v"(r) : "v"(lo), "v"(hi)); return r; }
typedef float f32x2 __attribute__((ext_vector_type(2)));
__device__ __forceinline__ f32x2 gelu_pk(f32x2 v) {
    const f32x2 av = __builtin_elementwise_abs(v), d = av * 0.2316418882f + 1.0f;
    f32x2 t; t.x = __builtin_amdgcn_rcpf(d.x); t.y = __builtin_amdgcn_rcpf(d.y);
    f32x2 q = t * 0.5307027145f + (-0.7265760135f); q = q * t + 0.7107068705f; q = q * t + (-0.142248368f); q = q * t + 0.127414796f; q = q * t;
    const f32x2 s = (v * v) * (-0.72134752044f);
    f32x2 e; e.x = __builtin_amdgcn_exp2f(s.x); e.y = __builtin_amdgcn_exp2f(s.y);
    const f32x2 m = v * (q * e), r = v - m;
    f32x2 o; o.x = v.x < 0.f ? m.x : r.x; o.y = v.y < 0.f ? m.y : r.y; return o;
}

template <int ACT  > struct EpiBf16 {
    static constexpr bool PERM = true, AFTER_DRAIN = false; static_assert(ACT == 0 || ACT == 1, "EpiBf16: ACT is 0 (none) or 1 (gelu_pk)");
    bf16_t* O; int ldc; const float* bias; int split_cols; size_t split_stride; float scale0;
    __device__ __forceinline__ void operator()(const f32x4 (&acc)[2][2][4][2], const Unit& u, int wr, int wc, int fr, int fq) const {
        const int row0 = u.pm * BM + wr * 64 + fr; int colt = u.pn * BM; bf16_t* base = O;
        float sc = 1.f; if (split_cols) { const int t = colt / split_cols; base += (size_t)t * split_stride; colt -= t * split_cols; if (t == 0) sc = scale0; }
        const int col0 = colt + wc * 32 + 8 * fq, bcol0 = u.pn * BM + wc * 32 + 8 * fq;
        f32x4 bv[2][2];
#pragma unroll
        for (int bj = 0; bj < 2; ++bj)
#pragma unroll
            for (int n = 0; n < 2; ++n) bv[bj][n] = bias ? *(const f32x4*)(bias + bcol0 + bj * HALF + 4 * n) : (f32x4){0.f, 0.f, 0.f, 0.f};
#pragma unroll
        for (int ai = 0; ai < 2; ++ai)
#pragma unroll
            for (int m = 0; m < 4; ++m) { bf16_t* rowp = base + (size_t)(row0 + ai * HALF + m * 16) * ldc + col0;
#pragma unroll
                for (int bj = 0; bj < 2; ++bj) { f32x4 v0 = acc[ai][bj][m][0] + bv[bj][0], v1 = acc[ai][bj][m][1] + bv[bj][1];
                    if (ACT == 1) { f32x2 a = gelu_pk((f32x2){v0[0], v0[1]}), b = gelu_pk((f32x2){v0[2], v0[3]}), c = gelu_pk((f32x2){v1[0], v1[1]}), d = gelu_pk((f32x2){v1[2], v1[3]});
                        v0 = (f32x4){a.x, a.y, b.x, b.y}; v1 = (f32x4){c.x, c.y, d.x, d.y}; }
                    v0 = v0 * sc; v1 = v1 * sc; u32x4 w; w.x = cvt_pk_bf16(v0[0], v0[1]); w.y = cvt_pk_bf16(v0[2], v0[3]); w.z = cvt_pk_bf16(v1[0], v1[1]); w.w = cvt_pk_bf16(v1[2], v1[3]);
                    *(u32x4*)(rowp + bj * HALF) = w; } }
    }
};
struct EpiResF32 {
    static constexpr bool PERM = false, AFTER_DRAIN = false;
    const float* res; float* out; int ldc; float alpha;
    __device__ __forceinline__ void operator()(const f32x4 (&acc)[2][2][4][2], const Unit& u, int wr, int wc, int fr, int fq) const {
        const int row0 = u.pm * BM + wr * 64 + fr, col0 = u.pn * BM + wc * 32 + 4 * fq;
#pragma unroll
        for (int ai = 0; ai < 2; ++ai)
#pragma unroll
            for (int m = 0; m < 4; ++m) { const size_t off = (size_t)(row0 + ai * HALF + m * 16) * ldc + col0;
#pragma unroll
                for (int bj = 0; bj < 2; ++bj)
#pragma unroll
                    for (int n = 0; n < 2; ++n) { const f32x4 rs = *(const f32x4*)(res + off + bj * HALF + n * 16); *(f32x4*)(out + off + bj * HALF + n * 16) = rs * alpha + acc[ai][bj][m][n]; }
                if (m & 1) asm volatile("" ::: "memory"); }
    }
};
template <class Epi, class Sched, bool ALIGN_EPI = false, bool SP2 = false>
__device__ __forceinline__ void gemm_phase(PG8_LAS unsigned char* lds, const Gemm g, const Sched& S, const Epi& E, int tid_in) {
    int tid_ = tid_in; asm volatile("" : "+v"(tid_));
    const int tid = tid_, wid = __builtin_amdgcn_readfirstlane(tid >> 6), lane = tid & 63, wr = wid >> 2, wc = wid & 3, fr = lane & 15, fq = lane >> 4;
    const int K = g.K, nt = K / BK;
    unsigned voffA[2], voffB[2];
#pragma unroll
    for (int i = 0; i < 2; ++i) { int R, C; stage_rc(tid * 16 + i * 8192, R, C); const int Rb = Epi::PERM ? ((R & ~31) + perm32(R & 31)) : R;
        voffA[i] = (unsigned)(R * K + C) * 2u; voffB[i] = (unsigned)(Rb * K + C) * 2u; }
    const size_t kstep = (size_t)(BK * 2);
    const size_t hstep = (size_t)HALF * K * 2;
    const size_t tstep = 2 * hstep;
    const unsigned ldsw = (unsigned)wid * 1024u;
    const int aoff = lds_byte(wr * 64 + fr, fq * 8), boff = lds_byte(wc * 32 + fr, fq * 8);
#define PG8_SA(b, h) (((b) * 2 + (h)) * HTB)
#define PG8_SB(b, h) ((4 + (b) * 2 + (h)) * HTB)
#define PG8_STAGE(bufoff, gbase, voff) do { _Pragma("unroll") for (int _i = 0; _i < 2; ++_i) \
        __builtin_amdgcn_global_load_lds((const unsigned*)((const char*)(gbase) + (voff)[_i]), (PG8_LAS unsigned*)(lds + (bufoff) + ldsw + _i * 8192), 16, 0, 0); } while (0)
#define PG8_LDA(dst, b, h) do { _Pragma("unroll") for (int m = 0; m < 4; ++m) _Pragma("unroll") for (int k = 0; k < 2; ++k) dst[m][k] = *(const PG8_LAS bf16x8*)(lds + PG8_SA(b, h) + aoff + m * 2048 + k * 1024); } while (0)
#define PG8_LDB(dst, b, h) do { _Pragma("unroll") for (int n = 0; n < 2; ++n) _Pragma("unroll") for (int k = 0; k < 2; ++k) dst[n][k] = *(const PG8_LAS bf16x8*)(lds + PG8_SB(b, h) + boff + n * 2048 + k * 1024); } while (0)
#define PG8_MMA(ai, bj, At, Bt) do { __builtin_amdgcn_s_setprio(1); _Pragma("unroll") for (int m = 0; m < 4; ++m) _Pragma("unroll") for (int n = 0; n < 2; ++n) _Pragma("unroll") for (int k = 0; k < 2; ++k) \
        acc[ai][bj][m][n] = __builtin_amdgcn_mfma_f32_16x16x32_bf16(Bt[n][k], At[m][k], acc[ai][bj][m][n], 0, 0, 0); __builtin_amdgcn_s_setprio(0); } while (0)
#define PG8_WAIT_V(n) asm volatile("s_waitcnt vmcnt(" #n ")" ::: "memory")
#define PG8_WAIT_L(n) asm volatile("s_waitcnt lgkmcnt(" #n ")" ::: "memory")
#define PG8_BAR __builtin_amdgcn_s_barrier()
#define PG8_SCHED __builtin_amdgcn_sched_barrier(0)
    Unit cur, nxt; int ui = 0;
    if (!S.next(0, cur)) return;
    f32x4 acc[2][2][4][2];
#pragma unroll
    for (int a = 0; a < 2; ++a)
#pragma unroll
        for (int b = 0; b < 2; ++b)
#pragma unroll
            for (int m = 0; m < 4; ++m)
#pragma unroll
                for (int n = 0; n < 2; ++n) acc[a][b][m][n] = (f32x4){0.f, 0.f, 0.f, 0.f};
    bf16x8 At[4][2], B0[2][2], B1[2][2];
    const char* cA = (const char*)g.A + (size_t)cur.pm * tstep; const char* cB = (const char*)g.Bt + (size_t)cur.pn * tstep;
    S.a_ready(cur);
    if constexpr (SP2) {
        PG8_STAGE(PG8_SB(0, 0), cB, voffB); PG8_STAGE(PG8_SB(0, 1), cB + hstep, voffB); PG8_STAGE(PG8_SA(0, 0), cA, voffA); PG8_STAGE(PG8_SA(0, 1), cA + hstep, voffA);
        if (wr == 1) PG8_BAR;
        PG8_WAIT_V(2); PG8_BAR;
        PG8_STAGE(PG8_SB(1, 0), cB + kstep, voffB); PG8_STAGE(PG8_SA(1, 0), cA + kstep, voffA); PG8_STAGE(PG8_SB(1, 1), cB + hstep + kstep, voffB);
        PG8_WAIT_V(6); PG8_BAR;
    } else {
        PG8_STAGE(PG8_SB(0, 0), cB, voffB); PG8_STAGE(PG8_SA(0, 0), cA, voffA); PG8_STAGE(PG8_SB(0, 1), cB + hstep, voffB); PG8_STAGE(PG8_SA(0, 1), cA + hstep, voffA);
        if (wr == 1) PG8_BAR;
        PG8_WAIT_V(4); PG8_BAR;
        PG8_STAGE(PG8_SB(1, 0), cB + kstep, voffB); PG8_STAGE(PG8_SA(1, 0), cA + kstep, voffA); PG8_STAGE(PG8_SB(1, 1), cB + hstep + kstep, voffB);
        PG8_WAIT_V(6); PG8_BAR;
    }
    for (;;) {
        const bool has_next = S.next(ui + 1, nxt);
        const char* nA = has_next ? (const char*)g.A + (size_t)nxt.pm * tstep : cA; const char* nB = has_next ? (const char*)g.Bt + (size_t)nxt.pn * tstep : cB;
        for (int t = 0; t < nt; t += 2) {
            const bool last = (t == nt - 2);
            const char* a1 = cA + (size_t)(t + 1) * kstep;
            const char* a2 = last ? nA : cA + (size_t)(t + 2) * kstep; const char* b2 = last ? nB : cB + (size_t)(t + 2) * kstep;
            const char* a3 = a2 + kstep; const char* b3 = b2 + kstep;
            if (last && has_next) S.a_ready(nxt);
            if constexpr (SP2) {
            PG8_LDB(B0, 0, 0); PG8_LDB(B1, 0, 1); PG8_SCHED; PG8_LDA(At, 0, 0); PG8_STAGE(PG8_SA(1, 1), a1 + hstep, voffA);
            PG8_WAIT_V(8); PG8_WAIT_L(0); PG8_BAR; PG8_MMA(0, 0, At, B0); PG8_MMA(0, 1, At, B1); PG8_BAR; PG8_SCHED;
            PG8_LDA(At, 0, 1); PG8_STAGE(PG8_SB(0, 0), b2, voffB); PG8_STAGE(PG8_SB(0, 1), b2 + hstep, voffB); PG8_STAGE(PG8_SA(0, 0), a2, voffA);
            PG8_WAIT_V(8); PG8_WAIT_L(0); PG8_BAR; PG8_MMA(1, 0, At, B0); PG8_MMA(1, 1, At, B1); PG8_BAR; PG8_SCHED;
            PG8_LDB(B0, 1, 0); PG8_LDB(B1, 1, 1); PG8_SCHED; PG8_LDA(At, 1, 0); PG8_STAGE(PG8_SA(0, 1), a2 + hstep, voffA);
            PG8_WAIT_V(8); PG8_WAIT_L(0); PG8_BAR; PG8_MMA(0, 0, At, B0); PG8_MMA(0, 1, At, B1); PG8_BAR; PG8_SCHED;
            PG8_LDA(At, 1, 1); PG8_STAGE(PG8_SB(1, 0), b3, voffB); PG8_STAGE(PG8_SB(1, 1), b3 + hstep, voffB); PG8_STAGE(PG8_SA(1, 0), a3, voffA);
            PG8_WAIT_V(8); PG8_WAIT_L(0); PG8_BAR; PG8_MMA(1, 0, At, B0); PG8_MMA(1, 1, At, B1); PG8_BAR; PG8_SCHED;
            } else {
            PG8_LDB(B0, 0, 0); PG8_SCHED; PG8_LDA(At, 0, 0); PG8_STAGE(PG8_SA(1, 1), a1 + hstep, voffA);
            PG8_WAIT_L(8); PG8_BAR; PG8_WAIT_L(0); PG8_MMA(0, 0, At, B0); PG8_BAR; PG8_SCHED;
            PG8_LDB(B1, 0, 1); PG8_STAGE(PG8_SB(0, 0), b2, voffB);
            PG8_BAR; PG8_WAIT_L(0); PG8_MMA(0, 1, At, B1); PG8_BAR;
            PG8_LDA(At, 0, 1); PG8_STAGE(PG8_SA(0, 0), a2, voffA);
            PG8_BAR; PG8_WAIT_L(0); PG8_MMA(1, 0, At, B0); PG8_BAR; PG8_SCHED;
            PG8_STAGE(PG8_SB(0, 1), b2 + hstep, voffB);
            PG8_WAIT_V(6); PG8_BAR; PG8_MMA(1, 1, At, B1); PG8_BAR;
            PG8_LDB(B0, 1, 0); PG8_SCHED; PG8_LDA(At, 1, 0); PG8_STAGE(PG8_SA(0, 1), a2 + hstep, voffA);
            PG8_WAIT_L(8); PG8_BAR; PG8_WAIT_L(0); PG8_MMA(0, 0, At, B0); PG8_BAR; PG8_SCHED;
            PG8_LDB(B1, 1, 1); PG8_STAGE(PG8_SB(1, 0), b3, voffB);
            PG8_BAR; PG8_WAIT_L(0); PG8_MMA(0, 1, At, B1); PG8_BAR;
            PG8_LDA(At, 1, 1); PG8_STAGE(PG8_SA(1, 0), a3, voffA);
            PG8_BAR; PG8_WAIT_L(0); PG8_MMA(1, 0, At, B0); PG8_BAR; PG8_SCHED;
            PG8_STAGE(PG8_SB(1, 1), b3 + hstep, voffB);
            PG8_WAIT_V(6); PG8_BAR; PG8_MMA(1, 1, At, B1); PG8_BAR;
            }
        }
        if constexpr (ALIGN_EPI) { if (wr == 0) PG8_BAR; }
        if constexpr (!Epi::AFTER_DRAIN) { E(acc, cur, wr, wc, fr, fq); S.done(cur); }
        if (!has_next) break;
#pragma unroll
        for (int a = 0; a < 2; ++a)
#pragma unroll
            for (int b = 0; b < 2; ++b)
#pragma unroll
                for (int m = 0; m < 4; ++m)
#pragma unroll
                    for (int n = 0; n < 2; ++n) acc[a][b][m][n] = (f32x4){0.f, 0.f, 0.f, 0.f};
        cur = nxt; cA = nA; cB = nB; ++ui;
        if constexpr (ALIGN_EPI) { if (wr == 1) PG8_BAR; }
    }
    PG8_WAIT_V(0);
    if constexpr (!ALIGN_EPI) { if (wr == 0) PG8_BAR; }
    PG8_BAR;
    if constexpr (Epi::AFTER_DRAIN) { E.fused(acc, cur, wr, wc, fr, fq, lds, wid, lane); S.done(cur); }
#undef PG8_SA
#undef PG8_SB
#undef PG8_STAGE
#undef PG8_LDA
#undef PG8_LDB
#undef PG8_MMA
#undef PG8_WAIT_V
#undef PG8_WAIT_L
#undef PG8_BAR
#undef PG8_SCHED
}
}

#ifndef PG8_SP2
#define PG8_SP2 true
#endif
#ifndef PG8_ALIGN
#define PG8_ALIGN true
#endif
#define GAS __attribute__((address_space(1)))
#define LAS __attribute__((address_space(3)))
typedef unsigned short bf16;
typedef unsigned v4u __attribute__((ext_vector_type(4)));
typedef float f32x4 __attribute__((ext_vector_type(4)));
typedef short bf16x8 __attribute__((ext_vector_type(8)));
typedef GAS unsigned gu32;
typedef GAS unsigned long long gu64;
#define RLX_AGENT __ATOMIC_RELAXED, __HIP_MEMORY_SCOPE_AGENT
#define LDS_WAIT() asm volatile("s_waitcnt lgkmcnt(0)" ::: "memory")
#define VM_WAIT() asm volatile("s_waitcnt vmcnt(0)" ::: "memory")
__device__ __forceinline__ unsigned long long rt() { return __builtin_amdgcn_s_memrealtime(); }
__device__ __forceinline__ unsigned f2bf(float f) { unsigned u = __builtin_bit_cast(unsigned, f); return (u + 0x7fffu + ((u >> 16) & 1u)) >> 16; }
typedef float pk2_f32x2_t __attribute__((ext_vector_type(2))); typedef __bf16 pk2_bf16x2_t __attribute__((ext_vector_type(2)));
__device__ __forceinline__ unsigned pk2(float lo, float hi) { const pk2_f32x2_t v = {lo, hi}; return __builtin_bit_cast(unsigned, __builtin_convertvector(v, pk2_bf16x2_t)); }

#define XB_TMO      128
#define XB_XCNT(j)  (256  + 64 * (j))
#define XB_XSUB(j)  (1280 + 64 * (j))
#define XB_XGEN(j)  (2304 + 64 * (j))
#define XB_TOP      3328
#define XB_TOPGEN   3392
#define XCD_BAR_WORDS 3456
#define XB_SPIN_CAP (1u << 18)

__device__ __forceinline__ unsigned xb_ld(unsigned* p)              { return __hip_atomic_load(p, __ATOMIC_RELAXED, __HIP_MEMORY_SCOPE_AGENT); }
__device__ __forceinline__ unsigned xb_add(unsigned* p, unsigned v) { return __hip_atomic_fetch_add(p, v, __ATOMIC_RELAXED, __HIP_MEMORY_SCOPE_AGENT); }
__device__ __forceinline__ unsigned xb_xcc_id() { return (unsigned)__builtin_amdgcn_s_getreg((3 << 11) | 20) & 0xFu; }
#define XB_SPIN(cond, bar) do { unsigned _sp = 0; while (cond) { __builtin_amdgcn_s_sleep(1); \
    if ((++_sp & 255u) == 0u) { if (xb_ld(&(bar)[XB_TMO])) break; if (_sp > XB_SPIN_CAP) { atomicAdd(&(bar)[XB_TMO], 1u); break; } } } } while (0)

struct XcdBarrier {
    unsigned* bar; unsigned x;
    volatile LAS unsigned* st;
};

__device__ __forceinline__ XcdBarrier xcd_barrier_post(unsigned* bar, volatile LAS unsigned* st) {
    XcdBarrier b; b.bar = bar; b.x = xb_xcc_id(); b.st = st;
    if (threadIdx.x == 0) (void)xb_add(&bar[XB_XCNT(b.x)], 1u);
    return b;
}
__device__ __forceinline__ void xcd_barrier_complete(unsigned* bar, unsigned x, unsigned& nloc, unsigned& nx) {
    const unsigned G = gridDim.x * gridDim.y * gridDim.z;
    unsigned sum, cnt, mine, sp = 0u;
    for (;;) {
        sum = 0u; cnt = 0u; mine = 0u;
#pragma unroll
        for (unsigned j = 0; j < 16; ++j) { const unsigned c = xb_ld(&bar[XB_XCNT(j)]); sum += c; cnt += (c > 0u) ? 1u : 0u; mine = (j == x) ? c : mine; }
        if (sum == G) break;
        __builtin_amdgcn_s_sleep(1);
        if ((++sp & 255u) == 0u) { if (xb_ld(&bar[XB_TMO])) break; if (sp > XB_SPIN_CAP) { atomicAdd(&bar[XB_TMO], 1u); break; } }
    }
    nloc = mine > 0u ? mine : 1u; nx = cnt > 0u ? cnt : 1u;
}

__device__ __forceinline__ void xcd_barrier(const XcdBarrier& b) {
    asm volatile("s_waitcnt vmcnt(0)" ::: "memory");
    __syncthreads();
    if (threadIdx.x == 0) {
        unsigned* bar = b.bar;
        __builtin_amdgcn_s_waitcnt(0);
        unsigned nloc = b.st[0], nx = b.st[1];
        if (nloc == 0u) { xcd_barrier_complete(bar, b.x, nloc, nx); b.st[0] = nloc; b.st[1] = nx; }
        const unsigned old = xb_add(&bar[XB_XSUB(b.x)], 1u);
        const unsigned gen = old / nloc;
        if (old + 1u == (gen + 1u) * nloc) {
            __builtin_amdgcn_fence(__ATOMIC_RELEASE, "agent");
            asm volatile("s_waitcnt vmcnt(0)" ::: "memory");
            const unsigned og = xb_add(&bar[XB_TOP], 1u);
            const unsigned tg = og / nx;
            if (og + 1u == (tg + 1u) * nx) xb_add(&bar[XB_TOPGEN], 1u);
            else XB_SPIN(xb_ld(&bar[XB_TOPGEN]) == tg, bar);
            __builtin_amdgcn_fence(__ATOMIC_ACQUIRE, "agent");
            xb_add(&bar[XB_XGEN(b.x)], 1u);
            asm volatile("s_waitcnt vmcnt(0)" ::: "memory");
        } else {
            XB_SPIN(xb_ld(&bar[XB_XGEN(b.x)]) == gen, bar);
            __builtin_amdgcn_fence(__ATOMIC_ACQUIRE, "agent");
            asm volatile("s_waitcnt vmcnt(0)" ::: "memory");
        }
    }
    __syncthreads();
}

constexpr int NWAVES = 8, NTHREADS = 512;
constexpr int DM = 1024, NB = 4, SEQ = 4096, DEPTH = 2, NTOK = NB * SEQ, NEXP = 16384;
constexpr int DIN = 1952, DINP = 2048;
constexpr float ALPHA = 1.4142135623730951f;
constexpr float LN_EPS = 1e-5f, RMS_EPS = 1e-6f;
constexpr float QSCALE = 0.10206207261596575f * 1.4426950408889634f;
constexpr int NPL = 10;
constexpr int NPHASE = 1 + NPL * DEPTH;
constexpr size_t MiB = 1u << 20;
constexpr size_t WS_CTL = 0, CTL_ZERO_BYTES = 64 * 1024;
constexpr size_t WS_WIT = 2 * MiB;
constexpr size_t WS_WQT = 10 * MiB;
constexpr size_t WS_WOT = 18 * MiB;
constexpr size_t WS_WUQT = 22 * MiB;
constexpr size_t WS_WUKVT = 23 * MiB;
constexpr size_t WS_KEYS = 24 * MiB;
constexpr size_t WS_ROPE = 25 * MiB;
constexpr size_t WS_SUV = 26 * MiB;
constexpr size_t WS_UT = 32 * MiB;
constexpr size_t WS_VT = 96 * MiB;
constexpr size_t WS_XB = 160 * MiB;
constexpr size_t WS_HB = 192 * MiB;
constexpr size_t WS_QM = 256 * MiB;
constexpr size_t WS_KM = 280 * MiB;
constexpr size_t WS_VMT = 304 * MiB;
constexpr size_t WS_VST = 320 * MiB;
constexpr size_t WS_OB = 336 * MiB;
constexpr size_t WS_EL = 368 * MiB;
constexpr size_t WS_GL = 376 * MiB;
constexpr size_t WS_XQ = WS_KM;
constexpr size_t WS_SX = WS_VST;
constexpr size_t WS_AC = WS_QM;
constexpr size_t WS_KSF = 384 * MiB;
constexpr size_t WS_END = 400 * MiB;
constexpr int CW_BAR = 1024;
static_assert((CW_BAR + XCD_BAR_WORDS) * 4 <= (int)CTL_ZERO_BYTES, "barrier words inside the memset region");
constexpr int RING_OFF = 0, RING_BYTES = 131072;
constexpr int LDSCTL_OFF = RING_BYTES, MISC_OFF = LDSCTL_OFF + 320;
constexpr int LDS_BYTES = 147456;
static_assert(MISC_OFF + 128 <= LDS_BYTES, "LDS map");

typedef float f32x16 __attribute__((ext_vector_type(16)));
typedef float f32x2 __attribute__((ext_vector_type(2)));
typedef unsigned v2u __attribute__((ext_vector_type(2)));
typedef __bf16 bf2_t __attribute__((ext_vector_type(2)));

struct Args { const float* in[15]; float* out; unsigned char* ws; int ph_lo, ph_hi; };
typedef const __attribute__((address_space(4))) Args* kap_t;
__device__ __forceinline__ kap_t ka_fresh() { kap_t p = (kap_t)__builtin_amdgcn_kernarg_segment_ptr(); asm volatile("" : "+s"(p)); return p; }
enum { I_X = 0, I_WIN, I_GCQ, I_WUQ, I_GCKV, I_WUKV, I_WO, I_LN1G, I_LN1B, I_WQ, I_KEYS, I_U, I_V, I_LN2G, I_LN2B };
struct Frame {
    LAS unsigned char* lds;
    volatile LAS unsigned* MISC;
    int tid, lane, wave, vcu, G;
};
template <class T> __device__ __forceinline__ T* wsp(kap_t ka, size_t off) { return (T*)(ka->ws + off); }

__device__ __forceinline__ float bflo(unsigned w) { return __uint_as_float(w << 16); }
__device__ __forceinline__ float bfhi(unsigned w) { return __uint_as_float(w & 0xffff0000u); }
__device__ __forceinline__ float bf1(short s) { return __uint_as_float(((unsigned)(unsigned short)s) << 16); }
__device__ __forceinline__ int crow(int r, int hi) { return (r & 3) + 8 * (r >> 2) + 4 * hi; }
__device__ __forceinline__ int kperm(int s) { return (s & ~15) | (((s >> 2) & 1) << 3) | (((s >> 3) & 1) << 2) | (s & 3); }
template <int CTRL> __device__ __forceinline__ float dpp_f(float v) { return __builtin_bit_cast(float, __builtin_amdgcn_update_dpp(0, __builtin_bit_cast(int, v), CTRL, 0xF, 0xF, true)); }
__device__ __forceinline__ int shx_i(int v, int mask, int lane) { return __builtin_amdgcn_ds_bpermute((lane ^ mask) << 2, v); }
__device__ __forceinline__ float shx_f(float v, int mask, int lane) { return __builtin_bit_cast(float, __builtin_amdgcn_ds_bpermute((lane ^ mask) << 2, __builtin_bit_cast(int, v))); }
__device__ __forceinline__ float wave_sum_all(float v, int lane) {
    v += dpp_f<0xB1>(v);
    v += dpp_f<0x4E>(v);
    v += dpp_f<0x141>(v);
    v += dpp_f<0x140>(v);
    v += shx_f(v, 16, lane);
    v += shx_f(v, 32, lane);
    return v;
}
__device__ __forceinline__ int wave_sum_all_i(int v, int lane) {
    v += __builtin_amdgcn_update_dpp(0, v, 0xB1, 0xF, 0xF, true); v += __builtin_amdgcn_update_dpp(0, v, 0x4E, 0xF, 0xF, true);
    v += __builtin_amdgcn_update_dpp(0, v, 0x141, 0xF, 0xF, true); v += __builtin_amdgcn_update_dpp(0, v, 0x140, 0xF, 0xF, true);
    v += shx_i(v, 16, lane); v += shx_i(v, 32, lane);
    return v;
}
__device__ __forceinline__ float wave_max_all(float v, int lane) {
    v = fmaxf(v, dpp_f<0xB1>(v)); v = fmaxf(v, dpp_f<0x4E>(v)); v = fmaxf(v, dpp_f<0x141>(v)); v = fmaxf(v, dpp_f<0x140>(v));
    v = fmaxf(v, shx_f(v, 16, lane)); v = fmaxf(v, shx_f(v, 32, lane));
    return v;
}
__device__ __forceinline__ bf16x8 pack8(float a0, float a1, float a2, float a3, float a4, float a5, float a6, float a7) {
    v4u w; w.x = pk2(a0, a1); w.y = pk2(a2, a3); w.z = pk2(a4, a5); w.w = pk2(a6, a7); return __builtin_bit_cast(bf16x8, w);
}

template <bool FRAG> __device__ __forceinline__ void p0_transpose_item(const float* W, int K, int N, bf16* WT, const float* gs, LAS float* scr, int item, int lane) {
    const int nblk = N / 32, kb = item / nblk, nb = item % nblk, k0 = 64 * kb, n0 = 32 * nb;
#pragma unroll 8
    for (int i = 0; i < 32; ++i) { const int kk = 2 * i + (lane >> 5); float w = W[(size_t)(k0 + kk) * N + n0 + (lane & 31)]; if (gs) w *= gs[k0 + kk]; scr[kk * 33 + (lane & 31)] = w; }
    LDS_WAIT(); asm volatile("" ::: "memory");
    const int c = lane & 7;
#pragma unroll
    for (int j = 0; j < 4; ++j) { const int n = (lane >> 3) + 8 * j; const LAS float* s = scr + (8 * c) * 33 + n;
        v4u o; o.x = pk2(s[0 * 33], s[1 * 33]); o.y = pk2(s[2 * 33], s[3 * 33]); o.z = pk2(s[4 * 33], s[5 * 33]); o.w = pk2(s[6 * 33], s[7 * 33]);
        if (FRAG) { const int nn = n0 + n, kk = k0 + 8 * c; *(GAS v4u*)(WT + ((size_t)((nn >> 5) * (K >> 4) + (kk >> 4)) * 64 + ((kk >> 3) & 1) * 32 + (nn & 31)) * 8) = o; }
        else *(GAS v4u*)(WT + (size_t)(n0 + n) * K + k0 + 8 * c) = o; }
    LDS_WAIT(); asm volatile("" ::: "memory");
}
__device__ __forceinline__ void cvt8_range(Frame& F, const float* src, bf16* dst, size_t n8) {
    const size_t gt = (size_t)blockIdx.x * NTHREADS + F.tid, nt = (size_t)F.G * NTHREADS;
    for (size_t i = gt; i < n8; i += nt) { const f32x4 a = *(const f32x4*)(src + i * 8), b = *(const f32x4*)(src + i * 8 + 4);
        v4u o; o.x = pk2(a.x, a.y); o.y = pk2(a.z, a.w); o.z = pk2(b.x, b.y); o.w = pk2(b.z, b.w); *(v4u*)(dst + i * 8) = o; }
}
__device__ __forceinline__ void p0_prologue(Frame& F, kap_t ka) {
    LAS float* scr = (LAS float*)(F.lds + RING_OFF + F.wave * 16384);
    const int gw = F.vcu * NWAVES + F.wave, NGW = F.G * NWAVES;
    constexpr int I_IN = 16 * 61, I_Q = 16 * 64, I_O = 16 * 32, I_UQ = 4 * 24, I_UKV = 2 * 32, I_L = I_IN + I_Q + I_O + I_UQ + I_UKV;
    for (int it = gw; it < DEPTH * I_L; it += NGW) {
        const int l = it / I_L; int r = it % I_L;
        if (r < I_IN) { p0_transpose_item<false>(ka->in[I_WIN] + (size_t)l * DM * DIN, DM, DIN, wsp<bf16>(ka, WS_WIT) + (size_t)l * DINP * DM, nullptr, scr, r, F.lane); continue; } r -= I_IN;
        if (r < I_Q) { p0_transpose_item<false>(ka->in[I_WQ] + (size_t)l * DM * 2048, DM, 2048, wsp<bf16>(ka, WS_WQT) + (size_t)l * 2048 * DM, nullptr, scr, r, F.lane); continue; } r -= I_Q;
        if (r < I_O) { p0_transpose_item<false>(ka->in[I_WO] + (size_t)l * DM * DM, DM, DM, wsp<bf16>(ka, WS_WOT) + (size_t)l * DM * DM, nullptr, scr, r, F.lane); continue; } r -= I_O;
        if (r < I_UQ) { p0_transpose_item<true>(ka->in[I_WUQ] + (size_t)l * 256 * 768, 256, 768, wsp<bf16>(ka, WS_WUQT) + (size_t)l * 768 * 256, ka->in[I_GCQ] + l * 256, scr, r, F.lane); continue; } r -= I_UQ;
        p0_transpose_item<true>(ka->in[I_WUKV] + (size_t)l * 128 * 1024, 128, 1024, wsp<bf16>(ka, WS_WUKVT) + (size_t)l * 1024 * 128, ka->in[I_GCKV] + l * 128, scr, r, F.lane);
    }
    const size_t gt = (size_t)blockIdx.x * NTHREADS + F.tid, nt = (size_t)F.G * NTHREADS;
    for (size_t i = gt; i < 2 * 12288; i += nt) { const size_t l = i / 12288, j = i % 12288; *(v4u*)(wsp<bf16>(ka, WS_WIT) + l * DINP * DM + (size_t)DIN * DM + j * 8) = (v4u){0u, 0u, 0u, 0u}; }
    for (size_t i = gt; i < (size_t)SEQ * 16; i += nt) { const int pos = (int)(i >> 4), k = (int)(i & 15);
        const float inv_freq = (float)pow(10000.0, -(double)k / 16.0); const float ang = (float)pos * inv_freq;
        wsp<f32x2>(ka, WS_ROPE)[i] = (f32x2){(float)cos((double)ang), (float)sin((double)ang)}; }
    for (size_t i = gt; i < (size_t)DEPTH * 8 * 2 * 128 * 16; i += nt) {
        const size_t lhc = i >> 11; const int n = (int)(i >> 4) & 127, dg = (int)i & 15;
        const float* src = ka->in[I_KEYS] + i * 8; const f32x4 a = *(const f32x4*)src, b = *(const f32x4*)(src + 4);
        v4u o; o.x = pk2(a.x, a.y); o.y = pk2(a.z, a.w); o.z = pk2(b.x, b.y); o.w = pk2(b.z, b.w);
        *(v4u*)(wsp<bf16>(ka, WS_KEYS) + (lhc * 2048 + (size_t)(((n >> 5) * 8 + (dg >> 1)) * 64 + (dg & 1) * 32 + (n & 31))) * 8) = o;
    }
    cvt8_range(F, ka->in[I_X], wsp<bf16>(ka, WS_XB), (size_t)NTOK * DM / 8);
    {
#ifdef MK_DBG_L0
        constexpr int NL = 1;
#else
        constexpr int NL = DEPTH;
#endif
        unsigned char* UQ = wsp<unsigned char>(ka, WS_UT); unsigned char* VQ = wsp<unsigned char>(ka, WS_VT); float* SUV = wsp<float>(ka, WS_SUV);
        for (int row = gw; row < 2 * NL * NEXP; row += NGW) {
            const int tbl = row / (NL * NEXP), r = row % (NL * NEXP);
            const float* src = (tbl ? ka->in[I_V] : ka->in[I_U]) + (size_t)r * DM + 16 * F.lane;
            f32x4 v[4]; float m = 0.f;
#pragma unroll
            for (int j = 0; j < 4; ++j) { v[j] = *(const f32x4*)(src + 4 * j); m = fmaxf(m, fmaxf(fmaxf(fabsf(v[j].x), fabsf(v[j].y)), fmaxf(fabsf(v[j].z), fabsf(v[j].w)))); }
            m = wave_max_all(m, F.lane);
            const float inv = m > 0.f ? 127.f / m : 0.f;
            const int off = 0;
            v4u o;
#pragma unroll
            for (int j = 0; j < 4; ++j) {
                const unsigned b0 = (unsigned)((int)rintf(v[j].x * inv) + off) & 0xffu, b1 = (unsigned)((int)rintf(v[j].y * inv) + off) & 0xffu, b2 = (unsigned)((int)rintf(v[j].z * inv) + off) & 0xffu, b3 = (unsigned)((int)rintf(v[j].w * inv) + off) & 0xffu;
                o[j] = b0 | (b1 << 8) | (b2 << 16) | (b3 << 24);
            }
            if (tbl) *(v4u*)(VQ + (size_t)(r / NEXP) * NEXP * DM + ((size_t)(F.lane >> 3) * NEXP + (size_t)(r % NEXP)) * 128 + 16 * (F.lane & 7)) = o;
            else *(v4u*)(UQ + (size_t)r * DM + 16 * F.lane) = o;
            if (F.lane == 0) SUV[2 * (size_t)r + tbl] = m * (1.f / 127.f);
        }
    }
}

__device__ __forceinline__ void p2_unit(Frame& F, kap_t ka, int l, int tb, int part) {
    const int lane = F.lane, r32 = lane & 31, hi = lane >> 5;
    const int tok = tb * 32 + r32, b = tok / SEQ, s = tok % SEQ;
    const bf16* hrow = wsp<bf16>(ka, WS_HB) + (size_t)tok * DINP;
    if (part < 2) {
        bf16x8 xf[16]; float ssq = 0.f;
#pragma unroll
        for (int ks = 0; ks < 16; ++ks) { xf[ks] = *(const bf16x8*)(hrow + 1536 + ks * 16 + 8 * hi);
#pragma unroll
            for (int e = 0; e < 8; ++e) { const float v = bf1(xf[ks][e]); ssq += v * v; } }
        ssq += shx_f(ssq, 32, lane);
        const float rstd = rsqrtf(ssq * (1.f / 256.f) + RMS_EPS) * QSCALE;
        const bf16* W = wsp<bf16>(ka, WS_WUQT) + (size_t)l * 768 * 256;
        const bf16* wbase = W + 8 * lane;
        bf16x8 wA[16];
#define P2Q_LOADW(WF, j) do { _Pragma("unroll") for (int ks = 0; ks < 16; ++ks) WF[ks] = *(const bf16x8*)(wbase + (size_t)((j) * 16 + ks) * 512); } while (0)
#define P2Q_MMA(WF, ACC) do { ACC = (f32x16){}; _Pragma("unroll") for (int ks = 0; ks < 16; ++ks) ACC = __builtin_amdgcn_mfma_f32_32x32x16_bf16(WF[ks], xf[ks], ACC, 0, 0, 0); } while (0)
#define P2Q_EPI(ACC, j) do { const int head_ = (j) / 3, sub_ = (j) % 3; float v[16]; \
            _Pragma("unroll") for (int r = 0; r < 16; ++r) v[r] = ACC[r] * rstd; \
            if (sub_ == 2) { _Pragma("unroll") for (int r = 0; r < 8; ++r) { const f32x2 cs = wsp<f32x2>(ka, WS_ROPE)[s * 16 + crow(r, hi)]; const float x1 = v[r], x2 = v[r + 8]; v[r] = x1 * cs.x - x2 * cs.y; v[r + 8] = x2 * cs.x + x1 * cs.y; } } \
            bf16* dst = wsp<bf16>(ka, WS_QM) + ((size_t)(b * 8 + head_) * SEQ + s) * 96 + sub_ * 32 + 4 * hi; \
            _Pragma("unroll") for (int g = 0; g < 4; ++g) { v2u w; w.x = pk2(v[4 * g], v[4 * g + 1]); w.y = pk2(v[4 * g + 2], v[4 * g + 3]); *(v2u*)(dst + 8 * g) = w; } } while (0)
        P2Q_LOADW(wA, part * 12);
        for (int jj = 0; jj < 12; ++jj) {
            const int j = part * 12 + jj; f32x16 acc;
            P2Q_MMA(wA, acc);
            __builtin_amdgcn_sched_barrier(0);
            P2Q_LOADW(wA, jj + 1 < 12 ? j + 1 : j);
            __builtin_amdgcn_sched_barrier(0);
            P2Q_EPI(acc, j);
        }
#undef P2Q_LOADW
#undef P2Q_MMA
#undef P2Q_EPI
    } else {
        const int h0 = (part - 2) * 4;
        bf16x8 xf[8]; float ssq = 0.f;
#pragma unroll
        for (int ks = 0; ks < 8; ++ks) { xf[ks] = *(const bf16x8*)(hrow + 1792 + ks * 16 + 8 * hi);
#pragma unroll
            for (int e = 0; e < 8; ++e) { const float v = bf1(xf[ks][e]); ssq += v * v; } }
        ssq += shx_f(ssq, 32, lane);
        const float rstd = rsqrtf(ssq * (1.f / 128.f) + RMS_EPS);
        const bf16* W = wsp<bf16>(ka, WS_WUKVT) + (size_t)l * 1024 * 128;
        const int sp = kperm(s);
        const bf16* wbase = W + 8 * lane;
        bf16x8 wA[8], wB[8];
#define P2K_LOADW(WF, j) do { _Pragma("unroll") for (int ks = 0; ks < 8; ++ks) WF[ks] = *(const bf16x8*)(wbase + (size_t)((j) * 8 + ks) * 512); } while (0)
#define P2K_MMA(WF, ACC) do { ACC = (f32x16){}; _Pragma("unroll") for (int ks = 0; ks < 8; ++ks) ACC = __builtin_amdgcn_mfma_f32_32x32x16_bf16(WF[ks], xf[ks], ACC, 0, 0, 0); } while (0)
        P2K_LOADW(wA, h0 * 4);
        for (int jj = 0; jj < 16; jj += 2) {
            f32x16 accA, accB;
            P2K_LOADW(wB, h0 * 4 + jj + 1);
            P2K_MMA(wA, accA);
            P2K_LOADW(wA, jj + 2 < 16 ? h0 * 4 + jj + 2 : h0 * 4 + jj + 1);
            P2K_MMA(wB, accB);
#pragma unroll
            for (int u2 = 0; u2 < 2; ++u2) {
                const int j = h0 * 4 + jj + u2; const int head = j >> 2, sub = j & 3; const f32x16 acc = u2 ? accB : accA;
            if (sub < 2) {
                bf16* dst = wsp<bf16>(ka, WS_KM) + (size_t)(b * 8 + head) * SEQ * 96 + (size_t)(s >> 5) * (6 * 512) + (size_t)r32 * 8 + 4 * hi;
#pragma unroll
                for (int g = 0; g < 4; ++g) { v2u w; w.x = pk2(acc[4 * g] * rstd, acc[4 * g + 1] * rstd); w.y = pk2(acc[4 * g + 2] * rstd, acc[4 * g + 3] * rstd); *(v2u*)(dst + (2 * sub + (g >> 1)) * 512 + (g & 1) * 256) = w; }
            } else {
                bf16* dst = wsp<bf16>(ka, WS_VMT) + (size_t)(b * 8 + head) * 64 * SEQ + (size_t)(s >> 5) * (4 * 512) + ((sub - 2) * 2 + ((s >> 4) & 1)) * 512 + ((sp >> 3) & 1) * 256 + (sp & 7);
#pragma unroll
                for (int r = 0; r < 16; ++r) dst[crow(r, hi) * 8] = (bf16)f2bf(acc[r] * rstd);
            }
            }
        }
#undef P2K_LOADW
#undef P2K_MMA
        { const bf16x8 a1 = *(const bf16x8*)(hrow + 1920 + 8 * hi), a2 = *(const bf16x8*)(hrow + 1936 + 8 * hi);
          float o1[8], o2[8];
#pragma unroll
          for (int e = 0; e < 8; ++e) { const f32x2 cs = wsp<f32x2>(ka, WS_ROPE)[s * 16 + 8 * hi + e]; const float x1 = bf1(a1[e]), x2 = bf1(a2[e]); o1[e] = x1 * cs.x - x2 * cs.y; o2[e] = x2 * cs.x + x1 * cs.y; }
          const bf16x8 p1 = pack8(o1[0], o1[1], o1[2], o1[3], o1[4], o1[5], o1[6], o1[7]), p2 = pack8(o2[0], o2[1], o2[2], o2[3], o2[4], o2[5], o2[6], o2[7]);
#pragma unroll
          for (int hh = 0; hh < 4; ++hh) { bf16* dst = wsp<bf16>(ka, WS_KM) + (size_t)(b * 8 + h0 + hh) * SEQ * 96 + (size_t)(s >> 5) * (6 * 512) + 4 * 512 + hi * 256 + (size_t)r32 * 8; *(bf16x8*)dst = p1; *(bf16x8*)(dst + 512) = p2; } }
#pragma unroll 1
        for (int hh = 0; hh < 4; ++hh) {
            const int head = h0 + hh;
#pragma unroll
            for (int c4 = 0; c4 < 4; ++c4) { const bf16x8 a = *(const bf16x8*)(hrow + 1024 + head * 64 + 32 * hi + c4 * 8);
                bf16* dst = wsp<bf16>(ka, WS_VST) + (size_t)(b * 8 + head) * 64 * SEQ + (size_t)(s >> 5) * (4 * 512) + (hi * 2 + ((s >> 4) & 1)) * 512 + ((sp >> 3) & 1) * 256 + c4 * 64 + (sp & 7);
#pragma unroll
                for (int e = 0; e < 8; ++e) dst[e * 8] = (bf16)a[e]; }
#pragma unroll
            for (int ks = 0; ks < 4; ++ks) *(bf16x8*)(wsp<bf16>(ka, WS_KSF) + (size_t)(b * 8 + head) * SEQ * 64 + (size_t)(s >> 5) * (4 * 512) + ks * 512 + (size_t)lane * 8) = *(const bf16x8*)(hrow + 512 + head * 64 + ks * 16 + 8 * hi);
        }
    }
}

__device__ __forceinline__ float xhalf_max(float v) { auto rr = __builtin_amdgcn_permlane32_swap(__float_as_uint(v), __float_as_uint(v), false, false); return fmaxf(__uint_as_float(rr[0]), __uint_as_float(rr[1])); }
__device__ __forceinline__ float xhalf_sum(float v) { auto rr = __builtin_amdgcn_permlane32_swap(__float_as_uint(v), __float_as_uint(v), false, false); return __uint_as_float(rr[0]) + __uint_as_float(rr[1]); }
constexpr float MLA_THR = 8.f;
__device__ __forceinline__ void mla_unit(Frame& F, kap_t ka, int bh, int qb) {
    const int lane = F.lane, r32 = lane & 31, hi = lane >> 5, q0 = qb * 32;
    const bf16* Qp = wsp<bf16>(ka, WS_QM) + ((size_t)bh * SEQ + q0 + r32) * 96 + 8 * hi;
    bf16x8 qf[6];
#pragma unroll
    for (int ks = 0; ks < 6; ++ks) qf[ks] = *(const bf16x8*)(Qp + ks * 16);
    f32x16 o0 = {}, o1 = {};
    float m = -1e30f, l = 0.f;
    const bf16* Kp = wsp<bf16>(ka, WS_KM) + (size_t)bh * SEQ * 96 + 8 * lane;
    const bf16* Vp = wsp<bf16>(ka, WS_VMT) + (size_t)bh * 64 * SEQ + 8 * lane;
#define MLA_LOADK(KF, kt) do { _Pragma("unroll") for (int ks = 0; ks < 6; ++ks) KF[ks] = *(const bf16x8*)(Kp + (size_t)((kt) * 6 + ks) * 512); } while (0)
#define MLA_LOADV(VF, kt) do { _Pragma("unroll") for (int i = 0; i < 4; ++i) VF[i] = *(const bf16x8*)(Vp + (size_t)((kt) * 4 + i) * 512); } while (0)
#define MLA_QK(S, KF) do { S = (f32x16){}; _Pragma("unroll") for (int ks = 0; ks < 6; ++ks) S = __builtin_amdgcn_mfma_f32_32x32x16_bf16(KF[ks], qf[ks], S, 0, 0, 0); } while (0)
#define MLA_SMPV(S, VF, kt) do { \
        if ((kt) == qb) { _Pragma("unroll") for (int r = 0; r < 16; ++r) if (crow(r, hi) > r32) S[r] = -1e30f; } \
        float mx = fmaxf(fmaxf(S[0], S[1]), fmaxf(S[2], S[3])); \
        _Pragma("unroll") for (int r = 4; r < 16; r += 4) mx = fmaxf(mx, fmaxf(fmaxf(S[r], S[r + 1]), fmaxf(S[r + 2], S[r + 3]))); \
        mx = xhalf_max(mx); \
        if (__any(mx - m > MLA_THR)) { const float mn = fmaxf(m, mx), alpha = __builtin_amdgcn_exp2f(m - mn); l *= alpha; m = mn; \
            _Pragma("unroll") for (int r = 0; r < 16; ++r) { o0[r] *= alpha; o1[r] *= alpha; } } \
        float p[16], rs0 = 0.f, rs1 = 0.f; \
        _Pragma("unroll") for (int r = 0; r < 16; r += 2) { p[r] = __builtin_amdgcn_exp2f(S[r] - m); p[r + 1] = __builtin_amdgcn_exp2f(S[r + 1] - m); rs0 += p[r]; rs1 += p[r + 1]; } \
        l += rs0 + rs1; \
        const bf16x8 pf0 = pack8(p[0], p[1], p[2], p[3], p[4], p[5], p[6], p[7]), pf1 = pack8(p[8], p[9], p[10], p[11], p[12], p[13], p[14], p[15]); \
        o0 = __builtin_amdgcn_mfma_f32_32x32x16_bf16(VF[0], pf0, o0, 0, 0, 0); \
        o1 = __builtin_amdgcn_mfma_f32_32x32x16_bf16(VF[2], pf0, o1, 0, 0, 0); \
        o0 = __builtin_amdgcn_mfma_f32_32x32x16_bf16(VF[1], pf1, o0, 0, 0, 0); \
        o1 = __builtin_amdgcn_mfma_f32_32x32x16_bf16(VF[3], pf1, o1, 0, 0, 0); } while (0)
    bf16x8 kA[6], kB[6], vA[4];
    f32x16 sA, sB;
    MLA_LOADK(kA, 0); MLA_LOADK(kB, 1);
    MLA_QK(sA, kA);
    for (int kt = 0; kt <= qb; kt += 2) {
        MLA_LOADK(kA, kt + 2); MLA_LOADV(vA, kt);
        MLA_QK(sB, kB);
        MLA_SMPV(sA, vA, kt);
        if (kt + 1 > qb) break;
        MLA_LOADK(kB, kt + 3); MLA_LOADV(vA, kt + 1);
        MLA_QK(sA, kA);
        MLA_SMPV(sB, vA, kt + 1);
    }
#undef MLA_LOADK
#undef MLA_LOADV
#undef MLA_QK
#undef MLA_SMPV
    l = xhalf_sum(l);
    const float rl = 1.f / l;
    const int b = bh >> 3, h = bh & 7;
    bf16* dst = wsp<bf16>(ka, WS_OB) + ((size_t)b * SEQ + q0 + r32) * DM + 512 + h * 64 + 4 * hi;
#pragma unroll
    for (int g = 0; g < 4; ++g) {
        v2u w; w.x = pk2(o0[4 * g] * rl, o0[4 * g + 1] * rl); w.y = pk2(o0[4 * g + 2] * rl, o0[4 * g + 3] * rl); *(v2u*)(dst + 8 * g) = w;
        v2u u; u.x = pk2(o1[4 * g] * rl, o1[4 * g + 1] * rl); u.y = pk2(o1[4 * g + 2] * rl, o1[4 * g + 3] * rl); *(v2u*)(dst + 32 + 8 * g) = u;
    }
}

__device__ __forceinline__ void mla_block(Frame& F, kap_t ka, int bh, int J) {
    const int tid = F.tid, lane = F.lane, r32 = lane & 31, hi = lane >> 5, wave = F.wave;
    const int qb = 8 * J + wave, q0 = qb * 32, T = 8 * J + 8;
    const bf16* Qp = wsp<bf16>(ka, WS_QM) + ((size_t)bh * SEQ + q0 + r32) * 96 + 8 * hi;
    bf16x8 qf[6];
#pragma unroll
    for (int ks = 0; ks < 6; ++ks) qf[ks] = *(const bf16x8*)(Qp + ks * 16);
    f32x16 o0 = {}, o1 = {};
    float m = -1e30f, l = 0.f;
    const unsigned char* Kt = (const unsigned char*)(wsp<bf16>(ka, WS_KM) + (size_t)bh * SEQ * 96);
    const unsigned char* Vt = (const unsigned char*)(wsp<bf16>(ka, WS_VMT) + (size_t)bh * 64 * SEQ);
    LAS unsigned char* ring = F.lds + RING_OFF;
    const bool c0k = tid < 384;
    const size_t off0 = c0k ? (size_t)tid * 16 : (size_t)(tid - 384) * 16, off1 = (size_t)(128 + tid) * 16;
#define MB_GLOAD(t) do { r0 = *(const v4u*)((c0k ? Kt + (size_t)(t) * 6144 : Vt + (size_t)(t) * 4096) + off0); if (tid < 128) r1 = *(const v4u*)(Vt + (size_t)(t) * 4096 + off1); } while (0)
#define MB_LWRITE(s) do { *(LAS v4u*)(ring + (s) * 10240 + tid * 16) = r0; if (tid < 128) *(LAS v4u*)(ring + (s) * 10240 + 8192 + tid * 16) = r1; } while (0)
    v4u r0 = {}, r1 = {};
    MB_GLOAD(0); MB_LWRITE(0);
    if (T > 1) MB_GLOAD(1);
    for (int t = 0; t < T; ++t) {
        __syncthreads();
        const bool active = t <= qb;
        bf16x8 kf[6], vf[4];
        if (active) { const LAS unsigned char* sl = ring + (t & 1) * 10240 + lane * 16;
#pragma unroll
            for (int ks = 0; ks < 6; ++ks) kf[ks] = *(const LAS bf16x8*)(sl + ks * 1024);
#pragma unroll
            for (int i = 0; i < 4; ++i) vf[i] = *(const LAS bf16x8*)(sl + 6144 + i * 1024); }
        if (t + 1 < T) MB_LWRITE((t + 1) & 1);
        if (t + 2 < T) MB_GLOAD(t + 2);
        if (active) {
            f32x16 sa = {};
#pragma unroll
            for (int ks = 0; ks < 6; ++ks) sa = __builtin_amdgcn_mfma_f32_32x32x16_bf16(kf[ks], qf[ks], sa, 0, 0, 0);
            if (t == qb) {
#pragma unroll
                for (int r = 0; r < 16; ++r) if (crow(r, hi) > r32) sa[r] = -1e30f;
            }
            float mx = fmaxf(fmaxf(sa[0], sa[1]), fmaxf(sa[2], sa[3]));
#pragma unroll
            for (int r = 4; r < 16; r += 4) mx = fmaxf(mx, fmaxf(fmaxf(sa[r], sa[r + 1]), fmaxf(sa[r + 2], sa[r + 3])));
            mx = xhalf_max(mx);
            if (__any(mx - m > MLA_THR)) { const float mn = fmaxf(m, mx), alpha = __builtin_amdgcn_exp2f(m - mn); l *= alpha; m = mn;
#pragma unroll
                for (int r = 0; r < 16; ++r) { o0[r] *= alpha; o1[r] *= alpha; } }
            float p[16], rs = 0.f;
#pragma unroll
            for (int r = 0; r < 16; ++r) { p[r] = __builtin_amdgcn_exp2f(sa[r] - m); rs += p[r]; }
            l += rs;
            const bf16x8 pf0 = pack8(p[0], p[1], p[2], p[3], p[4], p[5], p[6], p[7]), pf1 = pack8(p[8], p[9], p[10], p[11], p[12], p[13], p[14], p[15]);
            o0 = __builtin_amdgcn_mfma_f32_32x32x16_bf16(vf[0], pf0, o0, 0, 0, 0);
            o0 = __builtin_amdgcn_mfma_f32_32x32x16_bf16(vf[1], pf1, o0, 0, 0, 0);
            o1 = __builtin_amdgcn_mfma_f32_32x32x16_bf16(vf[2], pf0, o1, 0, 0, 0);
            o1 = __builtin_amdgcn_mfma_f32_32x32x16_bf16(vf[3], pf1, o1, 0, 0, 0);
        }
    }
#undef MB_GLOAD
#undef MB_LWRITE
    __syncthreads();
    l = xhalf_sum(l);
    const float rl = 1.f / l;
    const int b = bh >> 3, h = bh & 7;
    bf16* dst = wsp<bf16>(ka, WS_OB) + ((size_t)b * SEQ + q0 + r32) * DM + 512 + h * 64 + 4 * hi;
#pragma unroll
    for (int g = 0; g < 4; ++g) {
        v2u w; w.x = pk2(o0[4 * g] * rl, o0[4 * g + 1] * rl); w.y = pk2(o0[4 * g + 2] * rl, o0[4 * g + 3] * rl); *(v2u*)(dst + 8 * g) = w;
        v2u u; u.x = pk2(o1[4 * g] * rl, o1[4 * g + 1] * rl); u.y = pk2(o1[4 * g + 2] * rl, o1[4 * g + 3] * rl); *(v2u*)(dst + 32 + 8 * g) = u;
    }
}

__device__ __forceinline__ void sb_unit(Frame& F, kap_t ka, int bh, int qb) {
    const int lane = F.lane, r32 = lane & 31, hi = lane >> 5, q0 = qb * 32;
    const int b = bh >> 3, h = bh & 7;
    const bf16* Hb = wsp<bf16>(ka, WS_HB) + (size_t)b * SEQ * DINP + h * 64 + 8 * hi;
    bf16x8 qf[4];
#pragma unroll
    for (int ks = 0; ks < 4; ++ks) qf[ks] = *(const bf16x8*)(Hb + (size_t)(q0 + r32) * DINP + ks * 16);
    f32x16 o0 = {}, o1 = {};
    float R = 0.f;
    const bf16* Kp = wsp<bf16>(ka, WS_KSF) + (size_t)bh * SEQ * 64 + 8 * lane;
    const bf16* Vp = wsp<bf16>(ka, WS_VST) + (size_t)bh * 64 * SEQ + 8 * lane;
    for (int k0 = q0; k0 >= 0; k0 -= 32) {
        bf16x8 kf[4], vf[4];
#pragma unroll
        for (int ks = 0; ks < 4; ++ks) kf[ks] = *(const bf16x8*)(Kp + (size_t)((k0 >> 5) * 4 + ks) * 512);
#pragma unroll
        for (int i = 0; i < 4; ++i) vf[i] = *(const bf16x8*)(Vp + (size_t)((k0 >> 5) * 4 + i) * 512);
        f32x16 za = {};
#pragma unroll
        for (int ks = 0; ks < 4; ++ks) za = __builtin_amdgcn_mfma_f32_32x32x16_bf16(kf[ks], qf[ks], za, 0, 0, 0);
        const bool diag = (k0 == q0);
        float L[16], lw[16];
#pragma unroll
        for (int r = 0; r < 16; ++r) {
            const float z = za[r] * 0.125f;
            const float sp = fmaxf(z, 0.f) + __logf(1.f + __expf(-fabsf(z)));
            const bool valid = !diag || (crow(r, hi) < r32);
            L[r] = valid ? -sp : 0.f;
            lw[r] = valid ? (z - sp) : -1e30f;
        }
        float e[16], T[4], U[4];
#pragma unroll
        for (int g = 0; g < 4; ++g) { e[4 * g + 3] = 0.f; e[4 * g + 2] = L[4 * g + 3]; e[4 * g + 1] = e[4 * g + 2] + L[4 * g + 2]; e[4 * g] = e[4 * g + 1] + L[4 * g + 1]; T[g] = e[4 * g] + L[4 * g]; }
#pragma unroll
        for (int g = 0; g < 4; ++g) U[g] = shx_f(T[g], 32, lane);
        float sT[4], sUge[4];
        sT[3] = 0.f; sT[2] = T[3]; sT[1] = T[3] + T[2]; sT[0] = sT[1] + T[1];
        sUge[3] = U[3]; sUge[2] = U[3] + U[2]; sUge[1] = sUge[2] + U[1]; sUge[0] = sUge[1] + U[0];
        float w[16];
#pragma unroll
        for (int g = 0; g < 4; ++g) {
            const float sfx = R + sT[g] + (hi ? (sUge[g] - U[g]) : sUge[g]);
#pragma unroll
            for (int i = 0; i < 4; ++i) w[4 * g + i] = __expf(lw[4 * g + i] + sfx + e[4 * g + i]);
        }
        R += (sT[0] + T[0]) + sUge[0];
        const bf16x8 pf0 = pack8(w[0], w[1], w[2], w[3], w[4], w[5], w[6], w[7]), pf1 = pack8(w[8], w[9], w[10], w[11], w[12], w[13], w[14], w[15]);
        o0 = __builtin_amdgcn_mfma_f32_32x32x16_bf16(vf[0], pf0, o0, 0, 0, 0);
        o0 = __builtin_amdgcn_mfma_f32_32x32x16_bf16(vf[1], pf1, o0, 0, 0, 0);
        o1 = __builtin_amdgcn_mfma_f32_32x32x16_bf16(vf[2], pf0, o1, 0, 0, 0);
        o1 = __builtin_amdgcn_mfma_f32_32x32x16_bf16(vf[3], pf1, o1, 0, 0, 0);
        if (__all(R < -88.f)) break;
    }
    bf16* dst = wsp<bf16>(ka, WS_OB) + ((size_t)b * SEQ + q0 + r32) * DM + h * 64 + 4 * hi;
#pragma unroll
    for (int g = 0; g < 4; ++g) {
        v2u wv; wv.x = pk2(o0[4 * g], o0[4 * g + 1]); wv.y = pk2(o0[4 * g + 2], o0[4 * g + 3]); *(v2u*)(dst + 8 * g) = wv;
        v2u u; u.x = pk2(o1[4 * g], o1[4 * g + 1]); u.y = pk2(o1[4 * g + 2], o1[4 * g + 3]); *(v2u*)(dst + 32 + 8 * g) = u;
    }
}

template <bool QUANT> __device__ __forceinline__ void ln_row(Frame& F, kap_t ka, int row, const float* g, const float* bb) {
    float* yr = ka->out + (size_t)row * DM;
    f32x4 v[4]; float s = 0.f;
#pragma unroll
    for (int j = 0; j < 4; ++j) { v[j] = *(const f32x4*)(yr + 4 * F.lane + 256 * j); s += (v[j].x + v[j].y) + (v[j].z + v[j].w); }
    const float mean = wave_sum_all(s, F.lane) * (1.f / DM); float s2 = 0.f;
#pragma unroll
    for (int j = 0; j < 4; ++j) { v[j] = v[j] - mean; s2 += (v[j].x * v[j].x + v[j].y * v[j].y) + (v[j].z * v[j].z + v[j].w * v[j].w); }
    const float rstd = rsqrtf(wave_sum_all(s2, F.lane) * (1.f / DM) + LN_EPS);
#pragma unroll
    for (int j = 0; j < 4; ++j) { const int c = 4 * F.lane + 256 * j; const f32x4 gg = *(const f32x4*)(g + c), bv = *(const f32x4*)(bb + c);
        const f32x4 o = v[j] * rstd * gg + bv; *(f32x4*)(yr + c) = o; v[j] = o;
        v2u w; w.x = pk2(o.x, o.y); w.y = pk2(o.z, o.w); *(v2u*)(wsp<bf16>(ka, WS_XB) + (size_t)row * DM + c) = w; }
    if (QUANT) {
        float xm = 0.f;
#pragma unroll
        for (int j = 0; j < 4; ++j) xm = fmaxf(xm, fmaxf(fmaxf(fabsf(v[j].x), fabsf(v[j].y)), fmaxf(fabsf(v[j].z), fabsf(v[j].w))));
        xm = wave_max_all(xm, F.lane);
        const float inv = xm > 0.f ? 127.f / xm : 0.f;
        unsigned char* xq = wsp<unsigned char>(ka, WS_XQ) + (size_t)row * DM;
#pragma unroll
        for (int j = 0; j < 4; ++j) *(unsigned*)(xq + 4 * F.lane + 256 * j) = ((unsigned)(int)rintf(v[j].x * inv) & 0xffu) | (((unsigned)(int)rintf(v[j].y * inv) & 0xffu) << 8) | (((unsigned)(int)rintf(v[j].z * inv) & 0xffu) << 16) | (((unsigned)(int)rintf(v[j].w * inv) & 0xffu) << 24);
        if (F.lane == 0) wsp<float>(ka, WS_SX)[row] = xm * (1.f / 127.f);
    }
}

template <int N, int K, int J, bool FLIP> __device__ __forceinline__ void bitonic_stage(unsigned (&v)[N]) {
#pragma unroll
    for (int i = 0; i < N; ++i) { const int p = i ^ J; if (p > i) { const bool desc = (((i & K) == 0) != FLIP); const unsigned a = v[i], c = v[p]; const unsigned mx = a > c ? a : c, mn = a > c ? c : a; v[i] = desc ? mx : mn; v[p] = desc ? mn : mx; } }
}
template <bool FLIP> __device__ __forceinline__ void bitonic_merge16(unsigned (&v)[16]) {
    bitonic_stage<16, 16, 8, FLIP>(v); bitonic_stage<16, 16, 4, FLIP>(v); bitonic_stage<16, 16, 2, FLIP>(v); bitonic_stage<16, 16, 1, FLIP>(v);
}
__device__ __forceinline__ unsigned ord_key(float f, unsigned idx) { const unsigned u = __float_as_uint(f); const unsigned o = u ^ ((unsigned)((int)u >> 31) | 0x80000000u); return (o & 0xFFFFFF80u) | idx; }
__device__ __forceinline__ float key_val(unsigned k) { const unsigned o = (k & 0xFFFFFF80u) | 0x40u; const unsigned u = (o & 0x80000000u) ? (o ^ 0x80000000u) : ~o; return __uint_as_float(u); }
template <int N, int K, int J, bool FLIP> __device__ __forceinline__ void bitonic_stage_kv(unsigned (&k)[N], unsigned (&p)[N]) {
#pragma unroll
    for (int i = 0; i < N; ++i) { const int q = i ^ J; if (q > i) { const bool desc = (((i & K) == 0) != FLIP); const bool sw = desc ? (k[i] < k[q]) : (k[i] > k[q]);
        const unsigned ki = sw ? k[q] : k[i], kq = sw ? k[i] : k[q], pi = sw ? p[q] : p[i], pq = sw ? p[i] : p[q]; k[i] = ki; k[q] = kq; p[i] = pi; p[q] = pq; } }
}
template <bool FLIP> __device__ __forceinline__ void bitonic_merge16_kv(unsigned (&k)[16], unsigned (&p)[16]) {
    bitonic_stage_kv<16, 16, 8, FLIP>(k, p); bitonic_stage_kv<16, 16, 4, FLIP>(k, p); bitonic_stage_kv<16, 16, 2, FLIP>(k, p); bitonic_stage_kv<16, 16, 1, FLIP>(k, p);
}
__device__ __forceinline__ void p7_half(Frame& F, kap_t ka, int l, int tok, int h, int c, unsigned (&Cc)[16]) {
    const int lane = F.lane, hi = lane >> 5;
    const bf16* qrow = wsp<bf16>(ka, WS_HB) + (size_t)tok * 2048 + h * 256 + c * 128 + 8 * hi;
    bf16x8 qf[8];
#pragma unroll
    for (int ks = 0; ks < 8; ++ks) qf[ks] = *(const bf16x8*)(qrow + ks * 16);
    const bf16* kb = wsp<bf16>(ka, WS_KEYS) + (size_t)((l * 8 + h) * 2 + c) * 16384 + 8 * lane;
    unsigned key[64];
#pragma unroll
    for (int ch = 0; ch < 4; ++ch) {
        f32x16 acc = {};
#pragma unroll
        for (int ks = 0; ks < 8; ++ks) acc = __builtin_amdgcn_mfma_f32_32x32x16_bf16(*(const bf16x8*)(kb + (ch * 8 + ks) * 512), qf[ks], acc, 0, 0, 0);
#pragma unroll
        for (int r = 0; r < 16; ++r) key[ch * 16 + r] = ord_key(acc[r], (unsigned)(ch * 32 + crow(r, hi)));
    }
    bitonic_stage<64, 2, 1, false>(key);
    bitonic_stage<64, 4, 2, false>(key); bitonic_stage<64, 4, 1, false>(key);
    bitonic_stage<64, 8, 4, false>(key); bitonic_stage<64, 8, 2, false>(key); bitonic_stage<64, 8, 1, false>(key);
    bitonic_stage<64, 16, 8, false>(key); bitonic_stage<64, 16, 4, false>(key); bitonic_stage<64, 16, 2, false>(key); bitonic_stage<64, 16, 1, false>(key);
    unsigned A[16], B[16];
#pragma unroll
    for (int i = 0; i < 16; ++i) { A[i] = key[i] > key[16 + i] ? key[i] : key[16 + i]; B[i] = key[32 + i] > key[48 + i] ? key[32 + i] : key[48 + i]; }
    bitonic_merge16<false>(A);
    bitonic_merge16<true>(B);
#pragma unroll
    for (int i = 0; i < 16; ++i) A[i] = A[i] > B[i] ? A[i] : B[i];
    bitonic_merge16<false>(A);
#pragma unroll
    for (int i = 0; i < 16; ++i) B[i] = (unsigned)shx_i((int)A[i], 32, lane);
#pragma unroll
    for (int i = 0; i < 16; ++i) Cc[i] = A[i] > B[15 - i] ? A[i] : B[15 - i];
    bitonic_merge16<false>(Cc);
}
__device__ __forceinline__ void p7_unit(Frame& F, kap_t ka, int l, int tb, int h) {
    const int lane = F.lane, r32 = lane & 31, hi = lane >> 5;
    const int tok = tb * 32 + r32;
    unsigned L0[16], L1[16];
#pragma unroll
    for (int i = 0; i < 16; ++i) { L0[i] = 0u; L1[i] = 0u; }
#pragma unroll 1
    for (int c = 0; c < 2; ++c) {
        unsigned Cc[16];
        p7_half(F, ka, l, tok, h, c, Cc);
#pragma unroll
        for (int i = 0; i < 16; ++i) { L0[i] = c == 0 ? Cc[i] : L0[i]; L1[i] = c == 0 ? L1[i] : Cc[i]; }
    }
    __builtin_amdgcn_sched_barrier(0);
    unsigned key[64];
    {
        float v0[16], v1[16];
#pragma unroll
        for (int i = 0; i < 16; ++i) { v0[i] = key_val(L0[i]); v1[i] = key_val(L1[i]); }
#define P7_ROW(a, off, nb) { _Pragma("unroll") for (int b2 = 0; b2 < (nb); ++b2) { \
            const float sum = v0[a] + v1[b2]; const unsigned u = __float_as_uint(sum); const unsigned o = u ^ ((unsigned)((int)u >> 31) | 0x80000000u); \
            key[(off) + b2] = (o & 0xFFFFFF00u) | (unsigned)(255 - (16 * (a) + b2)); } }
        P7_ROW(0, 0, 16) P7_ROW(1, 16, 8) P7_ROW(2, 24, 5) P7_ROW(3, 29, 4) P7_ROW(4, 33, 3) P7_ROW(5, 36, 2) P7_ROW(6, 38, 2) P7_ROW(7, 40, 2)
        P7_ROW(8, 42, 1) P7_ROW(9, 43, 1) P7_ROW(10, 44, 1) P7_ROW(11, 45, 1) P7_ROW(12, 46, 1) P7_ROW(13, 47, 1) P7_ROW(14, 48, 1) P7_ROW(15, 49, 1)
#undef P7_ROW
#pragma unroll
        for (int i = 50; i < 64; ++i) key[i] = 0u;
    }
    LAS unsigned char* slot = F.lds + RING_OFF + F.wave * 2304 + lane * 36;
#pragma unroll
    for (int q = 0; q < 4; ++q) {
        ((LAS unsigned*)slot)[q] = (L0[4 * q] & 127u) | ((L0[4 * q + 1] & 127u) << 8) | ((L0[4 * q + 2] & 127u) << 16) | ((L0[4 * q + 3] & 127u) << 24);
        ((LAS unsigned*)slot)[4 + q] = (L1[4 * q] & 127u) | ((L1[4 * q + 1] & 127u) << 8) | ((L1[4 * q + 2] & 127u) << 16) | ((L1[4 * q + 3] & 127u) << 24);
    }
    bitonic_stage<64, 2, 1, false>(key);
    bitonic_stage<64, 4, 2, false>(key); bitonic_stage<64, 4, 1, false>(key);
    bitonic_stage<64, 8, 4, false>(key); bitonic_stage<64, 8, 2, false>(key); bitonic_stage<64, 8, 1, false>(key);
    bitonic_stage<64, 16, 8, false>(key); bitonic_stage<64, 16, 4, false>(key); bitonic_stage<64, 16, 2, false>(key); bitonic_stage<64, 16, 1, false>(key);
    unsigned A[16], B[16];
#pragma unroll
    for (int i = 0; i < 16; ++i) { A[i] = key[i] > key[16 + i] ? key[i] : key[16 + i]; B[i] = key[32 + i] > key[48 + i] ? key[32 + i] : key[48 + i]; }
    bitonic_merge16<false>(A);
    bitonic_merge16<true>(B);
#pragma unroll
    for (int i = 0; i < 16; ++i) A[i] = A[i] > B[i] ? A[i] : B[i];
    bitonic_merge16<false>(A);
    LDS_WAIT(); asm volatile("" ::: "memory");
    unsigned PA[16]; float g[16], den = 0.f;
    { const unsigned o0 = (A[0] & 0xFFFFFF00u) | 128u; const float m = __uint_as_float((o0 & 0x80000000u) ? (o0 ^ 0x80000000u) : ~o0);
#pragma unroll
      for (int i = 0; i < 16; ++i) { const unsigned o = (A[i] & 0xFFFFFF00u) | 128u; const float sv = __uint_as_float((o & 0x80000000u) ? (o ^ 0x80000000u) : ~o); g[i] = __expf(sv - m); den += g[i];
          const unsigned flat = 255u - (A[i] & 255u); PA[i] = (unsigned)slot[flat >> 4] * 128u + (unsigned)slot[16 + (flat & 15u)]; } }
    LDS_WAIT(); asm volatile("" ::: "memory");
    const float rden = 1.f / den;
    if (hi == 0) {
        unsigned* de = wsp<unsigned>(ka, WS_EL) + (size_t)tok * 128 + h * 16; float* dg = wsp<float>(ka, WS_GL) + (size_t)tok * 128 + h * 16;
#pragma unroll
        for (int q = 0; q < 4; ++q) { *(v4u*)(de + 4 * q) = (v4u){PA[4 * q], PA[4 * q + 1], PA[4 * q + 2], PA[4 * q + 3]};
            *(f32x4*)(dg + 4 * q) = (f32x4){g[4 * q] * rden, g[4 * q + 1] * rden, g[4 * q + 2] * rden, g[4 * q + 3] * rden}; }
    }
}

__device__ __forceinline__ float dot2_bf16(unsigned w, unsigned x, float acc) { return __builtin_amdgcn_fdot2_f32_bf16(__builtin_bit_cast(bf2_t, w), __builtin_bit_cast(bf2_t, x), acc, false); }
__device__ __forceinline__ float gelu_erf(float v) {
    const float av = fabsf(v), t = __builtin_amdgcn_rcpf(av * 0.2316418882f + 1.0f);
    float q = t * 0.5307027145f + (-0.7265760135f); q = q * t + 0.7107068705f; q = q * t + (-0.142248368f); q = q * t + 0.127414796f; q = q * t;
    const float e = __builtin_amdgcn_exp2f((v * v) * (-0.72134752044f));
    const float m = v * (q * e);
    return v < 0.f ? m : v - m;
}
struct P8aS { unsigned ev0, ev1; float gv0, gv1, sx; v4u x4[4]; f32x2 sc0, sc1; int N; unsigned ent[4]; v4u buf[4][4]; };
__device__ __forceinline__ void p8a_stageA(Frame& F, kap_t ka, int l, unsigned part, LAS unsigned* qu, P8aS& S) {
    const int lane = F.lane, qd = lane >> 4, i16 = lane & 15;
    const bool in0 = (S.ev0 >> 11) == part, in1 = (S.ev1 >> 11) == part;
    const f32x2* SUV = wsp<f32x2>(ka, WS_SUV) + (size_t)l * NEXP;
    S.sc0 = (f32x2){0.f, 0.f}; S.sc1 = (f32x2){0.f, 0.f};
    if (in0) S.sc0 = SUV[S.ev0];
    if (in1) S.sc1 = SUV[S.ev1];
    const unsigned long long m0 = __ballot(in0), m1 = __ballot(in1);
    const int n0 = __builtin_popcountll(m0); S.N = n0 + __builtin_popcountll(m1);
    if (in0) qu[__builtin_amdgcn_mbcnt_hi((unsigned)(m0 >> 32), __builtin_amdgcn_mbcnt_lo((unsigned)m0, 0u))] = S.ev0 | ((unsigned)lane << 16);
    if (in1) qu[n0 + __builtin_amdgcn_mbcnt_hi((unsigned)(m1 >> 32), __builtin_amdgcn_mbcnt_lo((unsigned)m1, 0u))] = S.ev1 | ((unsigned)(64 + lane) << 16);
    if (lane < 16) qu[S.N + lane] = (part << 11) | (128u << 16);
    LDS_WAIT(); asm volatile("" ::: "memory");
    const unsigned char* UQ = wsp<unsigned char>(ka, WS_UT) + (size_t)l * NEXP * DM;
    const unsigned loff = 16u * (unsigned)i16;
#pragma unroll
    for (int gi = 0; gi < 4; ++gi) { S.ent[gi] = qu[4 * gi + qd]; const unsigned ro = ((S.ent[gi] & 0xffffu) << 10) + loff;
#pragma unroll
        for (int c = 0; c < 4; ++c) S.buf[gi][c] = *(const v4u*)(UQ + (ro + 256u * c)); }
}
__device__ __forceinline__ int p8a_dot(const v4u (&b)[4], const v4u (&x4)[4]) {
    int p = 0;
#pragma unroll
    for (int c = 0; c < 4; ++c) { p = __builtin_amdgcn_sdot4((int)b[c].x, (int)x4[c].x, p, false); p = __builtin_amdgcn_sdot4((int)b[c].y, (int)x4[c].y, p, false);
        p = __builtin_amdgcn_sdot4((int)b[c].z, (int)x4[c].z, p, false); p = __builtin_amdgcn_sdot4((int)b[c].w, (int)x4[c].w, p, false); }
    return p;
}
__device__ __forceinline__ void p8a_stageB(Frame& F, kap_t ka, int l, int tok, unsigned part, LAS unsigned* qu, LAS int* res, P8aS& S) {
    const int lane = F.lane, qd = lane >> 4, i16 = lane & 15;
    int p[4];
#pragma unroll
    for (int gi = 0; gi < 4; ++gi) p[gi] = p8a_dot(S.buf[gi], S.x4);
#pragma unroll
    for (int gi = 0; gi < 4; ++gi) p[gi] += __builtin_amdgcn_update_dpp(0, p[gi], 0xB1, 0xF, 0xF, true);
#pragma unroll
    for (int gi = 0; gi < 4; ++gi) p[gi] += __builtin_amdgcn_update_dpp(0, p[gi], 0x4E, 0xF, 0xF, true);
#pragma unroll
    for (int gi = 0; gi < 4; ++gi) p[gi] += __builtin_amdgcn_update_dpp(0, p[gi], 0x141, 0xF, 0xF, true);
#pragma unroll
    for (int gi = 0; gi < 4; ++gi) p[gi] += __builtin_amdgcn_update_dpp(0, p[gi], 0x140, 0xF, 0xF, true);
#pragma unroll
    for (int gi = 0; gi < 4; ++gi) res[S.ent[gi] >> 16] = p[gi];
    if (S.N > 16) {
        const unsigned char* UQ = wsp<unsigned char>(ka, WS_UT) + (size_t)l * NEXP * DM; const unsigned loff = 16u * (unsigned)i16;
        for (int g0 = 16; g0 < S.N; g0 += 4) {
            const unsigned en = qu[g0 + qd]; const unsigned ro = ((en & 0xffffu) << 10) + loff; v4u bb[4];
#pragma unroll
            for (int c = 0; c < 4; ++c) bb[c] = *(const v4u*)(UQ + (ro + 256u * c));
            int q = p8a_dot(bb, S.x4);
            q += __builtin_amdgcn_update_dpp(0, q, 0xB1, 0xF, 0xF, true); q += __builtin_amdgcn_update_dpp(0, q, 0x4E, 0xF, 0xF, true);
            q += __builtin_amdgcn_update_dpp(0, q, 0x141, 0xF, 0xF, true); q += __builtin_amdgcn_update_dpp(0, q, 0x140, 0xF, 0xF, true);
            res[en >> 16] = q;
        }
    }
    LDS_WAIT(); asm volatile("" ::: "memory");
    const bool in0 = (S.ev0 >> 11) == part, in1 = (S.ev1 >> 11) == part;
    float* AC = wsp<float>(ka, WS_AC) + (size_t)tok * 128;
    if (in0) AC[lane] = S.gv0 * gelu_erf((float)res[lane] * (S.sc0.x * S.sx)) * S.sc0.y;
    if (in1) AC[64 + lane] = S.gv1 * gelu_erf((float)res[64 + lane] * (S.sc1.x * S.sx)) * S.sc1.y;
}
__device__ __forceinline__ void p8a_fetch(const unsigned* EL, const float* GL, const unsigned char* XQ, const float* SX, int t, P8aS& S) {
    const size_t o = (size_t)t * 128; S.ev0 = EL[o]; S.ev1 = EL[o + 64]; S.gv0 = GL[o]; S.gv1 = GL[o + 64]; S.sx = SX[t];
#pragma unroll
    for (int c = 0; c < 4; ++c) S.x4[c] = *(const v4u*)(XQ + (size_t)t * DM + 256 * c);
}

__device__ __forceinline__ void p8b_pair(Frame& F, kap_t ka, int l, int tokA, int tokB, bool storeB, unsigned part, const v4u ev, const f32x4 av, float* ybase, LAS unsigned* le, LAS unsigned* la8) {
    const int lane = F.lane, tk = lane >> 5, g = (lane >> 3) & 3, c = lane & 7, l32 = lane & 31;
    const int tok = tk ? tokB : tokA;
    const float* yrow = ka->out + (size_t)tok * DM + 128 * part + 16 * c;
    f32x4 xv[4] = {};
    if (g == 0) {
#pragma unroll
        for (int q = 0; q < 4; ++q) xv[q] = *(const f32x4*)(yrow + 4 * q);
    }
    float am = fmaxf(fmaxf(fabsf(av.x), fabsf(av.y)), fmaxf(fabsf(av.z), fabsf(av.w)));
    am = fmaxf(am, dpp_f<0xB1>(am)); am = fmaxf(am, dpp_f<0x4E>(am)); am = fmaxf(am, dpp_f<0x141>(am)); am = fmaxf(am, dpp_f<0x140>(am)); am = fmaxf(am, shx_f(am, 16, lane));
    const float inv = am > 0.f ? 127.f / am : 0.f, sa = am * (1.f / 127.f);
    *(LAS v4u*)(le + tk * 128 + 4 * l32) = ev;
    la8[tk * 32 + l32] = ((unsigned)(int)rintf(av.x * inv) & 0xffu) | (((unsigned)(int)rintf(av.y * inv) & 0xffu) << 8) | (((unsigned)(int)rintf(av.z * inv) & 0xffu) << 16) | (((unsigned)(int)rintf(av.w * inv) & 0xffu) << 24);
    LDS_WAIT(); asm volatile("" ::: "memory");
    const unsigned char* VQ = wsp<unsigned char>(ka, WS_VT) + (size_t)l * NEXP * DM + (size_t)part * NEXP * 128;
    const unsigned loff = 16u * (unsigned)c;
    const LAS unsigned* lek = le + tk * 128 + 4 * g;
    v4u R[32];
#pragma unroll
    for (int i = 0; i < 32; ++i) R[i] = *(const v4u*)(VQ + ((lek[16 * (i >> 2) + (i & 3)] << 7) + loff));
    int acc[16];
#pragma unroll
    for (int i = 0; i < 16; ++i) acc[i] = 0;
#pragma unroll
    for (int m = 0; m < 8; ++m) {
        const int ap = (int)la8[tk * 32 + 4 * m + g];
#pragma unroll
        for (int d = 0; d < 4; ++d) {
            const unsigned r0 = R[4 * m][d], r1 = R[4 * m + 1][d], r2 = R[4 * m + 2][d], r3 = R[4 * m + 3][d];
            const unsigned t01l = __builtin_amdgcn_perm(r1, r0, 0x05010400u), t01h = __builtin_amdgcn_perm(r1, r0, 0x07030602u);
            const unsigned t23l = __builtin_amdgcn_perm(r3, r2, 0x05010400u), t23h = __builtin_amdgcn_perm(r3, r2, 0x07030602u);
            acc[4 * d] = __builtin_amdgcn_sdot4((int)__builtin_amdgcn_perm(t23l, t01l, 0x05040100u), ap, acc[4 * d], false);
            acc[4 * d + 1] = __builtin_amdgcn_sdot4((int)__builtin_amdgcn_perm(t23l, t01l, 0x07060302u), ap, acc[4 * d + 1], false);
            acc[4 * d + 2] = __builtin_amdgcn_sdot4((int)__builtin_amdgcn_perm(t23h, t01h, 0x05040100u), ap, acc[4 * d + 2], false);
            acc[4 * d + 3] = __builtin_amdgcn_sdot4((int)__builtin_amdgcn_perm(t23h, t01h, 0x07060302u), ap, acc[4 * d + 3], false);
        }
    }
#pragma unroll
    for (int i = 0; i < 16; ++i) { acc[i] += shx_i(acc[i], 8, lane); acc[i] += shx_i(acc[i], 16, lane); }
    if (g == 0 && (tk == 0 || storeB)) {
        float* yd = ybase + (size_t)tok * DM + 128 * part + 16 * c;
#pragma unroll
        for (int q = 0; q < 4; ++q) { const f32x4 x = xv[q];
            *(f32x4*)(yd + 4 * q) = (f32x4){ALPHA * x.x + (float)acc[4 * q] * sa, ALPHA * x.y + (float)acc[4 * q + 1] * sa, ALPHA * x.z + (float)acc[4 * q + 2] * sa, ALPHA * x.w + (float)acc[4 * q + 3] * sa}; }
    }
    LDS_WAIT(); asm volatile("" ::: "memory");
}

__global__ void __launch_bounds__(NTHREADS, 2) mk_fwd(Args args) {
    extern __shared__ __attribute__((aligned(16))) unsigned char lds[];
    Frame F;
    F.lds = (LAS unsigned char*)lds;
    F.MISC = (volatile LAS unsigned*)(F.lds + MISC_OFF);
    F.tid = threadIdx.x; F.lane = F.tid & 63; F.wave = __builtin_amdgcn_readfirstlane(F.tid >> 6);
    F.G = gridDim.x; { const int bx = blockIdx.x; F.vcu = (F.G % 8 == 0) ? (bx % 8) * (F.G / 8) + bx / 8 : bx; }
    for (int u = F.tid; u < (LDS_BYTES - LDSCTL_OFF) / 4; u += NTHREADS) ((LAS unsigned*)(F.lds + LDSCTL_OFF))[u] = 0u;
    __syncthreads();
    const int lo = args.ph_lo, hi = args.ph_hi;
    unsigned* const barw = (unsigned*)(args.ws + WS_CTL) + CW_BAR;
    const bool one_phase = (hi - lo) == 1;
    XcdBarrier bar; bar.bar = barw; bar.x = 0; bar.st = nullptr;
    if (!one_phase) bar = xcd_barrier_post(barw, F.MISC + 8);
#ifndef MK_EN
#define MK_EN 0x7ff
#endif
#ifndef MK_MLA_LDS
#define MK_MLA_LDS 0
#endif
#ifndef MK_MLA_REP
#define MK_MLA_REP 1
#endif
#ifndef MK_SB_REP
#define MK_SB_REP 1
#endif
#ifndef MK_P8B_VAR
#define MK_P8B_VAR 0
#endif
#define EN(n) (((MK_EN) >> (n)) & 1)
#ifndef MK_REP
#define MK_REP 0
#endif
#define PHASE_REP(n) for (int rep_ = 0; rep_ < ((((MK_REP) >> (n)) & 1) + 1); ++rep_)
#define IN(k) (lo <= (k) && (k) < hi)
#define PHASE_IDS() do { unsigned z_ = 0u; asm volatile("" : "+v"(z_)); const int ln_ = (int)__builtin_amdgcn_mbcnt_hi(~0u, __builtin_amdgcn_mbcnt_lo(~0u, z_)); F.lane = ln_; F.tid = F.wave * 64 + ln_; } while (0)
#define SEAM(k) do { if (IN((k) + 1)) { XcdBarrier b_ = bar; asm volatile("" : "+s"(b_.bar), "+s"(b_.x));     xcd_barrier(b_); } } while (0)
    const int gw = F.vcu * NWAVES + F.wave, NGW = F.G * NWAVES;

    if (EN(0) && IN(0)) PHASE_REP(0) { PHASE_IDS(); p0_prologue(F, ka_fresh()); SEAM(0); }
#pragma unroll
    for (int l = 0; l < DEPTH; ++l) {
        const int pb = 1 + NPL * l;
        if (EN(1) && IN(pb + 0)) PHASE_REP(1) { const kap_t ka = ka_fresh(); PHASE_IDS();
            pg8::Gemm g{wsp<bf16>(ka, WS_XB), wsp<bf16>(ka, WS_WIT) + (size_t)l * DINP * DM, NTOK, DINP, DM}; pg8::StaticOrder S; S.init(NTOK, DINP, F.G, (int)blockIdx.x);
            pg8::EpiBf16<0> E{wsp<bf16>(ka, WS_HB), DINP, nullptr, 0, 0, 1.f};
            pg8::gemm_phase<pg8::EpiBf16<0>, pg8::StaticOrder, PG8_ALIGN, PG8_SP2>(F.lds + RING_OFF, g, S, E, F.tid);
            SEAM(pb + 0);
        }
        if (EN(2) && IN(pb + 1)) PHASE_REP(2) { const kap_t ka = ka_fresh(); PHASE_IDS();
            for (int u = gw; u < (NTOK / 32) * 4; u += NGW) p2_unit(F, ka, l, u >> 2, u & 3);
            SEAM(pb + 1);
        }
        if (EN(3) && IN(pb + 2)) PHASE_REP(3) { const kap_t ka = ka_fresh(); PHASE_IDS();
#if MK_MLA_LDS
            for (int u = F.vcu; u < 32 * 8; u += F.G) {
                const int bh = u >> 3, j = u & 7;
                mla_block(F, ka, bh, 15 - j); sb_unit(F, ka, bh, 8 * (15 - j) + F.wave);
                mla_block(F, ka, bh, j); sb_unit(F, ka, bh, 8 * j + F.wave);
            }
#else
            for (int u = gw; u < 32 * 64; u += NGW) {
                const int bh = u >> 6, pi = u & 63;
                for (int r_ = 0; r_ < MK_MLA_REP; ++r_) { mla_unit(F, ka, bh, 127 - pi); mla_unit(F, ka, bh, pi); }
            }
            PHASE_IDS();
            for (int u = gw; u < 32 * 64; u += NGW) {
                const int bh = u >> 6, pi = u & 63;
                for (int r_ = 0; r_ < MK_SB_REP; ++r_) { sb_unit(F, ka, bh, 127 - pi); sb_unit(F, ka, bh, pi); }
            }
#endif
            SEAM(pb + 2);
        }
        if (EN(4) && IN(pb + 3)) PHASE_REP(4) { const kap_t ka = ka_fresh(); PHASE_IDS();
            pg8::Gemm g{wsp<bf16>(ka, WS_OB), wsp<bf16>(ka, WS_WOT) + (size_t)l * DM * DM, NTOK, DM, DM}; pg8::StaticOrder S; S.init(NTOK, DM, F.G, (int)blockIdx.x);
            pg8::EpiResF32 E{l == 0 ? ka->in[I_X] : ka->out, ka->out, DM, ALPHA};
            pg8::gemm_phase<pg8::EpiResF32, pg8::StaticOrder, PG8_ALIGN, PG8_SP2>(F.lds + RING_OFF, g, S, E, F.tid);
            SEAM(pb + 3);
        }
        if (EN(5) && IN(pb + 4)) PHASE_REP(5) { const kap_t ka = ka_fresh(); PHASE_IDS();
            for (int r = gw; r < NTOK; r += NGW) ln_row<true>(F, ka, r, ka->in[I_LN1G] + l * DM, ka->in[I_LN1B] + l * DM);
            SEAM(pb + 4);
        }
        if (EN(6) && IN(pb + 5)) PHASE_REP(6) { const kap_t ka = ka_fresh(); PHASE_IDS();
            pg8::Gemm g{wsp<bf16>(ka, WS_XB), wsp<bf16>(ka, WS_WQT) + (size_t)l * 2048 * DM, NTOK, 2048, DM}; pg8::StaticOrder S; S.init(NTOK, 2048, F.G, (int)blockIdx.x);
            pg8::EpiBf16<0> E{wsp<bf16>(ka, WS_HB), 2048, nullptr, 0, 0, 1.f};
            pg8::gemm_phase<pg8::EpiBf16<0>, pg8::StaticOrder, PG8_ALIGN, PG8_SP2>(F.lds + RING_OFF, g, S, E, F.tid);
            SEAM(pb + 5);
        }
        if (EN(7) && IN(pb + 6)) PHASE_REP(7) { const kap_t ka = ka_fresh(); PHASE_IDS();
            for (int u = gw; u < (NTOK / 32) * 8; u += NGW) p7_unit(F, ka, l, u >> 3, u & 7);
            SEAM(pb + 6);
        }
        if (EN(8) && IN(pb + 7)) PHASE_REP(8) { const kap_t ka = ka_fresh(); PHASE_IDS();
            const bool split = (F.G % 8 == 0); const int npp = split ? F.G / 8 : F.G;
            for (unsigned part = split ? (unsigned)(F.vcu / npp) : 0u, pend = split ? part + 1u : 8u; part < pend; ++part) {
                const int pw = (F.vcu % npp) * NWAVES + F.wave, npw = npp * NWAVES;
                const unsigned* EL = wsp<unsigned>(ka, WS_EL) + F.lane; const float* GL = wsp<float>(ka, WS_GL) + F.lane;
                const unsigned char* XQ = wsp<unsigned char>(ka, WS_XQ) + 16 * (F.lane & 15); const float* SX = wsp<float>(ka, WS_SX);
                LAS unsigned* quA = (LAS unsigned*)(F.lds + RING_OFF + F.wave * 4096); LAS int* rsA = (LAS int*)(F.lds + RING_OFF + F.wave * 4096 + 1024);
                LAS unsigned* quB = (LAS unsigned*)(F.lds + RING_OFF + F.wave * 4096 + 2048); LAS int* rsB = (LAS int*)(F.lds + RING_OFF + F.wave * 4096 + 3072);
                const int nt = (NTOK - pw + npw - 1) / npw;
                if (nt > 0) {
                    P8aS SA, SB;
                    p8a_fetch(EL, GL, XQ, SX, pw, SA);
                    p8a_stageA(F, ka, l, part, quA, SA);
                    int t = pw;
                    for (int i = 0; i + 2 < nt; i += 2, t += 2 * npw) {
                        p8a_fetch(EL, GL, XQ, SX, t + npw, SB);
                        p8a_stageA(F, ka, l, part, quB, SB);
                        p8a_stageB(F, ka, l, t, part, quA, rsA, SA);
                        p8a_fetch(EL, GL, XQ, SX, t + 2 * npw, SA);
                        LDS_WAIT(); asm volatile("" ::: "memory");
                        p8a_stageA(F, ka, l, part, quA, SA);
                        p8a_stageB(F, ka, l, t + npw, part, quB, rsB, SB);
                        LDS_WAIT(); asm volatile("" ::: "memory");
                    }
                    if (t + npw < NTOK) {
                        p8a_fetch(EL, GL, XQ, SX, t + npw, SB);
                        p8a_stageA(F, ka, l, part, quB, SB);
                        p8a_stageB(F, ka, l, t, part, quA, rsA, SA);
                        p8a_stageB(F, ka, l, t + npw, part, quB, rsB, SB);
                    } else {
                        p8a_stageB(F, ka, l, t, part, quA, rsA, SA);
                    }
                    LDS_WAIT(); asm volatile("" ::: "memory");
                }
            }
            SEAM(pb + 7);
        }
        if (EN(9) && IN(pb + 8)) PHASE_REP(9) { const kap_t ka = ka_fresh(); PHASE_IDS();
            const bool split = (F.G % 8 == 0); const int npp = split ? F.G / 8 : F.G;
            for (unsigned part = split ? (unsigned)(F.vcu / npp) : 0u, pend = split ? part + 1u : 8u; part < pend; ++part) {
                const int pw = (F.vcu % npp) * NWAVES + F.wave, npw = npp * NWAVES;
                LAS unsigned* le = (LAS unsigned*)(F.lds + RING_OFF + F.wave * 2048); LAS unsigned* la8 = (LAS unsigned*)(F.lds + RING_OFF + F.wave * 2048 + 1024);
                float* ybase = (rep_ == 0) ? ka->out : (float*)wsp<bf16>(ka, WS_HB);
                const int tk = F.lane >> 5, l32 = F.lane & 31;
                const unsigned* EL = wsp<unsigned>(ka, WS_EL) + 4 * l32; const float* AC = wsp<float>(ka, WS_AC) + 4 * l32;
                v4u ev = {}; f32x4 av = {};
                { const int t0 = pw + tk * npw; if (pw < NTOK) { const int tt = t0 < NTOK ? t0 : pw; ev = *(const v4u*)(EL + (size_t)tt * 128); av = *(const f32x4*)(AC + (size_t)tt * 128); } }
                for (int t = pw; t < NTOK; t += 2 * npw) {
                    const int tB = t + npw; const bool hasB = tB < NTOK;
                    v4u nev = {}; f32x4 nav = {};
                    if (t + 2 * npw < NTOK) { const int t0 = t + 2 * npw + tk * npw; const int tt = t0 < NTOK ? t0 : t + 2 * npw; nev = *(const v4u*)(EL + (size_t)tt * 128); nav = *(const f32x4*)(AC + (size_t)tt * 128); }
                    p8b_pair(F, ka, l, t, hasB ? tB : t, hasB, part, ev, av, ybase, le, la8);
                    ev = nev; av = nav;
                }
            }
            SEAM(pb + 8);
        }
        if (EN(10) && IN(pb + 9)) PHASE_REP(10) { const kap_t ka = ka_fresh(); PHASE_IDS();
            for (int r = gw; r < NTOK; r += NGW) ln_row<false>(F, ka, r, ka->in[I_LN2G] + l * DM, ka->in[I_LN2B] + l * DM);
            if (l + 1 < DEPTH) SEAM(pb + 9);
        }
    }
#undef IN
#undef SEAM
}

#ifndef MK_PER_PHASE
#define MK_PER_PHASE 0
#endif
extern "C" void kernel_launch(void* const* d_in, const int* in_sizes, int n_in, void* d_out, int out_size, void* d_ws, size_t ws_size, hipStream_t stream) {
    static int grid = 0;
    if (grid == 0) {
        if (n_in != 15 || out_size != NTOK * DM || ws_size < WS_END) { fprintf(stderr, "kernel_launch: unexpected shapes (n_in %d, out %d, ws %zu); nothing launched\n", n_in, out_size, ws_size); grid = -1; return; }
        int dev = 0, cus = 0, per_cu = 0;
        if (hipGetDevice(&dev) != hipSuccess || hipDeviceGetAttribute(&cus, hipDeviceAttributeMultiprocessorCount, dev) != hipSuccess) { fprintf(stderr, "kernel_launch: device query failed\n"); grid = -1; return; }
        if (hipFuncSetAttribute((const void*)mk_fwd, hipFuncAttributeMaxDynamicSharedMemorySize, LDS_BYTES) != hipSuccess) { fprintf(stderr, "kernel_launch: hipFuncSetAttribute failed\n"); grid = -1; return; }
        if (hipOccupancyMaxActiveBlocksPerMultiprocessor(&per_cu, (const void*)mk_fwd, NTHREADS, LDS_BYTES) != hipSuccess || per_cu < 1) { fprintf(stderr, "kernel_launch: occupancy query says %d blocks per CU\n", per_cu); per_cu = 1; }
        (void)hipGetLastError();
        grid = cus;
        fprintf(stderr, "kernel_launch: grid %d (occupancy query %d per CU)\n", grid, per_cu);
    }
    if (grid < 0) return;
    (void)hipMemsetAsync((char*)d_ws + WS_CTL, 0, CTL_ZERO_BYTES, stream);
    Args a{};
    for (int i = 0; i < 15; ++i) a.in[i] = (const float*)d_in[i];
    a.out = (float*)d_out; a.ws = (unsigned char*)d_ws;
#if MK_PER_PHASE
    for (int p = 0; p < NPHASE; ++p) { a.ph_lo = p; a.ph_hi = p + 1; hipLaunchKernelGGL(mk_fwd, dim3(grid), dim3(NTHREADS), LDS_BYTES, stream, a); }
#else
    a.ph_lo = 0; a.ph_hi = NPHASE;
    void* kargs[] = {&a};
    const hipError_t e = hipLaunchCooperativeKernel((const void*)mk_fwd, dim3(grid), dim3(NTHREADS), kargs, LDS_BYTES, stream);
    if (e != hipSuccess) fprintf(stderr, "kernel_launch: cooperative launch failed: %s (grid %d)\n", hipGetErrorString(e), grid);
#endif
}
```

```cpp
#include <hip/hip_runtime.h>
#include <cstdio>
#include <cstdint>
#include <math.h>
namespace pg8 {
#define PG8_LAS __attribute__((address_space(3)))
typedef unsigned short bf16_t;
typedef short bf16x8 __attribute__((ext_vector_type(8)));
typedef float f32x4 __attribute__((ext_vector_type(4)));
typedef unsigned u32x4 __attribute__((ext_vector_type(4)));
constexpr int BM = 256, BK = 64, HALF = 128, HTB = HALF * BK * 2  , STAGE_BYTES = 8 * HTB, NXCD = 8, WGM = 8;

__host__ __device__ __forceinline__ int lds_byte(int r, int c) { const int st = (r >> 4) * 2 + (c >> 5), rr = r & 15, cc = c & 31, ob = rr * 64 + cc * 2; return st * 1024 + (ob ^ (((ob >> 9) & 1) << 5)); }
__host__ __device__ __forceinline__ void stage_rc(int b, int& R, int& C) { const int st = b / 1024, sb = b % 1024, swz = sb ^ (((sb >> 9) & 1) << 5); R = (st >> 1) * 16 + swz / 64; C = (st & 1) * 32 + (swz % 64) / 2; }
__host__ __device__ __forceinline__ int perm32(int rho) { const int n = rho >> 4, i = rho & 15; return 8 * (i >> 2) + 4 * n + (i & 3); }

struct Unit { int pm, pn; };
struct Gemm { const bf16_t* A; const bf16_t* Bt; int M, N, K; };

struct StaticOrder {
    int nM, nN, nwg, G, c;
    __host__ __device__ void init(int M, int N, int G_, int c_) { nM = M / BM; nN = N / BM; nwg = nM * nN; G = G_; c = c_; }
    __host__ __device__ bool next(int i, Unit& u) const {
        const long L = (long)i * G + c; if (L >= nwg) return false;
        int wgid = (int)L; { const int q = nwg / NXCD, r = nwg % NXCD, xcd = wgid % NXCD, off = wgid / NXCD; wgid = (xcd < r ? xcd * (q + 1) : r * (q + 1) + (xcd - r) * q) + off; }
        const int nig = WGM * nN, gid = wgid / nig, fm = gid * WGM, gsz = (nM - fm) < WGM ? (nM - fm) : WGM;
        u.pm = fm + ((wgid % nig) % gsz); u.pn = (wgid % nig) / gsz; return true;
    }
    __device__ __forceinline__ void a_ready(const Unit&) const {}
    __device__ __forceinline__ void done(const Unit&) const {}
};

__device__ __forceinline__ unsigned cvt_pk_bf16(float lo, float hi) { unsigned r; asm volatile("v_cvt_pk_bf16_f32 %0, %1, %2" : "=v"(r) : "v"(lo), "v"(hi)); return r; }
typedef float f32x2 __attribute__((ext_vector_type(2)));
__device__ __forceinline__ f32x2 gelu_pk(f32x2 v) {
    const f32x2 av = __builtin_elementwise_abs(v), d = av * 0.2316418882f + 1.0f;
    f32x2 t; t.x = __builtin_amdgcn_rcpf(d.x); t.y = __builtin_amdgcn_rcpf(d.y);
    f32x2 q = t * 0.5307027145f + (-0.7265760135f); q = q * t + 0.7107068705f; q = q * t + (-0.142248368f); q = q * t + 0.127414796f; q = q * t;
    const f32x2 s = (v * v) * (-0.72134752044f);
    f32x2 e; e.x = __builtin_amdgcn_exp2f(s.x); e.y = __builtin_amdgcn_exp2f(s.y);
    const f32x2 m = v * (q * e), r = v - m;
    f32x2 o; o.x = v.x < 0.f ? m.x : r.x; o.y = v.y < 0.f ? m.y : r.y; return o;
}

template <int ACT  > struct EpiBf16 {
    static constexpr bool PERM = true, AFTER_DRAIN = false; static_assert(ACT == 0 || ACT == 1, "EpiBf16: ACT is 0 (none) or 1 (gelu_pk)");
    bf16_t* O; int ldc; const float* bias; int split_cols; size_t split_stride; float scale0;
    __device__ __forceinline__ void operator()(const f32x4 (&acc)[2][2][4][2], const Unit& u, int wr, int wc, int fr, int fq) const {
        const int row0 = u.pm * BM + wr * 64 + fr; int colt = u.pn * BM; bf16_t* base = O;
        float sc = 1.f; if (split_cols) { const int t = colt / split_cols; base += (size_t)t * split_stride; colt -= t * split_cols; if (t == 0) sc = scale0; }
        const int col0 = colt + wc * 32 + 8 * fq, bcol0 = u.pn * BM + wc * 32 + 8 * fq;
        f32x4 bv[2][2];
#pragma unroll
        for (int bj = 0; bj < 2; ++bj)
#pragma unroll
            for (int n = 0; n < 2; ++n) bv[bj][n] = bias ? *(const f32x4*)(bias + bcol0 + bj * HALF + 4 * n) : (f32x4){0.f, 0.f, 0.f, 0.f};
#pragma unroll
        for (int ai = 0; ai < 2; ++ai)
#pragma unroll
            for (int m = 0; m < 4; ++m) { bf16_t* rowp = base + (size_t)(row0 + ai * HALF + m * 16) * ldc + col0;
#pragma unroll
                for (int bj = 0; bj < 2; ++bj) { f32x4 v0 = acc[ai][bj][m][0] + bv[bj][0], v1 = acc[ai][bj][m][1] + bv[bj][1];
                    if (ACT == 1) { f32x2 a = gelu_pk((f32x2){v0[0], v0[1]}), b = gelu_pk((f32x2){v0[2], v0[3]}), c = gelu_pk((f32x2){v1[0], v1[1]}), d = gelu_pk((f32x2){v1[2], v1[3]});
                        v0 = (f32x4){a.x, a.y, b.x, b.y}; v1 = (f32x4){c.x, c.y, d.x, d.y}; }
                    v0 = v0 * sc; v1 = v1 * sc; u32x4 w; w.x = cvt_pk_bf16(v0[0], v0[1]); w.y = cvt_pk_bf16(v0[2], v0[3]); w.z = cvt_pk_bf16(v1[0], v1[1]); w.w = cvt_pk_bf16(v1[2], v1[3]);
                    *(u32x4*)(rowp + bj * HALF) = w; } }
    }
};
struct EpiResF32 {
    static constexpr bool PERM = false, AFTER_DRAIN = false;
    const float* res; float* out; int ldc; float alpha;
    __device__ __forceinline__ void operator()(const f32x4 (&acc)[2][2][4][2], const Unit& u, int wr, int wc, int fr, int fq) const {
        const int row0 = u.pm * BM + wr * 64 + fr, col0 = u.pn * BM + wc * 32 + 4 * fq;
#pragma unroll
        for (int ai = 0; ai < 2; ++ai)
#pragma unroll
            for (int m = 0; m < 4; ++m) { const size_t off = (size_t)(row0 + ai * HALF + m * 16) * ldc + col0;
#pragma unroll
                for (int bj = 0; bj < 2; ++bj)
#pragma unroll
                    for (int n = 0; n < 2; ++n) { const f32x4 rs = *(const f32x4*)(res + off + bj * HALF + n * 16); *(f32x4*)(out + off + bj * HALF + n * 16) = rs * alpha + acc[ai][bj][m][n]; }
                if (m & 1) asm volatile("" ::: "memory"); }
    }
};
template <class Epi, class Sched, bool ALIGN_EPI = false, bool SP2 = false>
__device__ __forceinline__ void gemm_phase(PG8_LAS unsigned char* lds, const Gemm g, const Sched& S, const Epi& E, int tid_in) {
    int tid_ = tid_in; asm volatile("" : "+v"(tid_));
    const int tid = tid_, wid = __builtin_amdgcn_readfirstlane(tid >> 6), lane = tid & 63, wr = wid >> 2, wc = wid & 3, fr = lane & 15, fq = lane >> 4;
    const int K = g.K, nt = K / BK;
    unsigned voffA[2], voffB[2];
#pragma unroll
    for (int i = 0; i < 2; ++i) { int R, C; stage_rc(tid * 16 + i * 8192, R, C); const int Rb = Epi::PERM ? ((R & ~31) + perm32(R & 31)) : R;
        voffA[i] = (unsigned)(R * K + C) * 2u; voffB[i] = (unsigned)(Rb * K + C) * 2u; }
    const size_t kstep = (size_t)(BK * 2);
    const size_t hstep = (size_t)HALF * K * 2;
    const size_t tstep = 2 * hstep;
    const unsigned ldsw = (unsigned)wid * 1024u;
    const int aoff = lds_byte(wr * 64 + fr, fq * 8), boff = lds_byte(wc * 32 + fr, fq * 8);
#define PG8_SA(b, h) (((b) * 2 + (h)) * HTB)
#define PG8_SB(b, h) ((4 + (b) * 2 + (h)) * HTB)
#define PG8_STAGE(bufoff, gbase, voff) do { _Pragma("unroll") for (int _i = 0; _i < 2; ++_i) \
        __builtin_amdgcn_global_load_lds((const unsigned*)((const char*)(gbase) + (voff)[_i]), (PG8_LAS unsigned*)(lds + (bufoff) + ldsw + _i * 8192), 16, 0, 0); } while (0)
#define PG8_LDA(dst, b, h) do { _Pragma("unroll") for (int m = 0; m < 4; ++m) _Pragma("unroll") for (int k = 0; k < 2; ++k) dst[m][k] = *(const PG8_LAS bf16x8*)(lds + PG8_SA(b, h) + aoff + m * 2048 + k * 1024); } while (0)
#define PG8_LDB(dst, b, h) do { _Pragma("unroll") for (int n = 0; n < 2; ++n) _Pragma("unroll") for (int k = 0; k < 2; ++k) dst[n][k] = *(const PG8_LAS bf16x8*)(lds + PG8_SB(b, h) + boff + n * 2048 + k * 1024); } while (0)
#define PG8_MMA(ai, bj, At, Bt) do { __builtin_amdgcn_s_setprio(1); _Pragma("unroll") for (int m = 0; m < 4; ++m) _Pragma("unroll") for (int n = 0; n < 2; ++n) _Pragma("unroll") for (int k = 0; k < 2; ++k) \
        acc[ai][bj][m][n] = __builtin_amdgcn_mfma_f32_16x16x32_bf16(Bt[n][k], At[m][k], acc[ai][bj][m][n], 0, 0, 0); __builtin_amdgcn_s_setprio(0); } while (0)
#define PG8_WAIT_V(n) asm volatile("s_waitcnt vmcnt(" #n ")" ::: "memory")
#define PG8_WAIT_L(n) asm volatile("s_waitcnt lgkmcnt(" #n ")" ::: "memory")
#define PG8_BAR __builtin_amdgcn_s_barrier()
#define PG8_SCHED __builtin_amdgcn_sched_barrier(0)
    Unit cur, nxt; int ui = 0;
    if (!S.next(0, cur)) return;
    f32x4 acc[2][2][4][2];
#pragma unroll
    for (int a = 0; a < 2; ++a)
#pragma unroll
        for (int b = 0; b < 2; ++b)
#pragma unroll
            for (int m = 0; m < 4; ++m)
#pragma unroll
                for (int n = 0; n < 2; ++n) acc[a][b][m][n] = (f32x4){0.f, 0.f, 0.f, 0.f};
    bf16x8 At[4][2], B0[2][2], B1[2][2];
    const char* cA = (const char*)g.A + (size_t)cur.pm * tstep; const char* cB = (const char*)g.Bt + (size_t)cur.pn * tstep;
    S.a_ready(cur);
    if constexpr (SP2) {
        PG8_STAGE(PG8_SB(0, 0), cB, voffB); PG8_STAGE(PG8_SB(0, 1), cB + hstep, voffB); PG8_STAGE(PG8_SA(0, 0), cA, voffA); PG8_STAGE(PG8_SA(0, 1), cA + hstep, voffA);
        if (wr == 1) PG8_BAR;
        PG8_WAIT_V(2); PG8_BAR;
        PG8_STAGE(PG8_SB(1, 0), cB + kstep, voffB); PG8_STAGE(PG8_SA(1, 0), cA + kstep, voffA); PG8_STAGE(PG8_SB(1, 1), cB + hstep + kstep, voffB);
        PG8_WAIT_V(6); PG8_BAR;
    } else {
        PG8_STAGE(PG8_SB(0, 0), cB, voffB); PG8_STAGE(PG8_SA(0, 0), cA, voffA); PG8_STAGE(PG8_SB(0, 1), cB + hstep, voffB); PG8_STAGE(PG8_SA(0, 1), cA + hstep, voffA);
        if (wr == 1) PG8_BAR;
        PG8_WAIT_V(4); PG8_BAR;
        PG8_STAGE(PG8_SB(1, 0), cB + kstep, voffB); PG8_STAGE(PG8_SA(1, 0), cA + kstep, voffA); PG8_STAGE(PG8_SB(1, 1), cB + hstep + kstep, voffB);
        PG8_WAIT_V(6); PG8_BAR;
    }
    for (;;) {
        const bool has_next = S.next(ui + 1, nxt);
        const char* nA = has_next ? (const char*)g.A + (size_t)nxt.pm * tstep : cA; const char* nB = has_next ? (const char*)g.Bt + (size_t)nxt.pn * tstep : cB;
        for (int t = 0; t < nt; t += 2) {
            const bool last = (t == nt - 2);
            const char* a1 = cA + (size_t)(t + 1) * kstep;
            const char* a2 = last ? nA : cA + (size_t)(t + 2) * kstep; const char* b2 = last ? nB : cB + (size_t)(t + 2) * kstep;
            const char* a3 = a2 + kstep; const char* b3 = b2 + kstep;
            if (last && has_next) S.a_ready(nxt);
            if constexpr (SP2) {
            PG8_LDB(B0, 0, 0); PG8_LDB(B1, 0, 1); PG8_SCHED; PG8_LDA(At, 0, 0); PG8_STAGE(PG8_SA(1, 1), a1 + hstep, voffA);
            PG8_WAIT_V(8); PG8_WAIT_L(0); PG8_BAR; PG8_MMA(0, 0, At, B0); PG8_MMA(0, 1, At, B1); PG8_BAR; PG8_SCHED;
            PG8_LDA(At, 0, 1); PG8_STAGE(PG8_SB(0, 0), b2, voffB); PG8_STAGE(PG8_SB(0, 1), b2 + hstep, voffB); PG8_STAGE(PG8_SA(0, 0), a2, voffA);
            PG8_WAIT_V(8); PG8_WAIT_L(0); PG8_BAR; PG8_MMA(1, 0, At, B0); PG8_MMA(1, 1, At, B1); PG8_BAR; PG8_SCHED;
            PG8_LDB(B0, 1, 0); PG8_LDB(B1, 1, 1); PG8_SCHED; PG8_LDA(At, 1, 0); PG8_STAGE(PG8_SA(0, 1), a2 + hstep, voffA);
            PG8_WAIT_V(8); PG8_WAIT_L(0); PG8_BAR; PG8_MMA(0, 0, At, B0); PG8_MMA(0, 1, At, B1); PG8_BAR; PG8_SCHED;
            PG8_LDA(At, 1, 1); PG8_STAGE(PG8_SB(1, 0), b3, voffB); PG8_STAGE(PG8_SB(1, 1), b3 + hstep, voffB); PG8_STAGE(PG8_SA(1, 0), a3, voffA);
            PG8_WAIT_V(8); PG8_WAIT_L(0); PG8_BAR; PG8_MMA(1, 0, At, B0); PG8_MMA(1, 1, At, B1); PG8_BAR; PG8_SCHED;
            } else {
            PG8_LDB(B0, 0, 0); PG8_SCHED; PG8_LDA(At, 0, 0); PG8_STAGE(PG8_SA(1, 1), a1 + hstep, voffA);
            PG8_WAIT_L(8); PG8_BAR; PG8_WAIT_L(0); PG8_MMA(0, 0, At, B0); PG8_BAR; PG8_SCHED;
            PG8_LDB(B1, 0, 1); PG8_STAGE(PG8_SB(0, 0), b2, voffB);
            PG8_BAR; PG8_WAIT_L(0); PG8_MMA(0, 1, At, B1); PG8_BAR;
            PG8_LDA(At, 0, 1); PG8_STAGE(PG8_SA(0, 0), a2, voffA);
            PG8_BAR; PG8_WAIT_L(0); PG8_MMA(1, 0, At, B0); PG8_BAR; PG8_SCHED;
            PG8_STAGE(PG8_SB(0, 1), b2 + hstep, voffB);
            PG8_WAIT_V(6); PG8_BAR; PG8_MMA(1, 1, At, B1); PG8_BAR;
            PG8_LDB(B0, 1, 0); PG8_SCHED; PG8_LDA(At, 1, 0); PG8_STAGE(PG8_SA(0, 1), a2 + hstep, voffA);
            PG8_WAIT_L(8); PG8_BAR; PG8_WAIT_L(0); PG8_MMA(0, 0, At, B0); PG8_BAR; PG8_SCHED;
            PG8_LDB(B1, 1, 1); PG8_STAGE(PG8_SB(1, 0), b3, voffB);
            PG8_BAR; PG8_WAIT_L(0); PG8_MMA(0, 1, At, B1); PG8_BAR;
            PG8_LDA(At, 1, 1); PG8_STAGE(PG8_SA(1, 0), a3, voffA);
            PG8_BAR; PG8_WAIT_L(0); PG8_MMA(1, 0, At, B0); PG8_BAR; PG8_SCHED;
            PG8_STAGE(PG8_SB(1, 1), b3 + hstep, voffB);
            PG8_WAIT_V(6); PG8_BAR; PG8_MMA(1, 1, At, B1); PG8_BAR;
            }
        }
        if constexpr (ALIGN_EPI) { if (wr == 0) PG8_BAR; }
        if constexpr (!Epi::AFTER_DRAIN) { E(acc, cur, wr, wc, fr, fq); S.done(cur); }
        if (!has_next) break;
#pragma unroll
        for (int a = 0; a < 2; ++a)
#pragma unroll
            for (int b = 0; b < 2; ++b)
#pragma unroll
                for (int m = 0; m < 4; ++m)
#pragma unroll
                    for (int n = 0; n < 2; ++n) acc[a][b][m][n] = (f32x4){0.f, 0.f, 0.f, 0.f};
        cur = nxt; cA = nA; cB = nB; ++ui;
        if constexpr (ALIGN_EPI) { if (wr == 1) PG8_BAR; }
    }
    PG8_WAIT_V(0);
    if constexpr (!ALIGN_EPI) { if (wr == 0) PG8_BAR; }
    PG8_BAR;
    if constexpr (Epi::AFTER_DRAIN) { E.fused(acc, cur, wr, wc, fr, fq, lds, wid, lane); S.done(cur); }
#undef PG8_SA
#undef PG8_SB
#undef PG8_STAGE
#undef PG8_LDA
#undef PG8_LDB
#undef PG8_MMA
#undef PG8_WAIT_V
#undef PG8_WAIT_L
#undef PG8_BAR
#undef PG8_SCHED
}
}

#ifndef PG8_SP2
#define PG8_SP2 true
#endif
#ifndef PG8_ALIGN
#define PG8_ALIGN true
#endif
#define GAS __attribute__((address_space(1)))
#define LAS __attribute__((address_space(3)))
typedef unsigned short bf16;
typedef unsigned v4u __attribute__((ext_vector_type(4)));
typedef float f32x4 __attribute__((ext_vector_type(4)));
typedef short bf16x8 __attribute__((ext_vector_type(8)));
typedef GAS unsigned gu32;
typedef GAS unsigned long long gu64;
#define RLX_AGENT __ATOMIC_RELAXED, __HIP_MEMORY_SCOPE_AGENT
#define LDS_WAIT() asm volatile("s_waitcnt lgkmcnt(0)" ::: "memory")
#define VM_WAIT() asm volatile("s_waitcnt vmcnt(0)" ::: "memory")
__device__ __forceinline__ unsigned long long rt() { return __builtin_amdgcn_s_memrealtime(); }
__device__ __forceinline__ unsigned f2bf(float f) { unsigned u = __builtin_bit_cast(unsigned, f); return (u + 0x7fffu + ((u >> 16) & 1u)) >> 16; }
typedef float pk2_f32x2_t __attribute__((ext_vector_type(2))); typedef __bf16 pk2_bf16x2_t __attribute__((ext_vector_type(2)));
__device__ __forceinline__ unsigned pk2(float lo, float hi) { const pk2_f32x2_t v = {lo, hi}; return __builtin_bit_cast(unsigned, __builtin_convertvector(v, pk2_bf16x2_t)); }

#define XB_TMO      128
#define XB_XCNT(j)  (256  + 64 * (j))
#define XB_XSUB(j)  (1280 + 64 * (j))
#define XB_XGEN(j)  (2304 + 64 * (j))
#define XB_TOP      3328
#define XB_TOPGEN   3392
#define XCD_BAR_WORDS 3456
#define XB_SPIN_CAP (1u << 18)

__device__ __forceinline__ unsigned xb_ld(unsigned* p)              { return __hip_atomic_load(p, __ATOMIC_RELAXED, __HIP_MEMORY_SCOPE_AGENT); }
__device__ __forceinline__ unsigned xb_add(unsigned* p, unsigned v) { return __hip_atomic_fetch_add(p, v, __ATOMIC_RELAXED, __HIP_MEMORY_SCOPE_AGENT); }
__device__ __forceinline__ unsigned xb_xcc_id() { return (unsigned)__builtin_amdgcn_s_getreg((3 << 11) | 20) & 0xFu; }
#define XB_SPIN(cond, bar) do { unsigned _sp = 0; while (cond) { __builtin_amdgcn_s_sleep(1); \
    if ((++_sp & 255u) == 0u) { if (xb_ld(&(bar)[XB_TMO])) break; if (_sp > XB_SPIN_CAP) { atomicAdd(&(bar)[XB_TMO], 1u); break; } } } } while (0)

struct XcdBarrier {
    unsigned* bar; unsigned x;
    volatile LAS unsigned* st;
};

__device__ __forceinline__ XcdBarrier xcd_barrier_post(unsigned* bar, volatile LAS unsigned* st) {
    XcdBarrier b; b.bar = bar; b.x = xb_xcc_id(); b.st = st;
    if (threadIdx.x == 0) (void)xb_add(&bar[XB_XCNT(b.x)], 1u);
    return b;
}
__device__ __forceinline__ void xcd_barrier_complete(unsigned* bar, unsigned x, unsigned& nloc, unsigned& nx) {
    const unsigned G = gridDim.x * gridDim.y * gridDim.z;
    unsigned sum, cnt, mine, sp = 0u;
    for (;;) {
        sum = 0u; cnt = 0u; mine = 0u;
#pragma unroll
        for (unsigned j = 0; j < 16; ++j) { const unsigned c = xb_ld(&bar[XB_XCNT(j)]); sum += c; cnt += (c > 0u) ? 1u : 0u; mine = (j == x) ? c : mine; }
        if (sum == G) break;
        __builtin_amdgcn_s_sleep(1);
        if ((++sp & 255u) == 0u) { if (xb_ld(&bar[XB_TMO])) break; if (sp > XB_SPIN_CAP) { atomicAdd(&bar[XB_TMO], 1u); break; } }
    }
    nloc = mine > 0u ? mine : 1u; nx = cnt > 0u ? cnt : 1u;
}

__device__ __forceinline__ void xcd_barrier(const XcdBarrier& b) {
    asm volatile("s_waitcnt vmcnt(0)" ::: "memory");
    __syncthreads();
    if (threadIdx.x == 0) {
        unsigned* bar = b.bar;
        __builtin_amdgcn_s_waitcnt(0);
        unsigned nloc = b.st[0], nx = b.st[1];
        if (nloc == 0u) { xcd_barrier_complete(bar, b.x, nloc, nx); b.st[0] = nloc; b.st[1] = nx; }
        const unsigned old = xb_add(&bar[XB_XSUB(b.x)], 1u);
        const unsigned gen = old / nloc;
        if (old + 1u == (gen + 1u) * nloc) {
            __builtin_amdgcn_fence(__ATOMIC_RELEASE, "agent");
            asm volatile("s_waitcnt vmcnt(0)" ::: "memory");
            const unsigned og = xb_add(&bar[XB_TOP], 1u);
            const unsigned tg = og / nx;
            if (og + 1u == (tg + 1u) * nx) xb_add(&bar[XB_TOPGEN], 1u);
            else XB_SPIN(xb_ld(&bar[XB_TOPGEN]) == tg, bar);
            __builtin_amdgcn_fence(__ATOMIC_ACQUIRE, "agent");
            xb_add(&bar[XB_XGEN(b.x)], 1u);
            asm volatile("s_waitcnt vmcnt(0)" ::: "memory");
        } else {
            XB_SPIN(xb_ld(&bar[XB_XGEN(b.x)]) == gen, bar);
            __builtin_amdgcn_fence(__ATOMIC_ACQUIRE, "agent");
            asm volatile("s_waitcnt vmcnt(0)" ::: "memory");
        }
    }
    __syncthreads();
}

constexpr int NWAVES = 8, NTHREADS = 512;
constexpr int DM = 1024, NB = 4, SEQ = 4096, DEPTH = 2, NTOK = NB * SEQ, NEXP = 16384;
constexpr int DIN = 1952, DINP = 2048;
constexpr float ALPHA = 1.4142135623730951f;
constexpr float LN_EPS = 1e-5f, RMS_EPS = 1e-6f;
constexpr float QSCALE = 0.10206207261596575f * 1.4426950408889634f;
constexpr int NPL = 10;
constexpr int NPHASE = 1 + NPL * DEPTH;
constexpr size_t MiB = 1u << 20;
constexpr size_t WS_CTL = 0, CTL_ZERO_BYTES = 64 * 1024;
constexpr size_t WS_WIT = 2 * MiB;
constexpr size_t WS_WQT = 10 * MiB;
constexpr size_t WS_WOT = 18 * MiB;
constexpr size_t WS_WUQT = 22 * MiB;
constexpr size_t WS_WUKVT = 23 * MiB;
constexpr size_t WS_KEYS = 24 * MiB;
constexpr size_t WS_ROPE = 25 * MiB;
constexpr size_t WS_SUV = 26 * MiB;
constexpr size_t WS_UT = 32 * MiB;
constexpr size_t WS_VT = 96 * MiB;
constexpr size_t WS_XB = 160 * MiB;
constexpr size_t WS_HB = 192 * MiB;
constexpr size_t WS_QM = 256 * MiB;
constexpr size_t WS_KM = 280 * MiB;
constexpr size_t WS_VMT = 304 * MiB;
constexpr size_t WS_VST = 320 * MiB;
constexpr size_t WS_OB = 336 * MiB;
constexpr size_t WS_EL = 368 * MiB;
constexpr size_t WS_GL = 376 * MiB;
constexpr size_t WS_XQ = WS_KM;
constexpr size_t WS_SX = WS_VST;
constexpr size_t WS_AC = WS_QM;
constexpr size_t WS_KSF = 384 * MiB;
constexpr size_t WS_END = 400 * MiB;
constexpr int CW_BAR = 1024;
static_assert((CW_BAR + XCD_BAR_WORDS) * 4 <= (int)CTL_ZERO_BYTES, "barrier words inside the memset region");
constexpr int RING_OFF = 0, RING_BYTES = 131072;
constexpr int LDSCTL_OFF = RING_BYTES, MISC_OFF = LDSCTL_OFF + 320;
constexpr int LDS_BYTES = 147456;
static_assert(MISC_OFF + 128 <= LDS_BYTES, "LDS map");

typedef float f32x16 __attribute__((ext_vector_type(16)));
typedef float f32x2 __attribute__((ext_vector_type(2)));
typedef unsigned v2u __attribute__((ext_vector_type(2)));
typedef __bf16 bf2_t __attribute__((ext_vector_type(2)));

struct Args { const float* in[15]; float* out; unsigned char* ws; int ph_lo, ph_hi; };
typedef const __attribute__((address_space(4))) Args* kap_t;
__device__ __forceinline__ kap_t ka_fresh() { kap_t p = (kap_t)__builtin_amdgcn_kernarg_segment_ptr(); asm volatile("" : "+s"(p)); return p; }
enum { I_X = 0, I_WIN, I_GCQ, I_WUQ, I_GCKV, I_WUKV, I_WO, I_LN1G, I_LN1B, I_WQ, I_KEYS, I_U, I_V, I_LN2G, I_LN2B };
struct Frame {
    LAS unsigned char* lds;
    volatile LAS unsigned* MISC;
    int tid, lane, wave, vcu, G;
};
template <class T> __device__ __forceinline__ T* wsp(kap_t ka, size_t off) { return (T*)(ka->ws + off); }

__device__ __forceinline__ float bflo(unsigned w) { return __uint_as_float(w << 16); }
__device__ __forceinline__ float bfhi(unsigned w) { return __uint_as_float(w & 0xffff0000u); }
__device__ __forceinline__ float bf1(short s) { return __uint_as_float(((unsigned)(unsigned short)s) << 16); }
__device__ __forceinline__ int crow(int r, int hi) { return (r & 3) + 8 * (r >> 2) + 4 * hi; }
__device__ __forceinline__ int kperm(int s) { return (s & ~15) | (((s >> 2) & 1) << 3) | (((s >> 3) & 1) << 2) | (s & 3); }
template <int CTRL> __device__ __forceinline__ float dpp_f(float v) { return __builtin_bit_cast(float, __builtin_amdgcn_update_dpp(0, __builtin_bit_cast(int, v), CTRL, 0xF, 0xF, true)); }
__device__ __forceinline__ int shx_i(int v, int mask, int lane) { return __builtin_amdgcn_ds_bpermute((lane ^ mask) << 2, v); }
__device__ __forceinline__ float shx_f(float v, int mask, int lane) { return __builtin_bit_cast(float, __builtin_amdgcn_ds_bpermute((lane ^ mask) << 2, __builtin_bit_cast(int, v))); }
__device__ __forceinline__ float wave_sum_all(float v, int lane) {
    v += dpp_f<0xB1>(v);
    v += dpp_f<0x4E>(v);
    v += dpp_f<0x141>(v);
    v += dpp_f<0x140>(v);
    v += shx_f(v, 16, lane);
    v += shx_f(v, 32, lane);
    return v;
}
__device__ __forceinline__ int wave_sum_all_i(int v, int lane) {
    v += __builtin_amdgcn_update_dpp(0, v, 0xB1, 0xF, 0xF, true); v += __builtin_amdgcn_update_dpp(0, v, 0x4E, 0xF, 0xF, true);
    v += __builtin_amdgcn_update_dpp(0, v, 0x141, 0xF, 0xF, true); v += __builtin_amdgcn_update_dpp(0, v, 0x140, 0xF, 0xF, true);
    v += shx_i(v, 16, lane); v += shx_i(v, 32, lane);
    return v;
}
__device__ __forceinline__ float wave_max_all(float v, int lane) {
    v = fmaxf(v, dpp_f<0xB1>(v)); v = fmaxf(v, dpp_f<0x4E>(v)); v = fmaxf(v, dpp_f<0x141>(v)); v = fmaxf(v, dpp_f<0x140>(v));
    v = fmaxf(v, shx_f(v, 16, lane)); v = fmaxf(v, shx_f(v, 32, lane));
    return v;
}
__device__ __forceinline__ bf16x8 pack8(float a0, float a1, float a2, float a3, float a4, float a5, float a6, float a7) {
    v4u w; w.x = pk2(a0, a1); w.y = pk2(a2, a3); w.z = pk2(a4, a5); w.w = pk2(a6, a7); return __builtin_bit_cast(bf16x8, w);
}

template <bool FRAG> __device__ __forceinline__ void p0_transpose_item(const float* W, int K, int N, bf16* WT, const float* gs, LAS float* scr, int item, int lane) {
    const int nblk = N / 32, kb = item / nblk, nb = item % nblk, k0 = 64 * kb, n0 = 32 * nb;
#pragma unroll 8
    for (int i = 0; i < 32; ++i) { const int kk = 2 * i + (lane >> 5); float w = W[(size_t)(k0 + kk) * N + n0 + (lane & 31)]; if (gs) w *= gs[k0 + kk]; scr[kk * 33 + (lane & 31)] = w; }
    LDS_WAIT(); asm volatile("" ::: "memory");
    const int c = lane & 7;
#pragma unroll
    for (int j = 0; j < 4; ++j) { const int n = (lane >> 3) + 8 * j; const LAS float* s = scr + (8 * c) * 33 + n;
        v4u o; o.x = pk2(s[0 * 33], s[1 * 33]); o.y = pk2(s[2 * 33], s[3 * 33]); o.z = pk2(s[4 * 33], s[5 * 33]); o.w = pk2(s[6 * 33], s[7 * 33]);
        if (FRAG) { const int nn = n0 + n, kk = k0 + 8 * c; *(GAS v4u*)(WT + ((size_t)((nn >> 5) * (K >> 4) + (kk >> 4)) * 64 + ((kk >> 3) & 1) * 32 + (nn & 31)) * 8) = o; }
        else *(GAS v4u*)(WT + (size_t)(n0 + n) * K + k0 + 8 * c) = o; }
    LDS_WAIT(); asm volatile("" ::: "memory");
}
__device__ __forceinline__ void cvt8_range(Frame& F, const float* src, bf16* dst, size_t n8) {
    const size_t gt = (size_t)blockIdx.x * NTHREADS + F.tid, nt = (size_t)F.G * NTHREADS;
    for (size_t i = gt; i < n8; i += nt) { const f32x4 a = *(const f32x4*)(src + i * 8), b = *(const f32x4*)(src + i * 8 + 4);
        v4u o; o.x = pk2(a.x, a.y); o.y = pk2(a.z, a.w); o.z = pk2(b.x, b.y); o.w = pk2(b.z, b.w); *(v4u*)(dst + i * 8) = o; }
}
__device__ __forceinline__ void p0_prologue(Frame& F, kap_t ka) {
    LAS float* scr = (LAS float*)(F.lds + RING_OFF + F.wave * 16384);
    const int gw = F.vcu * NWAVES + F.wave, NGW = F.G * NWAVES;
    constexpr int I_IN = 16 * 61, I_Q = 16 * 64, I_O = 16 * 32, I_UQ = 4 * 24, I_UKV = 2 * 32, I_L = I_IN + I_Q + I_O + I_UQ + I_UKV;
    for (int it = gw; it < DEPTH * I_L; it += NGW) {
        const int l = it / I_L; int r = it % I_L;
        if (r < I_IN) { p0_transpose_item<false>(ka->in[I_WIN] + (size_t)l * DM * DIN, DM, DIN, wsp<bf16>(ka, WS_WIT) + (size_t)l * DINP * DM, nullptr, scr, r, F.lane); continue; } r -= I_IN;
        if (r < I_Q) { p0_transpose_item<false>(ka->in[I_WQ] + (size_t)l * DM * 2048, DM, 2048, wsp<bf16>(ka, WS_WQT) + (size_t)l * 2048 * DM, nullptr, scr, r, F.lane); continue; } r -= I_Q;
        if (r < I_O) { p0_transpose_item<false>(ka->in[I_WO] + (size_t)l * DM * DM, DM, DM, wsp<bf16>(ka, WS_WOT) + (size_t)l * DM * DM, nullptr, scr, r, F.lane); continue; } r -= I_O;
        if (r < I_UQ) { p0_transpose_item<true>(ka->in[I_WUQ] + (size_t)l * 256 * 768, 256, 768, wsp<bf16>(ka, WS_WUQT) + (size_t)l * 768 * 256, ka->in[I_GCQ] + l * 256, scr, r, F.lane); continue; } r -= I_UQ;
        p0_transpose_item<true>(ka->in[I_WUKV] + (size_t)l * 128 * 1024, 128, 1024, wsp<bf16>(ka, WS_WUKVT) + (size_t)l * 1024 * 128, ka->in[I_GCKV] + l * 128, scr, r, F.lane);
    }
    const size_t gt = (size_t)blockIdx.x * NTHREADS + F.tid, nt = (size_t)F.G * NTHREADS;
    for (size_t i = gt; i < 2 * 12288; i += nt) { const size_t l = i / 12288, j = i % 12288; *(v4u*)(wsp<bf16>(ka, WS_WIT) + l * DINP * DM + (size_t)DIN * DM + j * 8) = (v4u){0u, 0u, 0u, 0u}; }
    for (size_t i = gt; i < (size_t)SEQ * 16; i += nt) { const int pos = (int)(i >> 4), k = (int)(i & 15);
        const float inv_freq = (float)pow(10000.0, -(double)k / 16.0); const float ang = (float)pos * inv_freq;
        wsp<f32x2>(ka, WS_ROPE)[i] = (f32x2){(float)cos((double)ang), (float)sin((double)ang)}; }
    for (size_t i = gt; i < (size_t)DEPTH * 8 * 2 * 128 * 16; i += nt) {
        const size_t lhc = i >> 11; const int n = (int)(i >> 4) & 127, dg = (int)i & 15;
        const float* src = ka->in[I_KEYS] + i * 8; const f32x4 a = *(const f32x4*)src, b = *(const f32x4*)(src + 4);
        v4u o; o.x = pk2(a.x, a.y); o.y = pk2(a.z, a.w); o.z = pk2(b.x, b.y); o.w = pk2(b.z, b.w);
        *(v4u*)(wsp<bf16>(ka, WS_KEYS) + (lhc * 2048 + (size_t)(((n >> 5) * 8 + (dg >> 1)) * 64 + (dg & 1) * 32 + (n & 31))) * 8) = o;
    }
    cvt8_range(F, ka->in[I_X], wsp<bf16>(ka, WS_XB), (size_t)NTOK * DM / 8);
    {
#ifdef MK_DBG_L0
        constexpr int NL = 1;
#else
        constexpr int NL = DEPTH;
#endif
        unsigned char* UQ = wsp<unsigned char>(ka, WS_UT); unsigned char* VQ = wsp<unsigned char>(ka, WS_VT); float* SUV = wsp<float>(ka, WS_SUV);
        for (int row = gw; row < 2 * NL * NEXP; row += NGW) {
            const int tbl = row / (NL * NEXP), r = row % (NL * NEXP);
            const float* src = (tbl ? ka->in[I_V] : ka->in[I_U]) + (size_t)r * DM + 16 * F.lane;
            f32x4 v[4]; float m = 0.f;
#pragma unroll
            for (int j = 0; j < 4; ++j) { v[j] = *(const f32x4*)(src + 4 * j); m = fmaxf(m, fmaxf(fmaxf(fabsf(v[j].x), fabsf(v[j].y)), fmaxf(fabsf(v[j].z), fabsf(v[j].w)))); }
            m = wave_max_all(m, F.lane);
            const float inv = m > 0.f ? 127.f / m : 0.f;
            const int off = 0;
            v4u o;
#pragma unroll
            for (int j = 0; j < 4; ++j) {
                const unsigned b0 = (unsigned)((int)rintf(v[j].x * inv) + off) & 0xffu, b1 = (unsigned)((int)rintf(v[j].y * inv) + off) & 0xffu, b2 = (unsigned)((int)rintf(v[j].z * inv) + off) & 0xffu, b3 = (unsigned)((int)rintf(v[j].w * inv) + off) & 0xffu;
                o[j] = b0 | (b1 << 8) | (b2 << 16) | (b3 << 24);
            }
            if (tbl) *(v4u*)(VQ + (size_t)(r / NEXP) * NEXP * DM + ((size_t)(F.lane >> 3) * NEXP + (size_t)(r % NEXP)) * 128 + 16 * (F.lane & 7)) = o;
            else *(v4u*)(UQ + (size_t)r * DM + 16 * F.lane) = o;
            if (F.lane == 0) SUV[2 * (size_t)r + tbl] = m * (1.f / 127.f);
        }
    }
}

__device__ __forceinline__ void p2_unit(Frame& F, kap_t ka, int l, int tb, int part) {
    const int lane = F.lane, r32 = lane & 31, hi = lane >> 5;
    const int tok = tb * 32 + r32, b = tok / SEQ, s = tok % SEQ;
    const bf16* hrow = wsp<bf16>(ka, WS_HB) + (size_t)tok * DINP;
    if (part < 2) {
        bf16x8 xf[16]; float ssq = 0.f;
#pragma unroll
        for (int ks = 0; ks < 16; ++ks) { xf[ks] = *(const bf16x8*)(hrow + 1536 + ks * 16 + 8 * hi);
#pragma unroll
            for (int e = 0; e < 8; ++e) { const float v = bf1(xf[ks][e]); ssq += v * v; } }
        ssq += shx_f(ssq, 32, lane);
        const float rstd = rsqrtf(ssq * (1.f / 256.f) + RMS_EPS) * QSCALE;
        const bf16* W = wsp<bf16>(ka, WS_WUQT) + (size_t)l * 768 * 256;
        const bf16* wbase = W + 8 * lane;
        bf16x8 wA[16];
#define P2Q_LOADW(WF, j) do { _Pragma("unroll") for (int ks = 0; ks < 16; ++ks) WF[ks] = *(const bf16x8*)(wbase + (size_t)((j) * 16 + ks) * 512); } while (0)
#define P2Q_MMA(WF, ACC) do { ACC = (f32x16){}; _Pragma("unroll") for (int ks = 0; ks < 16; ++ks) ACC = __builtin_amdgcn_mfma_f32_32x32x16_bf16(WF[ks], xf[ks], ACC, 0, 0, 0); } while (0)
#define P2Q_EPI(ACC, j) do { const int head_ = (j) / 3, sub_ = (j) % 3; float v[16]; \
            _Pragma("unroll") for (int r = 0; r < 16; ++r) v[r] = ACC[r] * rstd; \
            if (sub_ == 2) { _Pragma("unroll") for (int r = 0; r < 8; ++r) { const f32x2 cs = wsp<f32x2>(ka, WS_ROPE)[s * 16 + crow(r, hi)]; const float x1 = v[r], x2 = v[r + 8]; v[r] = x1 * cs.x - x2 * cs.y; v[r + 8] = x2 * cs.x + x1 * cs.y; } } \
            bf16* dst = wsp<bf16>(ka, WS_QM) + ((size_t)(b * 8 + head_) * SEQ + s) * 96 + sub_ * 32 + 4 * hi; \
            _Pragma("unroll") for (int g = 0; g < 4; ++g) { v2u w; w.x = pk2(v[4 * g], v[4 * g + 1]); w.y = pk2(v[4 * g + 2], v[4 * g + 3]); *(v2u*)(dst + 8 * g) = w; } } while (0)
        P2Q_LOADW(wA, part * 12);
        for (int jj = 0; jj < 12; ++jj) {
            const int j = part * 12 + jj; f32x16 acc;
            P2Q_MMA(wA, acc);
            __builtin_amdgcn_sched_barrier(0);
            P2Q_LOADW(wA, jj + 1 < 12 ? j + 1 : j);
            __builtin_amdgcn_sched_barrier(0);
            P2Q_EPI(acc, j);
        }
#undef P2Q_LOADW
#undef P2Q_MMA
#undef P2Q_EPI
    } else {
        const int h0 = (part - 2) * 4;
        bf16x8 xf[8]; float ssq = 0.f;
#pragma unroll
        for (int ks = 0; ks < 8; ++ks) { xf[ks] = *(const bf16x8*)(hrow + 1792 + ks * 16 + 8 * hi);
#pragma unroll
            for (int e = 0; e < 8; ++e) { const float v = bf1(xf[ks][e]); ssq += v * v; } }
        ssq += shx_f(ssq, 32, lane);
        const float rstd = rsqrtf(ssq * (1.f / 128.f) + RMS_EPS);
        const bf16* W = wsp<bf16>(ka, WS_WUKVT) + (size_t)l * 1024 * 128;
        const int sp = kperm(s);
        const bf16* wbase = W + 8 * lane;
        bf16x8 wA[8], wB[8];
#define P2K_LOADW(WF, j) do { _Pragma("unroll") for (int ks = 0; ks < 8; ++ks) WF[ks] = *(const bf16x8*)(wbase + (size_t)((j) * 8 + ks) * 512); } while (0)
#define P2K_MMA(WF, ACC) do { ACC = (f32x16){}; _Pragma("unroll") for (int ks = 0; ks < 8; ++ks) ACC = __builtin_amdgcn_mfma_f32_32x32x16_bf16(WF[ks], xf[ks], ACC, 0, 0, 0); } while (0)
        P2K_LOADW(wA, h0 * 4);
        for (int jj = 0; jj < 16; jj += 2) {
            f32x16 accA, accB;
            P2K_LOADW(wB, h0 * 4 + jj + 1);
            P2K_MMA(wA, accA);
            P2K_LOADW(wA, jj + 2 < 16 ? h0 * 4 + jj + 2 : h0 * 4 + jj + 1);
            P2K_MMA(wB, accB);
#pragma unroll
            for (int u2 = 0; u2 < 2; ++u2) {
                const int j = h0 * 4 + jj + u2; const int head = j >> 2, sub = j & 3; const f32x16 acc = u2 ? accB : accA;
            if (sub < 2) {
                bf16* dst = wsp<bf16>(ka, WS_KM) + (size_t)(b * 8 + head) * SEQ * 96 + (size_t)(s >> 5) * (6 * 512) + (size_t)r32 * 8 + 4 * hi;
#pragma unroll
                for (int g = 0; g < 4; ++g) { v2u w; w.x = pk2(acc[4 * g] * rstd, acc[4 * g + 1] * rstd); w.y = pk2(acc[4 * g + 2] * rstd, acc[4 * g + 3] * rstd); *(v2u*)(dst + (2 * sub + (g >> 1)) * 512 + (g & 1) * 256) = w; }
            } else {
                bf16* dst = wsp<bf16>(ka, WS_VMT) + (size_t)(b * 8 + head) * 64 * SEQ + (size_t)(s >> 5) * (4 * 512) + ((sub - 2) * 2 + ((s >> 4) & 1)) * 512 + ((sp >> 3) & 1) * 256 + (sp & 7);
#pragma unroll
                for (int r = 0; r < 16; ++r) dst[crow(r, hi) * 8] = (bf16)f2bf(acc[r] * rstd);
            }
            }
        }
#undef P2K_LOADW
#undef P2K_MMA
        { const bf16x8 a1 = *(const bf16x8*)(hrow + 1920 + 8 * hi), a2 = *(const bf16x8*)(hrow + 1936 + 8 * hi);
          float o1[8], o2[8];
#pragma unroll
          for (int e = 0; e < 8; ++e) { const f32x2 cs = wsp<f32x2>(ka, WS_ROPE)[s * 16 + 8 * hi + e]; const float x1 = bf1(a1[e]), x2 = bf1(a2[e]); o1[e] = x1 * cs.x - x2 * cs.y; o2[e] = x2 * cs.x + x1 * cs.y; }
          const bf16x8 p1 = pack8(o1[0], o1[1], o1[2], o1[3], o1[4], o1[5], o1[6], o1[7]), p2 = pack8(o2[0], o2[1], o2[2], o2[3], o2[4], o2[5], o2[6], o2[7]);
#pragma unroll
          for (int hh = 0; hh < 4; ++hh) { bf16* dst = wsp<bf16>(ka, WS_KM) + (size_t)(b * 8 + h0 + hh) * SEQ * 96 + (size_t)(s >> 5) * (6 * 512) + 4 * 512 + hi * 256 + (size_t)r32 * 8; *(bf16x8*)dst = p1; *(bf16x8*)(dst + 512) = p2; } }
#pragma unroll 1
        for (int hh = 0; hh < 4; ++hh) {
            const int head = h0 + hh;
#pragma unroll
            for (int c4 = 0; c4 < 4; ++c4) { const bf16x8 a = *(const bf16x8*)(hrow + 1024 + head * 64 + 32 * hi + c4 * 8);
                bf16* dst = wsp<bf16>(ka, WS_VST) + (size_t)(b * 8 + head) * 64 * SEQ + (size_t)(s >> 5) * (4 * 512) + (hi * 2 + ((s >> 4) & 1)) * 512 + ((sp >> 3) & 1) * 256 + c4 * 64 + (sp & 7);
#pragma unroll
                for (int e = 0; e < 8; ++e) dst[e * 8] = (bf16)a[e]; }
#pragma unroll
            for (int ks = 0; ks < 4; ++ks) *(bf16x8*)(wsp<bf16>(ka, WS_KSF) + (size_t)(b * 8 + head) * SEQ * 64 + (size_t)(s >> 5) * (4 * 512) + ks * 512 + (size_t)lane * 8) = *(const bf16x8*)(hrow + 512 + head * 64 + ks * 16 + 8 * hi);
        }
    }
}

__device__ __forceinline__ float xhalf_max(float v) { auto rr = __builtin_amdgcn_permlane32_swap(__float_as_uint(v), __float_as_uint(v), false, false); return fmaxf(__uint_as_float(rr[0]), __uint_as_float(rr[1])); }
__device__ __forceinline__ float xhalf_sum(float v) { auto rr = __builtin_amdgcn_permlane32_swap(__float_as_uint(v), __float_as_uint(v), false, false); return __uint_as_float(rr[0]) + __uint_as_float(rr[1]); }
constexpr float MLA_THR = 8.f;
__device__ __forceinline__ void mla_unit(Frame& F, kap_t ka, int bh, int qb) {
    const int lane = F.lane, r32 = lane & 31, hi = lane >> 5, q0 = qb * 32;
    const bf16* Qp = wsp<bf16>(ka, WS_QM) + ((size_t)bh * SEQ + q0 + r32) * 96 + 8 * hi;
    bf16x8 qf[6];
#pragma unroll
    for (int ks = 0; ks < 6; ++ks) qf[ks] = *(const bf16x8*)(Qp + ks * 16);
    f32x16 o0 = {}, o1 = {};
    float m = -1e30f, l = 0.f;
    const bf16* Kp = wsp<bf16>(ka, WS_KM) + (size_t)bh * SEQ * 96 + 8 * lane;
    const bf16* Vp = wsp<bf16>(ka, WS_VMT) + (size_t)bh * 64 * SEQ + 8 * lane;
#define MLA_LOADK(KF, kt) do { _Pragma("unroll") for (int ks = 0; ks < 6; ++ks) KF[ks] = *(const bf16x8*)(Kp + (size_t)((kt) * 6 + ks) * 512); } while (0)
#define MLA_LOADV(VF, kt) do { _Pragma("unroll") for (int i = 0; i < 4; ++i) VF[i] = *(const bf16x8*)(Vp + (size_t)((kt) * 4 + i) * 512); } while (0)
#define MLA_QK(S, KF) do { S = (f32x16){}; _Pragma("unroll") for (int ks = 0; ks < 6; ++ks) S = __builtin_amdgcn_mfma_f32_32x32x16_bf16(KF[ks], qf[ks], S, 0, 0, 0); } while (0)
#define MLA_SMPV(S, VF, kt) do { \
        if ((kt) == qb) { _Pragma("unroll") for (int r = 0; r < 16; ++r) if (crow(r, hi) > r32) S[r] = -1e30f; } \
        float mx = fmaxf(fmaxf(S[0], S[1]), fmaxf(S[2], S[3])); \
        _Pragma("unroll") for (int r = 4; r < 16; r += 4) mx = fmaxf(mx, fmaxf(fmaxf(S[r], S[r + 1]), fmaxf(S[r + 2], S[r + 3]))); \
        mx = xhalf_max(mx); \
        if (__any(mx - m > MLA_THR)) { const float mn = fmaxf(m, mx), alpha = __builtin_amdgcn_exp2f(m - mn); l *= alpha; m = mn; \
            _Pragma("unroll") for (int r = 0; r < 16; ++r) { o0[r] *= alpha; o1[r] *= alpha; } } \
        float p[16], rs0 = 0.f, rs1 = 0.f; \
        _Pragma("unroll") for (int r = 0; r < 16; r += 2) { p[r] = __builtin_amdgcn_exp2f(S[r] - m); p[r + 1] = __builtin_amdgcn_exp2f(S[r + 1] - m); rs0 += p[r]; rs1 += p[r + 1]; } \
        l += rs0 + rs1; \
        const bf16x8 pf0 = pack8(p[0], p[1], p[2], p[3], p[4], p[5], p[6], p[7]), pf1 = pack8(p[8], p[9], p[10], p[11], p[12], p[13], p[14], p[15]); \
        o0 = __builtin_amdgcn_mfma_f32_32x32x16_bf16(VF[0], pf0, o0, 0, 0, 0); \
        o1 = __builtin_amdgcn_mfma_f32_32x32x16_bf16(VF[2], pf0, o1, 0, 0, 0); \
        o0 = __builtin_amdgcn_mfma_f32_32x32x16_bf16(VF[1], pf1, o0, 0, 0, 0); \
        o1 = __builtin_amdgcn_mfma_f32_32x32x16_bf16(VF[3], pf1, o1, 0, 0, 0); } while (0)
    bf16x8 kA[6], kB[6], vA[4];
    f32x16 sA, sB;
    MLA_LOADK(kA, 0); MLA_LOADK(kB, 1);
    MLA_QK(sA, kA);
    for (int kt = 0; kt <= qb; kt += 2) {
        MLA_LOADK(kA, kt + 2); MLA_LOADV(vA, kt);
        MLA_QK(sB, kB);
        MLA_SMPV(sA, vA, kt);
        if (kt + 1 > qb) break;
        MLA_LOADK(kB, kt + 3); MLA_LOADV(vA, kt + 1);
        MLA_QK(sA, kA);
        MLA_SMPV(sB, vA, kt + 1);
    }
#undef MLA_LOADK
#undef MLA_LOADV
#undef MLA_QK
#undef MLA_SMPV
    l = xhalf_sum(l);
    const float rl = 1.f / l;
    const int b = bh >> 3, h = bh & 7;
    bf16* dst = wsp<bf16>(ka, WS_OB) + ((size_t)b * SEQ + q0 + r32) * DM + 512 + h * 64 + 4 * hi;
#pragma unroll
    for (int g = 0; g < 4; ++g) {
        v2u w; w.x = pk2(o0[4 * g] * rl, o0[4 * g + 1] * rl); w.y = pk2(o0[4 * g + 2] * rl, o0[4 * g + 3] * rl); *(v2u*)(dst + 8 * g) = w;
        v2u u; u.x = pk2(o1[4 * g] * rl, o1[4 * g + 1] * rl); u.y = pk2(o1[4 * g + 2] * rl, o1[4 * g + 3] * rl); *(v2u*)(dst + 32 + 8 * g) = u;
    }
}

__device__ __forceinline__ void mla_block(Frame& F, kap_t ka, int bh, int J) {
    const int tid = F.tid, lane = F.lane, r32 = lane & 31, hi = lane >> 5, wave = F.wave;
    const int qb = 8 * J + wave, q0 = qb * 32, T = 8 * J + 8;
    const bf16* Qp = wsp<bf16>(ka, WS_QM) + ((size_t)bh * SEQ + q0 + r32) * 96 + 8 * hi;
    bf16x8 qf[6];
#pragma unroll
    for (int ks = 0; ks < 6; ++ks) qf[ks] = *(const bf16x8*)(Qp + ks * 16);
    f32x16 o0 = {}, o1 = {};
    float m = -1e30f, l = 0.f;
    const unsigned char* Kt = (const unsigned char*)(wsp<bf16>(ka, WS_KM) + (size_t)bh * SEQ * 96);
    const unsigned char* Vt = (const unsigned char*)(wsp<bf16>(ka, WS_VMT) + (size_t)bh * 64 * SEQ);
    LAS unsigned char* ring = F.lds + RING_OFF;
    const bool c0k = tid < 384;
    const size_t off0 = c0k ? (size_t)tid * 16 : (size_t)(tid - 384) * 16, off1 = (size_t)(128 + tid) * 16;
#define MB_GLOAD(t) do { r0 = *(const v4u*)((c0k ? Kt + (size_t)(t) * 6144 : Vt + (size_t)(t) * 4096) + off0); if (tid < 128) r1 = *(const v4u*)(Vt + (size_t)(t) * 4096 + off1); } while (0)
#define MB_LWRITE(s) do { *(LAS v4u*)(ring + (s) * 10240 + tid * 16) = r0; if (tid < 128) *(LAS v4u*)(ring + (s) * 10240 + 8192 + tid * 16) = r1; } while (0)
    v4u r0 = {}, r1 = {};
    MB_GLOAD(0); MB_LWRITE(0);
    if (T > 1) MB_GLOAD(1);
    for (int t = 0; t < T; ++t) {
        __syncthreads();
        const bool active = t <= qb;
        bf16x8 kf[6], vf[4];
        if (active) { const LAS unsigned char* sl = ring + (t & 1) * 10240 + lane * 16;
#pragma unroll
            for (int ks = 0; ks < 6; ++ks) kf[ks] = *(const LAS bf16x8*)(sl + ks * 1024);
#pragma unroll
            for (int i = 0; i < 4; ++i) vf[i] = *(const LAS bf16x8*)(sl + 6144 + i * 1024); }
        if (t + 1 < T) MB_LWRITE((t + 1) & 1);
        if (t + 2 < T) MB_GLOAD(t + 2);
        if (active) {
            f32x16 sa = {};
#pragma unroll
            for (int ks = 0; ks < 6; ++ks) sa = __builtin_amdgcn_mfma_f32_32x32x16_bf16(kf[ks], qf[ks], sa, 0, 0, 0);
            if (t == qb) {
#pragma unroll
                for (int r = 0; r < 16; ++r) if (crow(r, hi) > r32) sa[r] = -1e30f;
            }
            float mx = fmaxf(fmaxf(sa[0], sa[1]), fmaxf(sa[2], sa[3]));
#pragma unroll
            for (int r = 4; r < 16; r += 4) mx = fmaxf(mx, fmaxf(fmaxf(sa[r], sa[r + 1]), fmaxf(sa[r + 2], sa[r + 3])));
            mx = xhalf_max(mx);
            if (__any(mx - m > MLA_THR)) { const float mn = fmaxf(m, mx), alpha = __builtin_amdgcn_exp2f(m - mn); l *= alpha; m = mn;
#pragma unroll
                for (int r = 0; r < 16; ++r) { o0[r] *= alpha; o1[r] *= alpha; } }
            float p[16], rs = 0.f;
#pragma unroll
            for (int r = 0; r < 16; ++r) { p[r] = __builtin_amdgcn_exp2f(sa[r] - m); rs += p[r]; }
            l += rs;
            const bf16x8 pf0 = pack8(p[0], p[1], p[2], p[3], p[4], p[5], p[6], p[7]), pf1 = pack8(p[8], p[9], p[10], p[11], p[12], p[13], p[14], p[15]);
            o0 = __builtin_amdgcn_mfma_f32_32x32x16_bf16(vf[0], pf0, o0, 0, 0, 0);
            o0 = __builtin_amdgcn_mfma_f32_32x32x16_bf16(vf[1], pf1, o0, 0, 0, 0);
            o1 = __builtin_amdgcn_mfma_f32_32x32x16_bf16(vf[2], pf0, o1, 0, 0, 0);
            o1 = __builtin_amdgcn_mfma_f32_32x32x16_bf16(vf[3], pf1, o1, 0, 0, 0);
        }
    }
#undef MB_GLOAD
#undef MB_LWRITE
    __syncthreads();
    l = xhalf_sum(l);
    const float rl = 1.f / l;
    const int b = bh >> 3, h = bh & 7;
    bf16* dst = wsp<bf16>(ka, WS_OB) + ((size_t)b * SEQ + q0 + r32) * DM + 512 + h * 64 + 4 * hi;
#pragma unroll
    for (int g = 0; g < 4; ++g) {
        v2u w; w.x = pk2(o0[4 * g] * rl, o0[4 * g + 1] * rl); w.y = pk2(o0[4 * g + 2] * rl, o0[4 * g + 3] * rl); *(v2u*)(dst + 8 * g) = w;
        v2u u; u.x = pk2(o1[4 * g] * rl, o1[4 * g + 1] * rl); u.y = pk2(o1[4 * g + 2] * rl, o1[4 * g + 3] * rl); *(v2u*)(dst + 32 + 8 * g) = u;
    }
}

__device__ __forceinline__ void sb_unit(Frame& F, kap_t ka, int bh, int qb) {
    const int lane = F.lane, r32 = lane & 31, hi = lane >> 5, q0 = qb * 32;
    const int b = bh >> 3, h = bh & 7;
    const bf16* Hb = wsp<bf16>(ka, WS_HB) + (size_t)b * SEQ * DINP + h * 64 + 8 * hi;
    bf16x8 qf[4];
#pragma unroll
    for (int ks = 0; ks < 4; ++ks) qf[ks] = *(const bf16x8*)(Hb + (size_t)(q0 + r32) * DINP + ks * 16);
    f32x16 o0 = {}, o1 = {};
    float R = 0.f;
    const bf16* Kp = wsp<bf16>(ka, WS_KSF) + (size_t)bh * SEQ * 64 + 8 * lane;
    const bf16* Vp = wsp<bf16>(ka, WS_VST) + (size_t)bh * 64 * SEQ + 8 * lane;
    for (int k0 = q0; k0 >= 0; k0 -= 32) {
        bf16x8 kf[4], vf[4];
#pragma unroll
        for (int ks = 0; ks < 4; ++ks) kf[ks] = *(const bf16x8*)(Kp + (size_t)((k0 >> 5) * 4 + ks) * 512);
#pragma unroll
        for (int i = 0; i < 4; ++i) vf[i] = *(const bf16x8*)(Vp + (size_t)((k0 >> 5) * 4 + i) * 512);
        f32x16 za = {};
#pragma unroll
        for (int ks = 0; ks < 4; ++ks) za = __builtin_amdgcn_mfma_f32_32x32x16_bf16(kf[ks], qf[ks], za, 0, 0, 0);
        const bool diag = (k0 == q0);
        float L[16], lw[16];
#pragma unroll
        for (int r = 0; r < 16; ++r) {
            const float z = za[r] * 0.125f;
            const float sp = fmaxf(z, 0.f) + __logf(1.f + __expf(-fabsf(z)));
            const bool valid = !diag || (crow(r, hi) < r32);
            L[r] = valid ? -sp : 0.f;
            lw[r] = valid ? (z - sp) : -1e30f;
        }
        float e[16], T[4], U[4];
#pragma unroll
        for (int g = 0; g < 4; ++g) { e[4 * g + 3] = 0.f; e[4 * g + 2] = L[4 * g + 3]; e[4 * g + 1] = e[4 * g + 2] + L[4 * g + 2]; e[4 * g] = e[4 * g + 1] + L[4 * g + 1]; T[g] = e[4 * g] + L[4 * g]; }
#pragma unroll
        for (int g = 0; g < 4; ++g) U[g] = shx_f(T[g], 32, lane);
        float sT[4], sUge[4];
        sT[3] = 0.f; sT[2] = T[3]; sT[1] = T[3] + T[2]; sT[0] = sT[1] + T[1];
        sUge[3] = U[3]; sUge[2] = U[3] + U[2]; sUge[1] = sUge[2] + U[1]; sUge[0] = sUge[1] + U[0];
        float w[16];
#pragma unroll
        for (int g = 0; g < 4; ++g) {
            const float sfx = R + sT[g] + (hi ? (sUge[g] - U[g]) : sUge[g]);
#pragma unroll
            for (int i = 0; i < 4; ++i) w[4 * g + i] = __expf(lw[4 * g + i] + sfx + e[4 * g + i]);
        }
        R += (sT[0] + T[0]) + sUge[0];
        const bf16x8 pf0 = pack8(w[0], w[1], w[2], w[3], w[4], w[5], w[6], w[7]), pf1 = pack8(w[8], w[9], w[10], w[11], w[12], w[13], w[14], w[15]);
        o0 = __builtin_amdgcn_mfma_f32_32x32x16_bf16(vf[0], pf0, o0, 0, 0, 0);
        o0 = __builtin_amdgcn_mfma_f32_32x32x16_bf16(vf[1], pf1, o0, 0, 0, 0);
        o1 = __builtin_amdgcn_mfma_f32_32x32x16_bf16(vf[2], pf0, o1, 0, 0, 0);
        o1 = __builtin_amdgcn_mfma_f32_32x32x16_bf16(vf[3], pf1, o1, 0, 0, 0);
        if (__all(R < -88.f)) break;
    }
    bf16* dst = wsp<bf16>(ka, WS_OB) + ((size_t)b * SEQ + q0 + r32) * DM + h * 64 + 4 * hi;
#pragma unroll
    for (int g = 0; g < 4; ++g) {
        v2u wv; wv.x = pk2(o0[4 * g], o0[4 * g + 1]); wv.y = pk2(o0[4 * g + 2], o0[4 * g + 3]); *(v2u*)(dst + 8 * g) = wv;
        v2u u; u.x = pk2(o1[4 * g], o1[4 * g + 1]); u.y = pk2(o1[4 * g + 2], o1[4 * g + 3]); *(v2u*)(dst + 32 + 8 * g) = u;
    }
}

template <bool QUANT> __device__ __forceinline__ void ln_row(Frame& F, kap_t ka, int row, const float* g, const float* bb) {
    float* yr = ka->out + (size_t)row * DM;
    f32x4 v[4]; float s = 0.f;
#pragma unroll
    for (int j = 0; j < 4; ++j) { v[j] = *(const f32x4*)(yr + 4 * F.lane + 256 * j); s += (v[j].x + v[j].y) + (v[j].z + v[j].w); }
    const float mean = wave_sum_all(s, F.lane) * (1.f / DM); float s2 = 0.f;
#pragma unroll
    for (int j = 0; j < 4; ++j) { v[j] = v[j] - mean; s2 += (v[j].x * v[j].x + v[j].y * v[j].y) + (v[j].z * v[j].z + v[j].w * v[j].w); }
    const float rstd = rsqrtf(wave_sum_all(s2, F.lane) * (1.f / DM) + LN_EPS);
#pragma unroll
    for (int j = 0; j < 4; ++j) { const int c = 4 * F.lane + 256 * j; const f32x4 gg = *(const f32x4*)(g + c), bv = *(const f32x4*)(bb + c);
        const f32x4 o = v[j] * rstd * gg + bv; *(f32x4*)(yr + c) = o; v[j] = o;
        v2u w; w.x = pk2(o.x, o.y); w.y = pk2(o.z, o.w); *(v2u*)(wsp<bf16>(ka, WS_XB) + (size_t)row * DM + c) = w; }
    if (QUANT) {
        float xm = 0.f;
#pragma unroll
        for (int j = 0; j < 4; ++j) xm = fmaxf(xm, fmaxf(fmaxf(fabsf(v[j].x), fabsf(v[j].y)), fmaxf(fabsf(v[j].z), fabsf(v[j].w))));
        xm = wave_max_all(xm, F.lane);
        const float inv = xm > 0.f ? 127.f / xm : 0.f;
        unsigned char* xq = wsp<unsigned char>(ka, WS_XQ) + (size_t)row * DM;
#pragma unroll
        for (int j = 0; j < 4; ++j) *(unsigned*)(xq + 4 * F.lane + 256 * j) = ((unsigned)(int)rintf(v[j].x * inv) & 0xffu) | (((unsigned)(int)rintf(v[j].y * inv) & 0xffu) << 8) | (((unsigned)(int)rintf(v[j].z * inv) & 0xffu) << 16) | (((unsigned)(int)rintf(v[j].w * inv) & 0xffu) << 24);
        if (F.lane == 0) wsp<float>(ka, WS_SX)[row] = xm * (1.f / 127.f);
    }
}

template <int N, int K, int J, bool FLIP> __device__ __forceinline__ void bitonic_stage(unsigned (&v)[N]) {
#pragma unroll
    for (int i = 0; i < N; ++i) { const int p = i ^ J; if (p > i) { const bool desc = (((i & K) == 0) != FLIP); const unsigned a = v[i], c = v[p]; const unsigned mx = a > c ? a : c, mn = a > c ? c : a; v[i] = desc ? mx : mn; v[p] = desc ? mn : mx; } }
}
template <bool FLIP> __device__ __forceinline__ void bitonic_merge16(unsigned (&v)[16]) {
    bitonic_stage<16, 16, 8, FLIP>(v); bitonic_stage<16, 16, 4, FLIP>(v); bitonic_stage<16, 16, 2, FLIP>(v); bitonic_stage<16, 16, 1, FLIP>(v);
}
__device__ __forceinline__ unsigned ord_key(float f, unsigned idx) { const unsigned u = __float_as_uint(f); const unsigned o = u ^ ((unsigned)((int)u >> 31) | 0x80000000u); return (o & 0xFFFFFF80u) | idx; }
__device__ __forceinline__ float key_val(unsigned k) { const unsigned o = (k & 0xFFFFFF80u) | 0x40u; const unsigned u = (o & 0x80000000u) ? (o ^ 0x80000000u) : ~o; return __uint_as_float(u); }
template <int N, int K, int J, bool FLIP> __device__ __forceinline__ void bitonic_stage_kv(unsigned (&k)[N], unsigned (&p)[N]) {
#pragma unroll
    for (int i = 0; i < N; ++i) { const int q = i ^ J; if (q > i) { const bool desc = (((i & K) == 0) != FLIP); const bool sw = desc ? (k[i] < k[q]) : (k[i] > k[q]);
        const unsigned ki = sw ? k[q] : k[i], kq = sw ? k[i] : k[q], pi = sw ? p[q] : p[i], pq = sw ? p[i] : p[q]; k[i] = ki; k[q] = kq; p[i] = pi; p[q] = pq; } }
}
template <bool FLIP> __device__ __forceinline__ void bitonic_merge16_kv(unsigned (&k)[16], unsigned (&p)[16]) {
    bitonic_stage_kv<16, 16, 8, FLIP>(k, p); bitonic_stage_kv<16, 16, 4, FLIP>(k, p); bitonic_stage_kv<16, 16, 2, FLIP>(k, p); bitonic_stage_kv<16, 16, 1, FLIP>(k, p);
}
__device__ __forceinline__ void p7_half(Frame& F, kap_t ka, int l, int tok, int h, int c, unsigned (&Cc)[16], const LAS unsigned char* klds) {
    const int lane = F.lane, hi = lane >> 5;
    const bf16* qrow = wsp<bf16>(ka, WS_HB) + (size_t)tok * 2048 + h * 256 + c * 128 + 8 * hi;
    bf16x8 qf[8];
#pragma unroll
    for (int ks = 0; ks < 8; ++ks) qf[ks] = *(const bf16x8*)(qrow + ks * 16);
    const LAS unsigned char* kb = klds + c * 32768 + lane * 16;
    unsigned key[64];
#pragma unroll
    for (int ch = 0; ch < 4; ++ch) {
        f32x16 acc = {};
#pragma unroll
        for (int ks = 0; ks < 8; ++ks) acc = __builtin_amdgcn_mfma_f32_32x32x16_bf16(*(const LAS bf16x8*)(kb + (ch * 8 + ks) * 1024), qf[ks], acc, 0, 0, 0);
#pragma unroll
        for (int r = 0; r < 16; ++r) key[ch * 16 + r] = ord_key(acc[r], (unsigned)(ch * 32 + crow(r, hi)));
    }
    bitonic_stage<64, 2, 1, false>(key);
    bitonic_stage<64, 4, 2, false>(key); bitonic_stage<64, 4, 1, false>(key);
    bitonic_stage<64, 8, 4, false>(key); bitonic_stage<64, 8, 2, false>(key); bitonic_stage<64, 8, 1, false>(key);
    bitonic_stage<64, 16, 8, false>(key); bitonic_stage<64, 16, 4, false>(key); bitonic_stage<64, 16, 2, false>(key); bitonic_stage<64, 16, 1, false>(key);
    unsigned A[16], B[16];
#pragma unroll
    for (int i = 0; i < 16; ++i) { A[i] = key[i] > key[16 + i] ? key[i] : key[16 + i]; B[i] = key[32 + i] > key[48 + i] ? key[32 + i] : key[48 + i]; }
    bitonic_merge16<false>(A);
    bitonic_merge16<true>(B);
#pragma unroll
    for (int i = 0; i < 16; ++i) A[i] = A[i] > B[i] ? A[i] : B[i];
    bitonic_merge16<false>(A);
#pragma unroll
    for (int i = 0; i < 16; ++i) B[i] = (unsigned)shx_i((int)A[i], 32, lane);
#pragma unroll
    for (int i = 0; i < 16; ++i) Cc[i] = A[i] > B[15 - i] ? A[i] : B[15 - i];
    bitonic_merge16<false>(Cc);
}
__device__ __forceinline__ void p7_unit(Frame& F, kap_t ka, int l, int tb, int h, const LAS unsigned char* klds) {
    const int lane = F.lane, r32 = lane & 31, hi = lane >> 5;
    const int tok = tb * 32 + r32;
    unsigned L0[16], L1[16];
#pragma unroll
    for (int i = 0; i < 16; ++i) { L0[i] = 0u; L1[i] = 0u; }
#pragma unroll 1
    for (int c = 0; c < 2; ++c) {
        unsigned Cc[16];
        p7_half(F, ka, l, tok, h, c, Cc, klds);
#pragma unroll
        for (int i = 0; i < 16; ++i) { L0[i] = c == 0 ? Cc[i] : L0[i]; L1[i] = c == 0 ? L1[i] : Cc[i]; }
    }
    __builtin_amdgcn_sched_barrier(0);
    unsigned key[64];
    {
        float v0[16], v1[16];
#pragma unroll
        for (int i = 0; i < 16; ++i) { v0[i] = key_val(L0[i]); v1[i] = key_val(L1[i]); }
#define P7_ROW(a, off, nb) { _Pragma("unroll") for (int b2 = 0; b2 < (nb); ++b2) { \
            const float sum = v0[a] + v1[b2]; const unsigned u = __float_as_uint(sum); const unsigned o = u ^ ((unsigned)((int)u >> 31) | 0x80000000u); \
            key[(off) + b2] = (o & 0xFFFFFF00u) | (unsigned)(255 - (16 * (a) + b2)); } }
        P7_ROW(0, 0, 16) P7_ROW(1, 16, 8) P7_ROW(2, 24, 5) P7_ROW(3, 29, 4) P7_ROW(4, 33, 3) P7_ROW(5, 36, 2) P7_ROW(6, 38, 2) P7_ROW(7, 40, 2)
        P7_ROW(8, 42, 1) P7_ROW(9, 43, 1) P7_ROW(10, 44, 1) P7_ROW(11, 45, 1) P7_ROW(12, 46, 1) P7_ROW(13, 47, 1) P7_ROW(14, 48, 1) P7_ROW(15, 49, 1)
#undef P7_ROW
#pragma unroll
        for (int i = 50; i < 64; ++i) key[i] = 0u;
    }
    LAS unsigned char* slot = F.lds + RING_OFF + F.wave * 2304 + lane * 36;
#pragma unroll
    for (int q = 0; q < 4; ++q) {
        ((LAS unsigned*)slot)[q] = (L0[4 * q] & 127u) | ((L0[4 * q + 1] & 127u) << 8) | ((L0[4 * q + 2] & 127u) << 16) | ((L0[4 * q + 3] & 127u) << 24);
        ((LAS unsigned*)slot)[4 + q] = (L1[4 * q] & 127u) | ((L1[4 * q + 1] & 127u) << 8) | ((L1[4 * q + 2] & 127u) << 16) | ((L1[4 * q + 3] & 127u) << 24);
    }
    bitonic_stage<64, 2, 1, false>(key);
    bitonic_stage<64, 4, 2, false>(key); bitonic_stage<64, 4, 1, false>(key);
    bitonic_stage<64, 8, 4, false>(key); bitonic_stage<64, 8, 2, false>(key); bitonic_stage<64, 8, 1, false>(key);
    bitonic_stage<64, 16, 8, false>(key); bitonic_stage<64, 16, 4, false>(key); bitonic_stage<64, 16, 2, false>(key); bitonic_stage<64, 16, 1, false>(key);
    unsigned A[16], B[16];
#pragma unroll
    for (int i = 0; i < 16; ++i) { A[i] = key[i] > key[16 + i] ? key[i] : key[16 + i]; B[i] = key[32 + i] > key[48 + i] ? key[32 + i] : key[48 + i]; }
    bitonic_merge16<false>(A);
    bitonic_merge16<true>(B);
#pragma unroll
    for (int i = 0; i < 16; ++i) A[i] = A[i] > B[i] ? A[i] : B[i];
    bitonic_merge16<false>(A);
    LDS_WAIT(); asm volatile("" ::: "memory");
    unsigned PA[16]; float g[16], den = 0.f;
    { const unsigned o0 = (A[0] & 0xFFFFFF00u) | 128u; const float m = __uint_as_float((o0 & 0x80000000u) ? (o0 ^ 0x80000000u) : ~o0);
#pragma unroll
      for (int i = 0; i < 16; ++i) { const unsigned o = (A[i] & 0xFFFFFF00u) | 128u; const float sv = __uint_as_float((o & 0x80000000u) ? (o ^ 0x80000000u) : ~o); g[i] = __expf(sv - m); den += g[i];
          const unsigned flat = 255u - (A[i] & 255u); PA[i] = (unsigned)slot[flat >> 4] * 128u + (unsigned)slot[16 + (flat & 15u)]; } }
    LDS_WAIT(); asm volatile("" ::: "memory");
    const float rden = 1.f / den;
    if (hi == 0) {
        unsigned* de = wsp<unsigned>(ka, WS_EL) + (size_t)tok * 128 + h * 16; float* dg = wsp<float>(ka, WS_GL) + (size_t)tok * 128 + h * 16;
#pragma unroll
        for (int q = 0; q < 4; ++q) { *(v4u*)(de + 4 * q) = (v4u){PA[4 * q], PA[4 * q + 1], PA[4 * q + 2], PA[4 * q + 3]};
            *(f32x4*)(dg + 4 * q) = (f32x4){g[4 * q] * rden, g[4 * q + 1] * rden, g[4 * q + 2] * rden, g[4 * q + 3] * rden}; }
    }
}

__device__ __forceinline__ float dot2_bf16(unsigned w, unsigned x, float acc) { return __builtin_amdgcn_fdot2_f32_bf16(__builtin_bit_cast(bf2_t, w), __builtin_bit_cast(bf2_t, x), acc, false); }
__device__ __forceinline__ float gelu_erf(float v) {
    const float av = fabsf(v), t = __builtin_amdgcn_rcpf(av * 0.2316418882f + 1.0f);
    float q = t * 0.5307027145f + (-0.7265760135f); q = q * t + 0.7107068705f; q = q * t + (-0.142248368f); q = q * t + 0.127414796f; q = q * t;
    const float e = __builtin_amdgcn_exp2f((v * v) * (-0.72134752044f));
    const float m = v * (q * e);
    return v < 0.f ? m : v - m;
}
struct P8aS { unsigned ev0, ev1; float gv0, gv1, sx; v4u x4[4]; f32x2 sc0, sc1; int N; unsigned ent[4]; v4u buf[4][4]; };
__device__ __forceinline__ void p8a_stageA(Frame& F, kap_t ka, int l, unsigned part, LAS unsigned* qu, P8aS& S) {
    const int lane = F.lane, qd = lane >> 4, i16 = lane & 15;
    const bool in0 = (S.ev0 >> 11) == part, in1 = (S.ev1 >> 11) == part;
    const f32x2* SUV = wsp<f32x2>(ka, WS_SUV) + (size_t)l * NEXP;
    S.sc0 = (f32x2){0.f, 0.f}; S.sc1 = (f32x2){0.f, 0.f};
    if (in0) S.sc0 = SUV[S.ev0];
    if (in1) S.sc1 = SUV[S.ev1];
    const unsigned long long m0 = __ballot(in0), m1 = __ballot(in1);
    const int n0 = __builtin_popcountll(m0); S.N = n0 + __builtin_popcountll(m1);
    if (in0) qu[__builtin_amdgcn_mbcnt_hi((unsigned)(m0 >> 32), __builtin_amdgcn_mbcnt_lo((unsigned)m0, 0u))] = S.ev0 | ((unsigned)lane << 16);
    if (in1) qu[n0 + __builtin_amdgcn_mbcnt_hi((unsigned)(m1 >> 32), __builtin_amdgcn_mbcnt_lo((unsigned)m1, 0u))] = S.ev1 | ((unsigned)(64 + lane) << 16);
    if (lane < 16) qu[S.N + lane] = (part << 11) | (128u << 16);
    LDS_WAIT(); asm volatile("" ::: "memory");
    const unsigned char* UQ = wsp<unsigned char>(ka, WS_UT) + (size_t)l * NEXP * DM;
    const unsigned loff = 16u * (unsigned)i16;
#pragma unroll
    for (int gi = 0; gi < 4; ++gi) { S.ent[gi] = qu[4 * gi + qd]; const unsigned ro = ((S.ent[gi] & 0xffffu) << 10) + loff;
#pragma unroll
        for (int c = 0; c < 4; ++c) S.buf[gi][c] = *(const v4u*)(UQ + (ro + 256u * c)); }
}
__device__ __forceinline__ int p8a_dot(const v4u (&b)[4], const v4u (&x4)[4]) {
    int p = 0;
#pragma unroll
    for (int c = 0; c < 4; ++c) { p = __builtin_amdgcn_sdot4((int)b[c].x, (int)x4[c].x, p, false); p = __builtin_amdgcn_sdot4((int)b[c].y, (int)x4[c].y, p, false);
        p = __builtin_amdgcn_sdot4((int)b[c].z, (int)x4[c].z, p, false); p = __builtin_amdgcn_sdot4((int)b[c].w, (int)x4[c].w, p, false); }
    return p;
}
__device__ __forceinline__ void p8a_stageB(Frame& F, kap_t ka, int l, int tok, unsigned part, LAS unsigned* qu, LAS int* res, P8aS& S) {
    const int lane = F.lane, qd = lane >> 4, i16 = lane & 15;
    int p[4];
#pragma unroll
    for (int gi = 0; gi < 4; ++gi) p[gi] = p8a_dot(S.buf[gi], S.x4);
#pragma unroll
    for (int gi = 0; gi < 4; ++gi) p[gi] += __builtin_amdgcn_update_dpp(0, p[gi], 0xB1, 0xF, 0xF, true);
#pragma unroll
    for (int gi = 0; gi < 4; ++gi) p[gi] += __builtin_amdgcn_update_dpp(0, p[gi], 0x4E, 0xF, 0xF, true);
#pragma unroll
    for (int gi = 0; gi < 4; ++gi) p[gi] += __builtin_amdgcn_update_dpp(0, p[gi], 0x141, 0xF, 0xF, true);
#pragma unroll
    for (int gi = 0; gi < 4; ++gi) p[gi] += __builtin_amdgcn_update_dpp(0, p[gi], 0x140, 0xF, 0xF, true);
#pragma unroll
    for (int gi = 0; gi < 4; ++gi) res[S.ent[gi] >> 16] = p[gi];
    if (S.N > 16) {
        const unsigned char* UQ = wsp<unsigned char>(ka, WS_UT) + (size_t)l * NEXP * DM; const unsigned loff = 16u * (unsigned)i16;
        for (int g0 = 16; g0 < S.N; g0 += 4) {
            const unsigned en = qu[g0 + qd]; const unsigned ro = ((en & 0xffffu) << 10) + loff; v4u bb[4];
#pragma unroll
            for (int c = 0; c < 4; ++c) bb[c] = *(const v4u*)(UQ + (ro + 256u * c));
            int q = p8a_dot(bb, S.x4);
            q += __builtin_amdgcn_update_dpp(0, q, 0xB1, 0xF, 0xF, true); q += __builtin_amdgcn_update_dpp(0, q, 0x4E, 0xF, 0xF, true);
            q += __builtin_amdgcn_update_dpp(0, q, 0x141, 0xF, 0xF, true); q += __builtin_amdgcn_update_dpp(0, q, 0x140, 0xF, 0xF, true);
            res[en >> 16] = q;
        }
    }
    LDS_WAIT(); asm volatile("" ::: "memory");
    const bool in0 = (S.ev0 >> 11) == part, in1 = (S.ev1 >> 11) == part;
    float* AC = wsp<float>(ka, WS_AC) + (size_t)tok * 128;
    if (in0) AC[lane] = S.gv0 * gelu_erf((float)res[lane] * (S.sc0.x * S.sx)) * S.sc0.y;
    if (in1) AC[64 + lane] = S.gv1 * gelu_erf((float)res[64 + lane] * (S.sc1.x * S.sx)) * S.sc1.y;
}
__device__ __forceinline__ void p8a_fetch(const unsigned* EL, const float* GL, const unsigned char* XQ, const float* SX, int t, P8aS& S) {
    const size_t o = (size_t)t * 128; S.ev0 = EL[o]; S.ev1 = EL[o + 64]; S.gv0 = GL[o]; S.gv1 = GL[o + 64]; S.sx = SX[t];
#pragma unroll
    for (int c = 0; c < 4; ++c) S.x4[c] = *(const v4u*)(XQ + (size_t)t * DM + 256 * c);
}

__device__ __forceinline__ void p8b_pair(Frame& F, kap_t ka, int l, int tokA, int tokB, bool storeB, unsigned part, const v4u ev, const f32x4 av, float* ybase, LAS unsigned* le, LAS unsigned* la8) {
    const int lane = F.lane, tk = lane >> 5, g = (lane >> 3) & 3, c = lane & 7, l32 = lane & 31;
    const int tok = tk ? tokB : tokA;
    const float* yrow = ka->out + (size_t)tok * DM + 128 * part + 16 * c;
    f32x4 xv[4] = {};
    if (g == 0) {
#pragma unroll
        for (int q = 0; q < 4; ++q) xv[q] = *(const f32x4*)(yrow + 4 * q);
    }
    float am = fmaxf(fmaxf(fabsf(av.x), fabsf(av.y)), fmaxf(fabsf(av.z), fabsf(av.w)));
    am = fmaxf(am, dpp_f<0xB1>(am)); am = fmaxf(am, dpp_f<0x4E>(am)); am = fmaxf(am, dpp_f<0x141>(am)); am = fmaxf(am, dpp_f<0x140>(am)); am = fmaxf(am, shx_f(am, 16, lane));
    const float inv = am > 0.f ? 127.f / am : 0.f, sa = am * (1.f / 127.f);
    *(LAS v4u*)(le + tk * 128 + 4 * l32) = (v4u){ev.x << 7, ev.y << 7, ev.z << 7, ev.w << 7};
    la8[tk * 32 + l32] = ((unsigned)(int)rintf(av.x * inv) & 0xffu) | (((unsigned)(int)rintf(av.y * inv) & 0xffu) << 8) | (((unsigned)(int)rintf(av.z * inv) & 0xffu) << 16) | (((unsigned)(int)rintf(av.w * inv) & 0xffu) << 24);
    LDS_WAIT(); asm volatile("" ::: "memory");
    const unsigned char* VQ = wsp<unsigned char>(ka, WS_VT) + (size_t)l * NEXP * DM + (size_t)part * NEXP * 128;
    const unsigned loff = 16u * (unsigned)c;
    const LAS unsigned* lek = le + tk * 128 + 4 * g;
    v4u R[32];
#pragma unroll
    for (int m = 0; m < 8; ++m) { const v4u eo = *(const LAS v4u*)(lek + 16 * m);
#pragma unroll
        for (int r = 0; r < 4; ++r) R[4 * m + r] = *(const v4u*)(VQ + (eo[r] + loff)); }
    int acc[16];
#pragma unroll
    for (int i = 0; i < 16; ++i) acc[i] = 0;
#pragma unroll
    for (int m = 0; m < 8; ++m) {
        const int ap = (int)la8[tk * 32 + 4 * m + g];
#pragma unroll
        for (int d = 0; d < 4; ++d) {
            const unsigned r0 = R[4 * m][d], r1 = R[4 * m + 1][d], r2 = R[4 * m + 2][d], r3 = R[4 * m + 3][d];
            const unsigned t01l = __builtin_amdgcn_perm(r1, r0, 0x05010400u), t01h = __builtin_amdgcn_perm(r1, r0, 0x07030602u);
            const unsigned t23l = __builtin_amdgcn_perm(r3, r2, 0x05010400u), t23h = __builtin_amdgcn_perm(r3, r2, 0x07030602u);
            acc[4 * d] = __builtin_amdgcn_sdot4((int)__builtin_amdgcn_perm(t23l, t01l, 0x05040100u), ap, acc[4 * d], false);
            acc[4 * d + 1] = __builtin_amdgcn_sdot4((int)__builtin_amdgcn_perm(t23l, t01l, 0x07060302u), ap, acc[4 * d + 1], false);
            acc[4 * d + 2] = __builtin_amdgcn_sdot4((int)__builtin_amdgcn_perm(t23h, t01h, 0x05040100u), ap, acc[4 * d + 2], false);
            acc[4 * d + 3] = __builtin_amdgcn_sdot4((int)__builtin_amdgcn_perm(t23h, t01h, 0x07060302u), ap, acc[4 * d + 3], false);
        }
    }
#pragma unroll
    for (int i = 0; i < 16; ++i) { acc[i] += shx_i(acc[i], 8, lane); acc[i] += shx_i(acc[i], 16, lane); }
    if (g == 0 && (tk == 0 || storeB)) {
        float* yd = ybase + (size_t)tok * DM + 128 * part + 16 * c;
#pragma unroll
        for (int q = 0; q < 4; ++q) { const f32x4 x = xv[q];
            *(f32x4*)(yd + 4 * q) = (f32x4){ALPHA * x.x + (float)acc[4 * q] * sa, ALPHA * x.y + (float)acc[4 * q + 1] * sa, ALPHA * x.z + (float)acc[4 * q + 2] * sa, ALPHA * x.w + (float)acc[4 * q + 3] * sa}; }
    }
    LDS_WAIT(); asm volatile("" ::: "memory");
}

__global__ void __launch_bounds__(NTHREADS, 2) mk_fwd(Args args) {
    extern __shared__ __attribute__((aligned(16))) unsigned char lds[];
    Frame F;
    F.lds = (LAS unsigned char*)lds;
    F.MISC = (volatile LAS unsigned*)(F.lds + MISC_OFF);
    F.tid = threadIdx.x; F.lane = F.tid & 63; F.wave = __builtin_amdgcn_readfirstlane(F.tid >> 6);
    F.G = gridDim.x; { const int bx = blockIdx.x; F.vcu = (F.G % 8 == 0) ? (bx % 8) * (F.G / 8) + bx / 8 : bx; }
    for (int u = F.tid; u < (LDS_BYTES - LDSCTL_OFF) / 4; u += NTHREADS) ((LAS unsigned*)(F.lds + LDSCTL_OFF))[u] = 0u;
    __syncthreads();
    const int lo = args.ph_lo, hi = args.ph_hi;
    unsigned* const barw = (unsigned*)(args.ws + WS_CTL) + CW_BAR;
    const bool one_phase = (hi - lo) == 1;
    XcdBarrier bar; bar.bar = barw; bar.x = 0; bar.st = nullptr;
    if (!one_phase) bar = xcd_barrier_post(barw, F.MISC + 8);
#ifndef MK_EN
#define MK_EN 0x7ff
#endif
#ifndef MK_MLA_LDS
#define MK_MLA_LDS 0
#endif
#ifndef MK_MLA_REP
#define MK_MLA_REP 1
#endif
#ifndef MK_SB_REP
#define MK_SB_REP 1
#endif
#ifndef MK_P8B_VAR
#define MK_P8B_VAR 0
#endif
#define EN(n) (((MK_EN) >> (n)) & 1)
#ifndef MK_REP
#define MK_REP 0
#endif
#define PHASE_REP(n) for (int rep_ = 0; rep_ < ((((MK_REP) >> (n)) & 1) + 1); ++rep_)
#define IN(k) (lo <= (k) && (k) < hi)
#define PHASE_IDS() do { unsigned z_ = 0u; asm volatile("" : "+v"(z_)); const int ln_ = (int)__builtin_amdgcn_mbcnt_hi(~0u, __builtin_amdgcn_mbcnt_lo(~0u, z_)); F.lane = ln_; F.tid = F.wave * 64 + ln_; } while (0)
#define SEAM(k) do { if (IN((k) + 1)) { XcdBarrier b_ = bar; asm volatile("" : "+s"(b_.bar), "+s"(b_.x));     xcd_barrier(b_); } } while (0)
    const int gw = F.vcu * NWAVES + F.wave, NGW = F.G * NWAVES;

    if (EN(0) && IN(0)) PHASE_REP(0) { PHASE_IDS(); p0_prologue(F, ka_fresh()); SEAM(0); }
#pragma unroll
    for (int l = 0; l < DEPTH; ++l) {
        const int pb = 1 + NPL * l;
        if (EN(1) && IN(pb + 0)) PHASE_REP(1) { const kap_t ka = ka_fresh(); PHASE_IDS();
            pg8::Gemm g{wsp<bf16>(ka, WS_XB), wsp<bf16>(ka, WS_WIT) + (size_t)l * DINP * DM, NTOK, DINP, DM}; pg8::StaticOrder S; S.init(NTOK, DINP, F.G, (int)blockIdx.x);
            pg8::EpiBf16<0> E{wsp<bf16>(ka, WS_HB), DINP, nullptr, 0, 0, 1.f};
            pg8::gemm_phase<pg8::EpiBf16<0>, pg8::StaticOrder, PG8_ALIGN, PG8_SP2>(F.lds + RING_OFF, g, S, E, F.tid);
            SEAM(pb + 0);
        }
        if (EN(2) && IN(pb + 1)) PHASE_REP(2) { const kap_t ka = ka_fresh(); PHASE_IDS();
            for (int u = gw; u < (NTOK / 32) * 4; u += NGW) p2_unit(F, ka, l, u >> 2, u & 3);
            SEAM(pb + 1);
        }
        if (EN(3) && IN(pb + 2)) PHASE_REP(3) { const kap_t ka = ka_fresh(); PHASE_IDS();
#if MK_MLA_LDS
            for (int u = F.vcu; u < 32 * 8; u += F.G) {
                const int bh = u >> 3, j = u & 7;
                mla_block(F, ka, bh, 15 - j); sb_unit(F, ka, bh, 8 * (15 - j) + F.wave);
                mla_block(F, ka, bh, j); sb_unit(F, ka, bh, 8 * j + F.wave);
            }
#else
            for (int u = gw; u < 32 * 64; u += NGW) {
                const int bh = u >> 6, pi = u & 63;
                for (int r_ = 0; r_ < MK_MLA_REP; ++r_) { mla_unit(F, ka, bh, 127 - pi); mla_unit(F, ka, bh, pi); }
            }
            PHASE_IDS();
            for (int u = gw; u < 32 * 64; u += NGW) {
                const int bh = u >> 6, pi = u & 63;
                for (int r_ = 0; r_ < MK_SB_REP; ++r_) { sb_unit(F, ka, bh, 127 - pi); sb_unit(F, ka, bh, pi); }
            }
#endif
            SEAM(pb + 2);
        }
        if (EN(4) && IN(pb + 3)) PHASE_REP(4) { const kap_t ka = ka_fresh(); PHASE_IDS();
            pg8::Gemm g{wsp<bf16>(ka, WS_OB), wsp<bf16>(ka, WS_WOT) + (size_t)l * DM * DM, NTOK, DM, DM}; pg8::StaticOrder S; S.init(NTOK, DM, F.G, (int)blockIdx.x);
            pg8::EpiResF32 E{l == 0 ? ka->in[I_X] : ka->out, ka->out, DM, ALPHA};
            pg8::gemm_phase<pg8::EpiResF32, pg8::StaticOrder, PG8_ALIGN, PG8_SP2>(F.lds + RING_OFF, g, S, E, F.tid);
            SEAM(pb + 3);
        }
        if (EN(5) && IN(pb + 4)) PHASE_REP(5) { const kap_t ka = ka_fresh(); PHASE_IDS();
            for (int r = gw; r < NTOK; r += NGW) ln_row<true>(F, ka, r, ka->in[I_LN1G] + l * DM, ka->in[I_LN1B] + l * DM);
            SEAM(pb + 4);
        }
        if (EN(6) && IN(pb + 5)) PHASE_REP(6) { const kap_t ka = ka_fresh(); PHASE_IDS();
            pg8::Gemm g{wsp<bf16>(ka, WS_XB), wsp<bf16>(ka, WS_WQT) + (size_t)l * 2048 * DM, NTOK, 2048, DM}; pg8::StaticOrder S; S.init(NTOK, 2048, F.G, (int)blockIdx.x);
            pg8::EpiBf16<0> E{wsp<bf16>(ka, WS_HB), 2048, nullptr, 0, 0, 1.f};
            pg8::gemm_phase<pg8::EpiBf16<0>, pg8::StaticOrder, PG8_ALIGN, PG8_SP2>(F.lds + RING_OFF, g, S, E, F.tid);
            SEAM(pb + 5);
        }
        if (EN(7) && IN(pb + 6)) PHASE_REP(7) { const kap_t ka = ka_fresh(); PHASE_IDS();
            const LAS unsigned char* klds = F.lds + RING_OFF + 32768;
            int hcur = -1;
            for (int wu = F.vcu; wu < (NTOK / 32); wu += F.G) {
                const int h = wu & 7, tb = (wu >> 3) * 8 + F.wave;
                if (h != hcur) {
                    __syncthreads();
                    const v4u* src = (const v4u*)(wsp<bf16>(ka, WS_KEYS) + (size_t)(l * 8 + h) * 2 * 16384) + F.tid;
#pragma unroll
                    for (int i = 0; i < 8; ++i) *(LAS v4u*)(F.lds + RING_OFF + 32768 + (F.tid + 512 * i) * 16) = src[512 * i];
                    __syncthreads();
                    hcur = h;
                }
                p7_unit(F, ka, l, tb, h, klds);
            }
            SEAM(pb + 6);
        }
        if (EN(8) && IN(pb + 7)) PHASE_REP(8) { const kap_t ka = ka_fresh(); PHASE_IDS();
            const bool split = (F.G % 8 == 0); const int npp = split ? F.G / 8 : F.G;
            for (unsigned part = split ? (unsigned)(F.vcu / npp) : 0u, pend = split ? part + 1u : 8u; part < pend; ++part) {
                const int pw = (F.vcu % npp) * NWAVES + F.wave, npw = npp * NWAVES;
                const unsigned* EL = wsp<unsigned>(ka, WS_EL) + F.lane; const float* GL = wsp<float>(ka, WS_GL) + F.lane;
                const unsigned char* XQ = wsp<unsigned char>(ka, WS_XQ) + 16 * (F.lane & 15); const float* SX = wsp<float>(ka, WS_SX);
                LAS unsigned* quA = (LAS unsigned*)(F.lds + RING_OFF + F.wave * 4096); LAS int* rsA = (LAS int*)(F.lds + RING_OFF + F.wave * 4096 + 1024);
                LAS unsigned* quB = (LAS unsigned*)(F.lds + RING_OFF + F.wave * 4096 + 2048); LAS int* rsB = (LAS int*)(F.lds + RING_OFF + F.wave * 4096 + 3072);
                const int nt = (NTOK - pw + npw - 1) / npw;
                if (nt > 0) {
                    P8aS SA, SB;
                    p8a_fetch(EL, GL, XQ, SX, pw, SA);
                    p8a_stageA(F, ka, l, part, quA, SA);
                    int t = pw;
                    for (int i = 0; i + 2 < nt; i += 2, t += 2 * npw) {
                        p8a_fetch(EL, GL, XQ, SX, t + npw, SB);
                        p8a_stageA(F, ka, l, part, quB, SB);
                        p8a_stageB(F, ka, l, t, part, quA, rsA, SA);
                        p8a_fetch(EL, GL, XQ, SX, t + 2 * npw, SA);
                        LDS_WAIT(); asm volatile("" ::: "memory");
                        p8a_stageA(F, ka, l, part, quA, SA);
                        p8a_stageB(F, ka, l, t + npw, part, quB, rsB, SB);
                        LDS_WAIT(); asm volatile("" ::: "memory");
                    }
                    if (t + npw < NTOK) {
                        p8a_fetch(EL, GL, XQ, SX, t + npw, SB);
                        p8a_stageA(F, ka, l, part, quB, SB);
                        p8a_stageB(F, ka, l, t, part, quA, rsA, SA);
                        p8a_stageB(F, ka, l, t + npw, part, quB, rsB, SB);
                    } else {
                        p8a_stageB(F, ka, l, t, part, quA, rsA, SA);
                    }
                    LDS_WAIT(); asm volatile("" ::: "memory");
                }
            }
            SEAM(pb + 7);
        }
        if (EN(9) && IN(pb + 8)) PHASE_REP(9) { const kap_t ka = ka_fresh(); PHASE_IDS();
            const bool split = (F.G % 8 == 0); const int npp = split ? F.G / 8 : F.G;
            for (unsigned part = split ? (unsigned)(F.vcu / npp) : 0u, pend = split ? part + 1u : 8u; part < pend; ++part) {
                const int pw = (F.vcu % npp) * NWAVES + F.wave, npw = npp * NWAVES;
                LAS unsigned* le = (LAS unsigned*)(F.lds + RING_OFF + F.wave * 2048); LAS unsigned* la8 = (LAS unsigned*)(F.lds + RING_OFF + F.wave * 2048 + 1024);
                float* ybase = (rep_ == 0) ? ka->out : (float*)wsp<bf16>(ka, WS_HB);
                const int tk = F.lane >> 5, l32 = F.lane & 31;
                const unsigned* EL = wsp<unsigned>(ka, WS_EL) + 4 * l32; const float* AC = wsp<float>(ka, WS_AC) + 4 * l32;
                v4u ev = {}; f32x4 av = {};
                { const int t0 = pw + tk * npw; if (pw < NTOK) { const int tt = t0 < NTOK ? t0 : pw; ev = *(const v4u*)(EL + (size_t)tt * 128); av = *(const f32x4*)(AC + (size_t)tt * 128); } }
                for (int t = pw; t < NTOK; t += 2 * npw) {
                    const int tB = t + npw; const bool hasB = tB < NTOK;
                    v4u nev = {}; f32x4 nav = {};
                    if (t + 2 * npw < NTOK) { const int t0 = t + 2 * npw + tk * npw; const int tt = t0 < NTOK ? t0 : t + 2 * npw; nev = *(const v4u*)(EL + (size_t)tt * 128); nav = *(const f32x4*)(AC + (size_t)tt * 128); }
                    p8b_pair(F, ka, l, t, hasB ? tB : t, hasB, part, ev, av, ybase, le, la8);
                    ev = nev; av = nav;
                }
            }
            SEAM(pb + 8);
        }
        if (EN(10) && IN(pb + 9)) PHASE_REP(10) { const kap_t ka = ka_fresh(); PHASE_IDS();
            for (int r = gw; r < NTOK; r += NGW) ln_row<false>(F, ka, r, ka->in[I_LN2G] + l * DM, ka->in[I_LN2B] + l * DM);
            if (l + 1 < DEPTH) SEAM(pb + 9);
        }
    }
#undef IN
#undef SEAM
}

#ifndef MK_PER_PHASE
#define MK_PER_PHASE 0
#endif
extern "C" void kernel_launch(void* const* d_in, const int* in_sizes, int n_in, void* d_out, int out_size, void* d_ws, size_t ws_size, hipStream_t stream) {
    static int grid = 0;
    if (grid == 0) {
        if (n_in != 15 || out_size != NTOK * DM || ws_size < WS_END) { fprintf(stderr, "kernel_launch: unexpected shapes (n_in %d, out %d, ws %zu); nothing launched\n", n_in, out_size, ws_size); grid = -1; return; }
        int dev = 0, cus = 0, per_cu = 0;
        if (hipGetDevice(&dev) != hipSuccess || hipDeviceGetAttribute(&cus, hipDeviceAttributeMultiprocessorCount, dev) != hipSuccess) { fprintf(stderr, "kernel_launch: device query failed\n"); grid = -1; return; }
        if (hipFuncSetAttribute((const void*)mk_fwd, hipFuncAttributeMaxDynamicSharedMemorySize, LDS_BYTES) != hipSuccess) { fprintf(stderr, "kernel_launch: hipFuncSetAttribute failed\n"); grid = -1; return; }
        if (hipOccupancyMaxActiveBlocksPerMultiprocessor(&per_cu, (const void*)mk_fwd, NTHREADS, LDS_BYTES) != hipSuccess || per_cu < 1) { fprintf(stderr, "kernel_launch: occupancy query says %d blocks per CU\n", per_cu); per_cu = 1; }
        (void)hipGetLastError();
        grid = cus;
        fprintf(stderr, "kernel_launch: grid %d (occupancy query %d per CU)\n", grid, per_cu);
    }
    if (grid < 0) return;
    (void)hipMemsetAsync((char*)d_ws + WS_CTL, 0, CTL_ZERO_BYTES, stream);
    Args a{};
    for (int i = 0; i < 15; ++i) a.in[i] = (const float*)d_in[i];
    a.out = (float*)d_out; a.ws = (unsigned char*)d_ws;
#if MK_PER_PHASE
    for (int p = 0; p < NPHASE; ++p) { a.ph_lo = p; a.ph_hi = p + 1; hipLaunchKernelGGL(mk_fwd, dim3(grid), dim3(NTHREADS), LDS_BYTES, stream, a); }
#else
    a.ph_lo = 0; a.ph_hi = NPHASE;
    void* kargs[] = {&a};
    const hipError_t e = hipLaunchCooperativeKernel((const void*)mk_fwd, dim3(grid), dim3(NTHREADS), kargs, LDS_BYTES, stream);
    if (e != hipSuccess) fprintf(stderr, "kernel_launch: cooperative launch failed: %s (grid %d)\n", hipGetErrorString(e), grid);
#endif
}
```

```cpp
#include <hip/hip_runtime.h>
#include <cstdio>
#include <cstdint>
#include <math.h>
namespace pg8 {
#define PG8_LAS __attribute__((address_space(3)))
typedef unsigned short bf16_t;
typedef short bf16x8 __attribute__((ext_vector_type(8)));
typedef float f32x4 __attribute__((ext_vector_type(4)));
typedef unsigned u32x4 __attribute__((ext_vector_type(4)));
constexpr int BM = 256, BK = 64, HALF = 128, HTB = HALF * BK * 2  , STAGE_BYTES = 8 * HTB, NXCD = 8, WGM = 8;

__host__ __device__ __forceinline__ int lds_byte(int r, int c) { const int st = (r >> 4) * 2 + (c >> 5), rr = r & 15, cc = c & 31, ob = rr * 64 + cc * 2; return st * 1024 + (ob ^ (((ob >> 9) & 1) << 5)); }
__host__ __device__ __forceinline__ void stage_rc(int b, int& R, int& C) { const int st = b / 1024, sb = b % 1024, swz = sb ^ (((sb >> 9) & 1) << 5); R = (st >> 1) * 16 + swz / 64; C = (st & 1) * 32 + (swz % 64) / 2; }
__host__ __device__ __forceinline__ int perm32(int rho) { const int n = rho >> 4, i = rho & 15; return 8 * (i >> 2) + 4 * n + (i & 3); }

struct Unit { int pm, pn; };
struct Gemm { const bf16_t* A; const bf16_t* Bt; int M, N, K; };

struct StaticOrder {
    int nM, nN, nwg, G, c;
    __host__ __device__ void init(int M, int N, int G_, int c_) { nM = M / BM; nN = N / BM; nwg = nM * nN; G = G_; c = c_; }
    __host__ __device__ bool next(int i, Unit& u) const {
        const long L = (long)i * G + c; if (L >= nwg) return false;
        int wgid = (int)L; { const int q = nwg / NXCD, r = nwg % NXCD, xcd = wgid % NXCD, off = wgid / NXCD; wgid = (xcd < r ? xcd * (q + 1) : r * (q + 1) + (xcd - r) * q) + off; }
        const int nig = WGM * nN, gid = wgid / nig, fm = gid * WGM, gsz = (nM - fm) < WGM ? (nM - fm) : WGM;
        u.pm = fm + ((wgid % nig) % gsz); u.pn = (wgid % nig) / gsz; return true;
    }
    __device__ __forceinline__ void a_ready(const Unit&) const {}
    __device__ __forceinline__ void done(const Unit&) const {}
};

__device__ __forceinline__ unsigned cvt_pk_bf16(float lo, float hi) { unsigned r; asm volatile("v_cvt_pk_bf16_f32 %0, %1, %2" : "=v"(r) : "v"(lo), "v"(hi)); return r; }
typedef float f32x2 __attribute__((ext_vector_type(2)));
__device__ __forceinline__ f32x2 gelu_pk(f32x2 v) {
    const f32x2 av = __builtin_elementwise_abs(v), d = av * 0.2316418882f + 1.0f;
    f32x2 t; t.x = __builtin_amdgcn_rcpf(d.x); t.y = __builtin_amdgcn_rcpf(d.y);
    f32x2 q = t * 0.5307027145f + (-0.7265760135f); q = q * t + 0.7107068705f; q = q * t + (-0.142248368f); q = q * t + 0.127414796f; q = q * t;
    const f32x2 s = (v * v) * (-0.72134752044f);
    f32x2 e; e.x = __builtin_amdgcn_exp2f(s.x); e.y = __builtin_amdgcn_exp2f(s.y);
    const f32x2 m = v * (q * e), r = v - m;
    f32x2 o; o.x = v.x < 0.f ? m.x : r.x; o.y = v.y < 0.f ? m.y : r.y; return o;
}

template <int ACT  > struct EpiBf16 {
    static constexpr bool PERM = true, AFTER_DRAIN = false; static_assert(ACT == 0 || ACT == 1, "EpiBf16: ACT is 0 (none) or 1 (gelu_pk)");
    bf16_t* O; int ldc; const float* bias; int split_cols; size_t split_stride; float scale0;
    __device__ __forceinline__ void operator()(const f32x4 (&acc)[2][2][4][2], const Unit& u, int wr, int wc, int fr, int fq) const {
        const int row0 = u.pm * BM + wr * 64 + fr; int colt = u.pn * BM; bf16_t* base = O;
        float sc = 1.f; if (split_cols) { const int t = colt / split_cols; base += (size_t)t * split_stride; colt -= t * split_cols; if (t == 0) sc = scale0; }
        const int col0 = colt + wc * 32 + 8 * fq, bcol0 = u.pn * BM + wc * 32 + 8 * fq;
        f32x4 bv[2][2];
#pragma unroll
        for (int bj = 0; bj < 2; ++bj)
#pragma unroll
            for (int n = 0; n < 2; ++n) bv[bj][n] = bias ? *(const f32x4*)(bias + bcol0 + bj * HALF + 4 * n) : (f32x4){0.f, 0.f, 0.f, 0.f};
#pragma unroll
        for (int ai = 0; ai < 2; ++ai)
#pragma unroll
            for (int m = 0; m < 4; ++m) { bf16_t* rowp = base + (size_t)(row0 + ai * HALF + m * 16) * ldc + col0;
#pragma unroll
                for (int bj = 0; bj < 2; ++bj) { f32x4 v0 = acc[ai][bj][m][0] + bv[bj][0], v1 = acc[ai][bj][m][1] + bv[bj][1];
                    if (ACT == 1) { f32x2 a = gelu_pk((f32x2){v0[0], v0[1]}), b = gelu_pk((f32x2){v0[2], v0[3]}), c = gelu_pk((f32x2){v1[0], v1[1]}), d = gelu_pk((f32x2){v1[2], v1[3]});
                        v0 = (f32x4){a.x, a.y, b.x, b.y}; v1 = (f32x4){c.x, c.y, d.x, d.y}; }
                    v0 = v0 * sc; v1 = v1 * sc; u32x4 w; w.x = cvt_pk_bf16(v0[0], v0[1]); w.y = cvt_pk_bf16(v0[2], v0[3]); w.z = cvt_pk_bf16(v1[0], v1[1]); w.w = cvt_pk_bf16(v1[2], v1[3]);
                    *(u32x4*)(rowp + bj * HALF) = w; } }
    }
};
struct EpiResF32 {
    static constexpr bool PERM = false, AFTER_DRAIN = false;
    const float* res; float* out; int ldc; float alpha;
    __device__ __forceinline__ void operator()(const f32x4 (&acc)[2][2][4][2], const Unit& u, int wr, int wc, int fr, int fq) const {
        const int row0 = u.pm * BM + wr * 64 + fr, col0 = u.pn * BM + wc * 32 + 4 * fq;
#pragma unroll
        for (int ai = 0; ai < 2; ++ai)
#pragma unroll
            for (int m = 0; m < 4; ++m) { const size_t off = (size_t)(row0 + ai * HALF + m * 16) * ldc + col0;
#pragma unroll
                for (int bj = 0; bj < 2; ++bj)
#pragma unroll
                    for (int n = 0; n < 2; ++n) { const f32x4 rs = *(const f32x4*)(res + off + bj * HALF + n * 16); *(f32x4*)(out + off + bj * HALF + n * 16) = rs * alpha + acc[ai][bj][m][n]; }
                if (m & 1) asm volatile("" ::: "memory"); }
    }
};
template <class Epi, class Sched, bool ALIGN_EPI = false, bool SP2 = false>
__device__ __forceinline__ void gemm_phase(PG8_LAS unsigned char* lds, const Gemm g, const Sched& S, const Epi& E, int tid_in) {
    int tid_ = tid_in; asm volatile("" : "+v"(tid_));
    const int tid = tid_, wid = __builtin_amdgcn_readfirstlane(tid >> 6), lane = tid & 63, wr = wid >> 2, wc = wid & 3, fr = lane & 15, fq = lane >> 4;
    const int K = g.K, nt = K / BK;
    unsigned voffA[2], voffB[2];
#pragma unroll
    for (int i = 0; i < 2; ++i) { int R, C; stage_rc(tid * 16 + i * 8192, R, C); const int Rb = Epi::PERM ? ((R & ~31) + perm32(R & 31)) : R;
        voffA[i] = (unsigned)(R * K + C) * 2u; voffB[i] = (unsigned)(Rb * K + C) * 2u; }
    const size_t kstep = (size_t)(BK * 2);
    const size_t hstep = (size_t)HALF * K * 2;
    const size_t tstep = 2 * hstep;
    const unsigned ldsw = (unsigned)wid * 1024u;
    const int aoff = lds_byte(wr * 64 + fr, fq * 8), boff = lds_byte(wc * 32 + fr, fq * 8);
#define PG8_SA(b, h) (((b) * 2 + (h)) * HTB)
#define PG8_SB(b, h) ((4 + (b) * 2 + (h)) * HTB)
#define PG8_STAGE(bufoff, gbase, voff) do { _Pragma("unroll") for (int _i = 0; _i < 2; ++_i) \
        __builtin_amdgcn_global_load_lds((const unsigned*)((const char*)(gbase) + (voff)[_i]), (PG8_LAS unsigned*)(lds + (bufoff) + ldsw + _i * 8192), 16, 0, 0); } while (0)
#define PG8_LDA(dst, b, h) do { _Pragma("unroll") for (int m = 0; m < 4; ++m) _Pragma("unroll") for (int k = 0; k < 2; ++k) dst[m][k] = *(const PG8_LAS bf16x8*)(lds + PG8_SA(b, h) + aoff + m * 2048 + k * 1024); } while (0)
#define PG8_LDB(dst, b, h) do { _Pragma("unroll") for (int n = 0; n < 2; ++n) _Pragma("unroll") for (int k = 0; k < 2; ++k) dst[n][k] = *(const PG8_LAS bf16x8*)(lds + PG8_SB(b, h) + boff + n * 2048 + k * 1024); } while (0)
#define PG8_MMA(ai, bj, At, Bt) do { __builtin_amdgcn_s_setprio(1); _Pragma("unroll") for (int m = 0; m < 4; ++m) _Pragma("unroll") for (int n = 0; n < 2; ++n) _Pragma("unroll") for (int k = 0; k < 2; ++k) \
        acc[ai][bj][m][n] = __builtin_amdgcn_mfma_f32_16x16x32_bf16(Bt[n][k], At[m][k], acc[ai][bj][m][n], 0, 0, 0); __builtin_amdgcn_s_setprio(0); } while (0)
#define PG8_WAIT_V(n) asm volatile("s_waitcnt vmcnt(" #n ")" ::: "memory")
#define PG8_WAIT_L(n) asm volatile("s_waitcnt lgkmcnt(" #n ")" ::: "memory")
#define PG8_BAR __builtin_amdgcn_s_barrier()
#define PG8_SCHED __builtin_amdgcn_sched_barrier(0)
    Unit cur, nxt; int ui = 0;
    if (!S.next(0, cur)) return;
    f32x4 acc[2][2][4][2];
#pragma unroll
    for (int a = 0; a < 2; ++a)
#pragma unroll
        for (int b = 0; b < 2; ++b)
#pragma unroll
            for (int m = 0; m < 4; ++m)
#pragma unroll
                for (int n = 0; n < 2; ++n) acc[a][b][m][n] = (f32x4){0.f, 0.f, 0.f, 0.f};
    bf16x8 At[4][2], B0[2][2], B1[2][2];
    const char* cA = (const char*)g.A + (size_t)cur.pm * tstep; const char* cB = (const char*)g.Bt + (size_t)cur.pn * tstep;
    S.a_ready(cur);
    if constexpr (SP2) {
        PG8_STAGE(PG8_SB(0, 0), cB, voffB); PG8_STAGE(PG8_SB(0, 1), cB + hstep, voffB); PG8_STAGE(PG8_SA(0, 0), cA, voffA); PG8_STAGE(PG8_SA(0, 1), cA + hstep, voffA);
        if (wr == 1) PG8_BAR;
        PG8_WAIT_V(2); PG8_BAR;
        PG8_STAGE(PG8_SB(1, 0), cB + kstep, voffB); PG8_STAGE(PG8_SA(1, 0), cA + kstep, voffA); PG8_STAGE(PG8_SB(1, 1), cB + hstep + kstep, voffB);
        PG8_WAIT_V(6); PG8_BAR;
    } else {
        PG8_STAGE(PG8_SB(0, 0), cB, voffB); PG8_STAGE(PG8_SA(0, 0), cA, voffA); PG8_STAGE(PG8_SB(0, 1), cB + hstep, voffB); PG8_STAGE(PG8_SA(0, 1), cA + hstep, voffA);
        if (wr == 1) PG8_BAR;
        PG8_WAIT_V(4); PG8_BAR;
        PG8_STAGE(PG8_SB(1, 0), cB + kstep, voffB); PG8_STAGE(PG8_SA(1, 0), cA + kstep, voffA); PG8_STAGE(PG8_SB(1, 1), cB + hstep + kstep, voffB);
        PG8_WAIT_V(6); PG8_BAR;
    }
    for (;;) {
        const bool has_next = S.next(ui + 1, nxt);
        const char* nA = has_next ? (const char*)g.A + (size_t)nxt.pm * tstep : cA; const char* nB = has_next ? (const char*)g.Bt + (size_t)nxt.pn * tstep : cB;
        for (int t = 0; t < nt; t += 2) {
            const bool last = (t == nt - 2);
            const char* a1 = cA + (size_t)(t + 1) * kstep;
            const char* a2 = last ? nA : cA + (size_t)(t + 2) * kstep; const char* b2 = last ? nB : cB + (size_t)(t + 2) * kstep;
            const char* a3 = a2 + kstep; const char* b3 = b2 + kstep;
            if (last && has_next) S.a_ready(nxt);
            if constexpr (SP2) {
            PG8_LDB(B0, 0, 0); PG8_LDB(B1, 0, 1); PG8_SCHED; PG8_LDA(At, 0, 0); PG8_STAGE(PG8_SA(1, 1), a1 + hstep, voffA);
            PG8_WAIT_V(8); PG8_WAIT_L(0); PG8_BAR; PG8_MMA(0, 0, At, B0); PG8_MMA(0, 1, At, B1); PG8_BAR; PG8_SCHED;
            PG8_LDA(At, 0, 1); PG8_STAGE(PG8_SB(0, 0), b2, voffB); PG8_STAGE(PG8_SB(0, 1), b2 + hstep, voffB); PG8_STAGE(PG8_SA(0, 0), a2, voffA);
            PG8_WAIT_V(8); PG8_WAIT_L(0); PG8_BAR; PG8_MMA(1, 0, At, B0); PG8_MMA(1, 1, At, B1); PG8_BAR; PG8_SCHED;
            PG8_LDB(B0, 1, 0); PG8_LDB(B1, 1, 1); PG8_SCHED; PG8_LDA(At, 1, 0); PG8_STAGE(PG8_SA(0, 1), a2 + hstep, voffA);
            PG8_WAIT_V(8); PG8_WAIT_L(0); PG8_BAR; PG8_MMA(0, 0, At, B0); PG8_MMA(0, 1, At, B1); PG8_BAR; PG8_SCHED;
            PG8_LDA(At, 1, 1); PG8_STAGE(PG8_SB(1, 0), b3, voffB); PG8_STAGE(PG8_SB(1, 1), b3 + hstep, voffB); PG8_STAGE(PG8_SA(1, 0), a3, voffA);
            PG8_WAIT_V(8); PG8_WAIT_L(0); PG8_BAR; PG8_MMA(1, 0, At, B0); PG8_MMA(1, 1, At, B1); PG8_BAR; PG8_SCHED;
            } else {
            PG8_LDB(B0, 0, 0); PG8_SCHED; PG8_LDA(At, 0, 0); PG8_STAGE(PG8_SA(1, 1), a1 + hstep, voffA);
            PG8_WAIT_L(8); PG8_BAR; PG8_WAIT_L(0); PG8_MMA(0, 0, At, B0); PG8_BAR; PG8_SCHED;
            PG8_LDB(B1, 0, 1); PG8_STAGE(PG8_SB(0, 0), b2, voffB);
            PG8_BAR; PG8_WAIT_L(0); PG8_MMA(0, 1, At, B1); PG8_BAR;
            PG8_LDA(At, 0, 1); PG8_STAGE(PG8_SA(0, 0), a2, voffA);
            PG8_BAR; PG8_WAIT_L(0); PG8_MMA(1, 0, At, B0); PG8_BAR; PG8_SCHED;
            PG8_STAGE(PG8_SB(0, 1), b2 + hstep, voffB);
            PG8_WAIT_V(6); PG8_BAR; PG8_MMA(1, 1, At, B1); PG8_BAR;
            PG8_LDB(B0, 1, 0); PG8_SCHED; PG8_LDA(At, 1, 0); PG8_STAGE(PG8_SA(0, 1), a2 + hstep, voffA);
            PG8_WAIT_L(8); PG8_BAR; PG8_WAIT_L(0); PG8_MMA(0, 0, At, B0); PG8_BAR; PG8_SCHED;
            PG8_LDB(B1, 1, 1); PG8_STAGE(PG8_SB(1, 0), b3, voffB);
            PG8_BAR; PG8_WAIT_L(0); PG8_MMA(0, 1, At, B1); PG8_BAR;
            PG8_LDA(At, 1, 1); PG8_STAGE(PG8_SA(1, 0), a3, voffA);
            PG8_BAR; PG8_WAIT_L(0); PG8_MMA(1, 0, At, B0); PG8_BAR; PG8_SCHED;
            PG8_STAGE(PG8_SB(1, 1), b3 + hstep, voffB);
            PG8_WAIT_V(6); PG8_BAR; PG8_MMA(1, 1, At, B1); PG8_BAR;
            }
        }
        if constexpr (ALIGN_EPI) { if (wr == 0) PG8_BAR; }
        if constexpr (!Epi::AFTER_DRAIN) { E(acc, cur, wr, wc, fr, fq); S.done(cur); }
        if (!has_next) break;
#pragma unroll
        for (int a = 0; a < 2; ++a)
#pragma unroll
            for (int b = 0; b < 2; ++b)
#pragma unroll
                for (int m = 0; m < 4; ++m)
#pragma unroll
                    for (int n = 0; n < 2; ++n) acc[a][b][m][n] = (f32x4){0.f, 0.f, 0.f, 0.f};
        cur = nxt; cA = nA; cB = nB; ++ui;
        if constexpr (ALIGN_EPI) { if (wr == 1) PG8_BAR; }
    }
    PG8_WAIT_V(0);
    if constexpr (!ALIGN_EPI) { if (wr == 0) PG8_BAR; }
    PG8_BAR;
    if constexpr (Epi::AFTER_DRAIN) { E.fused(acc, cur, wr, wc, fr, fq, lds, wid, lane); S.done(cur); }
#undef PG8_SA
#undef PG8_SB
#undef PG8_STAGE
#undef PG8_LDA
#undef PG8_LDB
#undef PG8_MMA
#undef PG8_WAIT_V
#undef PG8_WAIT_L
#undef PG8_BAR
#undef PG8_SCHED
}
}

#ifndef PG8_SP2
#define PG8_SP2 true
#endif
#ifndef PG8_ALIGN
#define PG8_ALIGN true
#endif
#define GAS __attribute__((address_space(1)))
#define LAS __attribute__((address_space(3)))
typedef unsigned short bf16;
typedef unsigned v4u __attribute__((ext_vector_type(4)));
typedef float f32x4 __attribute__((ext_vector_type(4)));
typedef short bf16x8 __attribute__((ext_vector_type(8)));
typedef GAS unsigned gu32;
typedef GAS unsigned long long gu64;
#define RLX_AGENT __ATOMIC_RELAXED, __HIP_MEMORY_SCOPE_AGENT
#define LDS_WAIT() asm volatile("s_waitcnt lgkmcnt(0)" ::: "memory")
#define VM_WAIT() asm volatile("s_waitcnt vmcnt(0)" ::: "memory")
__device__ __forceinline__ unsigned long long rt() { return __builtin_amdgcn_s_memrealtime(); }
__device__ __forceinline__ unsigned f2bf(float f) { unsigned u = __builtin_bit_cast(unsigned, f); return (u + 0x7fffu + ((u >> 16) & 1u)) >> 16; }
typedef float pk2_f32x2_t __attribute__((ext_vector_type(2))); typedef __bf16 pk2_bf16x2_t __attribute__((ext_vector_type(2)));
__device__ __forceinline__ unsigned pk2(float lo, float hi) { const pk2_f32x2_t v = {lo, hi}; return __builtin_bit_cast(unsigned, __builtin_convertvector(v, pk2_bf16x2_t)); }

#define XB_TMO      128
#define XB_XCNT(j)  (256  + 64 * (j))
#define XB_XSUB(j)  (1280 + 64 * (j))
#define XB_XGEN(j)  (2304 + 64 * (j))
#define XB_TOP      3328
#define XB_TOPGEN   3392
#define XCD_BAR_WORDS 3456
#define XB_SPIN_CAP (1u << 18)

__device__ __forceinline__ unsigned xb_ld(unsigned* p)              { return __hip_atomic_load(p, __ATOMIC_RELAXED, __HIP_MEMORY_SCOPE_AGENT); }
__device__ __forceinline__ unsigned xb_add(unsigned* p, unsigned v) { return __hip_atomic_fetch_add(p, v, __ATOMIC_RELAXED, __HIP_MEMORY_SCOPE_AGENT); }
__device__ __forceinline__ unsigned xb_xcc_id() { return (unsigned)__builtin_amdgcn_s_getreg((3 << 11) | 20) & 0xFu; }
#define XB_SPIN(cond, bar) do { unsigned _sp = 0; while (cond) { __builtin_amdgcn_s_sleep(1); \
    if ((++_sp & 255u) == 0u) { if (xb_ld(&(bar)[XB_TMO])) break; if (_sp > XB_SPIN_CAP) { atomicAdd(&(bar)[XB_TMO], 1u); break; } } } } while (0)

struct XcdBarrier {
    unsigned* bar; unsigned x;
    volatile LAS unsigned* st;
};

__device__ __forceinline__ XcdBarrier xcd_barrier_post(unsigned* bar, volatile LAS unsigned* st) {
    XcdBarrier b; b.bar = bar; b.x = xb_xcc_id(); b.st = st;
    if (threadIdx.x == 0) (void)xb_add(&bar[XB_XCNT(b.x)], 1u);
    return b;
}
__device__ __forceinline__ void xcd_barrier_complete(unsigned* bar, unsigned x, unsigned& nloc, unsigned& nx) {
    const unsigned G = gridDim.x * gridDim.y * gridDim.z;
    unsigned sum, cnt, mine, sp = 0u;
    for (;;) {
        sum = 0u; cnt = 0u; mine = 0u;
#pragma unroll
        for (unsigned j = 0; j < 16; ++j) { const unsigned c = xb_ld(&bar[XB_XCNT(j)]); sum += c; cnt += (c > 0u) ? 1u : 0u; mine = (j == x) ? c : mine; }
        if (sum == G) break;
        __builtin_amdgcn_s_sleep(1);
        if ((++sp & 255u) == 0u) { if (xb_ld(&bar[XB_TMO])) break; if (sp > XB_SPIN_CAP) { atomicAdd(&bar[XB_TMO], 1u); break; } }
    }
    nloc = mine > 0u ? mine : 1u; nx = cnt > 0u ? cnt : 1u;
}

__device__ __forceinline__ void xcd_barrier(const XcdBarrier& b) {
    asm volatile("s_waitcnt vmcnt(0)" ::: "memory");
    __syncthreads();
    if (threadIdx.x == 0) {
        unsigned* bar = b.bar;
        __builtin_amdgcn_s_waitcnt(0);
        unsigned nloc = b.st[0], nx = b.st[1];
        if (nloc == 0u) { xcd_barrier_complete(bar, b.x, nloc, nx); b.st[0] = nloc; b.st[1] = nx; }
        const unsigned old = xb_add(&bar[XB_XSUB(b.x)], 1u);
        const unsigned gen = old / nloc;
        if (old + 1u == (gen + 1u) * nloc) {
            __builtin_amdgcn_fence(__ATOMIC_RELEASE, "agent");
            asm volatile("s_waitcnt vmcnt(0)" ::: "memory");
            const unsigned og = xb_add(&bar[XB_TOP], 1u);
            const unsigned tg = og / nx;
            if (og + 1u == (tg + 1u) * nx) xb_add(&bar[XB_TOPGEN], 1u);
            else XB_SPIN(xb_ld(&bar[XB_TOPGEN]) == tg, bar);
            __builtin_amdgcn_fence(__ATOMIC_ACQUIRE, "agent");
            xb_add(&bar[XB_XGEN(b.x)], 1u);
            asm volatile("s_waitcnt vmcnt(0)" ::: "memory");
        } else {
            XB_SPIN(xb_ld(&bar[XB_XGEN(b.x)]) == gen, bar);
            __builtin_amdgcn_fence(__ATOMIC_ACQUIRE, "agent");
            asm volatile("s_waitcnt vmcnt(0)" ::: "memory");
        }
    }
    __syncthreads();
}

constexpr int NWAVES = 8, NTHREADS = 512;
constexpr int DM = 1024, NB = 4, SEQ = 4096, DEPTH = 2, NTOK = NB * SEQ, NEXP = 16384;
constexpr int DIN = 1952, DINP = 2048;
constexpr float ALPHA = 1.4142135623730951f;
constexpr float LN_EPS = 1e-5f, RMS_EPS = 1e-6f;
constexpr float QSCALE = 0.10206207261596575f * 1.4426950408889634f;
constexpr int NPL = 10;
constexpr int NPHASE = 1 + NPL * DEPTH;
constexpr size_t MiB = 1u << 20;
constexpr size_t WS_CTL = 0, CTL_ZERO_BYTES = 64 * 1024;
constexpr size_t WS_WIT = 2 * MiB;
constexpr size_t WS_WQT = 10 * MiB;
constexpr size_t WS_WOT = 18 * MiB;
constexpr size_t WS_WUQT = 22 * MiB;
constexpr size_t WS_WUKVT = 23 * MiB;
constexpr size_t WS_KEYS = 24 * MiB;
constexpr size_t WS_ROPE = 25 * MiB;
constexpr size_t WS_SUV = 26 * MiB;
constexpr size_t WS_UT = 32 * MiB;
constexpr size_t WS_VT = 96 * MiB;
constexpr size_t WS_XB = 160 * MiB;
constexpr size_t WS_HB = 192 * MiB;
constexpr size_t WS_QM = 256 * MiB;
constexpr size_t WS_KM = 280 * MiB;
constexpr size_t WS_VMT = 304 * MiB;
constexpr size_t WS_VST = 320 * MiB;
constexpr size_t WS_OB = 336 * MiB;
constexpr size_t WS_EL = 368 * MiB;
constexpr size_t WS_GL = 376 * MiB;
constexpr size_t WS_XQ = WS_KM;
constexpr size_t WS_SX = WS_VST;
constexpr size_t WS_AC = WS_QM;
constexpr size_t WS_KSF = 384 * MiB;
constexpr size_t WS_END = 400 * MiB;
constexpr int CW_BAR = 1024;
static_assert((CW_BAR + XCD_BAR_WORDS) * 4 <= (int)CTL_ZERO_BYTES, "barrier words inside the memset region");
constexpr int RING_OFF = 0, RING_BYTES = 131072;
constexpr int LDSCTL_OFF = RING_BYTES, MISC_OFF = LDSCTL_OFF + 320;
constexpr int LDS_BYTES = 147456;
static_assert(MISC_OFF + 128 <= LDS_BYTES, "LDS map");

typedef float f32x16 __attribute__((ext_vector_type(16)));
typedef float f32x2 __attribute__((ext_vector_type(2)));
typedef unsigned v2u __attribute__((ext_vector_type(2)));
typedef __bf16 bf2_t __attribute__((ext_vector_type(2)));

struct Args { const float* in[15]; float* out; unsigned char* ws; int ph_lo, ph_hi; };
typedef const __attribute__((address_space(4))) Args* kap_t;
__device__ __forceinline__ kap_t ka_fresh() { kap_t p = (kap_t)__builtin_amdgcn_kernarg_segment_ptr(); asm volatile("" : "+s"(p)); return p; }
enum { I_X = 0, I_WIN, I_GCQ, I_WUQ, I_GCKV, I_WUKV, I_WO, I_LN1G, I_LN1B, I_WQ, I_KEYS, I_U, I_V, I_LN2G, I_LN2B };
struct Frame {
    LAS unsigned char* lds;
    volatile LAS unsigned* MISC;
    int tid, lane, wave, vcu, G;
};
template <class T> __device__ __forceinline__ T* wsp(kap_t ka, size_t off) { return (T*)(ka->ws + off); }

__device__ __forceinline__ float bflo(unsigned w) { return __uint_as_float(w << 16); }
__device__ __forceinline__ float bfhi(unsigned w) { return __uint_as_float(w & 0xffff0000u); }
__device__ __forceinline__ float bf1(short s) { return __uint_as_float(((unsigned)(unsigned short)s) << 16); }
__device__ __forceinline__ int crow(int r, int hi) { return (r & 3) + 8 * (r >> 2) + 4 * hi; }
__device__ __forceinline__ int kperm(int s) { return (s & ~15) | (((s >> 2) & 1) << 3) | (((s >> 3) & 1) << 2) | (s & 3); }
template <int CTRL> __device__ __forceinline__ float dpp_f(float v) { return __builtin_bit_cast(float, __builtin_amdgcn_update_dpp(0, __builtin_bit_cast(int, v), CTRL, 0xF, 0xF, true)); }
__device__ __forceinline__ int lxor_i(int v, int mask, int lane) { return __builtin_amdgcn_ds_bpermute((lane ^ mask) << 2, v); }
__device__ __forceinline__ float lxor_f(float v, int mask, int lane) { return __builtin_bit_cast(float, __builtin_amdgcn_ds_bpermute((lane ^ mask) << 2, __builtin_bit_cast(int, v))); }
__device__ __forceinline__ float wave_sum_all(float v, int lane) {
    v += dpp_f<0xB1>(v);
    v += dpp_f<0x4E>(v);
    v += dpp_f<0x141>(v);
    v += dpp_f<0x140>(v);
    v += lxor_f(v, 16, lane);
    v += lxor_f(v, 32, lane);
    return v;
}
__device__ __forceinline__ int wave_sum_all_i(int v, int lane) {
    v += __builtin_amdgcn_update_dpp(0, v, 0xB1, 0xF, 0xF, true); v += __builtin_amdgcn_update_dpp(0, v, 0x4E, 0xF, 0xF, true);
    v += __builtin_amdgcn_update_dpp(0, v, 0x141, 0xF, 0xF, true); v += __builtin_amdgcn_update_dpp(0, v, 0x140, 0xF, 0xF, true);
    v += lxor_i(v, 16, lane); v += lxor_i(v, 32, lane);
    return v;
}
__device__ __forceinline__ float wave_max_all(float v, int lane) {
    v = fmaxf(v, dpp_f<0xB1>(v)); v = fmaxf(v, dpp_f<0x4E>(v)); v = fmaxf(v, dpp_f<0x141>(v)); v = fmaxf(v, dpp_f<0x140>(v));
    v = fmaxf(v, lxor_f(v, 16, lane)); v = fmaxf(v, lxor_f(v, 32, lane));
    return v;
}
__device__ __forceinline__ bf16x8 pack8(float a0, float a1, float a2, float a3, float a4, float a5, float a6, float a7) {
    v4u w; w.x = pk2(a0, a1); w.y = pk2(a2, a3); w.z = pk2(a4, a5); w.w = pk2(a6, a7); return __builtin_bit_cast(bf16x8, w);
}

template <bool FRAG> __device__ __forceinline__ void p0_transpose_item(const float* W, int K, int N, bf16* WT, const float* gs, LAS float* scr, int item, int lane) {
    const int nblk = N / 32, kb = item / nblk, nb = item % nblk, k0 = 64 * kb, n0 = 32 * nb;
#pragma unroll 8
    for (int i = 0; i < 32; ++i) { const int kk = 2 * i + (lane >> 5); float w = W[(size_t)(k0 + kk) * N + n0 + (lane & 31)]; if (gs) w *= gs[k0 + kk]; scr[kk * 33 + (lane & 31)] = w; }
    LDS_WAIT(); asm volatile("" ::: "memory");
    const int c = lane & 7;
#pragma unroll
    for (int j = 0; j < 4; ++j) { const int n = (lane >> 3) + 8 * j; const LAS float* s = scr + (8 * c) * 33 + n;
        v4u o; o.x = pk2(s[0 * 33], s[1 * 33]); o.y = pk2(s[2 * 33], s[3 * 33]); o.z = pk2(s[4 * 33], s[5 * 33]); o.w = pk2(s[6 * 33], s[7 * 33]);
        if (FRAG) { const int nn = n0 + n, kk = k0 + 8 * c; *(GAS v4u*)(WT + ((size_t)((nn >> 5) * (K >> 4) + (kk >> 4)) * 64 + ((kk >> 3) & 1) * 32 + (nn & 31)) * 8) = o; }
        else *(GAS v4u*)(WT + (size_t)(n0 + n) * K + k0 + 8 * c) = o; }
    LDS_WAIT(); asm volatile("" ::: "memory");
}
__device__ __forceinline__ void cvt8_range(Frame& F, const float* src, bf16* dst, size_t n8) {
    const size_t gt = (size_t)blockIdx.x * NTHREADS + F.tid, nt = (size_t)F.G * NTHREADS;
    for (size_t i = gt; i < n8; i += nt) { const f32x4 a = *(const f32x4*)(src + i * 8), b = *(const f32x4*)(src + i * 8 + 4);
        v4u o; o.x = pk2(a.x, a.y); o.y = pk2(a.z, a.w); o.z = pk2(b.x, b.y); o.w = pk2(b.z, b.w); *(v4u*)(dst + i * 8) = o; }
}
__device__ __forceinline__ void p0_prologue(Frame& F, kap_t ka) {
    LAS float* scr = (LAS float*)(F.lds + RING_OFF + F.wave * 16384);
    const int gw = F.vcu * NWAVES + F.wave, NGW = F.G * NWAVES;
    constexpr int I_IN = 16 * 61, I_Q = 16 * 64, I_O = 16 * 32, I_UQ = 4 * 24, I_UKV = 2 * 32, I_L = I_IN + I_Q + I_O + I_UQ + I_UKV;
    for (int it = gw; it < DEPTH * I_L; it += NGW) {
        const int l = it / I_L; int r = it % I_L;
        if (r < I_IN) { p0_transpose_item<false>(ka->in[I_WIN] + (size_t)l * DM * DIN, DM, DIN, wsp<bf16>(ka, WS_WIT) + (size_t)l * DINP * DM, nullptr, scr, r, F.lane); continue; } r -= I_IN;
        if (r < I_Q) { p0_transpose_item<false>(ka->in[I_WQ] + (size_t)l * DM * 2048, DM, 2048, wsp<bf16>(ka, WS_WQT) + (size_t)l * 2048 * DM, nullptr, scr, r, F.lane); continue; } r -= I_Q;
        if (r < I_O) { p0_transpose_item<false>(ka->in[I_WO] + (size_t)l * DM * DM, DM, DM, wsp<bf16>(ka, WS_WOT) + (size_t)l * DM * DM, nullptr, scr, r, F.lane); continue; } r -= I_O;
        if (r < I_UQ) { p0_transpose_item<true>(ka->in[I_WUQ] + (size_t)l * 256 * 768, 256, 768, wsp<bf16>(ka, WS_WUQT) + (size_t)l * 768 * 256, ka->in[I_GCQ] + l * 256, scr, r, F.lane); continue; } r -= I_UQ;
        p0_transpose_item<true>(ka->in[I_WUKV] + (size_t)l * 128 * 1024, 128, 1024, wsp<bf16>(ka, WS_WUKVT) + (size_t)l * 1024 * 128, ka->in[I_GCKV] + l * 128, scr, r, F.lane);
    }
    const size_t gt = (size_t)blockIdx.x * NTHREADS + F.tid, nt = (size_t)F.G * NTHREADS;
    for (size_t i = gt; i < 2 * 12288; i += nt) { const size_t l = i / 12288, j = i % 12288; *(v4u*)(wsp<bf16>(ka, WS_WIT) + l * DINP * DM + (size_t)DIN * DM + j * 8) = (v4u){0u, 0u, 0u, 0u}; }
    for (size_t i = gt; i < (size_t)SEQ * 16; i += nt) { const int pos = (int)(i >> 4), k = (int)(i & 15);
        const float inv_freq = (float)pow(10000.0, -(double)k / 16.0); const float ang = (float)pos * inv_freq;
        wsp<f32x2>(ka, WS_ROPE)[i] = (f32x2){(float)cos((double)ang), (float)sin((double)ang)}; }
    for (size_t i = gt; i < (size_t)DEPTH * 8 * 2 * 128 * 16; i += nt) {
        const size_t lhc = i >> 11; const int n = (int)(i >> 4) & 127, dg = (int)i & 15;
        const float* src = ka->in[I_KEYS] + i * 8; const f32x4 a = *(const f32x4*)src, b = *(const f32x4*)(src + 4);
        v4u o; o.x = pk2(a.x, a.y); o.y = pk2(a.z, a.w); o.z = pk2(b.x, b.y); o.w = pk2(b.z, b.w);
        *(v4u*)(wsp<bf16>(ka, WS_KEYS) + (lhc * 2048 + (size_t)(((n >> 5) * 8 + (dg >> 1)) * 64 + (dg & 1) * 32 + (n & 31))) * 8) = o;
    }
    cvt8_range(F, ka->in[I_X], wsp<bf16>(ka, WS_XB), (size_t)NTOK * DM / 8);
    {
#ifdef MK_DBG_L0
        constexpr int NL = 1;
#else
        constexpr int NL = DEPTH;
#endif
        unsigned char* UQ = wsp<unsigned char>(ka, WS_UT); unsigned char* VQ = wsp<unsigned char>(ka, WS_VT); float* SUV = wsp<float>(ka, WS_SUV);
        for (int row = gw; row < 2 * NL * NEXP; row += NGW) {
            const int tbl = row / (NL * NEXP), r = row % (NL * NEXP);
            const float* src = (tbl ? ka->in[I_V] : ka->in[I_U]) + (size_t)r * DM + 16 * F.lane;
            f32x4 v[4]; float m = 0.f;
#pragma unroll
            for (int j = 0; j < 4; ++j) { v[j] = *(const f32x4*)(src + 4 * j); m = fmaxf(m, fmaxf(fmaxf(fabsf(v[j].x), fabsf(v[j].y)), fmaxf(fabsf(v[j].z), fabsf(v[j].w)))); }
            m = wave_max_all(m, F.lane);
            const float inv = m > 0.f ? 127.f / m : 0.f;
            const int off = 0;
            v4u o;
#pragma unroll
            for (int j = 0; j < 4; ++j) {
                const unsigned b0 = (unsigned)((int)rintf(v[j].x * inv) + off) & 0xffu, b1 = (unsigned)((int)rintf(v[j].y * inv) + off) & 0xffu, b2 = (unsigned)((int)rintf(v[j].z * inv) + off) & 0xffu, b3 = (unsigned)((int)rintf(v[j].w * inv) + off) & 0xffu;
                o[j] = b0 | (b1 << 8) | (b2 << 16) | (b3 << 24);
            }
            if (tbl) *(v4u*)(VQ + (size_t)(r / NEXP) * NEXP * DM + ((size_t)(F.lane >> 3) * NEXP + (size_t)(r % NEXP)) * 128 + 16 * (F.lane & 7)) = o;
            else *(v4u*)(UQ + (size_t)r * DM + 16 * F.lane) = o;
            if (F.lane == 0) SUV[2 * (size_t)r + tbl] = m * (1.f / 127.f);
        }
    }
}

__device__ __forceinline__ void p2_unit(Frame& F, kap_t ka, int l, int tb, int part) {
    const int lane = F.lane, r32 = lane & 31, hi = lane >> 5;
    const int tok = tb * 32 + r32, b = tok / SEQ, s = tok % SEQ;
    const bf16* hrow = wsp<bf16>(ka, WS_HB) + (size_t)tok * DINP;
    if (part < 2) {
        bf16x8 xf[16]; float ssq = 0.f;
#pragma unroll
        for (int ks = 0; ks < 16; ++ks) { xf[ks] = *(const bf16x8*)(hrow + 1536 + ks * 16 + 8 * hi);
#pragma unroll
            for (int e = 0; e < 8; ++e) { const float v = bf1(xf[ks][e]); ssq += v * v; } }
        ssq += lxor_f(ssq, 32, lane);
        const float rstd = rsqrtf(ssq * (1.f / 256.f) + RMS_EPS) * QSCALE;
        const bf16* W = wsp<bf16>(ka, WS_WUQT) + (size_t)l * 768 * 256;
        const bf16* wbase = W + 8 * lane;
        bf16x8 wA[16];
#define P2Q_LOADW(WF, j) do { _Pragma("unroll") for (int ks = 0; ks < 16; ++ks) WF[ks] = *(const bf16x8*)(wbase + (size_t)((j) * 16 + ks) * 512); } while (0)
#define P2Q_MMA(WF, ACC) do { ACC = (f32x16){}; _Pragma("unroll") for (int ks = 0; ks < 16; ++ks) ACC = __builtin_amdgcn_mfma_f32_32x32x16_bf16(WF[ks], xf[ks], ACC, 0, 0, 0); } while (0)
#define P2Q_EPI(ACC, j) do { const int head_ = (j) / 3, sub_ = (j) % 3; float v[16]; \
            _Pragma("unroll") for (int r = 0; r < 16; ++r) v[r] = ACC[r] * rstd; \
            if (sub_ == 2) { _Pragma("unroll") for (int r = 0; r < 8; ++r) { const f32x2 cs = wsp<f32x2>(ka, WS_ROPE)[s * 16 + crow(r, hi)]; const float x1 = v[r], x2 = v[r + 8]; v[r] = x1 * cs.x - x2 * cs.y; v[r + 8] = x2 * cs.x + x1 * cs.y; } } \
            bf16* dst = wsp<bf16>(ka, WS_QM) + ((size_t)(b * 8 + head_) * SEQ + s) * 96 + sub_ * 32 + 4 * hi; \
            _Pragma("unroll") for (int g = 0; g < 4; ++g) { v2u w; w.x = pk2(v[4 * g], v[4 * g + 1]); w.y = pk2(v[4 * g + 2], v[4 * g + 3]); *(v2u*)(dst + 8 * g) = w; } } while (0)
        P2Q_LOADW(wA, part * 12);
        for (int jj = 0; jj < 12; ++jj) {
            const int j = part * 12 + jj; f32x16 acc;
            P2Q_MMA(wA, acc);
            __builtin_amdgcn_sched_barrier(0);
            P2Q_LOADW(wA, jj + 1 < 12 ? j + 1 : j);
            __builtin_amdgcn_sched_barrier(0);
            P2Q_EPI(acc, j);
        }
#undef P2Q_LOADW
#undef P2Q_MMA
#undef P2Q_EPI
    } else {
        const int h0 = (part - 2) * 4;
        bf16x8 xf[8]; float ssq = 0.f;
#pragma unroll
        for (int ks = 0; ks < 8; ++ks) { xf[ks] = *(const bf16x8*)(hrow + 1792 + ks * 16 + 8 * hi);
#pragma unroll
            for (int e = 0; e < 8; ++e) { const float v = bf1(xf[ks][e]); ssq += v * v; } }
        ssq += lxor_f(ssq, 32, lane);
        const float rstd = rsqrtf(ssq * (1.f / 128.f) + RMS_EPS);
        const bf16* W = wsp<bf16>(ka, WS_WUKVT) + (size_t)l * 1024 * 128;
        const int sp = kperm(s);
        const bf16* wbase = W + 8 * lane;
        bf16x8 wA[8], wB[8];
#define P2K_LOADW(WF, j) do { _Pragma("unroll") for (int ks = 0; ks < 8; ++ks) WF[ks] = *(const bf16x8*)(wbase + (size_t)((j) * 8 + ks) * 512); } while (0)
#define P2K_MMA(WF, ACC) do { ACC = (f32x16){}; _Pragma("unroll") for (int ks = 0; ks < 8; ++ks) ACC = __builtin_amdgcn_mfma_f32_32x32x16_bf16(WF[ks], xf[ks], ACC, 0, 0, 0); } while (0)
        P2K_LOADW(wA, h0 * 4);
        for (int jj = 0; jj < 16; jj += 2) {
            f32x16 accA, accB;
            P2K_LOADW(wB, h0 * 4 + jj + 1);
            P2K_MMA(wA, accA);
            P2K_LOADW(wA, jj + 2 < 16 ? h0 * 4 + jj + 2 : h0 * 4 + jj + 1);
            P2K_MMA(wB, accB);
#pragma unroll
            for (int u2 = 0; u2 < 2; ++u2) {
                const int j = h0 * 4 + jj + u2; const int head = j >> 2, sub = j & 3; const f32x16 acc = u2 ? accB : accA;
            if (sub < 2) {
                bf16* dst = wsp<bf16>(ka, WS_KM) + (size_t)(b * 8 + head) * SEQ * 96 + (size_t)(s >> 5) * (6 * 512) + (size_t)r32 * 8 + 4 * hi;
#pragma unroll
                for (int g = 0; g < 4; ++g) { v2u w; w.x = pk2(acc[4 * g] * rstd, acc[4 * g + 1] * rstd); w.y = pk2(acc[4 * g + 2] * rstd, acc[4 * g + 3] * rstd); *(v2u*)(dst + (2 * sub + (g >> 1)) * 512 + (g & 1) * 256) = w; }
            } else {
                bf16* dst = wsp<bf16>(ka, WS_VMT) + (size_t)(b * 8 + head) * 64 * SEQ + (size_t)(s >> 5) * (4 * 512) + ((sub - 2) * 2 + ((s >> 4) & 1)) * 512 + ((sp >> 3) & 1) * 256 + (sp & 7);
#pragma unroll
                for (int r = 0; r < 16; ++r) dst[crow(r, hi) * 8] = (bf16)f2bf(acc[r] * rstd);
            }
            }
        }
#undef P2K_LOADW
#undef P2K_MMA
        { const bf16x8 a1 = *(const bf16x8*)(hrow + 1920 + 8 * hi), a2 = *(const bf16x8*)(hrow + 1936 + 8 * hi);
          float o1[8], o2[8];
#pragma unroll
          for (int e = 0; e < 8; ++e) { const f32x2 cs = wsp<f32x2>(ka, WS_ROPE)[s * 16 + 8 * hi + e]; const float x1 = bf1(a1[e]), x2 = bf1(a2[e]); o1[e] = x1 * cs.x - x2 * cs.y; o2[e] = x2 * cs.x + x1 * cs.y; }
          const bf16x8 p1 = pack8(o1[0], o1[1], o1[2], o1[3], o1[4], o1[5], o1[6], o1[7]), p2 = pack8(o2[0], o2[1], o2[2], o2[3], o2[4], o2[5], o2[6], o2[7]);
#pragma unroll
          for (int hh = 0; hh < 4; ++hh) { bf16* dst = wsp<bf16>(ka, WS_KM) + (size_t)(b * 8 + h0 + hh) * SEQ * 96 + (size_t)(s >> 5) * (6 * 512) + 4 * 512 + hi * 256 + (size_t)r32 * 8; *(bf16x8*)dst = p1; *(bf16x8*)(dst + 512) = p2; } }
#pragma unroll 1
        for (int hh = 0; hh < 4; ++hh) {
            const int head = h0 + hh;
#pragma unroll
            for (int c4 = 0; c4 < 4; ++c4) { const bf16x8 a = *(const bf16x8*)(hrow + 1024 + head * 64 + 32 * hi + c4 * 8);
                bf16* dst = wsp<bf16>(ka, WS_VST) + (size_t)(b * 8 + head) * 64 * SEQ + (size_t)(s >> 5) * (4 * 512) + (hi * 2 + ((s >> 4) & 1)) * 512 + ((sp >> 3) & 1) * 256 + c4 * 64 + (sp & 7);
#pragma unroll
                for (int e = 0; e < 8; ++e) dst[e * 8] = (bf16)a[e]; }
#pragma unroll
            for (int ks = 0; ks < 4; ++ks) *(bf16x8*)(wsp<bf16>(ka, WS_KSF) + (size_t)(b * 8 + head) * SEQ * 64 + (size_t)(s >> 5) * (4 * 512) + ks * 512 + (size_t)lane * 8) = *(const bf16x8*)(hrow + 512 + head * 64 + ks * 16 + 8 * hi);
        }
    }
}

__device__ __forceinline__ float xhalf_max(float v) { auto rr = __builtin_amdgcn_permlane32_swap(__float_as_uint(v), __float_as_uint(v), false, false); return fmaxf(__uint_as_float(rr[0]), __uint_as_float(rr[1])); }
__device__ __forceinline__ float xhalf_sum(float v) { auto rr = __builtin_amdgcn_permlane32_swap(__float_as_uint(v), __float_as_uint(v), false, false); return __uint_as_float(rr[0]) + __uint_as_float(rr[1]); }
constexpr float MLA_THR = 8.f;
__device__ __forceinline__ void mla_unit(Frame& F, kap_t ka, int bh, int qb) {
    const int lane = F.lane, r32 = lane & 31, hi = lane >> 5, q0 = qb * 32;
    const bf16* Qp = wsp<bf16>(ka, WS_QM) + ((size_t)bh * SEQ + q0 + r32) * 96 + 8 * hi;
    bf16x8 qf[6];
#pragma unroll
    for (int ks = 0; ks < 6; ++ks) qf[ks] = *(const bf16x8*)(Qp + ks * 16);
    f32x16 o0 = {}, o1 = {};
    float m = -1e30f, l = 0.f;
    const bf16* Kp = wsp<bf16>(ka, WS_KM) + (size_t)bh * SEQ * 96 + 8 * lane;
    const bf16* Vp = wsp<bf16>(ka, WS_VMT) + (size_t)bh * 64 * SEQ + 8 * lane;
#define MLA_LOADK(KF, kt) do { _Pragma("unroll") for (int ks = 0; ks < 6; ++ks) KF[ks] = *(const bf16x8*)(Kp + (size_t)((kt) * 6 + ks) * 512); } while (0)
#define MLA_LOADV(VF, kt) do { _Pragma("unroll") for (int i = 0; i < 4; ++i) VF[i] = *(const bf16x8*)(Vp + (size_t)((kt) * 4 + i) * 512); } while (0)
#define MLA_QK(S, KF) do { S = (f32x16){}; _Pragma("unroll") for (int ks = 0; ks < 6; ++ks) S = __builtin_amdgcn_mfma_f32_32x32x16_bf16(KF[ks], qf[ks], S, 0, 0, 0); } while (0)
#define MLA_SMPV(S, VF, kt) do { \
        if ((kt) == qb) { _Pragma("unroll") for (int r = 0; r < 16; ++r) if (crow(r, hi) > r32) S[r] = -1e30f; } \
        float mx = fmaxf(fmaxf(S[0], S[1]), fmaxf(S[2], S[3])); \
        _Pragma("unroll") for (int r = 4; r < 16; r += 4) mx = fmaxf(mx, fmaxf(fmaxf(S[r], S[r + 1]), fmaxf(S[r + 2], S[r + 3]))); \
        mx = xhalf_max(mx); \
        if (__any(mx - m > MLA_THR)) { const float mn = fmaxf(m, mx), alpha = __builtin_amdgcn_exp2f(m - mn); l *= alpha; m = mn; \
            _Pragma("unroll") for (int r = 0; r < 16; ++r) { o0[r] *= alpha; o1[r] *= alpha; } } \
        float p[16], rs0 = 0.f, rs1 = 0.f; \
        _Pragma("unroll") for (int r = 0; r < 16; r += 2) { p[r] = __builtin_amdgcn_exp2f(S[r] - m); p[r + 1] = __builtin_amdgcn_exp2f(S[r + 1] - m); rs0 += p[r]; rs1 += p[r + 1]; } \
        l += rs0 + rs1; \
        const bf16x8 pf0 = pack8(p[0], p[1], p[2], p[3], p[4], p[5], p[6], p[7]), pf1 = pack8(p[8], p[9], p[10], p[11], p[12], p[13], p[14], p[15]); \
        o0 = __builtin_amdgcn_mfma_f32_32x32x16_bf16(VF[0], pf0, o0, 0, 0, 0); \
        o1 = __builtin_amdgcn_mfma_f32_32x32x16_bf16(VF[2], pf0, o1, 0, 0, 0); \
        o0 = __builtin_amdgcn_mfma_f32_32x32x16_bf16(VF[1], pf1, o0, 0, 0, 0); \
        o1 = __builtin_amdgcn_mfma_f32_32x32x16_bf16(VF[3], pf1, o1, 0, 0, 0); } while (0)
    bf16x8 kA[6], kB[6], vA[4];
    f32x16 sA, sB;
    MLA_LOADK(kA, 0); MLA_LOADK(kB, 1);
    MLA_QK(sA, kA);
    for (int kt = 0; kt <= qb; kt += 2) {
        MLA_LOADK(kA, kt + 2); MLA_LOADV(vA, kt);
        MLA_QK(sB, kB);
        MLA_SMPV(sA, vA, kt);
        if (kt + 1 > qb) break;
        MLA_LOADK(kB, kt + 3); MLA_LOADV(vA, kt + 1);
        MLA_QK(sA, kA);
        MLA_SMPV(sB, vA, kt + 1);
    }
#undef MLA_LOADK
#undef MLA_LOADV
#undef MLA_QK
#undef MLA_SMPV
    l = xhalf_sum(l);
    const float rl = 1.f / l;
    const int b = bh >> 3, h = bh & 7;
    bf16* dst = wsp<bf16>(ka, WS_OB) + ((size_t)b * SEQ + q0 + r32) * DM + 512 + h * 64 + 4 * hi;
#pragma unroll
    for (int g = 0; g < 4; ++g) {
        v2u w; w.x = pk2(o0[4 * g] * rl, o0[4 * g + 1] * rl); w.y = pk2(o0[4 * g + 2] * rl, o0[4 * g + 3] * rl); *(v2u*)(dst + 8 * g) = w;
        v2u u; u.x = pk2(o1[4 * g] * rl, o1[4 * g + 1] * rl); u.y = pk2(o1[4 * g + 2] * rl, o1[4 * g + 3] * rl); *(v2u*)(dst + 32 + 8 * g) = u;
    }
}

__device__ __forceinline__ void mla_block(Frame& F, kap_t ka, int bh, int J) {
    const int tid = F.tid, lane = F.lane, r32 = lane & 31, hi = lane >> 5, wave = F.wave;
    const int qb = 8 * J + wave, q0 = qb * 32, T = 8 * J + 8;
    const bf16* Qp = wsp<bf16>(ka, WS_QM) + ((size_t)bh * SEQ + q0 + r32) * 96 + 8 * hi;
    bf16x8 qf[6];
#pragma unroll
    for (int ks = 0; ks < 6; ++ks) qf[ks] = *(const bf16x8*)(Qp + ks * 16);
    f32x16 o0 = {}, o1 = {};
    float m = -1e30f, l = 0.f;
    const unsigned char* Kt = (const unsigned char*)(wsp<bf16>(ka, WS_KM) + (size_t)bh * SEQ * 96);
    const unsigned char* Vt = (const unsigned char*)(wsp<bf16>(ka, WS_VMT) + (size_t)bh * 64 * SEQ);
    LAS unsigned char* ring = F.lds + RING_OFF;
    const bool c0k = tid < 384;
    const size_t off0 = c0k ? (size_t)tid * 16 : (size_t)(tid - 384) * 16, off1 = (size_t)(128 + tid) * 16;
#define MB_GLOAD(t) do { r0 = *(const v4u*)((c0k ? Kt + (size_t)(t) * 6144 : Vt + (size_t)(t) * 4096) + off0); if (tid < 128) r1 = *(const v4u*)(Vt + (size_t)(t) * 4096 + off1); } while (0)
#define MB_LWRITE(s) do { *(LAS v4u*)(ring + (s) * 10240 + tid * 16) = r0; if (tid < 128) *(LAS v4u*)(ring + (s) * 10240 + 8192 + tid * 16) = r1; } while (0)
    v4u r0 = {}, r1 = {};
    MB_GLOAD(0); MB_LWRITE(0);
    if (T > 1) MB_GLOAD(1);
    for (int t = 0; t < T; ++t) {
        __syncthreads();
        const bool active = t <= qb;
        bf16x8 kf[6], vf[4];
        if (active) { const LAS unsigned char* sl = ring + (t & 1) * 10240 + lane * 16;
#pragma unroll
            for (int ks = 0; ks < 6; ++ks) kf[ks] = *(const LAS bf16x8*)(sl + ks * 1024);
#pragma unroll
            for (int i = 0; i < 4; ++i) vf[i] = *(const LAS bf16x8*)(sl + 6144 + i * 1024); }
        if (t + 1 < T) MB_LWRITE((t + 1) & 1);
        if (t + 2 < T) MB_GLOAD(t + 2);
        if (active) {
            f32x16 sa = {};
#pragma unroll
            for (int ks = 0; ks < 6; ++ks) sa = __builtin_amdgcn_mfma_f32_32x32x16_bf16(kf[ks], qf[ks], sa, 0, 0, 0);
            if (t == qb) {
#pragma unroll
                for (int r = 0; r < 16; ++r) if (crow(r, hi) > r32) sa[r] = -1e30f;
            }
            float mx = fmaxf(fmaxf(sa[0], sa[1]), fmaxf(sa[2], sa[3]));
#pragma unroll
            for (int r = 4; r < 16; r += 4) mx = fmaxf(mx, fmaxf(fmaxf(sa[r], sa[r + 1]), fmaxf(sa[r + 2], sa[r + 3])));
            mx = xhalf_max(mx);
            if (__any(mx - m > MLA_THR)) { const float mn = fmaxf(m, mx), alpha = __builtin_amdgcn_exp2f(m - mn); l *= alpha; m = mn;
#pragma unroll
                for (int r = 0; r < 16; ++r) { o0[r] *= alpha; o1[r] *= alpha; } }
            float p[16], rs = 0.f;
#pragma unroll
            for (int r = 0; r < 16; ++r) { p[r] = __builtin_amdgcn_exp2f(sa[r] - m); rs += p[r]; }
            l += rs;
            const bf16x8 pf0 = pack8(p[0], p[1], p[2], p[3], p[4], p[5], p[6], p[7]), pf1 = pack8(p[8], p[9], p[10], p[11], p[12], p[13], p[14], p[15]);
            o0 = __builtin_amdgcn_mfma_f32_32x32x16_bf16(vf[0], pf0, o0, 0, 0, 0);
            o0 = __builtin_amdgcn_mfma_f32_32x32x16_bf16(vf[1], pf1, o0, 0, 0, 0);
            o1 = __builtin_amdgcn_mfma_f32_32x32x16_bf16(vf[2], pf0, o1, 0, 0, 0);
            o1 = __builtin_amdgcn_mfma_f32_32x32x16_bf16(vf[3], pf1, o1, 0, 0, 0);
        }
    }
#undef MB_GLOAD
#undef MB_LWRITE
    __syncthreads();
    l = xhalf_sum(l);
    const float rl = 1.f / l;
    const int b = bh >> 3, h = bh & 7;
    bf16* dst = wsp<bf16>(ka, WS_OB) + ((size_t)b * SEQ + q0 + r32) * DM + 512 + h * 64 + 4 * hi;
#pragma unroll
    for (int g = 0; g < 4; ++g) {
        v2u w; w.x = pk2(o0[4 * g] * rl, o0[4 * g + 1] * rl); w.y = pk2(o0[4 * g + 2] * rl, o0[4 * g + 3] * rl); *(v2u*)(dst + 8 * g) = w;
        v2u u; u.x = pk2(o1[4 * g] * rl, o1[4 * g + 1] * rl); u.y = pk2(o1[4 * g + 2] * rl, o1[4 * g + 3] * rl); *(v2u*)(dst + 32 + 8 * g) = u;
    }
}

__device__ __forceinline__ void sb_unit(Frame& F, kap_t ka, int bh, int qb) {
    const int lane = F.lane, r32 = lane & 31, hi = lane >> 5, q0 = qb * 32;
    const int b = bh >> 3, h = bh & 7;
    const bf16* Hb = wsp<bf16>(ka, WS_HB) + (size_t)b * SEQ * DINP + h * 64 + 8 * hi;
    bf16x8 qf[4];
#pragma unroll
    for (int ks = 0; ks < 4; ++ks) qf[ks] = *(const bf16x8*)(Hb + (size_t)(q0 + r32) * DINP + ks * 16);
    f32x16 o0 = {}, o1 = {};
    float R = 0.f;
    const bf16* Kp = wsp<bf16>(ka, WS_KSF) + (size_t)bh * SEQ * 64 + 8 * lane;
    const bf16* Vp = wsp<bf16>(ka, WS_VST) + (size_t)bh * 64 * SEQ + 8 * lane;
    for (int k0 = q0; k0 >= 0; k0 -= 32) {
        bf16x8 kf[4], vf[4];
#pragma unroll
        for (int ks = 0; ks < 4; ++ks) kf[ks] = *(const bf16x8*)(Kp + (size_t)((k0 >> 5) * 4 + ks) * 512);
#pragma unroll
        for (int i = 0; i < 4; ++i) vf[i] = *(const bf16x8*)(Vp + (size_t)((k0 >> 5) * 4 + i) * 512);
        f32x16 za = {};
#pragma unroll
        for (int ks = 0; ks < 4; ++ks) za = __builtin_amdgcn_mfma_f32_32x32x16_bf16(kf[ks], qf[ks], za, 0, 0, 0);
        const bool diag = (k0 == q0);
        float L[16], lw[16];
#pragma unroll
        for (int r = 0; r < 16; ++r) {
            const float z = za[r] * 0.125f;
            const float sp = fmaxf(z, 0.f) + __logf(1.f + __expf(-fabsf(z)));
            const bool valid = !diag || (crow(r, hi) < r32);
            L[r] = valid ? -sp : 0.f;
            lw[r] = valid ? (z - sp) : -1e30f;
        }
        float e[16], T[4], U[4];
#pragma unroll
        for (int g = 0; g < 4; ++g) { e[4 * g + 3] = 0.f; e[4 * g + 2] = L[4 * g + 3]; e[4 * g + 1] = e[4 * g + 2] + L[4 * g + 2]; e[4 * g] = e[4 * g + 1] + L[4 * g + 1]; T[g] = e[4 * g] + L[4 * g]; }
#pragma unroll
        for (int g = 0; g < 4; ++g) U[g] = lxor_f(T[g], 32, lane);
        float sT[4], sUge[4];
        sT[3] = 0.f; sT[2] = T[3]; sT[1] = T[3] + T[2]; sT[0] = sT[1] + T[1];
        sUge[3] = U[3]; sUge[2] = U[3] + U[2]; sUge[1] = sUge[2] + U[1]; sUge[0] = sUge[1] + U[0];
        float w[16];
#pragma unroll
        for (int g = 0; g < 4; ++g) {
            const float sfx = R + sT[g] + (hi ? (sUge[g] - U[g]) : sUge[g]);
#pragma unroll
            for (int i = 0; i < 4; ++i) w[4 * g + i] = __expf(lw[4 * g + i] + sfx + e[4 * g + i]);
        }
        R += (sT[0] + T[0]) + sUge[0];
        const bf16x8 pf0 = pack8(w[0], w[1], w[2], w[3], w[4], w[5], w[6], w[7]), pf1 = pack8(w[8], w[9], w[10], w[11], w[12], w[13], w[14], w[15]);
        o0 = __builtin_amdgcn_mfma_f32_32x32x16_bf16(vf[0], pf0, o0, 0, 0, 0);
        o0 = __builtin_amdgcn_mfma_f32_32x32x16_bf16(vf[1], pf1, o0, 0, 0, 0);
        o1 = __builtin_amdgcn_mfma_f32_32x32x16_bf16(vf[2], pf0, o1, 0, 0, 0);
        o1 = __builtin_amdgcn_mfma_f32_32x32x16_bf16(vf[3], pf1, o1, 0, 0, 0);
        if (__all(R < -88.f)) break;
    }
    bf16* dst = wsp<bf16>(ka, WS_OB) + ((size_t)b * SEQ + q0 + r32) * DM + h * 64 + 4 * hi;
#pragma unroll
    for (int g = 0; g < 4; ++g) {
        v2u wv; wv.x = pk2(o0[4 * g], o0[4 * g + 1]); wv.y = pk2(o0[4 * g + 2], o0[4 * g + 3]); *(v2u*)(dst + 8 * g) = wv;
        v2u u; u.x = pk2(o1[4 * g], o1[4 * g + 1]); u.y = pk2(o1[4 * g + 2], o1[4 * g + 3]); *(v2u*)(dst + 32 + 8 * g) = u;
    }
}

template <bool QUANT> __device__ __forceinline__ void ln_row(Frame& F, kap_t ka, int row, const float* g, const float* bb) {
    float* yr = ka->out + (size_t)row * DM;
    f32x4 v[4]; float s = 0.f;
#pragma unroll
    for (int j = 0; j < 4; ++j) { v[j] = *(const f32x4*)(yr + 4 * F.lane + 256 * j); s += (v[j].x + v[j].y) + (v[j].z + v[j].w); }
    const float mean = wave_sum_all(s, F.lane) * (1.f / DM); float s2 = 0.f;
#pragma unroll
    for (int j = 0; j < 4; ++j) { v[j] = v[j] - mean; s2 += (v[j].x * v[j].x + v[j].y * v[j].y) + (v[j].z * v[j].z + v[j].w * v[j].w); }
    const float rstd = rsqrtf(wave_sum_all(s2, F.lane) * (1.f / DM) + LN_EPS);
#pragma unroll
    for (int j = 0; j < 4; ++j) { const int c = 4 * F.lane + 256 * j; const f32x4 gg = *(const f32x4*)(g + c), bv = *(const f32x4*)(bb + c);
        const f32x4 o = v[j] * rstd * gg + bv; *(f32x4*)(yr + c) = o; v[j] = o;
        v2u w; w.x = pk2(o.x, o.y); w.y = pk2(o.z, o.w); *(v2u*)(wsp<bf16>(ka, WS_XB) + (size_t)row * DM + c) = w; }
    if (QUANT) {
        float xm = 0.f;
#pragma unroll
        for (int j = 0; j < 4; ++j) xm = fmaxf(xm, fmaxf(fmaxf(fabsf(v[j].x), fabsf(v[j].y)), fmaxf(fabsf(v[j].z), fabsf(v[j].w))));
        xm = wave_max_all(xm, F.lane);
        const float inv = xm > 0.f ? 127.f / xm : 0.f;
        unsigned char* xq = wsp<unsigned char>(ka, WS_XQ) + (size_t)row * DM;
#pragma unroll
        for (int j = 0; j < 4; ++j) *(unsigned*)(xq + 4 * F.lane + 256 * j) = ((unsigned)(int)rintf(v[j].x * inv) & 0xffu) | (((unsigned)(int)rintf(v[j].y * inv) & 0xffu) << 8) | (((unsigned)(int)rintf(v[j].z * inv) & 0xffu) << 16) | (((unsigned)(int)rintf(v[j].w * inv) & 0xffu) << 24);
        if (F.lane == 0) wsp<float>(ka, WS_SX)[row] = xm * (1.f / 127.f);
    }
}

template <int N, int K, int J, bool FLIP> __device__ __forceinline__ void bitonic_stage(unsigned (&v)[N]) {
#pragma unroll
    for (int i = 0; i < N; ++i) { const int p = i ^ J; if (p > i) { const bool desc = (((i & K) == 0) != FLIP); const unsigned a = v[i], c = v[p]; const unsigned mx = a > c ? a : c, mn = a > c ? c : a; v[i] = desc ? mx : mn; v[p] = desc ? mn : mx; } }
}
template <bool FLIP> __device__ __forceinline__ void bitonic_merge16(unsigned (&v)[16]) {
    bitonic_stage<16, 16, 8, FLIP>(v); bitonic_stage<16, 16, 4, FLIP>(v); bitonic_stage<16, 16, 2, FLIP>(v); bitonic_stage<16, 16, 1, FLIP>(v);
}
__device__ __forceinline__ unsigned ord_key(float f, unsigned idx) { const unsigned u = __float_as_uint(f); const unsigned o = u ^ ((unsigned)((int)u >> 31) | 0x80000000u); return (o & 0xFFFFFF80u) | idx; }
__device__ __forceinline__ float key_val(unsigned k) { const unsigned o = (k & 0xFFFFFF80u) | 0x40u; const unsigned u = (o & 0x80000000u) ? (o ^ 0x80000000u) : ~o; return __uint_as_float(u); }
template <int N, int K, int J, bool FLIP> __device__ __forceinline__ void bitonic_stage_kv(unsigned (&k)[N], unsigned (&p)[N]) {
#pragma unroll
    for (int i = 0; i < N; ++i) { const int q = i ^ J; if (q > i) { const bool desc = (((i & K) == 0) != FLIP); const bool sw = desc ? (k[i] < k[q]) : (k[i] > k[q]);
        const unsigned ki = sw ? k[q] : k[i], kq = sw ? k[i] : k[q], pi = sw ? p[q] : p[i], pq = sw ? p[i] : p[q]; k[i] = ki; k[q] = kq; p[i] = pi; p[q] = pq; } }
}
template <bool FLIP> __device__ __forceinline__ void bitonic_merge16_kv(unsigned (&k)[16], unsigned (&p)[16]) {
    bitonic_stage_kv<16, 16, 8, FLIP>(k, p); bitonic_stage_kv<16, 16, 4, FLIP>(k, p); bitonic_stage_kv<16, 16, 2, FLIP>(k, p); bitonic_stage_kv<16, 16, 1, FLIP>(k, p);
}
__device__ __forceinline__ void p7_half(Frame& F, kap_t ka, int l, int tok, int h, int c, unsigned (&Cc)[16], const LAS unsigned char* klds) {
    const int lane = F.lane, hi = lane >> 5;
    const bf16* qrow = wsp<bf16>(ka, WS_HB) + (size_t)tok * 2048 + h * 256 + c * 128 + 8 * hi;
    bf16x8 qf[8];
#pragma unroll
    for (int ks = 0; ks < 8; ++ks) qf[ks] = *(const bf16x8*)(qrow + ks * 16);
    const LAS unsigned char* kb = klds + c * 32768 + lane * 16;
    unsigned key[64];
#pragma unroll
    for (int ch = 0; ch < 4; ++ch) {
        f32x16 acc = {};
#pragma unroll
        for (int ks = 0; ks < 8; ++ks) acc = __builtin_amdgcn_mfma_f32_32x32x16_bf16(*(const LAS bf16x8*)(kb + (ch * 8 + ks) * 1024), qf[ks], acc, 0, 0, 0);
#pragma unroll
        for (int r = 0; r < 16; ++r) key[ch * 16 + r] = ord_key(acc[r], (unsigned)(ch * 32 + crow(r, hi)));
    }
    bitonic_stage<64, 2, 1, false>(key);
    bitonic_stage<64, 4, 2, false>(key); bitonic_stage<64, 4, 1, false>(key);
    bitonic_stage<64, 8, 4, false>(key); bitonic_stage<64, 8, 2, false>(key); bitonic_stage<64, 8, 1, false>(key);
    bitonic_stage<64, 16, 8, false>(key); bitonic_stage<64, 16, 4, false>(key); bitonic_stage<64, 16, 2, false>(key); bitonic_stage<64, 16, 1, false>(key);
    unsigned A[16], B[16];
#pragma unroll
    for (int i = 0; i < 16; ++i) { A[i] = key[i] > key[16 + i] ? key[i] : key[16 + i]; B[i] = key[32 + i] > key[48 + i] ? key[32 + i] : key[48 + i]; }
    bitonic_merge16<false>(A);
    bitonic_merge16<true>(B);
#pragma unroll
    for (int i = 0; i < 16; ++i) A[i] = A[i] > B[i] ? A[i] : B[i];
    bitonic_merge16<false>(A);
#pragma unroll
    for (int i = 0; i < 16; ++i) B[i] = (unsigned)lxor_i((int)A[i], 32, lane);
#pragma unroll
    for (int i = 0; i < 16; ++i) Cc[i] = A[i] > B[15 - i] ? A[i] : B[15 - i];
    bitonic_merge16<false>(Cc);
}
__device__ __forceinline__ void p7_unit(Frame& F, kap_t ka, int l, int tb, int h, const LAS unsigned char* klds) {
    const int lane = F.lane, r32 = lane & 31, hi = lane >> 5;
    const int tok = tb * 32 + r32;
    unsigned L0[16], L1[16];
#pragma unroll
    for (int i = 0; i < 16; ++i) { L0[i] = 0u; L1[i] = 0u; }
#pragma unroll 1
    for (int c = 0; c < 2; ++c) {
        unsigned Cc[16];
        p7_half(F, ka, l, tok, h, c, Cc, klds);
#pragma unroll
        for (int i = 0; i < 16; ++i) { L0[i] = c == 0 ? Cc[i] : L0[i]; L1[i] = c == 0 ? L1[i] : Cc[i]; }
    }
    __builtin_amdgcn_sched_barrier(0);
    unsigned key[64];
    {
        float v0[16], v1[16];
#pragma unroll
        for (int i = 0; i < 16; ++i) { v0[i] = key_val(L0[i]); v1[i] = key_val(L1[i]); }
#define P7_ROW(a, off, nb) { _Pragma("unroll") for (int b2 = 0; b2 < (nb); ++b2) { \
            const float sum = v0[a] + v1[b2]; const unsigned u = __float_as_uint(sum); const unsigned o = u ^ ((unsigned)((int)u >> 31) | 0x80000000u); \
            key[(off) + b2] = (o & 0xFFFFFF00u) | (unsigned)(255 - (16 * (a) + b2)); } }
        P7_ROW(0, 0, 16) P7_ROW(1, 16, 8) P7_ROW(2, 24, 5) P7_ROW(3, 29, 4) P7_ROW(4, 33, 3) P7_ROW(5, 36, 2) P7_ROW(6, 38, 2) P7_ROW(7, 40, 2)
        P7_ROW(8, 42, 1) P7_ROW(9, 43, 1) P7_ROW(10, 44, 1) P7_ROW(11, 45, 1) P7_ROW(12, 46, 1) P7_ROW(13, 47, 1) P7_ROW(14, 48, 1) P7_ROW(15, 49, 1)
#undef P7_ROW
#pragma unroll
        for (int i = 50; i < 64; ++i) key[i] = 0u;
    }
    LAS unsigned char* slot = F.lds + RING_OFF + F.wave * 2304 + lane * 36;
#pragma unroll
    for (int q = 0; q < 4; ++q) {
        ((LAS unsigned*)slot)[q] = (L0[4 * q] & 127u) | ((L0[4 * q + 1] & 127u) << 8) | ((L0[4 * q + 2] & 127u) << 16) | ((L0[4 * q + 3] & 127u) << 24);
        ((LAS unsigned*)slot)[4 + q] = (L1[4 * q] & 127u) | ((L1[4 * q + 1] & 127u) << 8) | ((L1[4 * q + 2] & 127u) << 16) | ((L1[4 * q + 3] & 127u) << 24);
    }
    bitonic_stage<64, 2, 1, false>(key);
    bitonic_stage<64, 4, 2, false>(key); bitonic_stage<64, 4, 1, false>(key);
    bitonic_stage<64, 8, 4, false>(key); bitonic_stage<64, 8, 2, false>(key); bitonic_stage<64, 8, 1, false>(key);
    bitonic_stage<64, 16, 8, false>(key); bitonic_stage<64, 16, 4, false>(key); bitonic_stage<64, 16, 2, false>(key); bitonic_stage<64, 16, 1, false>(key);
    unsigned A[16], B[16];
#pragma unroll
    for (int i = 0; i < 16; ++i) { A[i] = key[i] > key[16 + i] ? key[i] : key[16 + i]; B[i] = key[32 + i] > key[48 + i] ? key[32 + i] : key[48 + i]; }
    bitonic_merge16<false>(A);
    bitonic_merge16<true>(B);
#pragma unroll
    for (int i = 0; i < 16; ++i) A[i] = A[i] > B[i] ? A[i] : B[i];
    bitonic_merge16<false>(A);
    LDS_WAIT(); asm volatile("" ::: "memory");
    unsigned PA[16]; float g[16], den = 0.f;
    { const unsigned o0 = (A[0] & 0xFFFFFF00u) | 128u; const float m = __uint_as_float((o0 & 0x80000000u) ? (o0 ^ 0x80000000u) : ~o0);
#pragma unroll
      for (int i = 0; i < 16; ++i) { const unsigned o = (A[i] & 0xFFFFFF00u) | 128u; const float sv = __uint_as_float((o & 0x80000000u) ? (o ^ 0x80000000u) : ~o); g[i] = __expf(sv - m); den += g[i];
          const unsigned flat = 255u - (A[i] & 255u); PA[i] = (unsigned)slot[flat >> 4] * 128u + (unsigned)slot[16 + (flat & 15u)]; } }
    LDS_WAIT(); asm volatile("" ::: "memory");
    const float rden = 1.f / den;
    if (hi == 0) {
        unsigned* de = wsp<unsigned>(ka, WS_EL) + (size_t)tok * 128 + h * 16; float* dg = wsp<float>(ka, WS_GL) + (size_t)tok * 128 + h * 16;
#pragma unroll
        for (int q = 0; q < 4; ++q) { *(v4u*)(de + 4 * q) = (v4u){PA[4 * q], PA[4 * q + 1], PA[4 * q + 2], PA[4 * q + 3]};
            *(f32x4*)(dg + 4 * q) = (f32x4){g[4 * q] * rden, g[4 * q + 1] * rden, g[4 * q + 2] * rden, g[4 * q + 3] * rden}; }
    }
}

__device__ __forceinline__ float dot2_bf16(unsigned w, unsigned x, float acc) { return __builtin_amdgcn_fdot2_f32_bf16(__builtin_bit_cast(bf2_t, w), __builtin_bit_cast(bf2_t, x), acc, false); }
__device__ __forceinline__ float gelu_erf(float v) {
    const float av = fabsf(v), t = __builtin_amdgcn_rcpf(av * 0.2316418882f + 1.0f);
    float q = t * 0.5307027145f + (-0.7265760135f); q = q * t + 0.7107068705f; q = q * t + (-0.142248368f); q = q * t + 0.127414796f; q = q * t;
    const float e = __builtin_amdgcn_exp2f((v * v) * (-0.72134752044f));
    const float m = v * (q * e);
    return v < 0.f ? m : v - m;
}
struct P8aS { unsigned ev0, ev1; float gv0, gv1, sx; v4u x4[4]; f32x2 sc0, sc1; int N; unsigned ent[4]; v4u buf[4][4]; };
__device__ __forceinline__ void p8a_stageA(Frame& F, kap_t ka, int l, unsigned part, LAS unsigned* qu, P8aS& S) {
    const int lane = F.lane, qd = lane >> 4, i16 = lane & 15;
    const bool in0 = (S.ev0 >> 11) == part, in1 = (S.ev1 >> 11) == part;
    const f32x2* SUV = wsp<f32x2>(ka, WS_SUV) + (size_t)l * NEXP;
    S.sc0 = (f32x2){0.f, 0.f}; S.sc1 = (f32x2){0.f, 0.f};
    if (in0) S.sc0 = SUV[S.ev0];
    if (in1) S.sc1 = SUV[S.ev1];
    const unsigned long long m0 = __ballot(in0), m1 = __ballot(in1);
    const int n0 = __builtin_popcountll(m0); S.N = n0 + __builtin_popcountll(m1);
    if (in0) qu[__builtin_amdgcn_mbcnt_hi((unsigned)(m0 >> 32), __builtin_amdgcn_mbcnt_lo((unsigned)m0, 0u))] = S.ev0 | ((unsigned)lane << 16);
    if (in1) qu[n0 + __builtin_amdgcn_mbcnt_hi((unsigned)(m1 >> 32), __builtin_amdgcn_mbcnt_lo((unsigned)m1, 0u))] = S.ev1 | ((unsigned)(64 + lane) << 16);
    if (lane < 16) qu[S.N + lane] = (part << 11) | (128u << 16);
    LDS_WAIT(); asm volatile("" ::: "memory");
    const unsigned char* UQ = wsp<unsigned char>(ka, WS_UT) + (size_t)l * NEXP * DM;
    const unsigned loff = 16u * (unsigned)i16;
#pragma unroll
    for (int gi = 0; gi < 4; ++gi) { S.ent[gi] = qu[4 * gi + qd]; const unsigned ro = ((S.ent[gi] & 0xffffu) << 10) + loff;
#pragma unroll
        for (int c = 0; c < 4; ++c) S.buf[gi][c] = *(const v4u*)(UQ + (ro + 256u * c)); }
}
__device__ __forceinline__ int p8a_dot(const v4u (&b)[4], const v4u (&x4)[4]) {
    int p = 0;
#pragma unroll
    for (int c = 0; c < 4; ++c) { p = __builtin_amdgcn_sdot4((int)b[c].x, (int)x4[c].x, p, false); p = __builtin_amdgcn_sdot4((int)b[c].y, (int)x4[c].y, p, false);
        p = __builtin_amdgcn_sdot4((int)b[c].z, (int)x4[c].z, p, false); p = __builtin_amdgcn_sdot4((int)b[c].w, (int)x4[c].w, p, false); }
    return p;
}
__device__ __forceinline__ void p8a_stageB(Frame& F, kap_t ka, int l, int tok, unsigned part, LAS unsigned* qu, LAS int* res, P8aS& S) {
    const int lane = F.lane, qd = lane >> 4, i16 = lane & 15;
    int p[4];
#pragma unroll
    for (int gi = 0; gi < 4; ++gi) p[gi] = p8a_dot(S.buf[gi], S.x4);
#pragma unroll
    for (int gi = 0; gi < 4; ++gi) p[gi] += __builtin_amdgcn_update_dpp(0, p[gi], 0xB1, 0xF, 0xF, true);
#pragma unroll
    for (int gi = 0; gi < 4; ++gi) p[gi] += __builtin_amdgcn_update_dpp(0, p[gi], 0x4E, 0xF, 0xF, true);
#pragma unroll
    for (int gi = 0; gi < 4; ++gi) p[gi] += __builtin_amdgcn_update_dpp(0, p[gi], 0x141, 0xF, 0xF, true);
#pragma unroll
    for (int gi = 0; gi < 4; ++gi) p[gi] += __builtin_amdgcn_update_dpp(0, p[gi], 0x140, 0xF, 0xF, true);
#pragma unroll
    for (int gi = 0; gi < 4; ++gi) res[S.ent[gi] >> 16] = p[gi];
    if (S.N > 16) {
        const unsigned char* UQ = wsp<unsigned char>(ka, WS_UT) + (size_t)l * NEXP * DM; const unsigned loff = 16u * (unsigned)i16;
        for (int g0 = 16; g0 < S.N; g0 += 4) {
            const unsigned en = qu[g0 + qd]; const unsigned ro = ((en & 0xffffu) << 10) + loff; v4u bb[4];
#pragma unroll
            for (int c = 0; c < 4; ++c) bb[c] = *(const v4u*)(UQ + (ro + 256u * c));
            int q = p8a_dot(bb, S.x4);
            q += __builtin_amdgcn_update_dpp(0, q, 0xB1, 0xF, 0xF, true); q += __builtin_amdgcn_update_dpp(0, q, 0x4E, 0xF, 0xF, true);
            q += __builtin_amdgcn_update_dpp(0, q, 0x141, 0xF, 0xF, true); q += __builtin_amdgcn_update_dpp(0, q, 0x140, 0xF, 0xF, true);
            res[en >> 16] = q;
        }
    }
    LDS_WAIT(); asm volatile("" ::: "memory");
    const bool in0 = (S.ev0 >> 11) == part, in1 = (S.ev1 >> 11) == part;
    float* AC = wsp<float>(ka, WS_AC) + (size_t)tok * 128;
    if (in0) AC[lane] = S.gv0 * gelu_erf((float)res[lane] * (S.sc0.x * S.sx)) * S.sc0.y;
    if (in1) AC[64 + lane] = S.gv1 * gelu_erf((float)res[64 + lane] * (S.sc1.x * S.sx)) * S.sc1.y;
}
__device__ __forceinline__ void p8a_fetch(const unsigned* EL, const float* GL, const unsigned char* XQ, const float* SX, int t, P8aS& S) {
    const size_t o = (size_t)t * 128; S.ev0 = EL[o]; S.ev1 = EL[o + 64]; S.gv0 = GL[o]; S.gv1 = GL[o + 64]; S.sx = SX[t];
#pragma unroll
    for (int c = 0; c < 4; ++c) S.x4[c] = *(const v4u*)(XQ + (size_t)t * DM + 256 * c);
}

__device__ __forceinline__ void p8b_pair(Frame& F, kap_t ka, int l, int tokA, int tokB, bool storeB, unsigned part, const v4u ev, const f32x4 av, float* ybase, LAS unsigned* le, LAS unsigned* la8) {
    const int lane = F.lane, tk = lane >> 5, g = (lane >> 3) & 3, c = lane & 7, l32 = lane & 31;
    const int tok = tk ? tokB : tokA;
    const float* yrow = ka->out + (size_t)tok * DM + 128 * part + 16 * c;
    f32x4 xv[4] = {};
    if (g == 0) {
#pragma unroll
        for (int q = 0; q < 4; ++q) xv[q] = *(const f32x4*)(yrow + 4 * q);
    }
    float am = fmaxf(fmaxf(fabsf(av.x), fabsf(av.y)), fmaxf(fabsf(av.z), fabsf(av.w)));
    am = fmaxf(am, dpp_f<0xB1>(am)); am = fmaxf(am, dpp_f<0x4E>(am)); am = fmaxf(am, dpp_f<0x141>(am)); am = fmaxf(am, dpp_f<0x140>(am)); am = fmaxf(am, lxor_f(am, 16, lane));
    const float inv = am > 0.f ? 127.f / am : 0.f, sa = am * (1.f / 127.f);
    *(LAS v4u*)(le + tk * 128 + 4 * l32) = (v4u){ev.x << 7, ev.y << 7, ev.z << 7, ev.w << 7};
    la8[tk * 32 + l32] = ((unsigned)(int)rintf(av.x * inv) & 0xffu) | (((unsigned)(int)rintf(av.y * inv) & 0xffu) << 8) | (((unsigned)(int)rintf(av.z * inv) & 0xffu) << 16) | (((unsigned)(int)rintf(av.w * inv) & 0xffu) << 24);
    LDS_WAIT(); asm volatile("" ::: "memory");
    const unsigned char* VQ = wsp<unsigned char>(ka, WS_VT) + (size_t)l * NEXP * DM + (size_t)part * NEXP * 128;
    const unsigned loff = 16u * (unsigned)c;
    const LAS unsigned* lek = le + tk * 128 + 4 * g;
    v4u R[32];
#pragma unroll
    for (int m = 0; m < 8; ++m) { const v4u eo = *(const LAS v4u*)(lek + 16 * m);
#pragma unroll
        for (int r = 0; r < 4; ++r) R[4 * m + r] = *(const v4u*)(VQ + (eo[r] + loff)); }
    int acc[16];
#pragma unroll
    for (int i = 0; i < 16; ++i) acc[i] = 0;
#pragma unroll
    for (int m = 0; m < 8; ++m) {
        const int ap = (int)la8[tk * 32 + 4 * m + g];
#pragma unroll
        for (int d = 0; d < 4; ++d) {
            const unsigned r0 = R[4 * m][d], r1 = R[4 * m + 1][d], r2 = R[4 * m + 2][d], r3 = R[4 * m + 3][d];
            const unsigned t01l = __builtin_amdgcn_perm(r1, r0, 0x05010400u), t01h = __builtin_amdgcn_perm(r1, r0, 0x07030602u);
            const unsigned t23l = __builtin_amdgcn_perm(r3, r2, 0x05010400u), t23h = __builtin_amdgcn_perm(r3, r2, 0x07030602u);
            acc[4 * d] = __builtin_amdgcn_sdot4((int)__builtin_amdgcn_perm(t23l, t01l, 0x05040100u), ap, acc[4 * d], false);
            acc[4 * d + 1] = __builtin_amdgcn_sdot4((int)__builtin_amdgcn_perm(t23l, t01l, 0x07060302u), ap, acc[4 * d + 1], false);
            acc[4 * d + 2] = __builtin_amdgcn_sdot4((int)__builtin_amdgcn_perm(t23h, t01h, 0x05040100u), ap, acc[4 * d + 2], false);
            acc[4 * d + 3] = __builtin_amdgcn_sdot4((int)__builtin_amdgcn_perm(t23h, t01h, 0x07060302u), ap, acc[4 * d + 3], false);
        }
    }
#pragma unroll
    for (int i = 0; i < 16; ++i) { acc[i] += lxor_i(acc[i], 8, lane); acc[i] += lxor_i(acc[i], 16, lane); }
    if (g == 0 && (tk == 0 || storeB)) {
        float* yd = ybase + (size_t)tok * DM + 128 * part + 16 * c;
#pragma unroll
        for (int q = 0; q < 4; ++q) { const f32x4 x = xv[q];
            *(f32x4*)(yd + 4 * q) = (f32x4){ALPHA * x.x + (float)acc[4 * q] * sa, ALPHA * x.y + (float)acc[4 * q + 1] * sa, ALPHA * x.z + (float)acc[4 * q + 2] * sa, ALPHA * x.w + (float)acc[4 * q + 3] * sa}; }
    }
    LDS_WAIT(); asm volatile("" ::: "memory");
}

__global__ void __launch_bounds__(NTHREADS, 2) mk_fwd(Args args) {
    extern __shared__ __attribute__((aligned(16))) unsigned char lds[];
    Frame F;
    F.lds = (LAS unsigned char*)lds;
    F.MISC = (volatile LAS unsigned*)(F.lds + MISC_OFF);
    F.tid = threadIdx.x; F.lane = F.tid & 63; F.wave = __builtin_amdgcn_readfirstlane(F.tid >> 6);
    F.G = gridDim.x; { const int bx = blockIdx.x; F.vcu = (F.G % 8 == 0) ? (bx % 8) * (F.G / 8) + bx / 8 : bx; }
    for (int u = F.tid; u < (LDS_BYTES - LDSCTL_OFF) / 4; u += NTHREADS) ((LAS unsigned*)(F.lds + LDSCTL_OFF))[u] = 0u;
    __syncthreads();
    const int lo = args.ph_lo, hi = args.ph_hi;
    unsigned* const barw = (unsigned*)(args.ws + WS_CTL) + CW_BAR;
    const bool one_phase = (hi - lo) == 1;
    XcdBarrier bar; bar.bar = barw; bar.x = 0; bar.st = nullptr;
    if (!one_phase) bar = xcd_barrier_post(barw, F.MISC + 8);
#ifndef MK_EN
#define MK_EN 0x7ff
#endif
#ifndef MK_MLA_LDS
#define MK_MLA_LDS 0
#endif
#ifndef MK_MLA_REP
#define MK_MLA_REP 1
#endif
#ifndef MK_SB_REP
#define MK_SB_REP 1
#endif
#ifndef MK_P8B_VAR
#define MK_P8B_VAR 0
#endif
#define EN(n) (((MK_EN) >> (n)) & 1)
#ifndef MK_REP
#define MK_REP 0
#endif
#define PHASE_REP(n) for (int rep_ = 0; rep_ < ((((MK_REP) >> (n)) & 1) + 1); ++rep_)
#define IN(k) (lo <= (k) && (k) < hi)
#define PHASE_IDS() do { unsigned z_ = 0u; asm volatile("" : "+v"(z_)); const int ln_ = (int)__builtin_amdgcn_mbcnt_hi(~0u, __builtin_amdgcn_mbcnt_lo(~0u, z_)); F.lane = ln_; F.tid = F.wave * 64 + ln_; } while (0)
#define SEAM(k) do { if (IN((k) + 1)) { XcdBarrier b_ = bar; asm volatile("" : "+s"(b_.bar), "+s"(b_.x));     xcd_barrier(b_); } } while (0)
    const int gw = F.vcu * NWAVES + F.wave, NGW = F.G * NWAVES;

    if (EN(0) && IN(0)) PHASE_REP(0) { PHASE_IDS(); p0_prologue(F, ka_fresh()); SEAM(0); }
#pragma unroll
    for (int l = 0; l < DEPTH; ++l) {
        const int pb = 1 + NPL * l;
        if (EN(1) && IN(pb + 0)) PHASE_REP(1) { const kap_t ka = ka_fresh(); PHASE_IDS();
            pg8::Gemm g{wsp<bf16>(ka, WS_XB), wsp<bf16>(ka, WS_WIT) + (size_t)l * DINP * DM, NTOK, DINP, DM}; pg8::StaticOrder S; S.init(NTOK, DINP, F.G, (int)blockIdx.x);
            pg8::EpiBf16<0> E{wsp<bf16>(ka, WS_HB), DINP, nullptr, 0, 0, 1.f};
            pg8::gemm_phase<pg8::EpiBf16<0>, pg8::StaticOrder, PG8_ALIGN, PG8_SP2>(F.lds + RING_OFF, g, S, E, F.tid);
            SEAM(pb + 0);
        }
        if (EN(2) && IN(pb + 1)) PHASE_REP(2) { const kap_t ka = ka_fresh(); PHASE_IDS();
            for (int u = gw; u < (NTOK / 32) * 4; u += NGW) p2_unit(F, ka, l, u >> 2, u & 3);
            SEAM(pb + 1);
        }
        if (EN(3) && IN(pb + 2)) PHASE_REP(3) { const kap_t ka = ka_fresh(); PHASE_IDS();
#if MK_MLA_LDS
            for (int u = F.vcu; u < 32 * 8; u += F.G) {
                const int bh = u >> 3, j = u & 7;
                mla_block(F, ka, bh, 15 - j); sb_unit(F, ka, bh, 8 * (15 - j) + F.wave);
                mla_block(F, ka, bh, j); sb_unit(F, ka, bh, 8 * j + F.wave);
            }
#else
            for (int u = gw; u < 32 * 64; u += NGW) {
                const int bh = u >> 6, pi = u & 63;
                for (int r_ = 0; r_ < MK_MLA_REP; ++r_) { mla_unit(F, ka, bh, 127 - pi); mla_unit(F, ka, bh, pi); }
            }
            PHASE_IDS();
            for (int u = gw; u < 32 * 64; u += NGW) {
                const int bh = u >> 6, pi = u & 63;
                for (int r_ = 0; r_ < MK_SB_REP; ++r_) { sb_unit(F, ka, bh, 127 - pi); sb_unit(F, ka, bh, pi); }
            }
#endif
            SEAM(pb + 2);
        }
        if (EN(4) && IN(pb + 3)) PHASE_REP(4) { const kap_t ka = ka_fresh(); PHASE_IDS();
            pg8::Gemm g{wsp<bf16>(ka, WS_OB), wsp<bf16>(ka, WS_WOT) + (size_t)l * DM * DM, NTOK, DM, DM}; pg8::StaticOrder S; S.init(NTOK, DM, F.G, (int)blockIdx.x);
            pg8::EpiResF32 E{l == 0 ? ka->in[I_X] : ka->out, ka->out, DM, ALPHA};
            pg8::gemm_phase<pg8::EpiResF32, pg8::StaticOrder, PG8_ALIGN, PG8_SP2>(F.lds + RING_OFF, g, S, E, F.tid);
            SEAM(pb + 3);
        }
        if (EN(5) && IN(pb + 4)) PHASE_REP(5) { const kap_t ka = ka_fresh(); PHASE_IDS();
            for (int r = gw; r < NTOK; r += NGW) ln_row<true>(F, ka, r, ka->in[I_LN1G] + l * DM, ka->in[I_LN1B] + l * DM);
            SEAM(pb + 4);
        }
        if (EN(6) && IN(pb + 5)) PHASE_REP(6) { const kap_t ka = ka_fresh(); PHASE_IDS();
            pg8::Gemm g{wsp<bf16>(ka, WS_XB), wsp<bf16>(ka, WS_WQT) + (size_t)l * 2048 * DM, NTOK, 2048, DM}; pg8::StaticOrder S; S.init(NTOK, 2048, F.G, (int)blockIdx.x);
            pg8::EpiBf16<0> E{wsp<bf16>(ka, WS_HB), 2048, nullptr, 0, 0, 1.f};
            pg8::gemm_phase<pg8::EpiBf16<0>, pg8::StaticOrder, PG8_ALIGN, PG8_SP2>(F.lds + RING_OFF, g, S, E, F.tid);
            SEAM(pb + 5);
        }
        if (EN(7) && IN(pb + 6)) PHASE_REP(7) { const kap_t ka = ka_fresh(); PHASE_IDS();
            const LAS unsigned char* klds = F.lds + RING_OFF + 32768;
            int hcur = -1;
            for (int wu = F.vcu; wu < (NTOK / 32); wu += F.G) {
                const int h = wu & 7, tb = (wu >> 3) * 8 + F.wave;
                if (h != hcur) {
                    __syncthreads();
                    const v4u* src = (const v4u*)(wsp<bf16>(ka, WS_KEYS) + (size_t)(l * 8 + h) * 2 * 16384) + F.tid;
#pragma unroll
                    for (int i = 0; i < 8; ++i) *(LAS v4u*)(F.lds + RING_OFF + 32768 + (F.tid + 512 * i) * 16) = src[512 * i];
                    __syncthreads();
                    hcur = h;
                }
                p7_unit(F, ka, l, tb, h, klds);
            }
            SEAM(pb + 6);
        }
        if (EN(8) && IN(pb + 7)) PHASE_REP(8) { const kap_t ka = ka_fresh(); PHASE_IDS();
            const bool split = (F.G % 8 == 0); const int npp = split ? F.G / 8 : F.G;
            for (unsigned part = split ? (unsigned)(F.vcu / npp) : 0u, pend = split ? part + 1u : 8u; part < pend; ++part) {
                const int pw = (F.vcu % npp) * NWAVES + F.wave, npw = npp * NWAVES;
                const unsigned* EL = wsp<unsigned>(ka, WS_EL) + F.lane; const float* GL = wsp<float>(ka, WS_GL) + F.lane;
                const unsigned char* XQ = wsp<unsigned char>(ka, WS_XQ) + 16 * (F.lane & 15); const float* SX = wsp<float>(ka, WS_SX);
                LAS unsigned* quA = (LAS unsigned*)(F.lds + RING_OFF + F.wave * 4096); LAS int* rsA = (LAS int*)(F.lds + RING_OFF + F.wave * 4096 + 1024);
                LAS unsigned* quB = (LAS unsigned*)(F.lds + RING_OFF + F.wave * 4096 + 2048); LAS int* rsB = (LAS int*)(F.lds + RING_OFF + F.wave * 4096 + 3072);
                const int nt = (NTOK - pw + npw - 1) / npw;
                if (nt > 0) {
                    P8aS SA, SB;
                    p8a_fetch(EL, GL, XQ, SX, pw, SA);
                    p8a_stageA(F, ka, l, part, quA, SA);
                    int t = pw;
                    for (int i = 0; i + 2 < nt; i += 2, t += 2 * npw) {
                        p8a_fetch(EL, GL, XQ, SX, t + npw, SB);
                        p8a_stageA(F, ka, l, part, quB, SB);
                        p8a_stageB(F, ka, l, t, part, quA, rsA, SA);
                        p8a_fetch(EL, GL, XQ, SX, t + 2 * npw, SA);
                        LDS_WAIT(); asm volatile("" ::: "memory");
                        p8a_stageA(F, ka, l, part, quA, SA);
                        p8a_stageB(F, ka, l, t + npw, part, quB, rsB, SB);
                        LDS_WAIT(); asm volatile("" ::: "memory");
                    }
                    if (t + npw < NTOK) {
                        p8a_fetch(EL, GL, XQ, SX, t + npw, SB);
                        p8a_stageA(F, ka, l, part, quB, SB);
                        p8a_stageB(F, ka, l, t, part, quA, rsA, SA);
                        p8a_stageB(F, ka, l, t + npw, part, quB, rsB, SB);
                    } else {
                        p8a_stageB(F, ka, l, t, part, quA, rsA, SA);
                    }
                    LDS_WAIT(); asm volatile("" ::: "memory");
                }
            }
            SEAM(pb + 7);
        }
        if (EN(9) && IN(pb + 8)) PHASE_REP(9) { const kap_t ka = ka_fresh(); PHASE_IDS();
            const bool split = (F.G % 8 == 0); const int npp = split ? F.G / 8 : F.G;
            for (unsigned part = split ? (unsigned)(F.vcu / npp) : 0u, pend = split ? part + 1u : 8u; part < pend; ++part) {
                const int pw = (F.vcu % npp) * NWAVES + F.wave, npw = npp * NWAVES;
                LAS unsigned* le = (LAS unsigned*)(F.lds + RING_OFF + F.wave * 2048); LAS unsigned* la8 = (LAS unsigned*)(F.lds + RING_OFF + F.wave * 2048 + 1024);
                float* ybase = (rep_ == 0) ? ka->out : (float*)wsp<bf16>(ka, WS_HB);
                const int tk = F.lane >> 5, l32 = F.lane & 31;
                const unsigned* EL = wsp<unsigned>(ka, WS_EL) + 4 * l32; const float* AC = wsp<float>(ka, WS_AC) + 4 * l32;
                v4u ev = {}; f32x4 av = {};
                { const int t0 = pw + tk * npw; if (pw < NTOK) { const int tt = t0 < NTOK ? t0 : pw; ev = *(const v4u*)(EL + (size_t)tt * 128); av = *(const f32x4*)(AC + (size_t)tt * 128); } }
                for (int t = pw; t < NTOK; t += 2 * npw) {
                    const int tB = t + npw; const bool hasB = tB < NTOK;
                    v4u nev = {}; f32x4 nav = {};
                    if (t + 2 * npw < NTOK) { const int t0 = t + 2 * npw + tk * npw; const int tt = t0 < NTOK ? t0 : t + 2 * npw; nev = *(const v4u*)(EL + (size_t)tt * 128); nav = *(const f32x4*)(AC + (size_t)tt * 128); }
                    p8b_pair(F, ka, l, t, hasB ? tB : t, hasB, part, ev, av, ybase, le, la8);
                    ev = nev; av = nav;
                }
            }
            SEAM(pb + 8);
        }
        if (EN(10) && IN(pb + 9)) PHASE_REP(10) { const kap_t ka = ka_fresh(); PHASE_IDS();
            for (int r = gw; r < NTOK; r += NGW) ln_row<false>(F, ka, r, ka->in[I_LN2G] + l * DM, ka->in[I_LN2B] + l * DM);
            if (l + 1 < DEPTH) SEAM(pb + 9);
        }
    }
#undef IN
#undef SEAM
}

#ifndef MK_PER_PHASE
#define MK_PER_PHASE 0
#endif
extern "C" void kernel_launch(void* const* d_in, const int* in_sizes, int n_in, void* d_out, int out_size, void* d_ws, size_t ws_size, hipStream_t stream) {
    static int grid = 0;
    if (grid == 0) {
        if (n_in != 15 || out_size != NTOK * DM || ws_size < WS_END) { fprintf(stderr, "kernel_launch: unexpected shapes (n_in %d, out %d, ws %zu); nothing launched\n", n_in, out_size, ws_size); grid = -1; return; }
        int dev = 0, cus = 0, per_cu = 0;
        if (hipGetDevice(&dev) != hipSuccess || hipDeviceGetAttribute(&cus, hipDeviceAttributeMultiprocessorCount, dev) != hipSuccess) { fprintf(stderr, "kernel_launch: device query failed\n"); grid = -1; return; }
        if (hipFuncSetAttribute((const void*)mk_fwd, hipFuncAttributeMaxDynamicSharedMemorySize, LDS_BYTES) != hipSuccess) { fprintf(stderr, "kernel_launch: hipFuncSetAttribute failed\n"); grid = -1; return; }
        if (hipOccupancyMaxActiveBlocksPerMultiprocessor(&per_cu, (const void*)mk_fwd, NTHREADS, LDS_BYTES) != hipSuccess || per_cu < 1) { fprintf(stderr, "kernel_launch: occupancy query says %d blocks per CU\n", per_cu); per_cu = 1; }
        (void)hipGetLastError();
        grid = cus;
        fprintf(stderr, "kernel_launch: grid %d (occupancy query %d per CU)\n", grid, per_cu);
    }
    if (grid < 0) return;
    (void)hipMemsetAsync((char*)d_ws + WS_CTL, 0, CTL_ZERO_BYTES, stream);
    Args a{};
    for (int i = 0; i < 15; ++i) a.in[i] = (const float*)d_in[i];
    a.out = (float*)d_out; a.ws = (unsigned char*)d_ws;
#if MK_PER_PHASE
    for (int p = 0; p < NPHASE; ++p) { a.ph_lo = p; a.ph_hi = p + 1; hipLaunchKernelGGL(mk_fwd, dim3(grid), dim3(NTHREADS), LDS_BYTES, stream, a); }
#else
    a.ph_lo = 0; a.ph_hi = NPHASE;
    void* kargs[] = {&a};
    const hipError_t e = hipLaunchCooperativeKernel((const void*)mk_fwd, dim3(grid), dim3(NTHREADS), kargs, LDS_BYTES, stream);
    if (e != hipSuccess) fprintf(stderr, "kernel_launch: cooperative launch failed: %s (grid %d)\n", hipGetErrorString(e), grid);
#endif
}
```
